# Optimizing an MI355X kernel written in HIP

```python
import math
import jax
import jax.numpy as jnp
from jax import lax
import numpy as np

D_MODEL = 2048
BATCH = 4
SEQ = 2048
DEPTH = 4
DEC_BATCH = 128
DEC_SEQ = 1
PAST_LEN = 16384
PAGE_SIZE = 128

D_MIX = 2 * D_MODEL
BRANCH = D_MIX // 4
CONV_W = 4
EPS = 1e-6
TINY = 1e-30

HG_HEADS = 8
HG_DK = 128
HG_DV = BRANCH // HG_HEADS
HG_FDIM = HG_HEADS * HG_DK
HG_CHUNK = 16

RG_BLOCKS = 8
RG_BW = BRANCH // RG_BLOCKS
RG_C = 8.0

GLA_HEADS = 4
GLA_KDIM = BRANCH // 2
GLA_DK = GLA_KDIM // GLA_HEADS
GLA_DV = BRANCH // GLA_HEADS
GLA_RANK = 16
GLA_TAU = 16.0
GLA_CHUNK = 16

SSD_HEADDIM = 64
SSD_HEADS = BRANCH // SSD_HEADDIM
SSD_GROUPS = 2
SSD_DSTATE = 128
SSD_CONV_DIM = BRANCH + 2 * SSD_GROUPS * SSD_DSTATE
SSD_CHUNK = 64

IN_SIZES = (HG_FDIM, HG_FDIM, BRANCH, BRANCH,
            BRANCH, BRANCH,
            GLA_KDIM, GLA_KDIM, BRANCH, BRANCH, GLA_RANK,
            BRANCH, SSD_CONV_DIM, SSD_HEADS)
N_IN = sum(IN_SIZES)
IN_SPLIT_POINTS = tuple(int(v) for v in np.cumsum(IN_SIZES)[:-1])

kernel_name = 'hybrid_hgrn2_rglru_gla_ssd_step'


def rmsnorm(x, w):
    xf = x.astype(jnp.float32)
    y = xf * lax.rsqrt(jnp.mean(xf * xf, axis=-1, keepdims=True) + EPS)
    return (y * w.astype(jnp.float32)).astype(x.dtype)


def group_rmsnorm(x, w, groups):
    shp = x.shape
    xg = x.astype(jnp.float32).reshape(shp[:-1] + (groups, shp[-1] // groups))
    xg = xg * lax.rsqrt(jnp.mean(xg * xg, axis=-1, keepdims=True) + EPS)
    return xg.reshape(shp) * w.astype(jnp.float32)


def pad_time(a, t_pad):
    extra = t_pad - a.shape[1]
    if extra == 0:
        return a
    widths = [(0, 0)] * a.ndim
    widths[1] = (0, extra)
    return jnp.pad(a, widths)


def causal_conv(x, buf, w, b):
    seq = x.shape[1]
    xc = jnp.concatenate([buf.astype(x.dtype), x], axis=1)
    y = xc[:, 0:seq] * w[0]
    for j in range(1, CONV_W):
        y = y + xc[:, j:j + seq] * w[j]
    return y + b, xc[:, seq:]


def chunked_gated_linear_attention(q, k, v, log_f, s0, chunk):
    bsz, seq, nh, dk = q.shape
    dv = v.shape[-1]
    c = min(chunk, seq)
    n = -(-seq // c)
    t_pad = n * c
    q, k, v, log_f = (pad_time(a, t_pad) for a in (q, k, v, log_f))
    rs = lambda a: a.reshape(bsz, n, c, nh, a.shape[-1])
    q, k, v, log_f = rs(q), rs(k), rs(v), rs(log_f)
    b = jnp.cumsum(log_f, axis=2)
    b_last = b[:, :, -1:]
    b_ref = b[:, :, c // 2:c // 2 + 1]
    q_rel = q * jnp.exp(b - b_ref)
    k_rel = k * jnp.exp(b_ref - b)
    q_in = q * jnp.exp(b)
    k_end = k * jnp.exp(b_last - b)
    causal = jnp.tril(jnp.ones((c, c), dtype=bool))
    scores = jnp.einsum('bnthk,bnshk->bnhts', q_rel, k_rel)
    scores = jnp.where(causal, scores, 0.0)
    o_intra = jnp.einsum('bnhts,bnshv->bnthv', scores, v)
    decay = jnp.exp(b_last[:, :, 0])

    def step(s, inp):
        qc, kc, vc, dc = inp
        o = jnp.einsum('bthk,bhkv->bthv', qc, s)
        s = dc[..., None] * s + jnp.einsum('bshk,bshv->bhkv', kc, vc)
        return s, o

    xs = tuple(jnp.moveaxis(a, 1, 0) for a in (q_in, k_end, v, decay))
    s_fin, o_inter = lax.scan(step, s0.astype(jnp.float32), xs)
    o = o_intra + jnp.moveaxis(o_inter, 0, 1)
    return o.reshape(bsz, t_pad, nh, dv)[:, :seq], s_fin


def ssd_chunked(x, dt, a_head, b_in, c_in, d_skip, s0, chunk):
    bsz, seq, nh, hp = x.shape
    ng, ds = b_in.shape[2], b_in.shape[3]
    r = nh // ng
    c = min(chunk, seq)
    n = -(-seq // c)
    t_pad = n * c
    x, dt, b_in, c_in = (pad_time(a, t_pad) for a in (x, dt, b_in, c_in))
    xr = x.reshape(bsz, n, c, ng, r, hp)
    dtr = dt.reshape(bsz, n, c, ng, r)
    br = b_in.reshape(bsz, n, c, ng, ds)
    cr = c_in.reshape(bsz, n, c, ng, ds)
    cum = jnp.cumsum(dtr * a_head.reshape(ng, r), axis=2)
    xdt = xr * dtr[..., None]
    causal = jnp.tril(jnp.ones((c, c), dtype=bool))[None, None, :, :, None, None]
    seg = cum[:, :, :, None] - cum[:, :, None, :]
    lmat = jnp.where(causal, jnp.exp(jnp.where(causal, seg, 0.0)), 0.0)
    cb = jnp.einsum('bctgd,bcsgd->bcgts', cr, br)
    y_intra = jnp.einsum('bcgts,bctsgr,bcsgrp->bctgrp', cb, lmat, xdt)
    dec_in = jnp.exp(cum)
    w_end = jnp.exp(cum[:, :, -1:] - cum)
    dec_chunk = jnp.exp(cum[:, :, -1])

    def step(s, inp):
        cc, di, bc, wc, xc, dc = inp
        y = jnp.einsum('btgd,btgr,bgrpd->btgrp', cc, di, s)
        s = dc[..., None, None] * s + jnp.einsum('bsgd,bsgr,bsgrp->bgrpd', bc, wc, xc)
        return s, y

    s_init = s0.astype(jnp.float32).reshape(bsz, ng, r, hp, ds)
    xs = tuple(jnp.moveaxis(a, 1, 0) for a in (cr, dec_in, br, w_end, xdt, dec_chunk))
    s_fin, y_inter = lax.scan(step, s_init, xs)
    y = y_intra + jnp.moveaxis(y_inter, 0, 1) + xr * d_skip.reshape(ng, r)[..., None]
    return y.reshape(bsz, t_pad, nh, hp)[:, :seq], s_fin.reshape(bsz, nh, hp, ds)


def _linear_combine(e1, e2):
    a1, b1 = e1
    a2, b2 = e2
    return a1 * a2, a2 * b1 + b2


def rg_lru(x, h0, w_r, b_r, w_i, b_i, lam):
    bsz, seq, width = x.shape
    xb = x.reshape(bsz, seq, RG_BLOCKS, RG_BW)
    r = jax.nn.sigmoid(jnp.einsum('btni,nij->btnj', xb, w_r) + b_r).reshape(bsz, seq, width)
    i = jax.nn.sigmoid(jnp.einsum('btni,nij->btnj', xb, w_i) + b_i).reshape(bsz, seq, width)
    log_a = -RG_C * r * jax.nn.softplus(-lam.astype(jnp.float32))
    a = jnp.exp(log_a)
    u = jnp.sqrt(jnp.maximum(-jnp.expm1(2.0 * log_a), 0.0)) * (i * x)
    u = u.at[:, 0].add(a[:, 0] * h0.astype(jnp.float32))
    _, h = lax.associative_scan(_linear_combine, (a, u), axis=1)
    return h, h[:, -1]


def hybrid_layer(x, s_hg, s_rg, s_rgc, s_gla, s_ssd, s_ssdc, lb,
                 rms_w, w_in, hg_norm, rg_conv_w, rg_conv_b, rg_w_r, rg_b_r,
                 rg_w_i, rg_b_i, rg_lambda, gla_w_up, gla_b_up, gla_norm,
                 ssd_conv_w, ssd_conv_b, ssd_dt_bias, ssd_a_log, ssd_d, ssd_norm, w_out):
    bsz, seq, _ = x.shape
    silu = jax.nn.silu
    heads = lambda a, nh: a.reshape(bsz, seq, nh, a.shape[-1] // nh)
    h = rmsnorm(x, rms_w)
    proj = jnp.einsum('btd,de->bte', h, w_in).astype(jnp.float32)
    (hg_q, hg_f, hg_i, hg_g, rg_x, rg_g, gl_q, gl_k, gl_v, gl_g, gl_a,
     ss_z, ss_xbc, ss_dt) = jnp.split(proj, IN_SPLIT_POINTS, axis=-1)

    lb = lb.astype(jnp.float32)
    f_gate = lb + (1.0 - lb) * jax.nn.sigmoid(hg_f)
    log_f = jnp.log(jnp.maximum(f_gate, TINY))
    k_hg = (1.0 - lb) * jax.nn.sigmoid(-hg_f)
    o_hg, s_hg_new = chunked_gated_linear_attention(
        heads(silu(hg_q), HG_HEADS), heads(k_hg, HG_HEADS), heads(hg_i, HG_HEADS),
        heads(log_f, HG_HEADS), s_hg, HG_CHUNK)
    y_hg = group_rmsnorm(o_hg.reshape(bsz, seq, BRANCH), hg_norm, HG_HEADS) * silu(hg_g)

    rg_xc, s_rgc_new = causal_conv(rg_x, s_rgc, rg_conv_w, rg_conv_b)
    h_rg, s_rg_new = rg_lru(rg_xc, s_rg, rg_w_r, rg_b_r, rg_w_i, rg_b_i, rg_lambda)
    y_rg = h_rg * silu(rg_g)

    log_a = jax.nn.log_sigmoid(jnp.einsum('btr,rk->btk', gl_a, gla_w_up) + gla_b_up) / GLA_TAU
    o_gl, s_gla_new = chunked_gated_linear_attention(
        heads(gl_q * GLA_DK ** -0.5, GLA_HEADS), heads(gl_k, GLA_HEADS), heads(gl_v, GLA_HEADS),
        heads(log_a, GLA_HEADS), s_gla, GLA_CHUNK)
    y_gl = group_rmsnorm(o_gl.reshape(bsz, seq, BRANCH), gla_norm, GLA_HEADS) * silu(gl_g)

    xbc, s_ssdc_new = causal_conv(ss_xbc, s_ssdc, ssd_conv_w, ssd_conv_b)
    xbc = silu(xbc)
    ss_x, ss_b, ss_c = jnp.split(xbc, (BRANCH, BRANCH + SSD_GROUPS * SSD_DSTATE), axis=-1)
    dt = jax.nn.softplus(ss_dt + ssd_dt_bias)
    a_head = -jnp.exp(ssd_a_log.astype(jnp.float32))
    y_ss, s_ssd_new = ssd_chunked(heads(ss_x, SSD_HEADS), dt, a_head, heads(ss_b, SSD_GROUPS),
                                  heads(ss_c, SSD_GROUPS), ssd_d, s_ssd, SSD_CHUNK)
    y_ss = group_rmsnorm(y_ss.reshape(bsz, seq, BRANCH) * silu(ss_z), ssd_norm, SSD_GROUPS)

    mix = jnp.concatenate([y_hg, y_rg, y_gl, y_ss], axis=-1).astype(w_out.dtype)
    x = x + jnp.einsum('bte,ed->btd', mix, w_out).astype(x.dtype)
    return x, (s_hg_new, s_rg_new, s_rgc_new, s_gla_new, s_ssd_new, s_ssdc_new)


def run_trunk(x, st_hg, st_rg, st_rgc, st_gla, st_ssd, st_ssdc, lb_all, layer_weights, rms_final):
    new = ([], [], [], [], [], [])
    for l in range(DEPTH):
        x, states = hybrid_layer(x, st_hg[l], st_rg[l], st_rgc[l], st_gla[l], st_ssd[l], st_ssdc[l],
                                 lb_all[l], *(w[l] for w in layer_weights))
        for lst, s in zip(new, states):
            lst.append(s)
    y = rmsnorm(x, rms_final)
    return y, tuple(jnp.stack(lst) for lst in new)


def setup_inputs(seed: int = 0) -> dict:
    key = jax.random.key(seed)
    ks = list(jax.random.split(key, 40))
    f32 = jnp.float32
    nrm = lambda shape, scale: scale * jax.random.normal(ks.pop(), shape, f32)
    x_prompt = nrm((BATCH, SEQ, D_MODEL), 1.0)
    x_sample = nrm((DEC_BATCH, DEC_SEQ, D_MODEL), 1.0)
    state_hgrn = nrm((DEPTH, DEC_BATCH, HG_HEADS, HG_DK, HG_DV), 0.5)
    state_rglru = nrm((DEPTH, DEC_BATCH, BRANCH), 0.5)
    state_rglru_conv = nrm((DEPTH, DEC_BATCH, CONV_W - 1, BRANCH), 1.0)
    state_gla = nrm((DEPTH, DEC_BATCH, GLA_HEADS, GLA_DK, GLA_DV), 0.5)
    state_ssd = nrm((DEPTH, DEC_BATCH, SSD_HEADS, SSD_HEADDIM, SSD_DSTATE), 0.1)
    state_ssd_conv = nrm((DEPTH, DEC_BATCH, CONV_W - 1, SSD_CONV_DIM), 1.0)
    rms_in = 1.0 + nrm((DEPTH, D_MODEL), 0.02)
    w_in = nrm((DEPTH, D_MODEL, N_IN), D_MODEL ** -0.5)
    hgrn_lower_bounds = 1.0 + nrm((DEPTH, HG_FDIM), 0.1)
    hgrn_norm = 1.0 + nrm((DEPTH, BRANCH), 0.02)
    rglru_conv_w = nrm((DEPTH, CONV_W, BRANCH), CONV_W ** -0.5)
    rglru_conv_b = nrm((DEPTH, BRANCH), 0.01)
    rglru_w_r = nrm((DEPTH, RG_BLOCKS, RG_BW, RG_BW), RG_BW ** -0.5)
    rglru_b_r = nrm((DEPTH, RG_BLOCKS, RG_BW), 0.01)
    rglru_w_i = nrm((DEPTH, RG_BLOCKS, RG_BW, RG_BW), RG_BW ** -0.5)
    rglru_b_i = nrm((DEPTH, RG_BLOCKS, RG_BW), 0.01)
    u = jax.random.uniform(ks.pop(), (DEPTH, BRANCH), f32, 0.9, 0.999)
    a_base = u ** (1.0 / RG_C)
    rglru_lambda = jnp.log(a_base) - jnp.log1p(-a_base)
    gla_w_up = nrm((DEPTH, GLA_RANK, GLA_KDIM), GLA_RANK ** -0.5)
    gla_b_up = nrm((DEPTH, GLA_KDIM), 0.01)
    gla_norm = 1.0 + nrm((DEPTH, BRANCH), 0.02)
    ssd_conv_w = nrm((DEPTH, CONV_W, SSD_CONV_DIM), CONV_W ** -0.5)
    ssd_conv_b = nrm((DEPTH, SSD_CONV_DIM), 0.01)
    dt0 = jnp.exp(jax.random.uniform(ks.pop(), (DEPTH, SSD_HEADS), f32, math.log(1e-3), math.log(1e-1)))
    ssd_dt_bias = dt0 + jnp.log(-jnp.expm1(-dt0))
    ssd_a_log = jnp.log(jax.random.uniform(ks.pop(), (DEPTH, SSD_HEADS), f32, 1.0, 16.0))
    ssd_d = 1.0 + nrm((DEPTH, SSD_HEADS), 0.01)
    ssd_norm = 1.0 + nrm((DEPTH, BRANCH), 0.02)
    w_out = nrm((DEPTH, D_MIX, D_MODEL), D_MIX ** -0.5)
    rms_final = 1.0 + nrm((D_MODEL,), 0.02)
    return {'x_prompt': x_prompt, 'x_sample': x_sample,
            'state_hgrn': state_hgrn, 'state_rglru': state_rglru, 'state_rglru_conv': state_rglru_conv,
            'state_gla': state_gla, 'state_ssd': state_ssd, 'state_ssd_conv': state_ssd_conv,
            'rms_in': rms_in, 'w_in': w_in, 'hgrn_lower_bounds': hgrn_lower_bounds, 'hgrn_norm': hgrn_norm,
            'rglru_conv_w': rglru_conv_w, 'rglru_conv_b': rglru_conv_b,
            'rglru_w_r': rglru_w_r, 'rglru_b_r': rglru_b_r, 'rglru_w_i': rglru_w_i, 'rglru_b_i': rglru_b_i,
            'rglru_lambda': rglru_lambda, 'gla_w_up': gla_w_up, 'gla_b_up': gla_b_up, 'gla_norm': gla_norm,
            'ssd_conv_w': ssd_conv_w, 'ssd_conv_b': ssd_conv_b, 'ssd_dt_bias': ssd_dt_bias,
            'ssd_a_log': ssd_a_log, 'ssd_d': ssd_d, 'ssd_norm': ssd_norm, 'w_out': w_out,
            'rms_final': rms_final}


def reference(x_prompt, x_sample, state_hgrn, state_rglru, state_rglru_conv, state_gla,
              state_ssd, state_ssd_conv, rms_in, w_in, hgrn_lower_bounds, hgrn_norm,
              rglru_conv_w, rglru_conv_b, rglru_w_r, rglru_b_r, rglru_w_i, rglru_b_i,
              rglru_lambda, gla_w_up, gla_b_up, gla_norm, ssd_conv_w, ssd_conv_b,
              ssd_dt_bias, ssd_a_log, ssd_d, ssd_norm, w_out, rms_final):
    p = jax.nn.softmax(hgrn_lower_bounds.astype(jnp.float32), axis=0)
    lb_all = jnp.cumsum(p, axis=0) - p[0:1]
    layer_weights = (rms_in, w_in, hgrn_norm, rglru_conv_w, rglru_conv_b, rglru_w_r, rglru_b_r,
                     rglru_w_i, rglru_b_i, rglru_lambda, gla_w_up, gla_b_up, gla_norm,
                     ssd_conv_w, ssd_conv_b, ssd_dt_bias, ssd_a_log, ssd_d, ssd_norm, w_out)
    zeros = lambda s: jnp.zeros((DEPTH, BATCH) + s.shape[2:], jnp.float32)
    y_prompt, (p_hg, p_rg, p_rgc, p_gla, p_ssd, p_ssdc) = run_trunk(
        x_prompt, zeros(state_hgrn), zeros(state_rglru), zeros(state_rglru_conv), zeros(state_gla),
        zeros(state_ssd), zeros(state_ssd_conv), lb_all, layer_weights, rms_final)
    y_sample, (s_hg, s_rg, s_rgc, s_gla, s_ssd, s_ssdc) = run_trunk(
        x_sample, state_hgrn, state_rglru, state_rglru_conv, state_gla, state_ssd, state_ssd_conv,
        lb_all, layer_weights, rms_final)
    return (y_prompt, y_sample, p_hg, p_rg, p_rgc, p_gla, p_ssd, p_ssdc,
            s_hg, s_rg, s_rgc, s_gla, s_ssd, s_ssdc)
```

```cpp
#include <hip/hip_runtime.h>
#include <cstdio>
#include <cstdint>

#ifndef MK_ONE_LAUNCH
#define MK_ONE_LAUNCH 1
#endif

#ifndef PROBE_LONG_REP
#define PROBE_LONG_REP 1
#endif
#ifndef PROBE_RG_REP
#define PROBE_RG_REP PROBE_LONG_REP
#endif
#ifndef PROBE_G1_NOEPI
#define PROBE_G1_NOEPI 0
#endif
#ifndef PROBE_G2
#define PROBE_G2 0
#endif
#ifndef PROBE_G1
#define PROBE_G1 1
#endif
#define LAS __attribute__((address_space(3)))
#define DI __device__ __forceinline__

constexpr int D_MODEL = 2048, NB = 4, SEQ = 2048, DEPTH = 4, DEC = 128;
constexpr int BRANCH = 1024, D_MIX = 4096;
constexpr int TP = NB * SEQ;
constexpr int TT = TP + DEC;
constexpr int M_PAD = 8448;
constexpr int N_IN = 11808;
constexpr int LDP = 12544;
constexpr int N_MAIN = 12288;
constexpr int PST = 128 * LDP;
constexpr float EPS = 1e-6f, TINY = 1e-30f;
constexpr int C_HGQ = 0, C_HGF = 1024, C_HGI = 2048, C_HGG = 3072, C_RGX = 4096, C_RGG = 5120, C_GLQ = 6144, C_GLK = 6656, C_GLV = 7168, C_GLG = 8192,
              C_GLF = 9216, C_SSZ = 9728, C_XBC = 10752, C_DT = 12288;
constexpr int SRC_GLA = 9216, SRC_SSZ = 9232, SRC_DT = 11792;
enum { I_XP = 0, I_XS, I_SHG, I_SRG, I_SRGC, I_SGLA, I_SSSD, I_SSSDC, I_RMS, I_WIN, I_LB, I_HGN, I_RCW, I_RCB, I_WR, I_BR, I_WI, I_BI, I_LAM,
       I_GWU, I_GBU, I_GLN, I_SCW, I_SCB, I_DTB, I_ALOG, I_SD, I_SSN, I_WOUT, I_RMSF, N_INPUTS };
constexpr size_t O_YP = 0, O_YS = (size_t)TP * D_MODEL, O_HG_P = O_YS + (size_t)DEC * D_MODEL,
    O_RG_P = O_HG_P + (size_t)DEPTH * NB * 131072, O_RGC_P = O_RG_P + (size_t)DEPTH * NB * 1024, O_GLA_P = O_RGC_P + (size_t)DEPTH * NB * 3072,
    O_SSD_P = O_GLA_P + (size_t)DEPTH * NB * 131072, O_SSDC_P = O_SSD_P + (size_t)DEPTH * NB * 131072, O_HG_S = O_SSDC_P + (size_t)DEPTH * NB * 4608,
    O_RG_S = O_HG_S + (size_t)DEPTH * DEC * 131072, O_RGC_S = O_RG_S + (size_t)DEPTH * DEC * 1024, O_GLA_S = O_RGC_S + (size_t)DEPTH * DEC * 3072,
    O_SSD_S = O_GLA_S + (size_t)DEPTH * DEC * 131072, O_SSDC_S = O_SSD_S + (size_t)DEPTH * DEC * 131072, O_END = O_SSDC_S + (size_t)DEPTH * DEC * 4608;
constexpr size_t MiB = 1u << 20;
constexpr size_t WS_CTL = 0, CTL_ZERO_BYTES = 2 * MiB, WS_LB = 2 * MiB, WS_WIN = 3 * MiB, WS_WOUT = 199 * MiB, WS_XB = 263 * MiB, WS_PROJ = 296 * MiB,
    WS_DTB = 492 * MiB, WS_MIX = 493 * MiB, WS_PROJS = 559 * MiB, WS_XBCS = 584 * MiB, WS_END = 608 * MiB;
static_assert(WS_WIN + (size_t)DEPTH * LDP * D_MODEL * 2 <= WS_WOUT && WS_WOUT + (size_t)DEPTH * D_MODEL * D_MIX * 2 <= WS_XB && WS_XB + (size_t)M_PAD * D_MODEL * 2 <= WS_PROJ &&
              WS_PROJ + (size_t)TP * LDP * 2 <= WS_DTB && WS_DTB + (size_t)TP * 16 * 4 <= WS_MIX &&
              WS_MIX + (size_t)M_PAD * D_MIX * 2 <= WS_PROJS && WS_PROJS + (size_t)4 * DEC * LDP * 4 <= WS_XBCS && WS_XBCS + (size_t)TP * 1536 * 2 <= WS_END, "ws map");
constexpr int CW_BAR = 4096, CW_QCTR = 16384, CW_XPRE = 24576  , CW_STATS = 32768, CW_ROWSQ = 262144;
static_assert(CW_STATS + DEPTH * TP * 6 <= CW_ROWSQ && (size_t)(CW_ROWSQ + (DEPTH + 1) * M_PAD) * 4 <= CTL_ZERO_BYTES, "ctl map");
constexpr int LDS_BYTES = 147456, MISC_OFF = LDS_BYTES - 256;
constexpr int NPHASE = 2 + 4 * DEPTH;

typedef unsigned short bf16_t;
typedef short bf16x8 __attribute__((ext_vector_type(8)));
typedef float f32x4 __attribute__((ext_vector_type(4)));
typedef float f32x2 __attribute__((ext_vector_type(2)));
typedef float f32x16 __attribute__((ext_vector_type(16)));
typedef unsigned u32x4 __attribute__((ext_vector_type(4)));
typedef unsigned u32x2 __attribute__((ext_vector_type(2)));
typedef __bf16 bf16v2 __attribute__((ext_vector_type(2)));

DI unsigned pk2(float lo, float hi) { const f32x2 v = {lo, hi}; return __builtin_bit_cast(unsigned, __builtin_convertvector(v, bf16v2)); }
DI unsigned f2bf(float f) { return pk2(f, 0.f) & 0xffffu; }
DI float bflo(unsigned u) { return __builtin_bit_cast(float, u << 16); }
DI float bfhi(unsigned u) { return __builtin_bit_cast(float, u & 0xffff0000u); }
DI float bf1(bf16_t u) { return __builtin_bit_cast(float, (unsigned)u << 16); }
DI float ex2(float x) { return __builtin_amdgcn_exp2f(x); }
DI float lg2(float x) { return __builtin_amdgcn_logf(x); }
DI float rcp(float x) { return __builtin_amdgcn_rcpf(x); }
constexpr float LOG2E = 1.4426950408889634f, LN2 = 0.6931471805599453f;
DI float fexp(float x) { return ex2(x * LOG2E); }
DI float flog(float x) { return lg2(x) * LN2; }
DI float sigm(float x) { return rcp(1.0f + fexp(-x)); }
DI float silu(float x) { return x * sigm(x); }
DI float sigm_fast(float x) { return sigm(x); }
DI float silu_fast(float x) { return silu(x); }
DI float log1p_pos(float e) { const float a = e * (1.0f - e * (0.5f - e * (0.33333334f - 0.25f * e))), b = flog(1.0f + e); return e < 0.03f ? a : b; }
DI float softplus(float x) { return fmaxf(x, 0.f) + log1p_pos(fexp(-fabsf(x))); }
DI float neg_expm1(float x) { const float a = -x * (1.0f + 0.5f * x * (1.0f + 0.33333334f * x * (1.0f + 0.25f * x * (1.0f + 0.2f * x)))), b = 1.0f - fexp(x); return fabsf(x) < 0.25f ? a : b; }
DI float row_rstd(const float* rowsq, int row) { return rsqrtf(rowsq[row] * (1.0f / D_MODEL) + EPS); }
DI float clampf(float x, float lo, float hi) { return fminf(fmaxf(x, lo), hi); }
DI float shx(float v, int mask, int lane) { return __builtin_bit_cast(float, __builtin_amdgcn_ds_bpermute((lane ^ mask) << 2, __builtin_bit_cast(int, v))); }
DI float shup(float v, int o, int lane) { return __builtin_bit_cast(float, __builtin_amdgcn_ds_bpermute((lane >= o ? lane - o : lane) << 2, __builtin_bit_cast(int, v))); }
DI float wave_sum(float v, int lane) {
#pragma unroll
    for (int o = 1; o < 64; o <<= 1) v += shx(v, o, lane);
    return v;
}

struct Params { const float* in[N_INPUTS]; float* out; unsigned char* ws; int ph_lo, ph_hi; };
static_assert(sizeof(Params) == N_INPUTS * 8 + 8 + 8 + 8, "no padding holes in Params");
typedef const __attribute__((address_space(4))) Params* KP;
DI KP get_params() { auto kp = __builtin_amdgcn_kernarg_segment_ptr(); asm volatile("" : "+s"(kp)); return (KP)kp; }
DI int get_tid(int wv) { int ln; asm volatile("v_mbcnt_lo_u32_b32 %0, -1, 0\n\tv_mbcnt_hi_u32_b32 %0, -1, %0" : "=v"(ln)); return (wv << 6) | ln; }

#define XB_TMO      128
#define XB_XCNT(j)  (256  + 64 * (j))
#define XB_XSUB(j)  (1280 + 64 * (j))
#define XB_XGEN(j)  (2304 + 64 * (j))
#define XB_TOP      3328
#define XB_TOPGEN   3392
#define XCD_BAR_WORDS 3456
#define XB_SPIN_CAP (1u << 20)
DI unsigned xb_ld(unsigned* p)              { return __hip_atomic_load(p, __ATOMIC_RELAXED, __HIP_MEMORY_SCOPE_AGENT); }
DI unsigned xb_add(unsigned* p, unsigned v) { return __hip_atomic_fetch_add(p, v, __ATOMIC_RELAXED, __HIP_MEMORY_SCOPE_AGENT); }
DI unsigned xb_xcc_id() { return (unsigned)__builtin_amdgcn_s_getreg((3 << 11) | 20) & 0xFu; }
#define XB_SPIN(cond, bar) do { unsigned _sp = 0; while (cond) { __builtin_amdgcn_s_sleep(1); \
    if ((++_sp & 255u) == 0u) { if (xb_ld(&(bar)[XB_TMO])) break; if (_sp > XB_SPIN_CAP) { atomicAdd(&(bar)[XB_TMO], 1u); break; } } } } while (0)
struct XcdBarrier { unsigned* bar; unsigned x; volatile LAS unsigned* st; };
DI XcdBarrier xcd_barrier_post(unsigned* bar, volatile LAS unsigned* st, int tid) {
    XcdBarrier b; b.bar = bar; b.x = xb_xcc_id(); b.st = st;
    if (tid == 0) (void)xb_add(&bar[XB_XCNT(b.x)], 1u);
    return b;
}
DI void xcd_barrier_complete(unsigned* bar, unsigned x, unsigned& nloc, unsigned& nx) {
    const unsigned G = gridDim.x * gridDim.y * gridDim.z;
    unsigned sum, cnt, mine, sp = 0u;
    for (;;) {
        sum = 0u; cnt = 0u; mine = 0u;
#pragma unroll
        for (unsigned j = 0; j < 16; ++j) { const unsigned c = xb_ld(&bar[XB_XCNT(j)]); sum += c; cnt += (c > 0u) ? 1u : 0u; mine = (j == x) ? c : mine; }
        if (sum == G) break;
        __builtin_amdgcn_s_sleep(1);
        if ((++sp & 255u) == 0u) { if (xb_ld(&bar[XB_TMO])) break; if (sp > XB_SPIN_CAP) { atomicAdd(&bar[XB_TMO], 1u); break; } }
    }
    nloc = mine > 0u ? mine : 1u; nx = cnt > 0u ? cnt : 1u;
}
DI void xcd_barrier(const XcdBarrier& b, int wv) {
    asm volatile("s_waitcnt vmcnt(0)" ::: "memory");
    __syncthreads();
    if (get_tid(wv) == 0) {
        unsigned* bar = b.bar;
        __builtin_amdgcn_s_waitcnt(0);
        unsigned nloc = b.st[0], nx = b.st[1];
        if (nloc == 0u) { xcd_barrier_complete(bar, b.x, nloc, nx); b.st[0] = nloc; b.st[1] = nx; }
        const unsigned old = xb_add(&bar[XB_XSUB(b.x)], 1u);
        const unsigned gen = old / nloc;
        if (old + 1u == (gen + 1u) * nloc) {
            __builtin_amdgcn_fence(__ATOMIC_RELEASE, "agent");
            asm volatile("s_waitcnt vmcnt(0)" ::: "memory");
            const unsigned og = xb_add(&bar[XB_TOP], 1u);
            const unsigned tg = og / nx;
            if (og + 1u == (tg + 1u) * nx) xb_add(&bar[XB_TOPGEN], 1u);
            else XB_SPIN(xb_ld(&bar[XB_TOPGEN]) == tg, bar);
            __builtin_amdgcn_fence(__ATOMIC_ACQUIRE, "agent");
            xb_add(&bar[XB_XGEN(b.x)], 1u);
            asm volatile("s_waitcnt vmcnt(0)" ::: "memory");
        } else {
            XB_SPIN(xb_ld(&bar[XB_XGEN(b.x)]) == gen, bar);
            __builtin_amdgcn_fence(__ATOMIC_ACQUIRE, "agent");
            asm volatile("s_waitcnt vmcnt(0)" ::: "memory");
        }
    }
    __syncthreads();
}

namespace pg8 {
constexpr int BM = 256, BK = 64, HALF = 128, HTB = HALF * BK * 2, STAGE_BYTES = 8 * HTB, NXCD = 8, WGM = 8;
DI int lds_byte(int r, int c) { const int st = (r >> 4) * 2 + (c >> 5), rr = r & 15, cc = c & 31, ob = rr * 64 + cc * 2; return st * 1024 + (ob ^ (((ob >> 9) & 1) << 5)); }
DI void stage_rc(int b, int& R, int& C) { const int st = b / 1024, sb = b % 1024, swz = sb ^ (((sb >> 9) & 1) << 5); R = (st >> 1) * 16 + swz / 64; C = (st & 1) * 32 + (swz % 64) / 2; }
DI int perm32(int rho) { const int n = rho >> 4, i = rho & 15; return 8 * (i >> 2) + 4 * n + (i & 3); }
struct Unit { int pm, pn; };
struct Gemm { const bf16_t* A; const bf16_t* Bt; int M, N, K, lda, ldb; };
struct StaticOrder {
    int nM, nN, nwg, G, c, rep = 1;
    DI void init(int M, int N, int G_, int c_) { nM = M / BM; nN = N / BM; nwg = nM * nN; G = G_; c = c_; }
    DI bool next(int i, Unit& u) const {
        const long L = (long)(i / rep) * G + c; if (L >= nwg) return false;
        int wgid = (int)L; { const int q = nwg / NXCD, r = nwg % NXCD, xcd = wgid % NXCD, off = wgid / NXCD; wgid = (xcd < r ? xcd * (q + 1) : r * (q + 1) + (xcd - r) * q) + off; }
        const int nig = WGM * nN, gid = wgid / nig, fm = gid * WGM, gsz = (nM - fm) < WGM ? (nM - fm) : WGM;
        u.pm = fm + ((wgid % nig) % gsz); u.pn = (wgid % nig) / gsz; return true;
    }
    DI void a_ready(const Unit&) const {}
    DI void done(const Unit&) const {}
};
struct EpiProj {
    static constexpr bool PERM = true, TWICE = PROBE_G1_NOEPI != 0;
    bf16_t* P; const float* lb; const float* hgn; const float* gln; const float* bup; const float* rsq;
    template <int MODE>
    DI void body(const f32x4 (&acc)[2][2][4][2], bf16_t* prow, const float* vec, float scale, const float (&rs)[2][4]) const {
#pragma unroll
        for (int bj = 0; bj < 2; ++bj) {
            f32x4 c0 = (f32x4){1.f, 1.f, 1.f, 1.f}, c1 = c0;
            if constexpr (MODE >= 2) { c0 = *(const f32x4*)(vec + bj * HALF); c1 = *(const f32x4*)(vec + bj * HALF + 4); }
#pragma unroll
            for (int ai = 0; ai < 2; ++ai)
#pragma unroll
                for (int m = 0; m < 4; ++m) {
                    f32x4 a = acc[ai][bj][m][0] * rs[ai][m], b = acc[ai][bj][m][1] * rs[ai][m];
                    if constexpr (MODE == 0) { a = a * scale; b = b * scale; }
                    else if constexpr (MODE == 1) { a = (f32x4){silu(a.x), silu(a.y), silu(a.z), silu(a.w)}; b = (f32x4){silu(b.x), silu(b.y), silu(b.z), silu(b.w)}; }
                    else if constexpr (MODE == 2) { a = (f32x4){silu(a.x), silu(a.y), silu(a.z), silu(a.w)} * c0; b = (f32x4){silu(b.x), silu(b.y), silu(b.z), silu(b.w)} * c1; }
                    else if constexpr (MODE == 3) {
#define LOGF(x, l) flog(fmaxf((l) + (1.0f - (l)) * sigm(x), TINY))
                        a = (f32x4){LOGF(a.x, c0.x), LOGF(a.y, c0.y), LOGF(a.z, c0.z), LOGF(a.w, c0.w)}; b = (f32x4){LOGF(b.x, c1.x), LOGF(b.y, c1.y), LOGF(b.z, c1.z), LOGF(b.w, c1.w)};
#undef LOGF
                    } else {
#define LSIG(x, bb) (-0.0625f * (fmaxf(-((x) + (bb)), 0.f) + flog(1.0f + fexp(-fabsf((x) + (bb))))))
                        a = (f32x4){LSIG(a.x, c0.x), LSIG(a.y, c0.y), LSIG(a.z, c0.z), LSIG(a.w, c0.w)}; b = (f32x4){LSIG(b.x, c1.x), LSIG(b.y, c1.y), LSIG(b.z, c1.z), LSIG(b.w, c1.w)};
#undef LSIG
                    }
                    u32x4 w4; w4.x = pk2(a.x, a.y); w4.y = pk2(a.z, a.w); w4.z = pk2(b.x, b.y); w4.w = pk2(b.z, b.w);
                    *(u32x4*)(prow + (size_t)(ai * HALF + m * 16) * LDP + bj * HALF) = w4;
                }
        }
    }
    DI void operator()(const f32x4 (&acc)[2][2][4][2], const Unit& u, int wr, int wc, int fr, int fq) const {
        const int col = u.pn * BM + wc * 32 + 8 * fq;
        bf16_t* prow = P + (size_t)(u.pm * BM + wr * 64 + fr) * LDP + col;
        float rs[2][4];
#pragma unroll
        for (int ai = 0; ai < 2; ++ai)
#pragma unroll
            for (int m = 0; m < 4; ++m) rs[ai][m] = row_rstd(rsq, u.pm * BM + wr * 64 + fr + ai * HALF + m * 16);
        const int pn = u.pn;
        if (pn < 4) body<1>(acc, prow, nullptr, 1.f, rs);
        else if (pn < 8) body<3>(acc, prow, lb + (col - C_HGF), 1.f, rs);
        else if (pn < 12) body<0>(acc, prow, nullptr, 1.f, rs);
        else if (pn < 16) body<2>(acc, prow, hgn + (col - C_HGG), 1.f, rs);
        else if (pn < 20) body<0>(acc, prow, nullptr, 1.f, rs);
        else if (pn < 24) body<1>(acc, prow, nullptr, 1.f, rs);
        else if (pn < 26) body<0>(acc, prow, nullptr, 0.08838834764831845f, rs);
        else if (pn < 32) body<0>(acc, prow, nullptr, 1.f, rs);
        else if (pn < 36) body<2>(acc, prow, gln + (col - C_GLG), 1.f, rs);
        else if (pn < 38) body<4>(acc, prow, bup + (col - C_GLF), 1.f, rs);
        else if (pn < 42) body<1>(acc, prow, nullptr, 1.f, rs);
        else body<0>(acc, prow, nullptr, 1.f, rs);
    }
};
struct EpiSample {
    static constexpr bool PERM = false, TWICE = false;
    float* PS;
    DI void operator()(const f32x4 (&acc)[2][2][4][2], const Unit& u, int wr, int wc, int fr, int fq) const {
        const int row0 = wr * 64 + fr, col0 = u.pn * BM + wc * 32 + 4 * fq;
#pragma unroll
        for (int m = 0; m < 4; ++m) { float* op = PS + (size_t)(row0 + m * 16) * LDP + col0;
#pragma unroll
            for (int bj = 0; bj < 2; ++bj)
#pragma unroll
                for (int n = 0; n < 2; ++n) *(f32x4*)(op + bj * HALF + n * 16) = acc[0][bj][m][n]; }
    }
};
struct EpiResid {
    static constexpr bool PERM = true, TWICE = false;
    bf16_t* xb; float* rsq_next;
    DI void operator()(const f32x4 (&acc)[2][2][4][2], const Unit& u, int wr, int wc, int fr, int fq) const {
        const int row0 = u.pm * BM + wr * 64 + fr, col0 = u.pn * BM + wc * 32 + 8 * fq;
#pragma unroll
        for (int ai = 0; ai < 2; ++ai)
#pragma unroll
            for (int m = 0; m < 4; ++m) { const int row = row0 + ai * HALF + m * 16; bf16_t* xp = xb + (size_t)row * D_MODEL + col0; float ss = 0.f;
#pragma unroll
                for (int bj = 0; bj < 2; ++bj) { const u32x4 o = *(const u32x4*)(xp + bj * HALF); const f32x4 a = acc[ai][bj][m][0], b = acc[ai][bj][m][1];
                    const float x0 = bflo(o.x) + a.x, x1 = bfhi(o.x) + a.y, x2 = bflo(o.y) + a.z, x3 = bfhi(o.y) + a.w, x4 = bflo(o.z) + b.x, x5 = bfhi(o.z) + b.y, x6 = bflo(o.w) + b.z, x7 = bfhi(o.w) + b.w;
                    ss += ((x0 * x0 + x1 * x1) + (x2 * x2 + x3 * x3)) + ((x4 * x4 + x5 * x5) + (x6 * x6 + x7 * x7));
                    u32x4 n4; n4.x = pk2(x0, x1); n4.y = pk2(x2, x3); n4.z = pk2(x4, x5); n4.w = pk2(x6, x7); *(u32x4*)(xp + bj * HALF) = n4; }
                const int lane = fq * 16 + fr; ss += shx(ss, 16, lane); ss += shx(ss, 32, lane);
                if (fq == 0) atomicAdd(rsq_next + row, ss); }
    }
};
struct OneUnit {
    int pm, pn, have;
    DI bool next(int i, Unit& u) const { if (i != 0 || !have) return false; u.pm = pm; u.pn = pn; return true; }
    DI void a_ready(const Unit&) const {}
    DI void done(const Unit&) const {}
};
template <class Epi, class Sched>
DI void gemm_phase(LAS unsigned char* lds, const Gemm g, const Sched& S, const Epi& E, int wv) {
    const int tid = get_tid(wv), wid = wv, lane = tid & 63, wr = wid >> 2, wc = wid & 3, fr = lane & 15, fq = lane >> 4;
    const int K = g.K, nt = K / BK;
    unsigned voffA[2], voffB[2];
#pragma unroll
    for (int i = 0; i < 2; ++i) { int R, C; stage_rc(tid * 16 + i * 8192, R, C); const int Rb = Epi::PERM ? ((R & ~31) + perm32(R & 31)) : R;
        voffA[i] = (unsigned)(R * g.lda + C) * 2u; voffB[i] = (unsigned)(Rb * g.ldb + C) * 2u; }
    const size_t kstep = (size_t)(BK * 2);
    const size_t hstepA = (size_t)HALF * g.lda * 2, hstepB = (size_t)HALF * g.ldb * 2;
    const size_t tstepA = 2 * hstepA, tstepB = 2 * hstepB;
    const unsigned ldsw = (unsigned)wid * 1024u;
    const int aoff = lds_byte(wr * 64 + fr, fq * 8), boff = lds_byte(wc * 32 + fr, fq * 8);
#define PG8_SA(b, h) (((b) * 2 + (h)) * HTB)
#define PG8_SB(b, h) ((4 + (b) * 2 + (h)) * HTB)
#define PG8_STAGE(bufoff, gbase, voff) do { _Pragma("unroll") for (int _i = 0; _i < 2; ++_i) \
        __builtin_amdgcn_global_load_lds((const unsigned*)((const char*)(gbase) + (voff)[_i]), (LAS unsigned*)(lds + (bufoff) + ldsw + _i * 8192), 16, 0, 0); } while (0)
#define PG8_LDA(dst, b, h) do { _Pragma("unroll") for (int m = 0; m < 4; ++m) _Pragma("unroll") for (int k = 0; k < 2; ++k) dst[m][k] = *(const LAS bf16x8*)(lds + PG8_SA(b, h) + aoff + m * 2048 + k * 1024); } while (0)
#define PG8_LDB(dst, b, h) do { _Pragma("unroll") for (int n = 0; n < 2; ++n) _Pragma("unroll") for (int k = 0; k < 2; ++k) dst[n][k] = *(const LAS bf16x8*)(lds + PG8_SB(b, h) + boff + n * 2048 + k * 1024); } while (0)
#define PG8_MMA(ai, bj, At, Bt) do { __builtin_amdgcn_s_setprio(1); _Pragma("unroll") for (int m = 0; m < 4; ++m) _Pragma("unroll") for (int n = 0; n < 2; ++n) _Pragma("unroll") for (int k = 0; k < 2; ++k) \
        acc[ai][bj][m][n] = __builtin_amdgcn_mfma_f32_16x16x32_bf16(Bt[n][k], At[m][k], acc[ai][bj][m][n], 0, 0, 0); __builtin_amdgcn_s_setprio(0); } while (0)
#define PG8_WAIT_V(n) asm volatile("s_waitcnt vmcnt(" #n ")" ::: "memory")
#define PG8_WAIT_L(n) asm volatile("s_waitcnt lgkmcnt(" #n ")" ::: "memory")
#define PG8_BAR __builtin_amdgcn_s_barrier()
#define PG8_SCHED __builtin_amdgcn_sched_barrier(0)
    Unit cur, nxt; int ui = 0;
    if (!S.next(0, cur)) return;
    f32x4 acc[2][2][4][2];
#pragma unroll
    for (int a = 0; a < 2; ++a)
#pragma unroll
        for (int b = 0; b < 2; ++b)
#pragma unroll
            for (int m = 0; m < 4; ++m)
#pragma unroll
                for (int n = 0; n < 2; ++n) acc[a][b][m][n] = (f32x4){0.f, 0.f, 0.f, 0.f};
    bf16x8 At[4][2], B0[2][2], B1[2][2];
    const char* cA = (const char*)g.A + (size_t)cur.pm * tstepA; const char* cB = (const char*)g.Bt + (size_t)cur.pn * tstepB;
    S.a_ready(cur);
    PG8_STAGE(PG8_SB(0, 0), cB, voffB); PG8_STAGE(PG8_SA(0, 0), cA, voffA); PG8_STAGE(PG8_SB(0, 1), cB + hstepB, voffB); PG8_STAGE(PG8_SA(0, 1), cA + hstepA, voffA);
    if (wr == 1) PG8_BAR;
    PG8_WAIT_V(4); PG8_BAR;
    PG8_STAGE(PG8_SB(1, 0), cB + kstep, voffB); PG8_STAGE(PG8_SA(1, 0), cA + kstep, voffA); PG8_STAGE(PG8_SB(1, 1), cB + hstepB + kstep, voffB);
    PG8_WAIT_V(6); PG8_BAR;
    for (;;) {
        const bool has_next = S.next(ui + 1, nxt);
        const char* nA = has_next ? (const char*)g.A + (size_t)nxt.pm * tstepA : cA; const char* nB = has_next ? (const char*)g.Bt + (size_t)nxt.pn * tstepB : cB;
        for (int t = 0; t < nt; t += 2) {
            const bool last = (t == nt - 2);
            const char* a1 = cA + (size_t)(t + 1) * kstep;
            const char* a2 = last ? nA : cA + (size_t)(t + 2) * kstep; const char* b2 = last ? nB : cB + (size_t)(t + 2) * kstep;
            const char* a3 = a2 + kstep; const char* b3 = b2 + kstep;
            if (last && has_next) S.a_ready(nxt);
            PG8_LDB(B0, 0, 0); PG8_SCHED; PG8_LDA(At, 0, 0); PG8_STAGE(PG8_SA(1, 1), a1 + hstepA, voffA);
            PG8_WAIT_L(8); PG8_BAR; PG8_WAIT_L(0); PG8_MMA(0, 0, At, B0); PG8_BAR; PG8_SCHED;
            PG8_LDB(B1, 0, 1); PG8_STAGE(PG8_SB(0, 0), b2, voffB);
            PG8_BAR; PG8_WAIT_L(0); PG8_MMA(0, 1, At, B1); PG8_BAR;
            PG8_LDA(At, 0, 1); PG8_STAGE(PG8_SA(0, 0), a2, voffA);
            PG8_BAR; PG8_WAIT_L(0); PG8_MMA(1, 0, At, B0); PG8_BAR; PG8_SCHED;
            PG8_STAGE(PG8_SB(0, 1), b2 + hstepB, voffB);
            PG8_WAIT_V(6); PG8_BAR; PG8_MMA(1, 1, At, B1); PG8_BAR;
            PG8_LDB(B0, 1, 0); PG8_SCHED; PG8_LDA(At, 1, 0); PG8_STAGE(PG8_SA(0, 1), a2 + hstepA, voffA);
            PG8_WAIT_L(8); PG8_BAR; PG8_WAIT_L(0); PG8_MMA(0, 0, At, B0); PG8_BAR; PG8_SCHED;
            PG8_LDB(B1, 1, 1); PG8_STAGE(PG8_SB(1, 0), b3, voffB);
            PG8_BAR; PG8_WAIT_L(0); PG8_MMA(0, 1, At, B1); PG8_BAR;
            PG8_LDA(At, 1, 1); PG8_STAGE(PG8_SA(1, 0), a3, voffA);
            PG8_BAR; PG8_WAIT_L(0); PG8_MMA(1, 0, At, B0); PG8_BAR; PG8_SCHED;
            PG8_STAGE(PG8_SB(1, 1), b3 + hstepB, voffB);
            PG8_WAIT_V(6); PG8_BAR; PG8_MMA(1, 1, At, B1); PG8_BAR;
        }
        E(acc, cur, wr, wc, fr, fq);
        if constexpr (Epi::TWICE) {
#pragma unroll
            for (int a = 0; a < 2; ++a)
#pragma unroll
                for (int b = 0; b < 2; ++b) asm volatile("" : "+v"(acc[a][b][0][0]), "+v"(acc[a][b][0][1]), "+v"(acc[a][b][1][0]), "+v"(acc[a][b][1][1]), "+v"(acc[a][b][2][0]), "+v"(acc[a][b][2][1]), "+v"(acc[a][b][3][0]), "+v"(acc[a][b][3][1]) :: "memory");
            E(acc, cur, wr, wc, fr, fq); }
        S.done(cur);
        if (!has_next) break;
#pragma unroll
        for (int a = 0; a < 2; ++a)
#pragma unroll
            for (int b = 0; b < 2; ++b)
#pragma unroll
                for (int m = 0; m < 4; ++m)
#pragma unroll
                    for (int n = 0; n < 2; ++n) acc[a][b][m][n] = (f32x4){0.f, 0.f, 0.f, 0.f};
        cur = nxt; cA = nA; cB = nB; ++ui;
    }
    PG8_WAIT_V(0);
    if (wr == 0) PG8_BAR;
    PG8_BAR;
#undef PG8_SA
#undef PG8_SB
#undef PG8_STAGE
#undef PG8_LDA
#undef PG8_LDB
#undef PG8_MMA
#undef PG8_WAIT_V
#undef PG8_WAIT_L
#undef PG8_BAR
#undef PG8_SCHED
}
}

struct Ctx {
    KP kp; const float* const __attribute__((address_space(4)))* in; float* out; unsigned char* ws;
    LAS unsigned char* lds;
    int tid, lane, wave, G, wg;
    float* lb; bf16_t* win; bf16_t* wout; bf16_t* xb; bf16_t* proj; float* projs; float* dtb; bf16_t* mix; bf16_t* xbcs; float* rowsq; unsigned* ctl;
};
DI Ctx make_ctx(int wv) {
    extern __shared__ __attribute__((aligned(16))) unsigned char lds_raw[];
    Ctx c; c.kp = get_params(); c.in = c.kp->in; c.out = c.kp->out; c.ws = c.kp->ws;
    c.lds = (LAS unsigned char*)lds_raw;
    asm volatile("" : "+s"(wv));
    int wg = blockIdx.x; asm volatile("" : "+s"(wg));
    c.tid = get_tid(wv); c.lane = c.tid & 63; c.wave = wv; c.G = gridDim.x; c.wg = wg;
    unsigned char* ws = c.ws;
    c.ctl = (unsigned*)(ws + WS_CTL); c.lb = (float*)(ws + WS_LB); c.win = (bf16_t*)(ws + WS_WIN); c.wout = (bf16_t*)(ws + WS_WOUT); c.xb = (bf16_t*)(ws + WS_XB);
    c.proj = (bf16_t*)(ws + WS_PROJ); c.projs = (float*)(ws + WS_PROJS); c.dtb = (float*)(ws + WS_DTB); c.mix = (bf16_t*)(ws + WS_MIX); c.xbcs = (bf16_t*)(ws + WS_XBCS); c.rowsq = (float*)(c.ctl + CW_ROWSQ);
    return c;
}

DI void p0_transpose_item(const float* W, int ldw, int k0, int n0, bf16_t* WT, int K, int drow0, LAS float* scr, int lane, const float* ksc) {
    float t[32];
#pragma unroll
    for (int i = 0; i < 32; ++i) t[i] = W[(size_t)(k0 + 2 * i + (lane >> 5)) * ldw + n0 + (lane & 31)];
#pragma unroll
    for (int i = 0; i < 32; ++i) scr[(2 * i + (lane >> 5)) * 33 + (lane & 31)] = t[i];
    const int c = lane & 7;
    f32x4 s0 = (f32x4){1.f, 1.f, 1.f, 1.f}, s1 = s0;
    if (ksc) { s0 = *(const f32x4*)(ksc + k0 + 8 * c); s1 = *(const f32x4*)(ksc + k0 + 8 * c + 4); }
    asm volatile("s_waitcnt lgkmcnt(0)" ::: "memory");
#pragma unroll
    for (int j = 0; j < 4; ++j) { const int n = (lane >> 3) + 8 * j; const LAS float* s = scr + (8 * c) * 33 + n;
        u32x4 o; o.x = pk2(s[0 * 33] * s0.x, s[1 * 33] * s0.y); o.y = pk2(s[2 * 33] * s0.z, s[3 * 33] * s0.w); o.z = pk2(s[4 * 33] * s1.x, s[5 * 33] * s1.y); o.w = pk2(s[6 * 33] * s1.z, s[7 * 33] * s1.w);
        *(u32x4*)(WT + (size_t)(drow0 + n) * K + k0 + 8 * c) = o; }
    asm volatile("s_waitcnt lgkmcnt(0)" ::: "memory");
}
DI void phase_prologue(int wv) {
    const Ctx c = make_ctx(wv);
    LAS float* scr = (LAS float*)(c.lds + c.wave * 16384);
    const int gw = c.wg * 8 + c.wave, NGW = c.G * 8;
    constexpr int NB1 = SRC_GLA / 32, NB2 = (SRC_DT - SRC_SSZ) / 32;
    constexpr int I_A = (D_MODEL / 64) * NB1, I_B = (D_MODEL / 64) * NB2, I_O = (D_MIX / 64) * (D_MODEL / 32), I_L = I_A + I_B + I_O;
    for (int it = gw; it < DEPTH * I_L; it += NGW) {
        const int l = it / I_L; int r = it % I_L;
        const float* win = c.in[I_WIN] + (size_t)l * D_MODEL * N_IN; bf16_t* wt = c.win + (size_t)l * LDP * D_MODEL; const float* rmsw = c.in[I_RMS] + (size_t)l * D_MODEL;
        if (r < I_A) { const int kb = r / NB1, nb = r % NB1; p0_transpose_item(win, N_IN, 64 * kb, 32 * nb, wt, D_MODEL, 32 * nb, scr, c.lane, rmsw); }
        else if (r < I_A + I_B) { r -= I_A; const int kb = r / NB2, nb = r % NB2; p0_transpose_item(win, N_IN, 64 * kb, SRC_SSZ + 32 * nb, wt, D_MODEL, C_SSZ + 32 * nb, scr, c.lane, rmsw); }
        else { r -= I_A + I_B; const int kb = r / (D_MODEL / 32), nb = r % (D_MODEL / 32);
            p0_transpose_item(c.in[I_WOUT] + (size_t)l * D_MIX * D_MODEL, D_MODEL, 64 * kb, 32 * nb, c.wout + (size_t)l * D_MODEL * D_MIX, D_MIX, 32 * nb, scr, c.lane, nullptr); }
    }
    const int gt = c.wg * 512 + c.tid, NGT = c.G * 512;
    for (int it = gw; it < DEPTH * 32 * 8; it += NGW) {
        const int l = it >> 8, kb = (it >> 3) & 31, nb = it & 7, k = kb * 64 + c.lane;
        const float* wr = c.in[I_WIN] + ((size_t)l * D_MODEL + k) * N_IN + SRC_GLA; const float* up = c.in[I_GWU] + (size_t)l * 16 * 512 + nb * 64;
        const f32x4 a0 = *(const f32x4*)wr, a1 = *(const f32x4*)(wr + 4), a2 = *(const f32x4*)(wr + 8), a3 = *(const f32x4*)(wr + 12);
        const float rk = c.in[I_RMS][(size_t)l * D_MODEL + k];
        bf16_t* dst = c.win + ((size_t)l * LDP + C_GLF + nb * 64) * D_MODEL + k;
#pragma unroll 4
        for (int n = 0; n < 64; ++n) {
            const float s = a0.x * up[n] + a0.y * up[512 + n] + a0.z * up[1024 + n] + a0.w * up[1536 + n] + a1.x * up[2048 + n] + a1.y * up[2560 + n] + a1.z * up[3072 + n] + a1.w * up[3584 + n]
                          + a2.x * up[4096 + n] + a2.y * up[4608 + n] + a2.z * up[5120 + n] + a2.w * up[5632 + n] + a3.x * up[6144 + n] + a3.y * up[6656 + n] + a3.z * up[7168 + n] + a3.w * up[7680 + n];
            dst[(size_t)n * D_MODEL] = (bf16_t)f2bf(s * rk); }
    }
    for (int i = gt; i < DEPTH * 16 * D_MODEL; i += NGT) {
        const int l = i / (16 * D_MODEL), e = i % (16 * D_MODEL), n = e / D_MODEL, k = e % D_MODEL;
        c.win[((size_t)l * LDP + C_DT + n) * D_MODEL + k] = (bf16_t)f2bf(c.in[I_WIN][((size_t)l * D_MODEL + k) * N_IN + SRC_DT + n] * c.in[I_RMS][(size_t)l * D_MODEL + k]);
    }
    constexpr int PADW = (LDP - C_DT - 16) * D_MODEL * 2 / 16;
    for (int i = gt; i < DEPTH * PADW; i += NGT) { const int l = i / PADW, r = i % PADW;
        ((u32x4*)(c.win + ((size_t)l * LDP + C_DT + 16) * D_MODEL))[r] = (u32x4){0u, 0u, 0u, 0u}; }
    constexpr int PADX = (M_PAD - TT) * D_MODEL * 2 / 16;
    for (int i = gt; i < PADX; i += NGT) ((u32x4*)(c.xb + (size_t)TT * D_MODEL))[i] = (u32x4){0u, 0u, 0u, 0u};
    for (int r = gw; r < TT; r += NGW) {
        const f32x4* x4 = (const f32x4*)(r < TP ? c.in[I_XP] + (size_t)r * D_MODEL : c.in[I_XS] + (size_t)(r - TP) * D_MODEL);
        u32x2* o = (u32x2*)(c.xb + (size_t)r * D_MODEL); float s = 0.f;
#pragma unroll
        for (int j = 0; j < 8; ++j) { const f32x4 v = x4[c.lane + 64 * j]; s += (v.x * v.x + v.y * v.y) + (v.z * v.z + v.w * v.w); u32x2 p; p.x = pk2(v.x, v.y); p.y = pk2(v.z, v.w); o[c.lane + 64 * j] = p; }
        s = wave_sum(s, c.lane);
        if (c.lane == 0) c.rowsq[r] = s;
    }
    for (int i = gt; i < 1024; i += NGT) {
        const float* p = c.in[I_LB];
        const float a0 = p[i], a1 = p[1024 + i], a2 = p[2048 + i], a3 = p[3072 + i];
        const float mx = fmaxf(fmaxf(a0, a1), fmaxf(a2, a3));
        const float e0 = expf(a0 - mx), e1 = expf(a1 - mx), e2 = expf(a2 - mx), e3 = expf(a3 - mx);
        const float inv = 1.0f / (e0 + e1 + e2 + e3);
        c.lb[i] = 0.f; c.lb[1024 + i] = e1 * inv; c.lb[2048 + i] = (e1 + e2) * inv; c.lb[3072 + i] = (e1 + e2 + e3) * inv;
    }
}

DI void phase_final_norm(int wv) {
    const Ctx c = make_ctx(wv);
    const int gw = c.wg * 8 + c.wave, NGW = c.G * 8;
    const f32x4* w4 = (const f32x4*)c.in[I_RMSF];
    for (int r = gw; r < TT; r += NGW) {
        const u32x2* x2 = (const u32x2*)(c.xb + (size_t)r * D_MODEL);
        const float rstd = row_rstd(c.rowsq + DEPTH * M_PAD, r);
        f32x4* o = (f32x4*)(c.out + O_YP + (size_t)r * D_MODEL);
#pragma unroll
        for (int j = 0; j < 8; ++j) { const u32x2 p = x2[c.lane + 64 * j]; const f32x4 w = w4[c.lane + 64 * j];
            o[c.lane + 64 * j] = (f32x4){bflo(p.x) * rstd * w.x, bfhi(p.x) * rstd * w.y, bflo(p.y) * rstd * w.z, bfhi(p.y) * rstd * w.w}; }
    }
}

DI float ps4(const float* p) { return (p[0] + p[PST]) + (p[2 * PST] + p[3 * PST]); }
DI float conv1(const float* prow, float rs, int col, int ch, int nch, const float* cw, const float* cb, const float* buf) {
    return cb[ch] + cw[ch] * buf[ch] + cw[nch + ch] * buf[nch + ch] + cw[2 * nch + ch] * buf[2 * nch + ch] + cw[3 * nch + ch] * (ps4(prow + col + ch) * rs);
}
constexpr int SM_Q = 0, SM_K = 1024, SM_F = 2048, SM_V = 3072, SM_O = 4096, SM_WS = 5120, SM_PART = 5376;
DI void sample_item(const Ctx& c, int l, int s, int type) {
    LAS float* sm = (LAS float*)c.lds;
    LAS float* QS = sm + SM_Q; LAS float* KS = sm + SM_K; LAS float* FS = sm + SM_F; LAS float* VS = sm + SM_V; LAS float* OS_ = sm + SM_O; LAS float* WSUM = sm + SM_WS;
    const int tid = get_tid(c.wave), lane = tid & 63, w = c.wave;
    const float* pr = c.projs + (size_t)s * LDP; const float rs = row_rstd(c.rowsq + (size_t)l * M_PAD, TP + s);
    __syncthreads();
    if (type == 0) {
#pragma unroll
        for (int e = 0; e < 2; ++e) { const int ch = 2 * tid + e; const float qraw = (ps4(pr + C_HGQ + ch) * rs), fraw = (ps4(pr + C_HGF + ch) * rs), lbv = c.lb[(size_t)l * 1024 + ch];
            QS[ch] = silu(qraw); FS[ch] = fmaxf(lbv + (1.0f - lbv) * sigm(fraw), TINY); KS[ch] = (1.0f - lbv) * sigm(-fraw); VS[ch] = (ps4(pr + C_HGI + ch) * rs); }
    } else if (type == 1) {
#pragma unroll
        for (int e = 0; e < 2; ++e) { const int ch = 2 * tid + e; VS[ch] = (ps4(pr + C_GLV + ch) * rs);
            if (tid < 256) { QS[ch] = (ps4(pr + C_GLQ + ch) * rs) * 0.08838834764831845f; KS[ch] = (ps4(pr + C_GLK + ch) * rs);
                const float z = (ps4(pr + C_GLF + ch) * rs) + c.in[I_GBU][(size_t)l * 512 + ch]; FS[ch] = fexp(-softplus(-z) * (1.0f / 16.0f)); } }
    } else {
        const float* scw = c.in[I_SCW] + (size_t)l * 4 * 1536; const float* scb = c.in[I_SCB] + (size_t)l * 1536;
        const float* sbuf = c.in[I_SSSDC] + ((size_t)l * DEC + s) * 3 * 1536;
#pragma unroll
        for (int e = 0; e < 2; ++e) { const int ch = 2 * tid + e; VS[ch] = silu(conv1(pr, rs, C_XBC, ch, 1536, scw, scb, sbuf)); }
        if (tid < 256) { KS[tid] = silu(conv1(pr, rs, C_XBC, 1024 + tid, 1536, scw, scb, sbuf)); QS[tid] = silu(conv1(pr, rs, C_XBC, 1280 + tid, 1536, scw, scb, sbuf)); }
        if (tid < 16) { const float dt = softplus((ps4(pr + C_DT + tid) * rs) + c.in[I_DTB][l * 16 + tid]); FS[tid] = dt; FS[16 + tid] = fexp(-dt * expf(c.in[I_ALOG][l * 16 + tid])); }
    }
    __syncthreads();
    if (type < 2) {
        const int h = type == 0 ? w : (w >> 1), RS = type == 0 ? 128 : 256, voff = type == 0 ? 0 : 128 * (w & 1);
        const size_t sb = type == 0 ? (((size_t)l * DEC + s) * 8 + h) * 16384 : (((size_t)l * DEC + s) * 4 + h) * 32768;
        const float* s0 = (type == 0 ? c.in[I_SHG] : c.in[I_SGLA]) + sb; float* so = c.out + (type == 0 ? O_HG_S : O_GLA_S) + sb;
        const int vq = lane & 31, kh = lane >> 5, vb = (type == 0 ? h * 128 : h * 256 + voff) + 4 * vq, qb = h * 128;
        const f32x4 vv = *(const LAS f32x4*)(VS + vb); f32x4 o4 = (f32x4){0.f, 0.f, 0.f, 0.f};
        const int eo = kh * RS + voff + 4 * vq;
#pragma unroll 2
        for (int k8 = 0; k8 < 64; k8 += 8) {
            f32x4 st[8];
#pragma unroll
            for (int u = 0; u < 8; ++u) st[u] = *(const f32x4*)(s0 + (size_t)(2 * (k8 + u)) * RS + eo);
#pragma unroll
            for (int u = 0; u < 8; ++u) { const int k = 2 * (k8 + u) + kh; const float fk = FS[qb + k], kk = KS[qb + k], qk = QS[qb + k];
                st[u] = st[u] * fk + vv * kk; o4 += st[u] * qk; *(f32x4*)(so + (size_t)(2 * (k8 + u)) * RS + eo) = st[u]; }
        }
        o4.x += shx(o4.x, 32, lane); o4.y += shx(o4.y, 32, lane); o4.z += shx(o4.z, 32, lane); o4.w += shx(o4.w, 32, lane);
        if (kh == 0) *(LAS f32x4*)(OS_ + vb) = o4;
    } else {
        LAS float* PART = sm + SM_PART + w * 2304;
        const int nq = lane & 31, ph = lane >> 5, g = w >> 2;
        const f32x4 B4 = *(const LAS f32x4*)(KS + g * 128 + 4 * nq), C4 = *(const LAS f32x4*)(QS + g * 128 + 4 * nq);
#pragma unroll 1
        for (int hx = 0; hx < 2; ++hx) { const int h = 2 * w + hx;
            const size_t sb = (((size_t)l * DEC + s) * 16 + h) * 8192;
            const float* s0 = c.in[I_SSSD] + sb; float* so = c.out + O_SSD_S + sb;
            const float dt = FS[h], dA = FS[16 + h];
            const int eo = ph * 128 + 4 * nq;
#pragma unroll 2
            for (int p8 = 0; p8 < 32; p8 += 8) {
                f32x4 st[8];
#pragma unroll
                for (int u = 0; u < 8; ++u) st[u] = *(const f32x4*)(s0 + (size_t)(2 * (p8 + u)) * 128 + eo);
#pragma unroll
                for (int u = 0; u < 8; ++u) { const int p = 2 * (p8 + u) + ph; const float xv = VS[h * 64 + p] * dt;
                    st[u] = st[u] * dA + B4 * xv; *(f32x4*)(so + (size_t)(2 * (p8 + u)) * 128 + eo) = st[u];
                    PART[p * 36 + nq] = (st[u].x * C4.x + st[u].y * C4.y) + (st[u].z * C4.z + st[u].w * C4.w); }
            }
            asm volatile("s_waitcnt lgkmcnt(0)" ::: "memory");
            { float o = 0.f;
#pragma unroll
              for (int q = 0; q < 8; ++q) { const f32x4 t = *(const LAS f32x4*)(PART + lane * 36 + 4 * q); o += (t.x + t.y) + (t.z + t.w); }
              const float x = VS[h * 64 + lane], z = (ps4(pr + C_SSZ + h * 64 + lane) * rs);
              OS_[h * 64 + lane] = (o + c.in[I_SD][l * 16 + h] * x) * silu(z); }
            asm volatile("s_waitcnt lgkmcnt(0)" ::: "memory");
        }
    }
    __syncthreads();
    { const f32x2 o2 = *(const LAS f32x2*)(OS_ + 2 * tid);
      const float ssw = wave_sum(o2.x * o2.x + o2.y * o2.y, lane);
      if (lane == 0) WSUM[w] = ssw;
      __syncthreads();
      float ss, gsz; const float* nw; int mcol, gcol = 0;
      if (type == 0) { ss = WSUM[w]; gsz = 128.f; nw = c.in[I_HGN] + (size_t)l * 1024; mcol = 0; gcol = C_HGG; }
      else if (type == 1) { ss = WSUM[w & ~1] + WSUM[w | 1]; gsz = 256.f; nw = c.in[I_GLN] + (size_t)l * 1024; mcol = 2048; gcol = C_GLG; }
      else { const int b4 = w & ~3; ss = (WSUM[b4] + WSUM[b4 + 1]) + (WSUM[b4 + 2] + WSUM[b4 + 3]); gsz = 512.f; nw = c.in[I_SSN] + (size_t)l * 1024; mcol = 3072; }
      const float rstd = rsqrtf(ss / gsz + EPS);
      float y0 = o2.x * rstd * nw[2 * tid], y1 = o2.y * rstd * nw[2 * tid + 1];
      if (type < 2) { y0 *= silu((ps4(pr + gcol + 2 * tid) * rs)); y1 *= silu((ps4(pr + gcol + 2 * tid + 1) * rs)); }
      *(unsigned*)(c.mix + (size_t)(TP + s) * D_MIX + mcol + 2 * tid) = pk2(y0, y1); }
}

DI void lds_barrier() { asm volatile("s_waitcnt lgkmcnt(0)\n\ts_barrier" ::: "memory"); }
DI f32x16 mfma32(bf16x8 a, bf16x8 b, f32x16 c) { return __builtin_amdgcn_mfma_f32_32x32x16_bf16(a, b, c, 0, 0, 0); }
DI bf16x8 ldfrag(const LAS unsigned char* p) { return *(const LAS bf16x8*)p; }
DI int crow(int i, int hh) { return (i & 3) + 8 * (i >> 2) + 4 * hh; }
constexpr int L_QP = 0, L_KP = 17408, L_KPT = 34816, L_VT = 53248, L_VT2 = 71680, L_AM = 90112, L_TOT = 108544, L_E1 = 112640, L_E2 = 113152, L_CUM = 113664;
constexpr int SQ = 272, SV = 144;
#define ZERO16(x) do { _Pragma("unroll") for (int _i = 0; _i < 16; ++_i) (x)[_i] = 0.f; } while (0)

template <int TYPE>
DI void la_head_unit(const Ctx& c, int l, int b, int hu) {
    constexpr int DV = 128, NSW = DV / 32, OS = DV * 2 + 16, NC = DV / 8;
    LAS unsigned char* L = c.lds;
    const int tid = get_tid(c.wave), lane = tid & 63, w = c.wave;
    const int r = lane & 31, hh = lane >> 5;
    const int row0 = b * SEQ;
    const bf16_t* P = TYPE == 2 ? c.xbcs : c.proj;
    constexpr int LDR = TYPE == 2 ? 1536 : LDP;
    LAS float* TOT = (LAS float*)(L + L_TOT); LAS float* E1 = (LAS float*)(L + L_E1); LAS float* E2 = (LAS float*)(L + L_E2);
    int colQ, colK, colG, colV, colGate, colOut, sidx; const int grp = hu >> 2;
    if constexpr (TYPE == 0) { colQ = C_HGQ + hu * 128; colK = 0; colG = C_HGF + hu * 128; colV = C_HGI + hu * 128; colGate = C_HGG + hu * 128; colOut = hu * 128; sidx = 0; }
    else if constexpr (TYPE == 1) { const int hd = hu >> 1; colQ = C_GLQ + hd * 128; colK = C_GLK + hd * 128; colG = C_GLF + hd * 128; colV = C_GLV + hu * 128; colGate = C_GLG + hu * 128; colOut = 2048 + hu * 128; sidx = 2 + hd; }
    else { colK = 1024 + grp * 128; colQ = 1280 + grp * 128; colG = 0; colV = hu * 128; colGate = C_SSZ + hu * 128; colOut = 3072 + hu * 128; sidx = grp; }
    float Ah[2], Dh[2];
    if constexpr (TYPE == 2) {
#pragma unroll
        for (int e = 0; e < 2; ++e) { Ah[e] = -expf(c.in[I_ALOG][l * 16 + 2 * hu + e]); Dh[e] = c.in[I_SD][l * 16 + 2 * hu + e]; }
    }
    unsigned r0[8], r1[8], r2[8], r3[8]; float dtn = 0.f;
#define LOAD_CHUNK(tn) do { const bf16_t* pq_ = P + (size_t)(row0 + (tn) + 8 * w) * LDR + 2 * lane; \
        if constexpr (TYPE == 0) { _Pragma("unroll") for (int i = 0; i < 8; ++i) { r0[i] = *(const unsigned*)(pq_ + (size_t)i * LDR + colQ); r1[i] = *(const unsigned*)(pq_ + (size_t)i * LDR + colG); r2[i] = *(const unsigned*)(pq_ + (size_t)i * LDR + colV); } } \
        else if constexpr (TYPE == 1) { _Pragma("unroll") for (int i = 0; i < 8; ++i) { r0[i] = *(const unsigned*)(pq_ + (size_t)i * LDR + colQ); r1[i] = *(const unsigned*)(pq_ + (size_t)i * LDR + colK); \
                                                                                       r2[i] = *(const unsigned*)(pq_ + (size_t)i * LDR + colG); r3[i] = *(const unsigned*)(pq_ + (size_t)i * LDR + colV); } } \
        else { _Pragma("unroll") for (int i = 0; i < 8; ++i) { r0[i] = *(const unsigned*)(pq_ + (size_t)i * LDR + colQ); r1[i] = *(const unsigned*)(pq_ + (size_t)i * LDR + colK); r2[i] = *(const unsigned*)(pq_ + (size_t)i * LDR + colV); } \
            if (w < 2) dtn = c.dtb[(size_t)(row0 + (tn) + lane) * 16 + 2 * hu + w]; } } while (0)
    f32x16 S[4];
#pragma unroll
    for (int kt = 0; kt < 4; ++kt) ZERO16(S[kt]);
    float e2pa = 1.f, e2pb = 1.f;
    constexpr bool PF = true;
    if constexpr (PF) LOAD_CHUNK(0);
    for (int ck = -(SEQ / 64) * (PROBE_LONG_REP - 1); ck < SEQ / 64; ++ck) {
        if (PROBE_LONG_REP > 1 && ck == 0) { e2pa = 1.f; e2pb = 1.f;
#pragma unroll
            for (int kt = 0; kt < 4; ++kt) ZERO16(S[kt]); }
        const int t0 = (ck & (SEQ / 64 - 1)) * 64;
        LAS float* CUM = (LAS float*)(L + L_CUM + (ck & 1) * 1536);
        if constexpr (!PF) LOAD_CHUNK(t0);
        float qa[8], qb[8], ka[8], kb[8], ga[8], gb[8], xa[8], xb[8]; unsigned uv[8];
        if constexpr (TYPE == 0) {
            float ta = 0.f, tb = 0.f;
#pragma unroll
            for (int i = 0; i < 8; ++i) { qa[i] = bflo(r0[i]); qb[i] = bfhi(r0[i]); const float g0 = bflo(r1[i]), g1 = bfhi(r1[i]); uv[i] = r2[i];
                ka[i] = 1.0f - fexp(g0); kb[i] = 1.0f - fexp(g1); ta += g0; tb += g1; ga[i] = ta; gb[i] = tb; }
            *(LAS f32x2*)(TOT + w * 128 + 2 * lane) = (f32x2){ta, tb};
        } else if constexpr (TYPE == 1) {
            float ta = 0.f, tb = 0.f;
#pragma unroll
            for (int i = 0; i < 8; ++i) { qa[i] = bflo(r0[i]); qb[i] = bfhi(r0[i]); ka[i] = bflo(r1[i]); kb[i] = bfhi(r1[i]); ta += bflo(r2[i]); tb += bfhi(r2[i]); ga[i] = ta; gb[i] = tb; uv[i] = r3[i]; }
            *(LAS f32x2*)(TOT + w * 128 + 2 * lane) = (f32x2){ta, tb};
        } else {
#pragma unroll
            for (int i = 0; i < 8; ++i) { qa[i] = bflo(r0[i]); qb[i] = bfhi(r0[i]); ka[i] = bflo(r1[i]); kb[i] = bfhi(r1[i]); xa[i] = bflo(r2[i]); xb[i] = bfhi(r2[i]); }
            if (w < 2) {
                const float dt = dtn; float x = dt * (w == 0 ? Ah[0] : Ah[1]);
#pragma unroll
                for (int o = 1; o < 64; o <<= 1) { const float y = shup(x, o, lane); if (lane >= o) x += y; }
                CUM[w * 192 + lane] = x; CUM[w * 192 + 64 + lane] = fmaxf(dt, 1e-30f); CUM[w * 192 + 128 + lane] = fexp(x);
            }
        }
        lds_barrier();
        if constexpr (TYPE < 2) {
            float offa = 0.f, offb = 0.f, brefa = 0.f, brefb = 0.f, bla = 0.f, blb = 0.f;
#pragma unroll
            for (int g = 0; g < 8; ++g) { const f32x2 t = *(const LAS f32x2*)(TOT + g * 128 + 2 * lane);
                if (g < w) { offa += t.x; offb += t.y; }
                if (g < 4) { brefa += t.x; brefb += t.y; }
                bla += t.x; blb += t.y; }
#pragma unroll
            for (int i = 0; i < 8; ++i) { const float da = clampf(ga[i] + offa - brefa, -80.f, 80.f), db = clampf(gb[i] + offb - brefb, -80.f, 80.f);
                qa[i] *= fexp(da); ka[i] *= fexp(-da); qb[i] *= fexp(db); kb[i] *= fexp(-db); }
            if (w == 0) {
                const float e2a = fexp(bla - brefa), e2b = fexp(blb - brefb);
                *(LAS f32x2*)(E1 + 2 * lane) = (f32x2){fexp(brefa) * e2pa, fexp(brefb) * e2pb}; *(LAS f32x2*)(E2 + 2 * lane) = (f32x2){e2a, e2b}; e2pa = e2a; e2pb = e2b; }
        }
#pragma unroll
        for (int i = 0; i < 8; ++i) { *(LAS unsigned*)(L + L_QP + (8 * w + i) * SQ + 4 * lane) = pk2(qa[i], qb[i]); *(LAS unsigned*)(L + L_KP + (8 * w + i) * SQ + 4 * lane) = pk2(ka[i], kb[i]); }
        { u32x4 a, bq; a.x = pk2(ka[0], ka[1]); a.y = pk2(ka[2], ka[3]); a.z = pk2(ka[4], ka[5]); a.w = pk2(ka[6], ka[7]);
          bq.x = pk2(kb[0], kb[1]); bq.y = pk2(kb[2], kb[3]); bq.z = pk2(kb[4], kb[5]); bq.w = pk2(kb[6], kb[7]);
          *(LAS u32x4*)(L + L_KPT + (2 * lane) * SV + 16 * w) = a; *(LAS u32x4*)(L + L_KPT + (2 * lane + 1) * SV + 16 * w) = bq; }
        if constexpr (TYPE < 2) {
            u32x4 a, bq;
            a.x = (uv[0] & 0xffffu) | (uv[1] << 16); a.y = (uv[2] & 0xffffu) | (uv[3] << 16); a.z = (uv[4] & 0xffffu) | (uv[5] << 16); a.w = (uv[6] & 0xffffu) | (uv[7] << 16);
            bq.x = (uv[0] >> 16) | (uv[1] & 0xffff0000u); bq.y = (uv[2] >> 16) | (uv[3] & 0xffff0000u); bq.z = (uv[4] >> 16) | (uv[5] & 0xffff0000u); bq.w = (uv[6] >> 16) | (uv[7] & 0xffff0000u);
            *(LAS u32x4*)(L + L_VT + (2 * lane) * SV + 16 * w) = a; *(LAS u32x4*)(L + L_VT + (2 * lane + 1) * SV + 16 * w) = bq;
        } else {
            const int hs = lane >> 5;
            const LAS float* cm = CUM + hs * 192; const float cl = cm[63];
            float v1a[8], v1b[8], v2a[8], v2b[8];
#pragma unroll
            for (int j = 0; j < 8; ++j) { const int s = 8 * w + j; const float dt = cm[64 + s], wgt = fexp(fminf(cl - cm[s], 0.f));
                v1a[j] = dt * xa[j]; v1b[j] = dt * xb[j]; v2a[j] = v1a[j] * wgt; v2b[j] = v1b[j] * wgt; }
            u32x4 a, bq;
            a.x = pk2(v1a[0], v1a[1]); a.y = pk2(v1a[2], v1a[3]); a.z = pk2(v1a[4], v1a[5]); a.w = pk2(v1a[6], v1a[7]);
            bq.x = pk2(v1b[0], v1b[1]); bq.y = pk2(v1b[2], v1b[3]); bq.z = pk2(v1b[4], v1b[5]); bq.w = pk2(v1b[6], v1b[7]);
            *(LAS u32x4*)(L + L_VT + (2 * lane) * SV + 16 * w) = a; *(LAS u32x4*)(L + L_VT + (2 * lane + 1) * SV + 16 * w) = bq;
            a.x = pk2(v2a[0], v2a[1]); a.y = pk2(v2a[2], v2a[3]); a.z = pk2(v2a[4], v2a[5]); a.w = pk2(v2a[6], v2a[7]);
            bq.x = pk2(v2b[0], v2b[1]); bq.y = pk2(v2b[2], v2b[3]); bq.z = pk2(v2b[4], v2b[5]); bq.w = pk2(v2b[6], v2b[7]);
            *(LAS u32x4*)(L + L_VT2 + (2 * lane) * SV + 16 * w) = a; *(LAS u32x4*)(L + L_VT2 + (2 * lane + 1) * SV + 16 * w) = bq;
        }
        lds_barrier();
        if constexpr (PF) { if (ck + 1 < SEQ / 64) LOAD_CHUNK(((ck + 1) & (SEQ / 64 - 1)) * 64); }
        if (w >= 5) {
            const int sb = (w == 7) ? 1 : 0, tb = (w == 5) ? 0 : 1;
            f32x16 X; ZERO16(X);
#pragma unroll
            for (int k4 = 0; k4 < 8; k4 += 4) { bf16x8 fk[4], fq[4];
#pragma unroll
                for (int u = 0; u < 4; ++u) { fk[u] = ldfrag(L + L_KP + (32 * sb + r) * SQ + (16 * (k4 + u) + 8 * hh) * 2); fq[u] = ldfrag(L + L_QP + (32 * tb + r) * SQ + (16 * (k4 + u) + 8 * hh) * 2); }
#pragma unroll
                for (int u = 0; u < 4; ++u) X = mfma32(fk[u], fq[u], X); }
            const int t = 32 * tb + r;
#pragma unroll
            for (int hs = 0; hs < (TYPE == 2 ? 2 : 1); ++hs) {
                float ct = 0.f, ddt = 0.f;
                if constexpr (TYPE == 2) { ct = CUM[hs * 192 + t]; ddt = (hs == 0 ? Dh[0] : Dh[1]) / CUM[hs * 192 + 64 + t]; }
#pragma unroll
                for (int g = 0; g < 4; ++g) { const int s0 = 32 * sb + 8 * g + 4 * hh;
                    float x0 = X[4 * g], x1 = X[4 * g + 1], x2 = X[4 * g + 2], x3 = X[4 * g + 3];
                    if constexpr (TYPE == 2) { const f32x4 cs = *(const LAS f32x4*)(CUM + hs * 192 + s0);
                        x0 *= fexp(fminf(ct - cs.x, 0.f)); x1 *= fexp(fminf(ct - cs.y, 0.f)); x2 *= fexp(fminf(ct - cs.z, 0.f)); x3 *= fexp(fminf(ct - cs.w, 0.f));
                        x0 += (s0 == t) ? ddt : 0.f; x1 += (s0 + 1 == t) ? ddt : 0.f; x2 += (s0 + 2 == t) ? ddt : 0.f; x3 += (s0 + 3 == t) ? ddt : 0.f; }
                    x0 = (s0 <= t) ? x0 : 0.f; x1 = (s0 + 1 <= t) ? x1 : 0.f; x2 = (s0 + 2 <= t) ? x2 : 0.f; x3 = (s0 + 3 <= t) ? x3 : 0.f;
                    u32x2 p; p.x = pk2(x0, x1); p.y = pk2(x2, x3);
                    *(LAS u32x2*)(L + L_AM + hs * 9216 + t * SV + s0 * 2) = p; }
            }
        }
        f32x16 O[2]; bf16x8 Bv[4];
        const int hsw = w >> 1;
        if (w < NSW) {
            if constexpr (TYPE < 2) {
#pragma unroll
                for (int kt = 0; kt < 4; ++kt)
#pragma unroll
                    for (int g = 0; g < 4; ++g) { const f32x4 e = *(const LAS f32x4*)(E1 + 32 * kt + 8 * g + 4 * hh);
                        S[kt][4 * g] *= e.x; S[kt][4 * g + 1] *= e.y; S[kt][4 * g + 2] *= e.z; S[kt][4 * g + 3] *= e.w; }
            }
            ZERO16(O[0]); ZERO16(O[1]);
#pragma unroll
            for (int kt = 0; kt < 4; ++kt) {
                u32x2 ql[2][2], qh[2][2];
#pragma unroll
                for (int s = 0; s < 2; ++s)
#pragma unroll
                    for (int tt = 0; tt < 2; ++tt) { const LAS unsigned char* qp = L + L_QP + (32 * tt + r) * SQ + (32 * kt + 16 * s + 4 * hh) * 2;
                        ql[s][tt] = *(const LAS u32x2*)qp; qh[s][tt] = *(const LAS u32x2*)(qp + 16); }
#pragma unroll
                for (int s = 0; s < 2; ++s) {
                    u32x4 pa; pa.x = pk2(S[kt][8 * s], S[kt][8 * s + 1]); pa.y = pk2(S[kt][8 * s + 2], S[kt][8 * s + 3]); pa.z = pk2(S[kt][8 * s + 4], S[kt][8 * s + 5]); pa.w = pk2(S[kt][8 * s + 6], S[kt][8 * s + 7]);
                    const bf16x8 A = __builtin_bit_cast(bf16x8, pa);
#pragma unroll
                    for (int tt = 0; tt < 2; ++tt) O[tt] = mfma32(A, __builtin_bit_cast(bf16x8, (u32x4){ql[s][tt].x, ql[s][tt].y, qh[s][tt].x, qh[s][tt].y}), O[tt]);
                }
            }
            if constexpr (TYPE == 2) {
                const LAS float* cm = CUM + hsw * 192; const float e0 = cm[128 + r], e1 = cm[128 + 32 + r], sc = cm[128 + 63];
#pragma unroll
                for (int i = 0; i < 16; ++i) { O[0][i] *= e0; O[1][i] *= e1; }
#pragma unroll
                for (int kt = 0; kt < 4; ++kt)
#pragma unroll
                    for (int i = 0; i < 16; ++i) S[kt][i] *= sc;
            }
#pragma unroll
            for (int st = 0; st < 4; ++st) { bf16x8 kf[4];
                Bv[st] = ldfrag(L + (TYPE == 2 ? L_VT2 : L_VT) + (32 * w + r) * SV + (16 * st + 8 * hh) * 2);
#pragma unroll
                for (int kt = 0; kt < 4; ++kt) kf[kt] = ldfrag(L + L_KPT + (32 * kt + r) * SV + (16 * st + 8 * hh) * 2);
#pragma unroll
                for (int kt = 0; kt < 4; ++kt) S[kt] = mfma32(kf[kt], Bv[st], S[kt]); }
        }
        const int nt_ = tid >> 3, nseg = tid & 7;
        u32x4 gq[NC / 8];
        { const bf16_t* pg = c.proj + (size_t)(row0 + t0 + nt_) * LDP + colGate + nseg * NC;
#pragma unroll
          for (int q = 0; q < NC / 8; ++q) gq[q] = *(const u32x4*)(pg + 8 * q); }
        lds_barrier();
        if (w < NSW) {
#pragma unroll
            for (int st = 0; st < 4; ++st) { bf16x8 Av = Bv[st];
                if constexpr (TYPE == 2) Av = ldfrag(L + L_VT + (32 * w + r) * SV + (16 * st + 8 * hh) * 2);
#pragma unroll
                for (int tt = 0; tt < 2; ++tt) if (st < 2 || tt == 1)
                    O[tt] = mfma32(Av, ldfrag(L + L_AM + (TYPE == 2 ? hsw * 9216 : 0) + (32 * tt + r) * SV + (16 * st + 8 * hh) * 2), O[tt]); }
#pragma unroll
            for (int tt = 0; tt < 2; ++tt)
#pragma unroll
                for (int g = 0; g < 4; ++g) { u32x2 p; p.x = pk2(O[tt][4 * g], O[tt][4 * g + 1]); p.y = pk2(O[tt][4 * g + 2], O[tt][4 * g + 3]);
                    *(LAS u32x2*)(L + (32 * tt + r) * OS + (32 * w + 8 * g + 4 * hh) * 2) = p; }
        }
        lds_barrier();
        {
            float o[NC], gv[NC]; float ss = 0.f;
#pragma unroll
            for (int q = 0; q < NC / 8; ++q) { const u32x4 ov = *(const LAS u32x4*)(L + nt_ * OS + (nseg * NC + 8 * q) * 2);
                o[8 * q] = bflo(ov.x); o[8 * q + 1] = bfhi(ov.x); o[8 * q + 2] = bflo(ov.y); o[8 * q + 3] = bfhi(ov.y); o[8 * q + 4] = bflo(ov.z); o[8 * q + 5] = bfhi(ov.z); o[8 * q + 6] = bflo(ov.w); o[8 * q + 7] = bfhi(ov.w);
                gv[8 * q] = bflo(gq[q].x); gv[8 * q + 1] = bfhi(gq[q].x); gv[8 * q + 2] = bflo(gq[q].y); gv[8 * q + 3] = bfhi(gq[q].y); gv[8 * q + 4] = bflo(gq[q].z); gv[8 * q + 5] = bfhi(gq[q].z); gv[8 * q + 6] = bflo(gq[q].w); gv[8 * q + 7] = bfhi(gq[q].w); }
            if constexpr (TYPE == 2) {
#pragma unroll
                for (int e = 0; e < NC; ++e) o[e] *= gv[e];
            }
#pragma unroll
            for (int e = 0; e < NC; ++e) ss += o[e] * o[e];
            ss += shx(ss, 1, lane); ss += shx(ss, 2, lane); ss += shx(ss, 4, lane);
            float mul = 1.0f;
            if constexpr (TYPE == 0) mul = rsqrtf(ss * (1.0f / DV) + EPS);
            else { if (nseg == 0 && ck >= 0) atomicAdd((float*)(c.ctl + CW_STATS) + ((size_t)l * TP + row0 + t0 + nt_) * 6 + sidx, ss); }
            if constexpr (TYPE < 2) {
#pragma unroll
                for (int e = 0; e < NC; ++e) o[e] *= mul * gv[e];
            }
            bf16_t* pm = c.mix + (size_t)(row0 + t0 + nt_) * D_MIX + colOut + nseg * NC;
#pragma unroll
            for (int q = 0; q < NC / 8; ++q) { u32x4 ov; ov.x = pk2(o[8 * q], o[8 * q + 1]); ov.y = pk2(o[8 * q + 2], o[8 * q + 3]); ov.z = pk2(o[8 * q + 4], o[8 * q + 5]); ov.w = pk2(o[8 * q + 6], o[8 * q + 7]);
                *(u32x4*)(pm + 8 * q) = ov; }
        }
    }
#undef LOAD_CHUNK
    if (w < NSW) {
        const int lane2 = get_tid(c.wave) & 63, r = lane2 & 31, hh = lane2 >> 5;
        if constexpr (TYPE < 2) {
#pragma unroll
            for (int kt = 0; kt < 4; ++kt)
#pragma unroll
                for (int g = 0; g < 4; ++g) { const f32x4 e = *(const LAS f32x4*)(E2 + 32 * kt + 8 * g + 4 * hh);
                    S[kt][4 * g] *= e.x; S[kt][4 * g + 1] *= e.y; S[kt][4 * g + 2] *= e.z; S[kt][4 * g + 3] *= e.w; }
        }
        float* sout; int sk, sv, vb;
        if constexpr (TYPE == 0) { sout = c.out + O_HG_P + (((size_t)l * NB + b) * 8 + hu) * 16384; sk = 128; sv = 1; vb = 32 * w; }
        else if constexpr (TYPE == 1) { sout = c.out + O_GLA_P + (((size_t)l * NB + b) * 4 + (hu >> 1)) * 32768; sk = 256; sv = 1; vb = 128 * (hu & 1) + 32 * w; }
        else { sout = c.out + O_SSD_P + (((size_t)l * NB + b) * 16 + 2 * hu + (w >> 1)) * 8192; sk = 1; sv = 128; vb = 32 * (w & 1); }
#pragma unroll
        for (int kt = 0; kt < 4; ++kt)
#pragma unroll
            for (int i = 0; i < 16; ++i) sout[(32 * kt + crow(i, hh)) * sk + (vb + r) * sv] = S[kt][i];
    }
}

constexpr int R_WT = 74752;
DI void rg_load_gates(const Ctx& c, int l, int n, int tid, int j, int hh, bf16x8 (&Br)[8], bf16x8 (&Bi)[8]) {
    LAS unsigned char* L = c.lds;
    const float* wr = c.in[I_WR] + (size_t)(l * 8 + n) * 128 * 128; const float* wi = c.in[I_WI] + (size_t)(l * 8 + n) * 128 * 128;
    __syncthreads();
    f32x4 v[16];
#pragma unroll
    for (int q = 0; q < 16; ++q) { const int e = tid + 512 * q, mat = e >> 12, rem = e & 4095; v[q] = *(const f32x4*)((mat ? wi : wr) + rem * 4); }
#pragma unroll
    for (int q = 0; q < 16; ++q) { const int e = tid + 512 * q, mat = e >> 12, rem = e & 4095, i = rem >> 5, j4 = (rem & 31) * 4;
        LAS unsigned char* p = L + R_WT + mat * 34816 + j4 * SQ + i * 2;
        *(LAS bf16_t*)(p) = (bf16_t)f2bf(v[q].x); *(LAS bf16_t*)(p + SQ) = (bf16_t)f2bf(v[q].y); *(LAS bf16_t*)(p + 2 * SQ) = (bf16_t)f2bf(v[q].z); *(LAS bf16_t*)(p + 3 * SQ) = (bf16_t)f2bf(v[q].w); }
    __syncthreads();
#pragma unroll
    for (int ks = 0; ks < 8; ++ks) { Br[ks] = ldfrag(L + R_WT + j * SQ + (16 * ks + 8 * hh) * 2); Bi[ks] = ldfrag(L + R_WT + 34816 + j * SQ + (16 * ks + 8 * hh) * 2); }
}
constexpr int R_XCB = 0, R_XCF = 17408, R_SUMA = 50176, R_SUMU = 58368, R_HIN = 66560;
DI void rg_chunk_unit(const Ctx& c, int l, int b, int n) {
    LAS unsigned char* L = c.lds;
    const int tid = get_tid(c.wave), lane = tid & 63, w = c.wave, r = lane & 31, hh = lane >> 5;
    const int tb = w >> 2, jb = w & 3;
    const int j = 32 * jb + r, ch = n * 128 + j;
    const int row0 = b * SEQ;
    const bf16_t* P = c.proj;
    LAS float* XCF = (LAS float*)(L + R_XCF); LAS float* SUMA = (LAS float*)(L + R_SUMA); LAS float* SUMU = (LAS float*)(L + R_SUMU); LAS float* HIN = (LAS float*)(L + R_HIN);
    bf16x8 Br[8], Bi[8];
    rg_load_gates(c, l, n, tid, j, hh, Br, Bi);
    const float sp = softplus(-c.in[I_LAM][l * 1024 + ch]), brv = c.in[I_BR][(l * 8 + n) * 128 + j], biv = c.in[I_BI][(l * 8 + n) * 128 + j];
    float cw[4][2], cb[2];
#pragma unroll
    for (int e = 0; e < 2; ++e) {
#pragma unroll
        for (int m = 0; m < 4; ++m) cw[m][e] = c.in[I_RCW][l * 4 * 1024 + m * 1024 + n * 128 + 2 * lane + e];
        cb[e] = c.in[I_RCB][l * 1024 + n * 128 + 2 * lane + e]; }
    float hcarry = 0.f;
    for (int ck = -(SEQ / 64) * (PROBE_RG_REP - 1); ck < SEQ / 64; ++ck) {
        if (PROBE_RG_REP > 1 && ck == 0) hcarry = 0.f;
        const int t0 = (ck & (SEQ / 64 - 1)) * 64;
        { const bf16_t* pq = P + (size_t)(row0 + t0 + 8 * w) * LDP + C_RGX + n * 128 + 2 * lane; const bool first = (t0 == 0 && w == 0);
          unsigned ux[11];
#pragma unroll
          for (int jx = 0; jx < 11; ++jx) ux[jx] = (first && jx < 3) ? 0u : *(const unsigned*)(pq + (ptrdiff_t)(jx - 3) * LDP);
#pragma unroll
          for (int i = 0; i < 8; ++i) { const int t = 8 * w + i;
              const float x0 = cb[0] + cw[0][0] * bflo(ux[i]) + cw[1][0] * bflo(ux[i + 1]) + cw[2][0] * bflo(ux[i + 2]) + cw[3][0] * bflo(ux[i + 3]);
              const float x1 = cb[1] + cw[0][1] * bfhi(ux[i]) + cw[1][1] * bfhi(ux[i + 1]) + cw[2][1] * bfhi(ux[i + 2]) + cw[3][1] * bfhi(ux[i + 3]);
              *(LAS f32x2*)(XCF + t * 128 + 2 * lane) = (f32x2){x0, x1}; *(LAS unsigned*)(L + R_XCB + t * SQ + 4 * lane) = pk2(x0, x1); } }
        float gt[16];
        { const bf16_t* pg = P + (size_t)(row0 + t0 + 32 * tb) * LDP; const int goff = 4 * hh * LDP + C_RGG + ch;
#pragma unroll
          for (int i = 0; i < 16; ++i) gt[i] = bf1((pg + (size_t)((i & 3) + 8 * (i >> 2)) * LDP)[goff]); }
        lds_barrier();
        f32x16 R, I; ZERO16(R); ZERO16(I);
#pragma unroll
        for (int ks = 0; ks < 8; ++ks) { const bf16x8 a = ldfrag(L + R_XCB + (32 * tb + r) * SQ + (16 * ks + 8 * hh) * 2); R = mfma32(a, Br[ks], R); I = mfma32(a, Bi[ks], I); }
        float av[16], uv[16];
#pragma unroll
        for (int i = 0; i < 16; ++i) { const int t = 32 * tb + crow(i, hh); const float rr = sigm_fast(R[i] + brv), ii = sigm_fast(I[i] + biv), xc = XCF[t * 128 + j];
            const float la = -8.0f * rr * sp; av[i] = fexp(la); uv[i] = sqrtf(fmaxf(neg_expm1(2.0f * la), 0.f)) * (ii * xc); }
#pragma unroll
        for (int g = 0; g < 4; ++g) { float A = 1.f, U = 0.f;
#pragma unroll
            for (int m = 0; m < 4; ++m) { U = av[4 * g + m] * U + uv[4 * g + m]; A *= av[4 * g + m]; }
            const int gi = 8 * tb + 2 * g + hh; SUMA[gi * 128 + j] = A; SUMU[gi * 128 + j] = U; }
        lds_barrier();
        if (tid < 128) { float hc = hcarry;
#pragma unroll
            for (int gi = 0; gi < 16; ++gi) { HIN[gi * 128 + tid] = hc; hc = SUMA[gi * 128 + tid] * hc + SUMU[gi * 128 + tid]; }
            hcarry = hc; }
        lds_barrier();
        { bf16_t* pm = c.mix + (size_t)(row0 + t0 + 32 * tb) * D_MIX; const int moff = 4 * hh * D_MIX + 1024 + ch;
#pragma unroll
          for (int g = 0; g < 4; ++g) { float hc = HIN[(8 * tb + 2 * g + hh) * 128 + j];
#pragma unroll
            for (int m = 0; m < 4; ++m) { const int i = 4 * g + m; hc = av[i] * hc + uv[i];
                (pm + (size_t)((i & 3) + 8 * (i >> 2)) * D_MIX)[moff] = (bf16_t)f2bf(hc * gt[i]); } } }
    }
    if (tid < 128) c.out[O_RG_P + ((size_t)l * NB + b) * 1024 + n * 128 + tid] = hcarry;
}

DI void rg_sample_unit(const Ctx& c, int l, int n) {
    LAS unsigned char* L = c.lds;
    const int tid = get_tid(c.wave), lane = tid & 63, w = c.wave, r = lane & 31, hh = lane >> 5;
    const int tb = w >> 2, jb = w & 3;
    const int j = 32 * jb + r, ch = n * 128 + j;
    LAS float* XCF = (LAS float*)(L + R_XCF);
    bf16x8 Br[8], Bi[8];
    rg_load_gates(c, l, n, tid, j, hh, Br, Bi);
    const float sp = softplus(-c.in[I_LAM][l * 1024 + ch]), brv = c.in[I_BR][(l * 8 + n) * 128 + j], biv = c.in[I_BI][(l * 8 + n) * 128 + j];
    float cw[4][2], cb[2];
#pragma unroll
    for (int e = 0; e < 2; ++e) {
#pragma unroll
        for (int m = 0; m < 4; ++m) cw[m][e] = c.in[I_RCW][l * 4 * 1024 + m * 1024 + n * 128 + 2 * lane + e];
        cb[e] = c.in[I_RCB][l * 1024 + n * 128 + 2 * lane + e]; }
    for (int chunk = 0; chunk < 2; ++chunk) {
        __syncthreads();
#pragma unroll
        for (int i = 0; i < 8; ++i) { const int t = 8 * w + i, s = 64 * chunk + t;
            const float* buf = c.in[I_SRGC] + ((size_t)l * DEC + s) * 3 * 1024 + n * 128 + 2 * lane;
            const f32x2 b0 = *(const f32x2*)buf, b1 = *(const f32x2*)(buf + 1024), b2 = *(const f32x2*)(buf + 2048), xn = (f32x2){ps4(c.projs + (size_t)s * LDP + C_RGX + n * 128 + 2 * lane), ps4(c.projs + (size_t)s * LDP + C_RGX + n * 128 + 2 * lane + 1)} * row_rstd(c.rowsq + (size_t)l * M_PAD, TP + s);
            const float x0 = cb[0] + cw[0][0] * b0.x + cw[1][0] * b1.x + cw[2][0] * b2.x + cw[3][0] * xn.x;
            const float x1 = cb[1] + cw[0][1] * b0.y + cw[1][1] * b1.y + cw[2][1] * b2.y + cw[3][1] * xn.y;
            *(LAS f32x2*)(XCF + t * 128 + 2 * lane) = (f32x2){x0, x1}; *(LAS unsigned*)(L + R_XCB + t * SQ + 4 * lane) = pk2(x0, x1); }
        __syncthreads();
        f32x16 R, I; ZERO16(R); ZERO16(I);
#pragma unroll
        for (int ks = 0; ks < 8; ++ks) { const bf16x8 a = ldfrag(L + R_XCB + (32 * tb + r) * SQ + (16 * ks + 8 * hh) * 2); R = mfma32(a, Br[ks], R); I = mfma32(a, Bi[ks], I); }
#pragma unroll
        for (int i = 0; i < 16; ++i) { const int t = 32 * tb + crow(i, hh), s = 64 * chunk + t;
            const float rr = sigm(R[i] + brv), ii = sigm(I[i] + biv), xc = XCF[t * 128 + j];
            const float la = -8.0f * rr * sp, a = fexp(la);
            const float hn = a * c.in[I_SRG][((size_t)l * DEC + s) * 1024 + ch] + sqrtf(fmaxf(neg_expm1(2.0f * la), 0.f)) * (ii * xc);
            c.mix[(size_t)(TP + s) * D_MIX + 1024 + ch] = (bf16_t)f2bf(hn * silu(ps4(c.projs + (size_t)s * LDP + C_RGG + ch) * row_rstd(c.rowsq + (size_t)l * M_PAD, TP + s)));
            c.out[O_RG_S + ((size_t)l * DEC + s) * 1024 + ch] = hn; }
    }
}

#ifndef PROBE_REP_LONG
#define PROBE_REP_LONG 1
#endif
#ifndef PROBE_G1_REP
#define PROBE_G1_REP 1
#endif
#ifndef PROBE_REP_SHORT
#define PROBE_REP_SHORT 1
#endif
DI void xbc_prepass_item(const Ctx& c, int l, int it) {
    const int tid = get_tid(c.wave);
    const float* scw = c.in[I_SCW] + (size_t)l * 4 * 1536; const float* scb = c.in[I_SCB] + (size_t)l * 1536;
    const int r0 = it * 32; const bool head = (r0 & (SEQ - 1)) == 0;
    for (int p = tid; p < 768; p += 512) {
        float cw[4][2], cb[2];
#pragma unroll
        for (int e = 0; e < 2; ++e) { cb[e] = scb[2 * p + e];
#pragma unroll
            for (int m = 0; m < 4; ++m) cw[m][e] = scw[m * 1536 + 2 * p + e]; }
        const bf16_t* src = c.proj + (size_t)r0 * LDP + C_XBC + 2 * p; bf16_t* dst = c.xbcs + (size_t)r0 * 1536 + 2 * p;
        unsigned u0 = head ? 0u : *(const unsigned*)(src - 3 * (ptrdiff_t)LDP), u1 = head ? 0u : *(const unsigned*)(src - 2 * (ptrdiff_t)LDP), u2 = head ? 0u : *(const unsigned*)(src - (ptrdiff_t)LDP);
#pragma unroll 8
        for (int i = 0; i < 32; ++i) { const unsigned u3 = *(const unsigned*)(src + (size_t)i * LDP);
            const float a = silu(cb[0] + cw[0][0] * bflo(u0) + cw[1][0] * bflo(u1) + cw[2][0] * bflo(u2) + cw[3][0] * bflo(u3));
            const float b = silu(cb[1] + cw[0][1] * bfhi(u0) + cw[1][1] * bfhi(u1) + cw[2][1] * bfhi(u2) + cw[3][1] * bfhi(u3));
            *(unsigned*)(dst + (size_t)i * 1536) = pk2(a, b); u0 = u1; u1 = u2; u2 = u3; }
    }
}
DI void phase_mixer(int l, int wv) {
    const Ctx c = make_ctx(wv);
    constexpr int PER_B = 8 + 8 + 8 + 8;
    constexpr int N_LONG = NB * PER_B, N_SHORT = 8 + DEC * 3;
    constexpr int NREP = 1;
    volatile LAS int* slot = (volatile LAS int*)(c.lds + MISC_OFF + 64);
    unsigned* xpre = c.ctl + CW_XPRE + 64 * l;
    if (c.wg >= N_LONG) {
        const int nfree = c.G - N_LONG; int done = 0;
        for (int it = c.wg - N_LONG; it < TP / 32; it += nfree) { xbc_prepass_item(c, l, it); ++done; }
        asm volatile("s_waitcnt vmcnt(0)" ::: "memory"); __syncthreads();
        if (c.tid == 0) { __builtin_amdgcn_fence(__ATOMIC_RELEASE, "agent"); asm volatile("s_waitcnt vmcnt(0)" ::: "memory"); __hip_atomic_fetch_add(xpre, (unsigned)done, __ATOMIC_RELAXED, __HIP_MEMORY_SCOPE_AGENT); }
    }
    for (int rep = 0; rep < NREP; ++rep) {
    unsigned* ctr = c.ctl + CW_QCTR + 64 * (l * 4 + rep);
    int cur = c.wg; bool dyn = false;
    for (;;) {
        int item;
        if (!dyn) { if (cur < N_LONG) { item = cur; cur += c.G; } else { dyn = true; continue; } }
        else {
            __syncthreads();
            if (c.tid == 0) *slot = (int)atomicAdd(ctr, 1u);
            __syncthreads();
            item = N_LONG + *slot;
            if (item >= N_LONG + N_SHORT) break;
        }
        if (item < N_LONG) {
            const int b = item & 3, u = item >> 2;
            if (u < 8) la_head_unit<1>(c, l, b, u); else if (u < 16) la_head_unit<0>(c, l, b, u - 8); else if (u < 24) {
                if (c.tid == 0) { unsigned sp = 0; while (__hip_atomic_load(xpre, __ATOMIC_RELAXED, __HIP_MEMORY_SCOPE_AGENT) < (unsigned)(TP / 32)) { __builtin_amdgcn_s_sleep(8); if (++sp > (1u << 22)) break; }
                    __builtin_amdgcn_fence(__ATOMIC_ACQUIRE, "agent"); asm volatile("s_waitcnt vmcnt(0)" ::: "memory"); }
                __syncthreads();
                la_head_unit<2>(c, l, b, u - 16); } else rg_chunk_unit(c, l, b, u - 24);
            __syncthreads();
        } else { const int it = item - N_LONG;
            for (int rp = 0; rp < PROBE_REP_SHORT; ++rp) { if (it < 8) rg_sample_unit(c, l, it); else sample_item(c, l, (it - 8) / 3, (it - 8) % 3); } }
    }
    __syncthreads();
    }
}

DI void phase_finalize(int l, int wv) {
    const Ctx c = make_ctx(wv);
    const int gw = c.wg * 8 + c.wave, NGW = c.G * 8, lane = c.lane;
    const float* ssn = c.in[I_SSN] + (size_t)l * 1024;
    const float* stats = (const float*)(c.ctl + CW_STATS) + (size_t)l * TP * 6;
    for (int r = gw; r < TP; r += NGW) {
        bf16_t* mrow = c.mix + (size_t)r * D_MIX;
        const float rs = rsqrtf(stats[(size_t)r * 6 + (lane >> 5)] * (1.0f / 512.0f) + EPS), rg = rsqrtf(stats[(size_t)r * 6 + 2 + (lane >> 4)] * (1.0f / 256.0f) + EPS);
        u32x4* ps = (u32x4*)(mrow + 3072 + lane * 16); u32x4* pgl = (u32x4*)(mrow + 2048 + lane * 16);
#pragma unroll
        for (int q = 0; q < 2; ++q) { const u32x4 ov = ps[q]; const f32x4 w0 = *(const f32x4*)(ssn + lane * 16 + 8 * q), w1 = *(const f32x4*)(ssn + lane * 16 + 8 * q + 4); u32x4 nv;
            nv.x = pk2(bflo(ov.x) * rs * w0.x, bfhi(ov.x) * rs * w0.y); nv.y = pk2(bflo(ov.y) * rs * w0.z, bfhi(ov.y) * rs * w0.w);
            nv.z = pk2(bflo(ov.z) * rs * w1.x, bfhi(ov.z) * rs * w1.y); nv.w = pk2(bflo(ov.w) * rs * w1.z, bfhi(ov.w) * rs * w1.w); ps[q] = nv;
            const u32x4 gv = pgl[q]; u32x4 ng;
            ng.x = pk2(bflo(gv.x) * rg, bfhi(gv.x) * rg); ng.y = pk2(bflo(gv.y) * rg, bfhi(gv.y) * rg); ng.z = pk2(bflo(gv.z) * rg, bfhi(gv.z) * rg); ng.w = pk2(bflo(gv.w) * rg, bfhi(gv.w) * rg); pgl[q] = ng; }
    }
    const int gt = c.wg * 512 + c.tid, NGT = c.G * 512;
    constexpr int PER_SEQ = 3 * 1024 + 3 * 1536;
    for (int i = gt; i < (NB + DEC) * PER_SEQ; i += NGT) {
        const int q = i / PER_SEQ, e = i % PER_SEQ; const bool prompt = q < NB; const int s = q - NB;
        const bool isrg = e < 3072; const int e2 = isrg ? e : e - 3072; const int nch = isrg ? 1024 : 1536; const int j = e2 / nch, ch = e2 % nch;
        const int col = (isrg ? C_RGX : C_XBC) + ch;
        float v;
        if (prompt) v = bf1(c.proj[(size_t)(q * SEQ + SEQ - 3 + j) * LDP + col]);
        else if (j == 2) v = ps4(c.projs + (size_t)s * LDP + col) * row_rstd(c.rowsq + (size_t)l * M_PAD, TP + s);
        else v = (isrg ? c.in[I_SRGC] + ((size_t)l * DEC + s) * 3072 : c.in[I_SSSDC] + ((size_t)l * DEC + s) * 4608)[(j + 1) * nch + ch];
        float* o = c.out + (isrg ? (prompt ? O_RGC_P + ((size_t)l * NB + q) * 3072 : O_RGC_S + ((size_t)l * DEC + s) * 3072)
                                 : (prompt ? O_SSDC_P + ((size_t)l * NB + q) * 4608 : O_SSDC_S + ((size_t)l * DEC + s) * 4608));
        o[j * nch + ch] = v;
    }
}

DI void phase_dt(const Ctx& c, int l) {
    LAS float* PT = (LAS float*)c.lds;
    const int tid = get_tid(c.wave), lane = tid & 63, w = c.wave, r = lane & 31, hh = lane >> 5;
    for (int rt = c.wg; rt < TP / 32; rt += c.G) {
        const bf16_t* pa = c.xb + (size_t)(rt * 32 + r) * D_MODEL + w * 256 + 8 * hh;
        const bf16_t* pb = c.win + ((size_t)l * LDP + C_DT + r) * D_MODEL + w * 256 + 8 * hh;
        f32x16 acc; ZERO16(acc);
#pragma unroll
        for (int k4 = 0; k4 < 16; k4 += 8) { bf16x8 fa[8], fb[8];
#pragma unroll
            for (int u = 0; u < 8; ++u) { fa[u] = *(const bf16x8*)(pa + 16 * (k4 + u)); fb[u] = *(const bf16x8*)(pb + 16 * (k4 + u)); }
#pragma unroll
            for (int u = 0; u < 8; ++u) acc = mfma32(fa[u], fb[u], acc); }
        __syncthreads();
#pragma unroll
        for (int i = 0; i < 16; ++i) PT[w * 1024 + crow(i, hh) * 32 + r] = acc[i];
        __syncthreads();
        { const int row = tid >> 4, col = tid & 15; float s = 0.f;
#pragma unroll
          for (int q = 0; q < 8; ++q) s += PT[q * 1024 + row * 32 + col];
          c.dtb[(size_t)(rt * 32 + row) * 16 + col] = softplus(s * row_rstd(c.rowsq + (size_t)l * M_PAD, rt * 32 + row) + c.in[I_DTB][l * 16 + col]); }
    }
}

DI void g2_sample(const Ctx& c, int l) {
    LAS float* PT = (LAS float*)c.lds;
    const int tid = get_tid(c.wave), lane = tid & 63, w = c.wave, rr = lane & 15, quad = lane >> 4;
    float* rsq_next = c.rowsq + (size_t)(l + 1) * M_PAD;
    for (int ct = c.wg; ct < D_MODEL / 8; ct += c.G) {
        const bf16_t* pa = c.mix + (size_t)(TP + rr) * D_MIX + 512 * w + 8 * quad;
        const bf16_t* pb = c.wout + (size_t)l * D_MODEL * D_MIX + (size_t)(8 * ct + (rr & 7)) * D_MIX + 512 * w + 8 * quad;
        f32x4 acc[8];
#pragma unroll
        for (int rt = 0; rt < 8; ++rt) acc[rt] = (f32x4){0.f, 0.f, 0.f, 0.f};
#pragma unroll 1
        for (int k2 = 0; k2 < 16; k2 += 2) { bf16x8 fa[2][8], fb[2];
#pragma unroll
            for (int u = 0; u < 2; ++u) { fb[u] = *(const bf16x8*)(pb + 32 * (k2 + u));
#pragma unroll
                for (int rt = 0; rt < 8; ++rt) fa[u][rt] = *(const bf16x8*)(pa + (size_t)16 * rt * D_MIX + 32 * (k2 + u)); }
#pragma unroll
            for (int u = 0; u < 2; ++u) { const bf16x8 z = {0, 0, 0, 0, 0, 0, 0, 0}; const bf16x8 bb = rr < 8 ? fb[u] : z;
#pragma unroll
                for (int rt = 0; rt < 8; ++rt) acc[rt] = __builtin_amdgcn_mfma_f32_16x16x32_bf16(fa[u][rt], bb, acc[rt], 0, 0, 0); } }
        __syncthreads();
#pragma unroll
        for (int rt = 0; rt < 8; ++rt)
#pragma unroll
            for (int j = 0; j < 4; ++j) PT[(w * 128 + 16 * rt + 4 * quad + j) * 16 + rr] = acc[rt][j];
        __syncthreads();
        { const int row = tid >> 2, c2 = 2 * (tid & 3); float x0 = 0.f, x1 = 0.f;
#pragma unroll
          for (int q = 0; q < 8; ++q) { const f32x2 t = *(const LAS f32x2*)(PT + (q * 128 + row) * 16 + c2); x0 += t.x; x1 += t.y; }
          unsigned* xp = (unsigned*)(c.xb + (size_t)(TP + row) * D_MODEL + 8 * ct + c2); const unsigned o = *xp;
          x0 += bflo(o); x1 += bfhi(o); *xp = pk2(x0, x1);
          float ss = x0 * x0 + x1 * x1; ss += shx(ss, 1, lane); ss += shx(ss, 2, lane);
          if ((tid & 3) == 0) atomicAdd(rsq_next + TP + row, ss); }
    }
}

__global__ void __launch_bounds__(512, 2) mk_fwd(Params p) {
    extern __shared__ __attribute__((aligned(16))) unsigned char lds_raw[];
    LAS unsigned char* lds = (LAS unsigned char*)lds_raw;
    volatile LAS unsigned* misc = (volatile LAS unsigned*)(lds + MISC_OFF);
    const int wv = __builtin_amdgcn_readfirstlane(threadIdx.x >> 6);
    if (threadIdx.x < 32) misc[threadIdx.x] = 0u;
    __syncthreads();
    const int lo = p.ph_lo, hi = p.ph_hi;
    unsigned* barw = (unsigned*)(p.ws + WS_CTL) + CW_BAR;
    XcdBarrier bar; bar.bar = barw; bar.x = 0; bar.st = misc;
    if (hi - lo > 1) bar = xcd_barrier_post(barw, misc, get_tid(wv));
#define PH_IN(k) (lo <= (k) && (k) < hi)
#define SEAM(k) do { if (PH_IN(k) && PH_IN((k) + 1)) xcd_barrier(bar, wv); } while (0)
    if (PH_IN(0)) { phase_prologue(wv); }
    SEAM(0);
    for (int l = 0; l < DEPTH; ++l) {
        const int pb = 1 + 4 * l;
        if (PH_IN(pb)) {
            __syncthreads();
            const Ctx c = make_ctx(wv);
            {
                pg8::Gemm g{c.xb, c.win + (size_t)l * LDP * D_MODEL, TP, N_MAIN, D_MODEL, D_MODEL, D_MODEL}; pg8::StaticOrder S; S.init(TP, N_MAIN, c.G, c.wg); S.rep = PROBE_G1;
                pg8::EpiProj E{c.proj, c.lb + (size_t)l * 1024, c.in[I_HGN] + (size_t)l * 1024, c.in[I_GLN] + (size_t)l * 1024, c.in[I_GBU] + (size_t)l * 512, c.rowsq + (size_t)l * M_PAD};
                pg8::gemm_phase<pg8::EpiProj, pg8::StaticOrder>(c.lds, g, S, E, wv); }
            __syncthreads();
            {
                const int pn = c.wg % 49, ks = c.wg / 49;
                pg8::Gemm g{c.xb + (size_t)TP * D_MODEL + ks * 512, c.win + (size_t)l * LDP * D_MODEL + ks * 512, 256, LDP, 512, D_MODEL, D_MODEL};
                pg8::OneUnit S{0, pn, c.wg < 196 ? 1 : 0};
                pg8::EpiSample E{c.projs + (size_t)ks * PST};
                pg8::gemm_phase<pg8::EpiSample, pg8::OneUnit>(c.lds, g, S, E, wv); }
            __syncthreads();
            phase_dt(c, l);
            __syncthreads();
        }
        SEAM(pb);
        if (PH_IN(pb + 1)) phase_mixer(l, wv);
        SEAM(pb + 1);
        if (PH_IN(pb + 2)) phase_finalize(l, wv);
        SEAM(pb + 2);
        if (PH_IN(pb + 3)) {
            __syncthreads();
            const Ctx c = make_ctx(wv);
            {
                pg8::Gemm g{c.mix, c.wout + (size_t)l * D_MODEL * D_MIX, TP, D_MODEL, D_MIX, D_MIX, D_MIX}; pg8::StaticOrder S; S.init(TP, D_MODEL, c.G, c.wg);
                pg8::EpiResid E{c.xb, c.rowsq + (size_t)(l + 1) * M_PAD};
                pg8::gemm_phase<pg8::EpiResid, pg8::StaticOrder>(c.lds, g, S, E, wv); }
            __syncthreads();
            g2_sample(c, l);
            __syncthreads();
        }
        SEAM(pb + 3);
    }
    if (PH_IN(NPHASE - 1)) phase_final_norm(wv);
#undef PH_IN
#undef SEAM
}

extern "C" void kernel_launch(void* const* d_in, const int* in_sizes, int n_in, void* d_out, int out_size, void* d_ws, size_t ws_size, hipStream_t stream) {
    static int grid = 0;
    if (grid == 0) {
        if (n_in != N_INPUTS || (size_t)out_size != O_END || ws_size < WS_END) { fprintf(stderr, "kernel_launch: unexpected shapes (n_in %d out %d ws %zu)\n", n_in, out_size, ws_size); grid = -1; return; }
        int dev = 0, cus = 0;
        if (hipGetDevice(&dev) != hipSuccess || hipDeviceGetAttribute(&cus, hipDeviceAttributeMultiprocessorCount, dev) != hipSuccess) { grid = -1; return; }
        if (hipFuncSetAttribute((const void*)mk_fwd, hipFuncAttributeMaxDynamicSharedMemorySize, LDS_BYTES) != hipSuccess) { fprintf(stderr, "kernel_launch: hipFuncSetAttribute failed\n"); grid = -1; return; }
        int per_cu = 0;
        if (hipOccupancyMaxActiveBlocksPerMultiprocessor(&per_cu, (const void*)mk_fwd, 512, LDS_BYTES) != hipSuccess || per_cu < 1) fprintf(stderr, "kernel_launch: occupancy query says %d\n", per_cu);
        (void)hipGetLastError();
        grid = cus;
    }
    if (grid < 0) return;
    (void)hipMemsetAsync((char*)d_ws + WS_CTL, 0, CTL_ZERO_BYTES, stream);
    Params p{};
    for (int i = 0; i < N_INPUTS; ++i) p.in[i] = (const float*)d_in[i];
    p.out = (float*)d_out; p.ws = (unsigned char*)d_ws;
#if MK_ONE_LAUNCH
    p.ph_lo = 0; p.ph_hi = NPHASE;
    hipLaunchKernelGGL(mk_fwd, dim3(grid), dim3(512), LDS_BYTES, stream, p);
#else
    for (int ph = 0; ph < NPHASE; ++ph) { p.ph_lo = ph; p.ph_hi = ph + 1; hipLaunchKernelGGL(mk_fwd, dim3(grid), dim3(512), LDS_BYTES, stream, p); }
#endif
}
```

```cpp
#include <hip/hip_runtime.h>
#include <cstdio>
#include <cstdint>

#ifndef MK_ONE_LAUNCH
#define MK_ONE_LAUNCH 1
#endif

#ifndef PROBE_LONG_REP
#define PROBE_LONG_REP 1
#endif
#ifndef PROBE_RG_REP
#define PROBE_RG_REP PROBE_LONG_REP
#endif
#ifndef PROBE_G1_NOEPI
#define PROBE_G1_NOEPI 0
#endif
#ifndef PROBE_G2
#define PROBE_G2 0
#endif
#ifndef PROBE_G1
#define PROBE_G1 1
#endif
#define LAS __attribute__((address_space(3)))
#define DI __device__ __forceinline__

constexpr int D_MODEL = 2048, NB = 4, SEQ = 2048, DEPTH = 4, DEC = 128;
constexpr int BRANCH = 1024, D_MIX = 4096;
constexpr int TP = NB * SEQ;
constexpr int TT = TP + DEC;
constexpr int M_PAD = 8448;
constexpr int N_IN = 11808;
constexpr int LDP = 12544;
constexpr int N_MAIN = 12288;
constexpr int PST = 128 * LDP;
constexpr float EPS = 1e-6f, TINY = 1e-30f;
constexpr int C_HGQ = 0, C_HGF = 1024, C_HGI = 2048, C_HGG = 3072, C_RGX = 4096, C_RGG = 5120, C_GLQ = 6144, C_GLK = 6656, C_GLV = 7168, C_GLG = 8192,
              C_GLF = 9216, C_SSZ = 9728, C_XBC = 10752, C_DT = 12288;
constexpr int SRC_GLA = 9216, SRC_SSZ = 9232, SRC_DT = 11792;
enum { I_XP = 0, I_XS, I_SHG, I_SRG, I_SRGC, I_SGLA, I_SSSD, I_SSSDC, I_RMS, I_WIN, I_LB, I_HGN, I_RCW, I_RCB, I_WR, I_BR, I_WI, I_BI, I_LAM,
       I_GWU, I_GBU, I_GLN, I_SCW, I_SCB, I_DTB, I_ALOG, I_SD, I_SSN, I_WOUT, I_RMSF, N_INPUTS };
constexpr size_t O_YP = 0, O_YS = (size_t)TP * D_MODEL, O_HG_P = O_YS + (size_t)DEC * D_MODEL,
    O_RG_P = O_HG_P + (size_t)DEPTH * NB * 131072, O_RGC_P = O_RG_P + (size_t)DEPTH * NB * 1024, O_GLA_P = O_RGC_P + (size_t)DEPTH * NB * 3072,
    O_SSD_P = O_GLA_P + (size_t)DEPTH * NB * 131072, O_SSDC_P = O_SSD_P + (size_t)DEPTH * NB * 131072, O_HG_S = O_SSDC_P + (size_t)DEPTH * NB * 4608,
    O_RG_S = O_HG_S + (size_t)DEPTH * DEC * 131072, O_RGC_S = O_RG_S + (size_t)DEPTH * DEC * 1024, O_GLA_S = O_RGC_S + (size_t)DEPTH * DEC * 3072,
    O_SSD_S = O_GLA_S + (size_t)DEPTH * DEC * 131072, O_SSDC_S = O_SSD_S + (size_t)DEPTH * DEC * 131072, O_END = O_SSDC_S + (size_t)DEPTH * DEC * 4608;
constexpr size_t MiB = 1u << 20;
constexpr size_t WS_CTL = 0, CTL_ZERO_BYTES = 2 * MiB, WS_LB = 2 * MiB, WS_WIN = 3 * MiB, WS_WOUT = 199 * MiB, WS_XB = 263 * MiB, WS_PROJ = 296 * MiB,
    WS_DTB = 492 * MiB, WS_MIX = 493 * MiB, WS_PROJS = 559 * MiB, WS_XBCS = 584 * MiB, WS_END = 608 * MiB;
static_assert(WS_WIN + (size_t)DEPTH * LDP * D_MODEL * 2 <= WS_WOUT && WS_WOUT + (size_t)DEPTH * D_MODEL * D_MIX * 2 <= WS_XB && WS_XB + (size_t)M_PAD * D_MODEL * 2 <= WS_PROJ &&
              WS_PROJ + (size_t)TP * LDP * 2 <= WS_DTB && WS_DTB + (size_t)TP * 16 * 4 <= WS_MIX &&
              WS_MIX + (size_t)M_PAD * D_MIX * 2 <= WS_PROJS && WS_PROJS + (size_t)4 * DEC * LDP * 4 <= WS_XBCS && WS_XBCS + (size_t)TP * 1536 * 2 <= WS_END, "ws map");
constexpr int CW_BAR = 4096, CW_QCTR = 16384, CW_XPRE = 24576  , CW_STATS = 32768, CW_ROWSQ = 262144;
static_assert(CW_STATS + DEPTH * TP * 6 <= CW_ROWSQ && (size_t)(CW_ROWSQ + (DEPTH + 1) * M_PAD) * 4 <= CTL_ZERO_BYTES, "ctl map");
constexpr int LDS_BYTES = 147456, MISC_OFF = LDS_BYTES - 256;
constexpr int NPHASE = 2 + 4 * DEPTH;

typedef unsigned short bf16_t;
typedef short bf16x8 __attribute__((ext_vector_type(8)));
typedef float f32x4 __attribute__((ext_vector_type(4)));
typedef float f32x2 __attribute__((ext_vector_type(2)));
typedef float f32x16 __attribute__((ext_vector_type(16)));
typedef unsigned u32x4 __attribute__((ext_vector_type(4)));
typedef unsigned u32x2 __attribute__((ext_vector_type(2)));
typedef __bf16 bf16v2 __attribute__((ext_vector_type(2)));

DI unsigned pk2(float lo, float hi) { const f32x2 v = {lo, hi}; return __builtin_bit_cast(unsigned, __builtin_convertvector(v, bf16v2)); }
DI unsigned f2bf(float f) { return pk2(f, 0.f) & 0xffffu; }
DI float bflo(unsigned u) { return __builtin_bit_cast(float, u << 16); }
DI float bfhi(unsigned u) { return __builtin_bit_cast(float, u & 0xffff0000u); }
DI float bf1(bf16_t u) { return __builtin_bit_cast(float, (unsigned)u << 16); }
DI float ex2(float x) { return __builtin_amdgcn_exp2f(x); }
DI float lg2(float x) { return __builtin_amdgcn_logf(x); }
DI float rcp(float x) { return __builtin_amdgcn_rcpf(x); }
constexpr float LOG2E = 1.4426950408889634f, LN2 = 0.6931471805599453f;
DI float fexp(float x) { return ex2(x * LOG2E); }
DI float flog(float x) { return lg2(x) * LN2; }
DI float sigm(float x) { return rcp(1.0f + fexp(-x)); }
DI float silu(float x) { return x * sigm(x); }
DI float sigm_fast(float x) { return sigm(x); }
DI float silu_fast(float x) { return silu(x); }
DI float log1p_pos(float e) { const float a = e * (1.0f - e * (0.5f - e * (0.33333334f - 0.25f * e))), b = flog(1.0f + e); return e < 0.03f ? a : b; }
DI float softplus(float x) { return fmaxf(x, 0.f) + log1p_pos(fexp(-fabsf(x))); }
DI float neg_expm1(float x) { const float a = -x * (1.0f + 0.5f * x * (1.0f + 0.33333334f * x * (1.0f + 0.25f * x * (1.0f + 0.2f * x)))), b = 1.0f - fexp(x); return fabsf(x) < 0.25f ? a : b; }
DI float row_rstd(const float* rowsq, int row) { return rsqrtf(rowsq[row] * (1.0f / D_MODEL) + EPS); }
DI float clampf(float x, float lo, float hi) { return fminf(fmaxf(x, lo), hi); }
DI float shx(float v, int mask, int lane) { return __builtin_bit_cast(float, __builtin_amdgcn_ds_bpermute((lane ^ mask) << 2, __builtin_bit_cast(int, v))); }
DI float shup(float v, int o, int lane) { return __builtin_bit_cast(float, __builtin_amdgcn_ds_bpermute((lane >= o ? lane - o : lane) << 2, __builtin_bit_cast(int, v))); }
DI float wave_sum(float v, int lane) {
#pragma unroll
    for (int o = 1; o < 64; o <<= 1) v += shx(v, o, lane);
    return v;
}

struct Params { const float* in[N_INPUTS]; float* out; unsigned char* ws; int ph_lo, ph_hi; };
static_assert(sizeof(Params) == N_INPUTS * 8 + 8 + 8 + 8, "no padding holes in Params");
typedef const __attribute__((address_space(4))) Params* KP;
DI KP get_params() { auto kp = __builtin_amdgcn_kernarg_segment_ptr(); asm volatile("" : "+s"(kp)); return (KP)kp; }
DI int get_tid(int wv) { int ln; asm volatile("v_mbcnt_lo_u32_b32 %0, -1, 0\n\tv_mbcnt_hi_u32_b32 %0, -1, %0" : "=v"(ln)); return (wv << 6) | ln; }

#define XB_TMO      128
#define XB_XCNT(j)  (256  + 64 * (j))
#define XB_XSUB(j)  (1280 + 64 * (j))
#define XB_XGEN(j)  (2304 + 64 * (j))
#define XB_TOP      3328
#define XB_TOPGEN   3392
#define XCD_BAR_WORDS 3456
#define XB_SPIN_CAP (1u << 20)
DI unsigned xb_ld(unsigned* p)              { return __hip_atomic_load(p, __ATOMIC_RELAXED, __HIP_MEMORY_SCOPE_AGENT); }
DI unsigned xb_add(unsigned* p, unsigned v) { return __hip_atomic_fetch_add(p, v, __ATOMIC_RELAXED, __HIP_MEMORY_SCOPE_AGENT); }
DI unsigned xb_xcc_id() { return (unsigned)__builtin_amdgcn_s_getreg((3 << 11) | 20) & 0xFu; }
#define XB_SPIN(cond, bar) do { unsigned _sp = 0; while (cond) { __builtin_amdgcn_s_sleep(1); \
    if ((++_sp & 255u) == 0u) { if (xb_ld(&(bar)[XB_TMO])) break; if (_sp > XB_SPIN_CAP) { atomicAdd(&(bar)[XB_TMO], 1u); break; } } } } while (0)
struct XcdBarrier { unsigned* bar; unsigned x; volatile LAS unsigned* st; };
DI XcdBarrier xcd_barrier_post(unsigned* bar, volatile LAS unsigned* st, int tid) {
    XcdBarrier b; b.bar = bar; b.x = xb_xcc_id(); b.st = st;
    if (tid == 0) (void)xb_add(&bar[XB_XCNT(b.x)], 1u);
    return b;
}
DI void xcd_barrier_complete(unsigned* bar, unsigned x, unsigned& nloc, unsigned& nx) {
    const unsigned G = gridDim.x * gridDim.y * gridDim.z;
    unsigned sum, cnt, mine, sp = 0u;
    for (;;) {
        sum = 0u; cnt = 0u; mine = 0u;
#pragma unroll
        for (unsigned j = 0; j < 16; ++j) { const unsigned c = xb_ld(&bar[XB_XCNT(j)]); sum += c; cnt += (c > 0u) ? 1u : 0u; mine = (j == x) ? c : mine; }
        if (sum == G) break;
        __builtin_amdgcn_s_sleep(1);
        if ((++sp & 255u) == 0u) { if (xb_ld(&bar[XB_TMO])) break; if (sp > XB_SPIN_CAP) { atomicAdd(&bar[XB_TMO], 1u); break; } }
    }
    nloc = mine > 0u ? mine : 1u; nx = cnt > 0u ? cnt : 1u;
}
DI void xcd_barrier(const XcdBarrier& b, int wv) {
    asm volatile("s_waitcnt vmcnt(0)" ::: "memory");
    __syncthreads();
    if (get_tid(wv) == 0) {
        unsigned* bar = b.bar;
        __builtin_amdgcn_s_waitcnt(0);
        unsigned nloc = b.st[0], nx = b.st[1];
        if (nloc == 0u) { xcd_barrier_complete(bar, b.x, nloc, nx); b.st[0] = nloc; b.st[1] = nx; }
        const unsigned old = xb_add(&bar[XB_XSUB(b.x)], 1u);
        const unsigned gen = old / nloc;
        if (old + 1u == (gen + 1u) * nloc) {
            __builtin_amdgcn_fence(__ATOMIC_RELEASE, "agent");
            asm volatile("s_waitcnt vmcnt(0)" ::: "memory");
            const unsigned og = xb_add(&bar[XB_TOP], 1u);
            const unsigned tg = og / nx;
            if (og + 1u == (tg + 1u) * nx) xb_add(&bar[XB_TOPGEN], 1u);
            else XB_SPIN(xb_ld(&bar[XB_TOPGEN]) == tg, bar);
            __builtin_amdgcn_fence(__ATOMIC_ACQUIRE, "agent");
            xb_add(&bar[XB_XGEN(b.x)], 1u);
            asm volatile("s_waitcnt vmcnt(0)" ::: "memory");
        } else {
            XB_SPIN(xb_ld(&bar[XB_XGEN(b.x)]) == gen, bar);
            __builtin_amdgcn_fence(__ATOMIC_ACQUIRE, "agent");
            asm volatile("s_waitcnt vmcnt(0)" ::: "memory");
        }
    }
    __syncthreads();
}

namespace pg8 {
constexpr int BM = 256, BK = 64, HALF = 128, HTB = HALF * BK * 2, STAGE_BYTES = 8 * HTB, NXCD = 8, WGM = 8;
DI int lds_byte(int r, int c) { const int st = (r >> 4) * 2 + (c >> 5), rr = r & 15, cc = c & 31, ob = rr * 64 + cc * 2; return st * 1024 + (ob ^ (((ob >> 9) & 1) << 5)); }
DI void stage_rc(int b, int& R, int& C) { const int st = b / 1024, sb = b % 1024, swz = sb ^ (((sb >> 9) & 1) << 5); R = (st >> 1) * 16 + swz / 64; C = (st & 1) * 32 + (swz % 64) / 2; }
DI int perm32(int rho) { const int n = rho >> 4, i = rho & 15; return 8 * (i >> 2) + 4 * n + (i & 3); }
struct Unit { int pm, pn; };
struct Gemm { const bf16_t* A; const bf16_t* Bt; int M, N, K, lda, ldb; };
struct StaticOrder {
    int nM, nN, nwg, G, c, rep = 1;
    DI void init(int M, int N, int G_, int c_) { nM = M / BM; nN = N / BM; nwg = nM * nN; G = G_; c = c_; }
    DI bool next(int i, Unit& u) const {
        const long L = (long)(i / rep) * G + c; if (L >= nwg) return false;
        int wgid = (int)L; { const int q = nwg / NXCD, r = nwg % NXCD, xcd = wgid % NXCD, off = wgid / NXCD; wgid = (xcd < r ? xcd * (q + 1) : r * (q + 1) + (xcd - r) * q) + off; }
        const int nig = WGM * nN, gid = wgid / nig, fm = gid * WGM, gsz = (nM - fm) < WGM ? (nM - fm) : WGM;
        u.pm = fm + ((wgid % nig) % gsz); u.pn = (wgid % nig) / gsz; return true;
    }
    DI void a_ready(const Unit&) const {}
    DI void done(const Unit&) const {}
};
struct EpiProj {
    static constexpr bool PERM = true, TWICE = PROBE_G1_NOEPI != 0;
    bf16_t* P; const float* lb; const float* hgn; const float* gln; const float* bup; const float* rsq;
    template <int MODE>
    DI void body(const f32x4 (&acc)[2][2][4][2], bf16_t* prow, const float* vec, float scale, const float (&rs)[2][4]) const {
#pragma unroll
        for (int bj = 0; bj < 2; ++bj) {
            f32x4 c0 = (f32x4){1.f, 1.f, 1.f, 1.f}, c1 = c0;
            if constexpr (MODE >= 2) { c0 = *(const f32x4*)(vec + bj * HALF); c1 = *(const f32x4*)(vec + bj * HALF + 4); }
#pragma unroll
            for (int ai = 0; ai < 2; ++ai)
#pragma unroll
                for (int m = 0; m < 4; ++m) {
                    f32x4 a = acc[ai][bj][m][0] * rs[ai][m], b = acc[ai][bj][m][1] * rs[ai][m];
                    if constexpr (MODE == 0) { a = a * scale; b = b * scale; }
                    else if constexpr (MODE == 1) { a = (f32x4){silu(a.x), silu(a.y), silu(a.z), silu(a.w)}; b = (f32x4){silu(b.x), silu(b.y), silu(b.z), silu(b.w)}; }
                    else if constexpr (MODE == 2) { a = (f32x4){silu(a.x), silu(a.y), silu(a.z), silu(a.w)} * c0; b = (f32x4){silu(b.x), silu(b.y), silu(b.z), silu(b.w)} * c1; }
                    else if constexpr (MODE == 3) {
#define LOGF(x, l) flog(fmaxf((l) + (1.0f - (l)) * sigm(x), TINY))
                        a = (f32x4){LOGF(a.x, c0.x), LOGF(a.y, c0.y), LOGF(a.z, c0.z), LOGF(a.w, c0.w)}; b = (f32x4){LOGF(b.x, c1.x), LOGF(b.y, c1.y), LOGF(b.z, c1.z), LOGF(b.w, c1.w)};
#undef LOGF
                    } else {
#define LSIG(x, bb) (-0.0625f * (fmaxf(-((x) + (bb)), 0.f) + flog(1.0f + fexp(-fabsf((x) + (bb))))))
                        a = (f32x4){LSIG(a.x, c0.x), LSIG(a.y, c0.y), LSIG(a.z, c0.z), LSIG(a.w, c0.w)}; b = (f32x4){LSIG(b.x, c1.x), LSIG(b.y, c1.y), LSIG(b.z, c1.z), LSIG(b.w, c1.w)};
#undef LSIG
                    }
                    u32x4 w4; w4.x = pk2(a.x, a.y); w4.y = pk2(a.z, a.w); w4.z = pk2(b.x, b.y); w4.w = pk2(b.z, b.w);
                    *(u32x4*)(prow + (size_t)(ai * HALF + m * 16) * LDP + bj * HALF) = w4;
                }
        }
    }
    DI void operator()(const f32x4 (&acc)[2][2][4][2], const Unit& u, int wr, int wc, int fr, int fq) const {
        const int col = u.pn * BM + wc * 32 + 8 * fq;
        bf16_t* prow = P + (size_t)(u.pm * BM + wr * 64 + fr) * LDP + col;
        float rs[2][4];
#pragma unroll
        for (int ai = 0; ai < 2; ++ai)
#pragma unroll
            for (int m = 0; m < 4; ++m) rs[ai][m] = row_rstd(rsq, u.pm * BM + wr * 64 + fr + ai * HALF + m * 16);
        const int pn = u.pn;
        if (pn < 4) body<1>(acc, prow, nullptr, 1.f, rs);
        else if (pn < 8) body<3>(acc, prow, lb + (col - C_HGF), 1.f, rs);
        else if (pn < 12) body<0>(acc, prow, nullptr, 1.f, rs);
        else if (pn < 16) body<2>(acc, prow, hgn + (col - C_HGG), 1.f, rs);
        else if (pn < 20) body<0>(acc, prow, nullptr, 1.f, rs);
        else if (pn < 24) body<1>(acc, prow, nullptr, 1.f, rs);
        else if (pn < 26) body<0>(acc, prow, nullptr, 0.08838834764831845f, rs);
        else if (pn < 32) body<0>(acc, prow, nullptr, 1.f, rs);
        else if (pn < 36) body<2>(acc, prow, gln + (col - C_GLG), 1.f, rs);
        else if (pn < 38) body<4>(acc, prow, bup + (col - C_GLF), 1.f, rs);
        else if (pn < 42) body<1>(acc, prow, nullptr, 1.f, rs);
        else body<0>(acc, prow, nullptr, 1.f, rs);
    }
};
struct EpiSample {
    static constexpr bool PERM = false, TWICE = false;
    float* PS;
    DI void operator()(const f32x4 (&acc)[2][2][4][2], const Unit& u, int wr, int wc, int fr, int fq) const {
        const int row0 = wr * 64 + fr, col0 = u.pn * BM + wc * 32 + 4 * fq;
#pragma unroll
        for (int m = 0; m < 4; ++m) { float* op = PS + (size_t)(row0 + m * 16) * LDP + col0;
#pragma unroll
            for (int bj = 0; bj < 2; ++bj)
#pragma unroll
                for (int n = 0; n < 2; ++n) *(f32x4*)(op + bj * HALF + n * 16) = acc[0][bj][m][n]; }
    }
};
struct EpiResid {
    static constexpr bool PERM = true, TWICE = false;
    bf16_t* xb; float* rsq_next;
    DI void operator()(const f32x4 (&acc)[2][2][4][2], const Unit& u, int wr, int wc, int fr, int fq) const {
        const int row0 = u.pm * BM + wr * 64 + fr, col0 = u.pn * BM + wc * 32 + 8 * fq;
#pragma unroll
        for (int ai = 0; ai < 2; ++ai)
#pragma unroll
            for (int m = 0; m < 4; ++m) { const int row = row0 + ai * HALF + m * 16; bf16_t* xp = xb + (size_t)row * D_MODEL + col0; float ss = 0.f;
#pragma unroll
                for (int bj = 0; bj < 2; ++bj) { const u32x4 o = *(const u32x4*)(xp + bj * HALF); const f32x4 a = acc[ai][bj][m][0], b = acc[ai][bj][m][1];
                    const float x0 = bflo(o.x) + a.x, x1 = bfhi(o.x) + a.y, x2 = bflo(o.y) + a.z, x3 = bfhi(o.y) + a.w, x4 = bflo(o.z) + b.x, x5 = bfhi(o.z) + b.y, x6 = bflo(o.w) + b.z, x7 = bfhi(o.w) + b.w;
                    ss += ((x0 * x0 + x1 * x1) + (x2 * x2 + x3 * x3)) + ((x4 * x4 + x5 * x5) + (x6 * x6 + x7 * x7));
                    u32x4 n4; n4.x = pk2(x0, x1); n4.y = pk2(x2, x3); n4.z = pk2(x4, x5); n4.w = pk2(x6, x7); *(u32x4*)(xp + bj * HALF) = n4; }
                const int lane = fq * 16 + fr; ss += shx(ss, 16, lane); ss += shx(ss, 32, lane);
                if (fq == 0) atomicAdd(rsq_next + row, ss); }
    }
};
struct OneUnit {
    int pm, pn, have;
    DI bool next(int i, Unit& u) const { if (i != 0 || !have) return false; u.pm = pm; u.pn = pn; return true; }
    DI void a_ready(const Unit&) const {}
    DI void done(const Unit&) const {}
};
template <class Epi, class Sched>
DI void gemm_phase(LAS unsigned char* lds, const Gemm g, const Sched& S, const Epi& E, int wv) {
    const int tid = get_tid(wv), wid = wv, lane = tid & 63, wr = wid >> 2, wc = wid & 3, fr = lane & 15, fq = lane >> 4;
    const int K = g.K, nt = K / BK;
    unsigned voffA[2], voffB[2];
#pragma unroll
    for (int i = 0; i < 2; ++i) { int R, C; stage_rc(tid * 16 + i * 8192, R, C); const int Rb = Epi::PERM ? ((R & ~31) + perm32(R & 31)) : R;
        voffA[i] = (unsigned)(R * g.lda + C) * 2u; voffB[i] = (unsigned)(Rb * g.ldb + C) * 2u; }
    const size_t kstep = (size_t)(BK * 2);
    const size_t hstepA = (size_t)HALF * g.lda * 2, hstepB = (size_t)HALF * g.ldb * 2;
    const size_t tstepA = 2 * hstepA, tstepB = 2 * hstepB;
    const unsigned ldsw = (unsigned)wid * 1024u;
    const int aoff = lds_byte(wr * 64 + fr, fq * 8), boff = lds_byte(wc * 32 + fr, fq * 8);
#define PG8_SA(b, h) (((b) * 2 + (h)) * HTB)
#define PG8_SB(b, h) ((4 + (b) * 2 + (h)) * HTB)
#define PG8_STAGE(bufoff, gbase, voff) do { _Pragma("unroll") for (int _i = 0; _i < 2; ++_i) \
        __builtin_amdgcn_global_load_lds((const unsigned*)((const char*)(gbase) + (voff)[_i]), (LAS unsigned*)(lds + (bufoff) + ldsw + _i * 8192), 16, 0, 0); } while (0)
#define PG8_LDA(dst, b, h) do { _Pragma("unroll") for (int m = 0; m < 4; ++m) _Pragma("unroll") for (int k = 0; k < 2; ++k) dst[m][k] = *(const LAS bf16x8*)(lds + PG8_SA(b, h) + aoff + m * 2048 + k * 1024); } while (0)
#define PG8_LDB(dst, b, h) do { _Pragma("unroll") for (int n = 0; n < 2; ++n) _Pragma("unroll") for (int k = 0; k < 2; ++k) dst[n][k] = *(const LAS bf16x8*)(lds + PG8_SB(b, h) + boff + n * 2048 + k * 1024); } while (0)
#define PG8_MMA(ai, bj, At, Bt) do { __builtin_amdgcn_s_setprio(1); _Pragma("unroll") for (int m = 0; m < 4; ++m) _Pragma("unroll") for (int n = 0; n < 2; ++n) _Pragma("unroll") for (int k = 0; k < 2; ++k) \
        acc[ai][bj][m][n] = __builtin_amdgcn_mfma_f32_16x16x32_bf16(Bt[n][k], At[m][k], acc[ai][bj][m][n], 0, 0, 0); __builtin_amdgcn_s_setprio(0); } while (0)
#define PG8_WAIT_V(n) asm volatile("s_waitcnt vmcnt(" #n ")" ::: "memory")
#define PG8_WAIT_L(n) asm volatile("s_waitcnt lgkmcnt(" #n ")" ::: "memory")
#define PG8_BAR __builtin_amdgcn_s_barrier()
#define PG8_SCHED __builtin_amdgcn_sched_barrier(0)
    Unit cur, nxt; int ui = 0;
    if (!S.next(0, cur)) return;
    f32x4 acc[2][2][4][2];
#pragma unroll
    for (int a = 0; a < 2; ++a)
#pragma unroll
        for (int b = 0; b < 2; ++b)
#pragma unroll
            for (int m = 0; m < 4; ++m)
#pragma unroll
                for (int n = 0; n < 2; ++n) acc[a][b][m][n] = (f32x4){0.f, 0.f, 0.f, 0.f};
    bf16x8 At[4][2], B0[2][2], B1[2][2];
    const char* cA = (const char*)g.A + (size_t)cur.pm * tstepA; const char* cB = (const char*)g.Bt + (size_t)cur.pn * tstepB;
    S.a_ready(cur);
    PG8_STAGE(PG8_SB(0, 0), cB, voffB); PG8_STAGE(PG8_SA(0, 0), cA, voffA); PG8_STAGE(PG8_SB(0, 1), cB + hstepB, voffB); PG8_STAGE(PG8_SA(0, 1), cA + hstepA, voffA);
    if (wr == 1) PG8_BAR;
    PG8_WAIT_V(4); PG8_BAR;
    PG8_STAGE(PG8_SB(1, 0), cB + kstep, voffB); PG8_STAGE(PG8_SA(1, 0), cA + kstep, voffA); PG8_STAGE(PG8_SB(1, 1), cB + hstepB + kstep, voffB);
    PG8_WAIT_V(6); PG8_BAR;
    for (;;) {
        const bool has_next = S.next(ui + 1, nxt);
        const char* nA = has_next ? (const char*)g.A + (size_t)nxt.pm * tstepA : cA; const char* nB = has_next ? (const char*)g.Bt + (size_t)nxt.pn * tstepB : cB;
        for (int t = 0; t < nt; t += 2) {
            const bool last = (t == nt - 2);
            const char* a1 = cA + (size_t)(t + 1) * kstep;
            const char* a2 = last ? nA : cA + (size_t)(t + 2) * kstep; const char* b2 = last ? nB : cB + (size_t)(t + 2) * kstep;
            const char* a3 = a2 + kstep; const char* b3 = b2 + kstep;
            if (last && has_next) S.a_ready(nxt);
            PG8_LDB(B0, 0, 0); PG8_SCHED; PG8_LDA(At, 0, 0); PG8_STAGE(PG8_SA(1, 1), a1 + hstepA, voffA);
            PG8_WAIT_L(8); PG8_BAR; PG8_WAIT_L(0); PG8_MMA(0, 0, At, B0); PG8_BAR; PG8_SCHED;
            PG8_LDB(B1, 0, 1); PG8_STAGE(PG8_SB(0, 0), b2, voffB);
            PG8_BAR; PG8_WAIT_L(0); PG8_MMA(0, 1, At, B1); PG8_BAR;
            PG8_LDA(At, 0, 1); PG8_STAGE(PG8_SA(0, 0), a2, voffA);
            PG8_BAR; PG8_WAIT_L(0); PG8_MMA(1, 0, At, B0); PG8_BAR; PG8_SCHED;
            PG8_STAGE(PG8_SB(0, 1), b2 + hstepB, voffB);
            PG8_WAIT_V(6); PG8_BAR; PG8_MMA(1, 1, At, B1); PG8_BAR;
            PG8_LDB(B0, 1, 0); PG8_SCHED; PG8_LDA(At, 1, 0); PG8_STAGE(PG8_SA(0, 1), a2 + hstepA, voffA);
            PG8_WAIT_L(8); PG8_BAR; PG8_WAIT_L(0); PG8_MMA(0, 0, At, B0); PG8_BAR; PG8_SCHED;
            PG8_LDB(B1, 1, 1); PG8_STAGE(PG8_SB(1, 0), b3, voffB);
            PG8_BAR; PG8_WAIT_L(0); PG8_MMA(0, 1, At, B1); PG8_BAR;
            PG8_LDA(At, 1, 1); PG8_STAGE(PG8_SA(1, 0), a3, voffA);
            PG8_BAR; PG8_WAIT_L(0); PG8_MMA(1, 0, At, B0); PG8_BAR; PG8_SCHED;
            PG8_STAGE(PG8_SB(1, 1), b3 + hstepB, voffB);
            PG8_WAIT_V(6); PG8_BAR; PG8_MMA(1, 1, At, B1); PG8_BAR;
        }
        E(acc, cur, wr, wc, fr, fq);
        if constexpr (Epi::TWICE) {
#pragma unroll
            for (int a = 0; a < 2; ++a)
#pragma unroll
                for (int b = 0; b < 2; ++b) asm volatile("" : "+v"(acc[a][b][0][0]), "+v"(acc[a][b][0][1]), "+v"(acc[a][b][1][0]), "+v"(acc[a][b][1][1]), "+v"(acc[a][b][2][0]), "+v"(acc[a][b][2][1]), "+v"(acc[a][b][3][0]), "+v"(acc[a][b][3][1]) :: "memory");
            E(acc, cur, wr, wc, fr, fq); }
        S.done(cur);
        if (!has_next) break;
#pragma unroll
        for (int a = 0; a < 2; ++a)
#pragma unroll
            for (int b = 0; b < 2; ++b)
#pragma unroll
                for (int m = 0; m < 4; ++m)
#pragma unroll
                    for (int n = 0; n < 2; ++n) acc[a][b][m][n] = (f32x4){0.f, 0.f, 0.f, 0.f};
        cur = nxt; cA = nA; cB = nB; ++ui;
    }
    PG8_WAIT_V(0);
    if (wr == 0) PG8_BAR;
    PG8_BAR;
#undef PG8_SA
#undef PG8_SB
#undef PG8_STAGE
#undef PG8_LDA
#undef PG8_LDB
#undef PG8_MMA
#undef PG8_WAIT_V
#undef PG8_WAIT_L
#undef PG8_BAR
#undef PG8_SCHED
}
}

struct Ctx {
    KP kp; const float* const __attribute__((address_space(4)))* in; float* out; unsigned char* ws;
    LAS unsigned char* lds;
    int tid, lane, wave, G, wg;
    float* lb; bf16_t* win; bf16_t* wout; bf16_t* xb; bf16_t* proj; float* projs; float* dtb; bf16_t* mix; bf16_t* xbcs; float* rowsq; unsigned* ctl;
};
DI Ctx make_ctx(int wv) {
    extern __shared__ __attribute__((aligned(16))) unsigned char lds_raw[];
    Ctx c; c.kp = get_params(); c.in = c.kp->in; c.out = c.kp->out; c.ws = c.kp->ws;
    c.lds = (LAS unsigned char*)lds_raw;
    asm volatile("" : "+s"(wv));
    int wg = blockIdx.x; asm volatile("" : "+s"(wg));
    c.tid = get_tid(wv); c.lane = c.tid & 63; c.wave = wv; c.G = gridDim.x; c.wg = wg;
    unsigned char* ws = c.ws;
    c.ctl = (unsigned*)(ws + WS_CTL); c.lb = (float*)(ws + WS_LB); c.win = (bf16_t*)(ws + WS_WIN); c.wout = (bf16_t*)(ws + WS_WOUT); c.xb = (bf16_t*)(ws + WS_XB);
    c.proj = (bf16_t*)(ws + WS_PROJ); c.projs = (float*)(ws + WS_PROJS); c.dtb = (float*)(ws + WS_DTB); c.mix = (bf16_t*)(ws + WS_MIX); c.xbcs = (bf16_t*)(ws + WS_XBCS); c.rowsq = (float*)(c.ctl + CW_ROWSQ);
    return c;
}

DI void p0_transpose_item(const float* W, int ldw, int k0, int n0, bf16_t* WT, int K, int drow0, LAS float* scr, int lane, const float* ksc) {
    float t[32];
#pragma unroll
    for (int i = 0; i < 32; ++i) t[i] = W[(size_t)(k0 + 2 * i + (lane >> 5)) * ldw + n0 + (lane & 31)];
#pragma unroll
    for (int i = 0; i < 32; ++i) scr[(2 * i + (lane >> 5)) * 33 + (lane & 31)] = t[i];
    const int c = lane & 7;
    f32x4 s0 = (f32x4){1.f, 1.f, 1.f, 1.f}, s1 = s0;
    if (ksc) { s0 = *(const f32x4*)(ksc + k0 + 8 * c); s1 = *(const f32x4*)(ksc + k0 + 8 * c + 4); }
    asm volatile("s_waitcnt lgkmcnt(0)" ::: "memory");
#pragma unroll
    for (int j = 0; j < 4; ++j) { const int n = (lane >> 3) + 8 * j; const LAS float* s = scr + (8 * c) * 33 + n;
        u32x4 o; o.x = pk2(s[0 * 33] * s0.x, s[1 * 33] * s0.y); o.y = pk2(s[2 * 33] * s0.z, s[3 * 33] * s0.w); o.z = pk2(s[4 * 33] * s1.x, s[5 * 33] * s1.y); o.w = pk2(s[6 * 33] * s1.z, s[7 * 33] * s1.w);
        *(u32x4*)(WT + (size_t)(drow0 + n) * K + k0 + 8 * c) = o; }
    asm volatile("s_waitcnt lgkmcnt(0)" ::: "memory");
}
DI void phase_prologue(int wv) {
    const Ctx c = make_ctx(wv);
    LAS float* scr = (LAS float*)(c.lds + c.wave * 16384);
    const int gw = c.wg * 8 + c.wave, NGW = c.G * 8;
    constexpr int NB1 = SRC_GLA / 32, NB2 = (SRC_DT - SRC_SSZ) / 32;
    constexpr int I_A = (D_MODEL / 64) * NB1, I_B = (D_MODEL / 64) * NB2, I_O = (D_MIX / 64) * (D_MODEL / 32), I_L = I_A + I_B + I_O;
    for (int it = gw; it < DEPTH * I_L; it += NGW) {
        const int l = it / I_L; int r = it % I_L;
        const float* win = c.in[I_WIN] + (size_t)l * D_MODEL * N_IN; bf16_t* wt = c.win + (size_t)l * LDP * D_MODEL; const float* rmsw = c.in[I_RMS] + (size_t)l * D_MODEL;
        if (r < I_A) { const int kb = r / NB1, nb = r % NB1; p0_transpose_item(win, N_IN, 64 * kb, 32 * nb, wt, D_MODEL, 32 * nb, scr, c.lane, rmsw); }
        else if (r < I_A + I_B) { r -= I_A; const int kb = r / NB2, nb = r % NB2; p0_transpose_item(win, N_IN, 64 * kb, SRC_SSZ + 32 * nb, wt, D_MODEL, C_SSZ + 32 * nb, scr, c.lane, rmsw); }
        else { r -= I_A + I_B; const int kb = r / (D_MODEL / 32), nb = r % (D_MODEL / 32);
            p0_transpose_item(c.in[I_WOUT] + (size_t)l * D_MIX * D_MODEL, D_MODEL, 64 * kb, 32 * nb, c.wout + (size_t)l * D_MODEL * D_MIX, D_MIX, 32 * nb, scr, c.lane, nullptr); }
    }
    const int gt = c.wg * 512 + c.tid, NGT = c.G * 512;
    for (int it = gw; it < DEPTH * 32 * 8; it += NGW) {
        const int l = it >> 8, kb = (it >> 3) & 31, nb = it & 7, k = kb * 64 + c.lane;
        const float* wr = c.in[I_WIN] + ((size_t)l * D_MODEL + k) * N_IN + SRC_GLA; const float* up = c.in[I_GWU] + (size_t)l * 16 * 512 + nb * 64;
        const f32x4 a0 = *(const f32x4*)wr, a1 = *(const f32x4*)(wr + 4), a2 = *(const f32x4*)(wr + 8), a3 = *(const f32x4*)(wr + 12);
        const float rk = c.in[I_RMS][(size_t)l * D_MODEL + k];
        bf16_t* dst = c.win + ((size_t)l * LDP + C_GLF + nb * 64) * D_MODEL + k;
#pragma unroll 4
        for (int n = 0; n < 64; ++n) {
            const float s = a0.x * up[n] + a0.y * up[512 + n] + a0.z * up[1024 + n] + a0.w * up[1536 + n] + a1.x * up[2048 + n] + a1.y * up[2560 + n] + a1.z * up[3072 + n] + a1.w * up[3584 + n]
                          + a2.x * up[4096 + n] + a2.y * up[4608 + n] + a2.z * up[5120 + n] + a2.w * up[5632 + n] + a3.x * up[6144 + n] + a3.y * up[6656 + n] + a3.z * up[7168 + n] + a3.w * up[7680 + n];
            dst[(size_t)n * D_MODEL] = (bf16_t)f2bf(s * rk); }
    }
    for (int i = gt; i < DEPTH * 16 * D_MODEL; i += NGT) {
        const int l = i / (16 * D_MODEL), e = i % (16 * D_MODEL), n = e / D_MODEL, k = e % D_MODEL;
        c.win[((size_t)l * LDP + C_DT + n) * D_MODEL + k] = (bf16_t)f2bf(c.in[I_WIN][((size_t)l * D_MODEL + k) * N_IN + SRC_DT + n] * c.in[I_RMS][(size_t)l * D_MODEL + k]);
    }
    constexpr int PADW = (LDP - C_DT - 16) * D_MODEL * 2 / 16;
    for (int i = gt; i < DEPTH * PADW; i += NGT) { const int l = i / PADW, r = i % PADW;
        ((u32x4*)(c.win + ((size_t)l * LDP + C_DT + 16) * D_MODEL))[r] = (u32x4){0u, 0u, 0u, 0u}; }
    constexpr int PADX = (M_PAD - TT) * D_MODEL * 2 / 16;
    for (int i = gt; i < PADX; i += NGT) ((u32x4*)(c.xb + (size_t)TT * D_MODEL))[i] = (u32x4){0u, 0u, 0u, 0u};
    for (int r = gw; r < TT; r += NGW) {
        const f32x4* x4 = (const f32x4*)(r < TP ? c.in[I_XP] + (size_t)r * D_MODEL : c.in[I_XS] + (size_t)(r - TP) * D_MODEL);
        u32x2* o = (u32x2*)(c.xb + (size_t)r * D_MODEL); float s = 0.f;
#pragma unroll
        for (int j = 0; j < 8; ++j) { const f32x4 v = x4[c.lane + 64 * j]; s += (v.x * v.x + v.y * v.y) + (v.z * v.z + v.w * v.w); u32x2 p; p.x = pk2(v.x, v.y); p.y = pk2(v.z, v.w); o[c.lane + 64 * j] = p; }
        s = wave_sum(s, c.lane);
        if (c.lane == 0) c.rowsq[r] = s;
    }
    for (int i = gt; i < 1024; i += NGT) {
        const float* p = c.in[I_LB];
        const float a0 = p[i], a1 = p[1024 + i], a2 = p[2048 + i], a3 = p[3072 + i];
        const float mx = fmaxf(fmaxf(a0, a1), fmaxf(a2, a3));
        const float e0 = expf(a0 - mx), e1 = expf(a1 - mx), e2 = expf(a2 - mx), e3 = expf(a3 - mx);
        const float inv = 1.0f / (e0 + e1 + e2 + e3);
        c.lb[i] = 0.f; c.lb[1024 + i] = e1 * inv; c.lb[2048 + i] = (e1 + e2) * inv; c.lb[3072 + i] = (e1 + e2 + e3) * inv;
    }
}

DI void phase_final_norm(int wv) {
    const Ctx c = make_ctx(wv);
    const int gw = c.wg * 8 + c.wave, NGW = c.G * 8;
    const f32x4* w4 = (const f32x4*)c.in[I_RMSF];
    for (int r = gw; r < TT; r += NGW) {
        const u32x2* x2 = (const u32x2*)(c.xb + (size_t)r * D_MODEL);
        const float rstd = row_rstd(c.rowsq + DEPTH * M_PAD, r);
        f32x4* o = (f32x4*)(c.out + O_YP + (size_t)r * D_MODEL);
#pragma unroll
        for (int j = 0; j < 8; ++j) { const u32x2 p = x2[c.lane + 64 * j]; const f32x4 w = w4[c.lane + 64 * j];
            o[c.lane + 64 * j] = (f32x4){bflo(p.x) * rstd * w.x, bfhi(p.x) * rstd * w.y, bflo(p.y) * rstd * w.z, bfhi(p.y) * rstd * w.w}; }
    }
}

DI float ps4(const float* p) { return (p[0] + p[PST]) + (p[2 * PST] + p[3 * PST]); }
DI float conv1(const float* prow, float rs, int col, int ch, int nch, const float* cw, const float* cb, const float* buf) {
    return cb[ch] + cw[ch] * buf[ch] + cw[nch + ch] * buf[nch + ch] + cw[2 * nch + ch] * buf[2 * nch + ch] + cw[3 * nch + ch] * (ps4(prow + col + ch) * rs);
}
constexpr int SM_Q = 0, SM_K = 1024, SM_F = 2048, SM_V = 3072, SM_O = 4096, SM_WS = 5120, SM_PART = 5376;
DI void sample_item(const Ctx& c, int l, int s, int type) {
    LAS float* sm = (LAS float*)c.lds;
    LAS float* QS = sm + SM_Q; LAS float* KS = sm + SM_K; LAS float* FS = sm + SM_F; LAS float* VS = sm + SM_V; LAS float* OS_ = sm + SM_O; LAS float* WSUM = sm + SM_WS;
    const int tid = get_tid(c.wave), lane = tid & 63, w = c.wave;
    const float* pr = c.projs + (size_t)s * LDP; const float rs = row_rstd(c.rowsq + (size_t)l * M_PAD, TP + s);
    __syncthreads();
    if (type == 0) {
#pragma unroll
        for (int e = 0; e < 2; ++e) { const int ch = 2 * tid + e; const float qraw = (ps4(pr + C_HGQ + ch) * rs), fraw = (ps4(pr + C_HGF + ch) * rs), lbv = c.lb[(size_t)l * 1024 + ch];
            QS[ch] = silu(qraw); FS[ch] = fmaxf(lbv + (1.0f - lbv) * sigm(fraw), TINY); KS[ch] = (1.0f - lbv) * sigm(-fraw); VS[ch] = (ps4(pr + C_HGI + ch) * rs); }
    } else if (type == 1) {
#pragma unroll
        for (int e = 0; e < 2; ++e) { const int ch = 2 * tid + e; VS[ch] = (ps4(pr + C_GLV + ch) * rs);
            if (tid < 256) { QS[ch] = (ps4(pr + C_GLQ + ch) * rs) * 0.08838834764831845f; KS[ch] = (ps4(pr + C_GLK + ch) * rs);
                const float z = (ps4(pr + C_GLF + ch) * rs) + c.in[I_GBU][(size_t)l * 512 + ch]; FS[ch] = fexp(-softplus(-z) * (1.0f / 16.0f)); } }
    } else {
        const float* scw = c.in[I_SCW] + (size_t)l * 4 * 1536; const float* scb = c.in[I_SCB] + (size_t)l * 1536;
        const float* sbuf = c.in[I_SSSDC] + ((size_t)l * DEC + s) * 3 * 1536;
#pragma unroll
        for (int e = 0; e < 2; ++e) { const int ch = 2 * tid + e; VS[ch] = silu(conv1(pr, rs, C_XBC, ch, 1536, scw, scb, sbuf)); }
        if (tid < 256) { KS[tid] = silu(conv1(pr, rs, C_XBC, 1024 + tid, 1536, scw, scb, sbuf)); QS[tid] = silu(conv1(pr, rs, C_XBC, 1280 + tid, 1536, scw, scb, sbuf)); }
        if (tid < 16) { const float dt = softplus((ps4(pr + C_DT + tid) * rs) + c.in[I_DTB][l * 16 + tid]); FS[tid] = dt; FS[16 + tid] = fexp(-dt * expf(c.in[I_ALOG][l * 16 + tid])); }
    }
    __syncthreads();
    if (type < 2) {
        const int h = type == 0 ? w : (w >> 1), RS = type == 0 ? 128 : 256, voff = type == 0 ? 0 : 128 * (w & 1);
        const size_t sb = type == 0 ? (((size_t)l * DEC + s) * 8 + h) * 16384 : (((size_t)l * DEC + s) * 4 + h) * 32768;
        const float* s0 = (type == 0 ? c.in[I_SHG] : c.in[I_SGLA]) + sb; float* so = c.out + (type == 0 ? O_HG_S : O_GLA_S) + sb;
        const int vq = lane & 31, kh = lane >> 5, vb = (type == 0 ? h * 128 : h * 256 + voff) + 4 * vq, qb = h * 128;
        const f32x4 vv = *(const LAS f32x4*)(VS + vb); f32x4 o4 = (f32x4){0.f, 0.f, 0.f, 0.f};
        const int eo = kh * RS + voff + 4 * vq;
#pragma unroll 2
        for (int k8 = 0; k8 < 64; k8 += 8) {
            f32x4 st[8];
#pragma unroll
            for (int u = 0; u < 8; ++u) st[u] = *(const f32x4*)(s0 + (size_t)(2 * (k8 + u)) * RS + eo);
#pragma unroll
            for (int u = 0; u < 8; ++u) { const int k = 2 * (k8 + u) + kh; const float fk = FS[qb + k], kk = KS[qb + k], qk = QS[qb + k];
                st[u] = st[u] * fk + vv * kk; o4 += st[u] * qk; *(f32x4*)(so + (size_t)(2 * (k8 + u)) * RS + eo) = st[u]; }
        }
        o4.x += shx(o4.x, 32, lane); o4.y += shx(o4.y, 32, lane); o4.z += shx(o4.z, 32, lane); o4.w += shx(o4.w, 32, lane);
        if (kh == 0) *(LAS f32x4*)(OS_ + vb) = o4;
    } else {
        LAS float* PART = sm + SM_PART + w * 2304;
        const int nq = lane & 31, ph = lane >> 5, g = w >> 2;
        const f32x4 B4 = *(const LAS f32x4*)(KS + g * 128 + 4 * nq), C4 = *(const LAS f32x4*)(QS + g * 128 + 4 * nq);
#pragma unroll 1
        for (int hx = 0; hx < 2; ++hx) { const int h = 2 * w + hx;
            const size_t sb = (((size_t)l * DEC + s) * 16 + h) * 8192;
            const float* s0 = c.in[I_SSSD] + sb; float* so = c.out + O_SSD_S + sb;
            const float dt = FS[h], dA = FS[16 + h];
            const int eo = ph * 128 + 4 * nq;
#pragma unroll 2
            for (int p8 = 0; p8 < 32; p8 += 8) {
                f32x4 st[8];
#pragma unroll
                for (int u = 0; u < 8; ++u) st[u] = *(const f32x4*)(s0 + (size_t)(2 * (p8 + u)) * 128 + eo);
#pragma unroll
                for (int u = 0; u < 8; ++u) { const int p = 2 * (p8 + u) + ph; const float xv = VS[h * 64 + p] * dt;
                    st[u] = st[u] * dA + B4 * xv; *(f32x4*)(so + (size_t)(2 * (p8 + u)) * 128 + eo) = st[u];
                    PART[p * 36 + nq] = (st[u].x * C4.x + st[u].y * C4.y) + (st[u].z * C4.z + st[u].w * C4.w); }
            }
            asm volatile("s_waitcnt lgkmcnt(0)" ::: "memory");
            { float o = 0.f;
#pragma unroll
              for (int q = 0; q < 8; ++q) { const f32x4 t = *(const LAS f32x4*)(PART + lane * 36 + 4 * q); o += (t.x + t.y) + (t.z + t.w); }
              const float x = VS[h * 64 + lane], z = (ps4(pr + C_SSZ + h * 64 + lane) * rs);
              OS_[h * 64 + lane] = (o + c.in[I_SD][l * 16 + h] * x) * silu(z); }
            asm volatile("s_waitcnt lgkmcnt(0)" ::: "memory");
        }
    }
    __syncthreads();
    { const f32x2 o2 = *(const LAS f32x2*)(OS_ + 2 * tid);
      const float ssw = wave_sum(o2.x * o2.x + o2.y * o2.y, lane);
      if (lane == 0) WSUM[w] = ssw;
      __syncthreads();
      float ss, gsz; const float* nw; int mcol, gcol = 0;
      if (type == 0) { ss = WSUM[w]; gsz = 128.f; nw = c.in[I_HGN] + (size_t)l * 1024; mcol = 0; gcol = C_HGG; }
      else if (type == 1) { ss = WSUM[w & ~1] + WSUM[w | 1]; gsz = 256.f; nw = c.in[I_GLN] + (size_t)l * 1024; mcol = 2048; gcol = C_GLG; }
      else { const int b4 = w & ~3; ss = (WSUM[b4] + WSUM[b4 + 1]) + (WSUM[b4 + 2] + WSUM[b4 + 3]); gsz = 512.f; nw = c.in[I_SSN] + (size_t)l * 1024; mcol = 3072; }
      const float rstd = rsqrtf(ss / gsz + EPS);
      float y0 = o2.x * rstd * nw[2 * tid], y1 = o2.y * rstd * nw[2 * tid + 1];
      if (type < 2) { y0 *= silu((ps4(pr + gcol + 2 * tid) * rs)); y1 *= silu((ps4(pr + gcol + 2 * tid + 1) * rs)); }
      *(unsigned*)(c.mix + (size_t)(TP + s) * D_MIX + mcol + 2 * tid) = pk2(y0, y1); }
}

DI void lds_barrier() { asm volatile("s_waitcnt lgkmcnt(0)\n\ts_barrier" ::: "memory"); }
DI f32x16 mfma32(bf16x8 a, bf16x8 b, f32x16 c) { return __builtin_amdgcn_mfma_f32_32x32x16_bf16(a, b, c, 0, 0, 0); }
DI bf16x8 ldfrag(const LAS unsigned char* p) { return *(const LAS bf16x8*)p; }
DI int crow(int i, int hh) { return (i & 3) + 8 * (i >> 2) + 4 * hh; }
constexpr int L_QP = 0, L_KP = 17408, L_KPT = 34816, L_VT = 53248, L_VT2 = 71680, L_AM = 90112, L_TOT = 108544, L_E1 = 112640, L_E2 = 113152, L_CUM = 113664;
constexpr int SQ = 272, SV = 144;
#define ZERO16(x) do { _Pragma("unroll") for (int _i = 0; _i < 16; ++_i) (x)[_i] = 0.f; } while (0)

template <int TYPE>
DI void la_head_unit(const Ctx& c, int l, int b, int hu) {
    constexpr int DV = 128, NSW = DV / 32, OS = DV * 2 + 16, NC = DV / 8;
    LAS unsigned char* L = c.lds;
    const int tid = get_tid(c.wave), lane = tid & 63, w = c.wave;
    const int r = lane & 31, hh = lane >> 5;
    const int row0 = b * SEQ;
    const bf16_t* P = TYPE == 2 ? c.xbcs : c.proj;
    constexpr int LDR = TYPE == 2 ? 1536 : LDP;
    LAS float* TOT = (LAS float*)(L + L_TOT); LAS float* E1 = (LAS float*)(L + L_E1); LAS float* E2 = (LAS float*)(L + L_E2);
    int colQ, colK, colG, colV, colGate, colOut, sidx; const int grp = hu >> 2;
    if constexpr (TYPE == 0) { colQ = C_HGQ + hu * 128; colK = 0; colG = C_HGF + hu * 128; colV = C_HGI + hu * 128; colGate = C_HGG + hu * 128; colOut = hu * 128; sidx = 0; }
    else if constexpr (TYPE == 1) { const int hd = hu >> 1; colQ = C_GLQ + hd * 128; colK = C_GLK + hd * 128; colG = C_GLF + hd * 128; colV = C_GLV + hu * 128; colGate = C_GLG + hu * 128; colOut = 2048 + hu * 128; sidx = 2 + hd; }
    else { colK = 1024 + grp * 128; colQ = 1280 + grp * 128; colG = 0; colV = hu * 128; colGate = C_SSZ + hu * 128; colOut = 3072 + hu * 128; sidx = grp; }
    float Ah[2], Dh[2];
    if constexpr (TYPE == 2) {
#pragma unroll
        for (int e = 0; e < 2; ++e) { Ah[e] = -expf(c.in[I_ALOG][l * 16 + 2 * hu + e]); Dh[e] = c.in[I_SD][l * 16 + 2 * hu + e]; }
    }
    unsigned r0[8], r1[8], r2[8], r3[8]; float dtn = 0.f;
#define LOAD_CHUNK(tn) do { const bf16_t* pq_ = P + (size_t)(row0 + (tn) + 8 * w) * LDR + 2 * lane; \
        if constexpr (TYPE == 0) { _Pragma("unroll") for (int i = 0; i < 8; ++i) { r0[i] = *(const unsigned*)(pq_ + (size_t)i * LDR + colQ); r1[i] = *(const unsigned*)(pq_ + (size_t)i * LDR + colG); r2[i] = *(const unsigned*)(pq_ + (size_t)i * LDR + colV); } } \
        else if constexpr (TYPE == 1) { _Pragma("unroll") for (int i = 0; i < 8; ++i) { r0[i] = *(const unsigned*)(pq_ + (size_t)i * LDR + colQ); r1[i] = *(const unsigned*)(pq_ + (size_t)i * LDR + colK); \
                                                                                       r2[i] = *(const unsigned*)(pq_ + (size_t)i * LDR + colG); r3[i] = *(const unsigned*)(pq_ + (size_t)i * LDR + colV); } } \
        else { _Pragma("unroll") for (int i = 0; i < 8; ++i) { r0[i] = *(const unsigned*)(pq_ + (size_t)i * LDR + colQ); r1[i] = *(const unsigned*)(pq_ + (size_t)i * LDR + colK); r2[i] = *(const unsigned*)(pq_ + (size_t)i * LDR + colV); } \
            if (w < 2) dtn = c.dtb[(size_t)(row0 + (tn) + lane) * 16 + 2 * hu + w]; } } while (0)
    f32x16 S[4];
#pragma unroll
    for (int kt = 0; kt < 4; ++kt) ZERO16(S[kt]);
    float e2pa = 1.f, e2pb = 1.f;
    constexpr bool PF = true;
    if constexpr (PF) LOAD_CHUNK(0);
    for (int ck = -(SEQ / 64) * (PROBE_LONG_REP - 1); ck < SEQ / 64; ++ck) {
        if (PROBE_LONG_REP > 1 && ck == 0) { e2pa = 1.f; e2pb = 1.f;
#pragma unroll
            for (int kt = 0; kt < 4; ++kt) ZERO16(S[kt]); }
        const int t0 = (ck & (SEQ / 64 - 1)) * 64;
        LAS float* CUM = (LAS float*)(L + L_CUM + (ck & 1) * 1536);
        if constexpr (!PF) LOAD_CHUNK(t0);
        float qa[8], qb[8], ka[8], kb[8], ga[8], gb[8], xa[8], xb[8]; unsigned uv[8];
        if constexpr (TYPE == 0) {
            float ta = 0.f, tb = 0.f;
#pragma unroll
            for (int i = 0; i < 8; ++i) { qa[i] = bflo(r0[i]); qb[i] = bfhi(r0[i]); const float g0 = bflo(r1[i]), g1 = bfhi(r1[i]); uv[i] = r2[i];
                ka[i] = 1.0f - fexp(g0); kb[i] = 1.0f - fexp(g1); ta += g0; tb += g1; ga[i] = ta; gb[i] = tb; }
            *(LAS f32x2*)(TOT + w * 128 + 2 * lane) = (f32x2){ta, tb};
        } else if constexpr (TYPE == 1) {
            float ta = 0.f, tb = 0.f;
#pragma unroll
            for (int i = 0; i < 8; ++i) { qa[i] = bflo(r0[i]); qb[i] = bfhi(r0[i]); ka[i] = bflo(r1[i]); kb[i] = bfhi(r1[i]); ta += bflo(r2[i]); tb += bfhi(r2[i]); ga[i] = ta; gb[i] = tb; uv[i] = r3[i]; }
            *(LAS f32x2*)(TOT + w * 128 + 2 * lane) = (f32x2){ta, tb};
        } else {
#pragma unroll
            for (int i = 0; i < 8; ++i) { qa[i] = bflo(r0[i]); qb[i] = bfhi(r0[i]); ka[i] = bflo(r1[i]); kb[i] = bfhi(r1[i]); xa[i] = bflo(r2[i]); xb[i] = bfhi(r2[i]); }
            if (w < 2) {
                const float dt = dtn; float x = dt * (w == 0 ? Ah[0] : Ah[1]);
#pragma unroll
                for (int o = 1; o < 64; o <<= 1) { const float y = shup(x, o, lane); if (lane >= o) x += y; }
                CUM[w * 192 + lane] = x; CUM[w * 192 + 64 + lane] = fmaxf(dt, 1e-30f); CUM[w * 192 + 128 + lane] = fexp(x);
            }
        }
        lds_barrier();
        if constexpr (TYPE < 2) {
            float offa = 0.f, offb = 0.f, brefa = 0.f, brefb = 0.f, bla = 0.f, blb = 0.f;
#pragma unroll
            for (int g = 0; g < 8; ++g) { const f32x2 t = *(const LAS f32x2*)(TOT + g * 128 + 2 * lane);
                if (g < w) { offa += t.x; offb += t.y; }
                if (g < 4) { brefa += t.x; brefb += t.y; }
                bla += t.x; blb += t.y; }
#pragma unroll
            for (int i = 0; i < 8; ++i) { const float da = clampf(ga[i] + offa - brefa, -80.f, 80.f), db = clampf(gb[i] + offb - brefb, -80.f, 80.f);
                qa[i] *= fexp(da); ka[i] *= fexp(-da); qb[i] *= fexp(db); kb[i] *= fexp(-db); }
            if (w == 0) {
                const float e2a = fexp(bla - brefa), e2b = fexp(blb - brefb);
                *(LAS f32x2*)(E1 + 2 * lane) = (f32x2){fexp(brefa) * e2pa, fexp(brefb) * e2pb}; *(LAS f32x2*)(E2 + 2 * lane) = (f32x2){e2a, e2b}; e2pa = e2a; e2pb = e2b; }
        }
#pragma unroll
        for (int i = 0; i < 8; ++i) { *(LAS unsigned*)(L + L_QP + (8 * w + i) * SQ + 4 * lane) = pk2(qa[i], qb[i]); *(LAS unsigned*)(L + L_KP + (8 * w + i) * SQ + 4 * lane) = pk2(ka[i], kb[i]); }
        { u32x4 a, bq; a.x = pk2(ka[0], ka[1]); a.y = pk2(ka[2], ka[3]); a.z = pk2(ka[4], ka[5]); a.w = pk2(ka[6], ka[7]);
          bq.x = pk2(kb[0], kb[1]); bq.y = pk2(kb[2], kb[3]); bq.z = pk2(kb[4], kb[5]); bq.w = pk2(kb[6], kb[7]);
          *(LAS u32x4*)(L + L_KPT + (2 * lane) * SV + 16 * w) = a; *(LAS u32x4*)(L + L_KPT + (2 * lane + 1) * SV + 16 * w) = bq; }
        if constexpr (TYPE < 2) {
            u32x4 a, bq;
            a.x = (uv[0] & 0xffffu) | (uv[1] << 16); a.y = (uv[2] & 0xffffu) | (uv[3] << 16); a.z = (uv[4] & 0xffffu) | (uv[5] << 16); a.w = (uv[6] & 0xffffu) | (uv[7] << 16);
            bq.x = (uv[0] >> 16) | (uv[1] & 0xffff0000u); bq.y = (uv[2] >> 16) | (uv[3] & 0xffff0000u); bq.z = (uv[4] >> 16) | (uv[5] & 0xffff0000u); bq.w = (uv[6] >> 16) | (uv[7] & 0xffff0000u);
            *(LAS u32x4*)(L + L_VT + (2 * lane) * SV + 16 * w) = a; *(LAS u32x4*)(L + L_VT + (2 * lane + 1) * SV + 16 * w) = bq;
        } else {
            const int hs = lane >> 5;
            const LAS float* cm = CUM + hs * 192; const float cl = cm[63];
            float v1a[8], v1b[8], v2a[8], v2b[8];
#pragma unroll
            for (int j = 0; j < 8; ++j) { const int s = 8 * w + j; const float dt = cm[64 + s], wgt = fexp(fminf(cl - cm[s], 0.f));
                v1a[j] = dt * xa[j]; v1b[j] = dt * xb[j]; v2a[j] = v1a[j] * wgt; v2b[j] = v1b[j] * wgt; }
            u32x4 a, bq;
            a.x = pk2(v1a[0], v1a[1]); a.y = pk2(v1a[2], v1a[3]); a.z = pk2(v1a[4], v1a[5]); a.w = pk2(v1a[6], v1a[7]);
            bq.x = pk2(v1b[0], v1b[1]); bq.y = pk2(v1b[2], v1b[3]); bq.z = pk2(v1b[4], v1b[5]); bq.w = pk2(v1b[6], v1b[7]);
            *(LAS u32x4*)(L + L_VT + (2 * lane) * SV + 16 * w) = a; *(LAS u32x4*)(L + L_VT + (2 * lane + 1) * SV + 16 * w) = bq;
            a.x = pk2(v2a[0], v2a[1]); a.y = pk2(v2a[2], v2a[3]); a.z = pk2(v2a[4], v2a[5]); a.w = pk2(v2a[6], v2a[7]);
            bq.x = pk2(v2b[0], v2b[1]); bq.y = pk2(v2b[2], v2b[3]); bq.z = pk2(v2b[4], v2b[5]); bq.w = pk2(v2b[6], v2b[7]);
            *(LAS u32x4*)(L + L_VT2 + (2 * lane) * SV + 16 * w) = a; *(LAS u32x4*)(L + L_VT2 + (2 * lane + 1) * SV + 16 * w) = bq;
        }
        lds_barrier();
        if constexpr (PF) { if (ck + 1 < SEQ / 64) LOAD_CHUNK(((ck + 1) & (SEQ / 64 - 1)) * 64); }
        if (w >= 5) {
            const int sb = (w == 7) ? 1 : 0, tb = (w == 5) ? 0 : 1;
            f32x16 X; ZERO16(X);
#pragma unroll
            for (int k4 = 0; k4 < 8; k4 += 4) { bf16x8 fk[4], fq[4];
#pragma unroll
                for (int u = 0; u < 4; ++u) { fk[u] = ldfrag(L + L_KP + (32 * sb + r) * SQ + (16 * (k4 + u) + 8 * hh) * 2); fq[u] = ldfrag(L + L_QP + (32 * tb + r) * SQ + (16 * (k4 + u) + 8 * hh) * 2); }
#pragma unroll
                for (int u = 0; u < 4; ++u) X = mfma32(fk[u], fq[u], X); }
            const int t = 32 * tb + r;
#pragma unroll
            for (int hs = 0; hs < (TYPE == 2 ? 2 : 1); ++hs) {
                float ct = 0.f, ddt = 0.f;
                if constexpr (TYPE == 2) { ct = CUM[hs * 192 + t]; ddt = (hs == 0 ? Dh[0] : Dh[1]) / CUM[hs * 192 + 64 + t]; }
#pragma unroll
                for (int g = 0; g < 4; ++g) { const int s0 = 32 * sb + 8 * g + 4 * hh;
                    float x0 = X[4 * g], x1 = X[4 * g + 1], x2 = X[4 * g + 2], x3 = X[4 * g + 3];
                    if constexpr (TYPE == 2) { const f32x4 cs = *(const LAS f32x4*)(CUM + hs * 192 + s0);
                        x0 *= fexp(fminf(ct - cs.x, 0.f)); x1 *= fexp(fminf(ct - cs.y, 0.f)); x2 *= fexp(fminf(ct - cs.z, 0.f)); x3 *= fexp(fminf(ct - cs.w, 0.f));
                        x0 += (s0 == t) ? ddt : 0.f; x1 += (s0 + 1 == t) ? ddt : 0.f; x2 += (s0 + 2 == t) ? ddt : 0.f; x3 += (s0 + 3 == t) ? ddt : 0.f; }
                    x0 = (s0 <= t) ? x0 : 0.f; x1 = (s0 + 1 <= t) ? x1 : 0.f; x2 = (s0 + 2 <= t) ? x2 : 0.f; x3 = (s0 + 3 <= t) ? x3 : 0.f;
                    u32x2 p; p.x = pk2(x0, x1); p.y = pk2(x2, x3);
                    *(LAS u32x2*)(L + L_AM + hs * 9216 + t * SV + s0 * 2) = p; }
            }
        }
        f32x16 O[2]; bf16x8 Bv[4];
        const int hsw = w >> 1;
        if (w < NSW) {
            if constexpr (TYPE < 2) {
#pragma unroll
                for (int kt = 0; kt < 4; ++kt)
#pragma unroll
                    for (int g = 0; g < 4; ++g) { const f32x4 e = *(const LAS f32x4*)(E1 + 32 * kt + 8 * g + 4 * hh);
                        S[kt][4 * g] *= e.x; S[kt][4 * g + 1] *= e.y; S[kt][4 * g + 2] *= e.z; S[kt][4 * g + 3] *= e.w; }
            }
            ZERO16(O[0]); ZERO16(O[1]);
#pragma unroll
            for (int kt = 0; kt < 4; ++kt) {
                u32x2 ql[2][2], qh[2][2];
#pragma unroll
                for (int s = 0; s < 2; ++s)
#pragma unroll
                    for (int tt = 0; tt < 2; ++tt) { const LAS unsigned char* qp = L + L_QP + (32 * tt + r) * SQ + (32 * kt + 16 * s + 4 * hh) * 2;
                        ql[s][tt] = *(const LAS u32x2*)qp; qh[s][tt] = *(const LAS u32x2*)(qp + 16); }
#pragma unroll
                for (int s = 0; s < 2; ++s) {
                    u32x4 pa; pa.x = pk2(S[kt][8 * s], S[kt][8 * s + 1]); pa.y = pk2(S[kt][8 * s + 2], S[kt][8 * s + 3]); pa.z = pk2(S[kt][8 * s + 4], S[kt][8 * s + 5]); pa.w = pk2(S[kt][8 * s + 6], S[kt][8 * s + 7]);
                    const bf16x8 A = __builtin_bit_cast(bf16x8, pa);
#pragma unroll
                    for (int tt = 0; tt < 2; ++tt) O[tt] = mfma32(A, __builtin_bit_cast(bf16x8, (u32x4){ql[s][tt].x, ql[s][tt].y, qh[s][tt].x, qh[s][tt].y}), O[tt]);
                }
            }
            if constexpr (TYPE == 2) {
                const LAS float* cm = CUM + hsw * 192; const float e0 = cm[128 + r], e1 = cm[128 + 32 + r], sc = cm[128 + 63];
#pragma unroll
                for (int i = 0; i < 16; ++i) { O[0][i] *= e0; O[1][i] *= e1; }
#pragma unroll
                for (int kt = 0; kt < 4; ++kt)
#pragma unroll
                    for (int i = 0; i < 16; ++i) S[kt][i] *= sc;
            }
#pragma unroll
            for (int st = 0; st < 4; ++st) { bf16x8 kf[4];
                Bv[st] = ldfrag(L + (TYPE == 2 ? L_VT2 : L_VT) + (32 * w + r) * SV + (16 * st + 8 * hh) * 2);
#pragma unroll
                for (int kt = 0; kt < 4; ++kt) kf[kt] = ldfrag(L + L_KPT + (32 * kt + r) * SV + (16 * st + 8 * hh) * 2);
#pragma unroll
                for (int kt = 0; kt < 4; ++kt) S[kt] = mfma32(kf[kt], Bv[st], S[kt]); }
        }
        const int nt_ = tid >> 3, nseg = tid & 7;
        u32x4 gq[NC / 8];
        { const bf16_t* pg = c.proj + (size_t)(row0 + t0 + nt_) * LDP + colGate + nseg * NC;
#pragma unroll
          for (int q = 0; q < NC / 8; ++q) gq[q] = *(const u32x4*)(pg + 8 * q); }
        lds_barrier();
        if (w < NSW) {
#pragma unroll
            for (int st = 0; st < 4; ++st) { bf16x8 Av = Bv[st];
                if constexpr (TYPE == 2) Av = ldfrag(L + L_VT + (32 * w + r) * SV + (16 * st + 8 * hh) * 2);
#pragma unroll
                for (int tt = 0; tt < 2; ++tt) if (st < 2 || tt == 1)
                    O[tt] = mfma32(Av, ldfrag(L + L_AM + (TYPE == 2 ? hsw * 9216 : 0) + (32 * tt + r) * SV + (16 * st + 8 * hh) * 2), O[tt]); }
#pragma unroll
            for (int tt = 0; tt < 2; ++tt)
#pragma unroll
                for (int g = 0; g < 4; ++g) { u32x2 p; p.x = pk2(O[tt][4 * g], O[tt][4 * g + 1]); p.y = pk2(O[tt][4 * g + 2], O[tt][4 * g + 3]);
                    *(LAS u32x2*)(L + (32 * tt + r) * OS + (32 * w + 8 * g + 4 * hh) * 2) = p; }
        }
        lds_barrier();
        {
            float o[NC], gv[NC]; float ss = 0.f;
#pragma unroll
            for (int q = 0; q < NC / 8; ++q) { const u32x4 ov = *(const LAS u32x4*)(L + nt_ * OS + (nseg * NC + 8 * q) * 2);
                o[8 * q] = bflo(ov.x); o[8 * q + 1] = bfhi(ov.x); o[8 * q + 2] = bflo(ov.y); o[8 * q + 3] = bfhi(ov.y); o[8 * q + 4] = bflo(ov.z); o[8 * q + 5] = bfhi(ov.z); o[8 * q + 6] = bflo(ov.w); o[8 * q + 7] = bfhi(ov.w);
                gv[8 * q] = bflo(gq[q].x); gv[8 * q + 1] = bfhi(gq[q].x); gv[8 * q + 2] = bflo(gq[q].y); gv[8 * q + 3] = bfhi(gq[q].y); gv[8 * q + 4] = bflo(gq[q].z); gv[8 * q + 5] = bfhi(gq[q].z); gv[8 * q + 6] = bflo(gq[q].w); gv[8 * q + 7] = bfhi(gq[q].w); }
            if constexpr (TYPE == 2) {
#pragma unroll
                for (int e = 0; e < NC; ++e) o[e] *= gv[e];
            }
#pragma unroll
            for (int e = 0; e < NC; ++e) ss += o[e] * o[e];
            ss += shx(ss, 1, lane); ss += shx(ss, 2, lane); ss += shx(ss, 4, lane);
            float mul = 1.0f;
            if constexpr (TYPE == 0) mul = rsqrtf(ss * (1.0f / DV) + EPS);
            else { if (nseg == 0 && ck >= 0) atomicAdd((float*)(c.ctl + CW_STATS) + ((size_t)l * TP + row0 + t0 + nt_) * 6 + sidx, ss); }
            if constexpr (TYPE < 2) {
#pragma unroll
                for (int e = 0; e < NC; ++e) o[e] *= mul * gv[e];
            }
            bf16_t* pm = c.mix + (size_t)(row0 + t0 + nt_) * D_MIX + colOut + nseg * NC;
#pragma unroll
            for (int q = 0; q < NC / 8; ++q) { u32x4 ov; ov.x = pk2(o[8 * q], o[8 * q + 1]); ov.y = pk2(o[8 * q + 2], o[8 * q + 3]); ov.z = pk2(o[8 * q + 4], o[8 * q + 5]); ov.w = pk2(o[8 * q + 6], o[8 * q + 7]);
                *(u32x4*)(pm + 8 * q) = ov; }
        }
    }
#undef LOAD_CHUNK
    if (w < NSW) {
        const int lane2 = get_tid(c.wave) & 63, r = lane2 & 31, hh = lane2 >> 5;
        if constexpr (TYPE < 2) {
#pragma unroll
            for (int kt = 0; kt < 4; ++kt)
#pragma unroll
                for (int g = 0; g < 4; ++g) { const f32x4 e = *(const LAS f32x4*)(E2 + 32 * kt + 8 * g + 4 * hh);
                    S[kt][4 * g] *= e.x; S[kt][4 * g + 1] *= e.y; S[kt][4 * g + 2] *= e.z; S[kt][4 * g + 3] *= e.w; }
        }
        float* sout; int sk, sv, vb;
        if constexpr (TYPE == 0) { sout = c.out + O_HG_P + (((size_t)l * NB + b) * 8 + hu) * 16384; sk = 128; sv = 1; vb = 32 * w; }
        else if constexpr (TYPE == 1) { sout = c.out + O_GLA_P + (((size_t)l * NB + b) * 4 + (hu >> 1)) * 32768; sk = 256; sv = 1; vb = 128 * (hu & 1) + 32 * w; }
        else { sout = c.out + O_SSD_P + (((size_t)l * NB + b) * 16 + 2 * hu + (w >> 1)) * 8192; sk = 1; sv = 128; vb = 32 * (w & 1); }
#pragma unroll
        for (int kt = 0; kt < 4; ++kt)
#pragma unroll
            for (int i = 0; i < 16; ++i) sout[(32 * kt + crow(i, hh)) * sk + (vb + r) * sv] = S[kt][i];
    }
}

constexpr int R_WT = 74752;
DI void rg_load_gates(const Ctx& c, int l, int n, int tid, int j, int hh, bf16x8 (&Br)[8], bf16x8 (&Bi)[8]) {
    LAS unsigned char* L = c.lds;
    const float* wr = c.in[I_WR] + (size_t)(l * 8 + n) * 128 * 128; const float* wi = c.in[I_WI] + (size_t)(l * 8 + n) * 128 * 128;
    __syncthreads();
    f32x4 v[16];
#pragma unroll
    for (int q = 0; q < 16; ++q) { const int e = tid + 512 * q, mat = e >> 12, rem = e & 4095; v[q] = *(const f32x4*)((mat ? wi : wr) + rem * 4); }
#pragma unroll
    for (int q = 0; q < 16; ++q) { const int e = tid + 512 * q, mat = e >> 12, rem = e & 4095, i = rem >> 5, j4 = (rem & 31) * 4;
        LAS unsigned char* p = L + R_WT + mat * 34816 + j4 * SQ + i * 2;
        *(LAS bf16_t*)(p) = (bf16_t)f2bf(v[q].x); *(LAS bf16_t*)(p + SQ) = (bf16_t)f2bf(v[q].y); *(LAS bf16_t*)(p + 2 * SQ) = (bf16_t)f2bf(v[q].z); *(LAS bf16_t*)(p + 3 * SQ) = (bf16_t)f2bf(v[q].w); }
    __syncthreads();
#pragma unroll
    for (int ks = 0; ks < 8; ++ks) { Br[ks] = ldfrag(L + R_WT + j * SQ + (16 * ks + 8 * hh) * 2); Bi[ks] = ldfrag(L + R_WT + 34816 + j * SQ + (16 * ks + 8 * hh) * 2); }
}
constexpr int R_XCB = 0, R_XCF = 17408, R_SUMA = 50176, R_SUMU = 58368, R_HIN = 66560;
DI void rg_chunk_unit(const Ctx& c, int l, int b, int n) {
    LAS unsigned char* L = c.lds;
    const int tid = get_tid(c.wave), lane = tid & 63, w = c.wave, r = lane & 31, hh = lane >> 5;
    const int tb = w >> 2, jb = w & 3;
    const int j = 32 * jb + r, ch = n * 128 + j;
    const int row0 = b * SEQ;
    const bf16_t* P = c.proj;
    LAS float* XCF = (LAS float*)(L + R_XCF); LAS float* SUMA = (LAS float*)(L + R_SUMA); LAS float* SUMU = (LAS float*)(L + R_SUMU); LAS float* HIN = (LAS float*)(L + R_HIN);
    bf16x8 Br[8], Bi[8];
    rg_load_gates(c, l, n, tid, j, hh, Br, Bi);
    const float sp = softplus(-c.in[I_LAM][l * 1024 + ch]), brv = c.in[I_BR][(l * 8 + n) * 128 + j], biv = c.in[I_BI][(l * 8 + n) * 128 + j];
    float cw[4][2], cb[2];
#pragma unroll
    for (int e = 0; e < 2; ++e) {
#pragma unroll
        for (int m = 0; m < 4; ++m) cw[m][e] = c.in[I_RCW][l * 4 * 1024 + m * 1024 + n * 128 + 2 * lane + e];
        cb[e] = c.in[I_RCB][l * 1024 + n * 128 + 2 * lane + e]; }
    float hcarry = 0.f;
    for (int ck = -(SEQ / 64) * (PROBE_RG_REP - 1); ck < SEQ / 64; ++ck) {
        if (PROBE_RG_REP > 1 && ck == 0) hcarry = 0.f;
        const int t0 = (ck & (SEQ / 64 - 1)) * 64;
        { const bf16_t* pq = P + (size_t)(row0 + t0 + 8 * w) * LDP + C_RGX + n * 128 + 2 * lane; const bool first = (t0 == 0 && w == 0);
          unsigned ux[11];
#pragma unroll
          for (int jx = 0; jx < 11; ++jx) ux[jx] = (first && jx < 3) ? 0u : *(const unsigned*)(pq + (ptrdiff_t)(jx - 3) * LDP);
#pragma unroll
          for (int i = 0; i < 8; ++i) { const int t = 8 * w + i;
              const float x0 = cb[0] + cw[0][0] * bflo(ux[i]) + cw[1][0] * bflo(ux[i + 1]) + cw[2][0] * bflo(ux[i + 2]) + cw[3][0] * bflo(ux[i + 3]);
              const float x1 = cb[1] + cw[0][1] * bfhi(ux[i]) + cw[1][1] * bfhi(ux[i + 1]) + cw[2][1] * bfhi(ux[i + 2]) + cw[3][1] * bfhi(ux[i + 3]);
              *(LAS f32x2*)(XCF + t * 128 + 2 * lane) = (f32x2){x0, x1}; *(LAS unsigned*)(L + R_XCB + t * SQ + 4 * lane) = pk2(x0, x1); } }
        float gt[16];
        { const bf16_t* pg = P + (size_t)(row0 + t0 + 32 * tb) * LDP; const int goff = 4 * hh * LDP + C_RGG + ch;
#pragma unroll
          for (int i = 0; i < 16; ++i) gt[i] = bf1((pg + (size_t)((i & 3) + 8 * (i >> 2)) * LDP)[goff]); }
        lds_barrier();
        f32x16 R, I; ZERO16(R); ZERO16(I);
#pragma unroll
        for (int ks = 0; ks < 8; ++ks) { const bf16x8 a = ldfrag(L + R_XCB + (32 * tb + r) * SQ + (16 * ks + 8 * hh) * 2); R = mfma32(a, Br[ks], R); I = mfma32(a, Bi[ks], I); }
        float av[16], uv[16];
#pragma unroll
        for (int i = 0; i < 16; ++i) { const int t = 32 * tb + crow(i, hh); const float rr = sigm_fast(R[i] + brv), ii = sigm_fast(I[i] + biv), xc = XCF[t * 128 + j];
            const float la = -8.0f * rr * sp; av[i] = fexp(la); uv[i] = sqrtf(fmaxf(neg_expm1(2.0f * la), 0.f)) * (ii * xc); }
#pragma unroll
        for (int g = 0; g < 4; ++g) { float A = 1.f, U = 0.f;
#pragma unroll
            for (int m = 0; m < 4; ++m) { U = av[4 * g + m] * U + uv[4 * g + m]; A *= av[4 * g + m]; }
            const int gi = 8 * tb + 2 * g + hh; SUMA[gi * 128 + j] = A; SUMU[gi * 128 + j] = U; }
        lds_barrier();
        if (tid < 128) { float hc = hcarry;
#pragma unroll
            for (int gi = 0; gi < 16; ++gi) { HIN[gi * 128 + tid] = hc; hc = SUMA[gi * 128 + tid] * hc + SUMU[gi * 128 + tid]; }
            hcarry = hc; }
        lds_barrier();
        { bf16_t* pm = c.mix + (size_t)(row0 + t0 + 32 * tb) * D_MIX; const int moff = 4 * hh * D_MIX + 1024 + ch;
#pragma unroll
          for (int g = 0; g < 4; ++g) { float hc = HIN[(8 * tb + 2 * g + hh) * 128 + j];
#pragma unroll
            for (int m = 0; m < 4; ++m) { const int i = 4 * g + m; hc = av[i] * hc + uv[i];
                (pm + (size_t)((i & 3) + 8 * (i >> 2)) * D_MIX)[moff] = (bf16_t)f2bf(hc * gt[i]); } } }
    }
    if (tid < 128) c.out[O_RG_P + ((size_t)l * NB + b) * 1024 + n * 128 + tid] = hcarry;
}

DI void rg_sample_unit(const Ctx& c, int l, int n) {
    LAS unsigned char* L = c.lds;
    const int tid = get_tid(c.wave), lane = tid & 63, w = c.wave, r = lane & 31, hh = lane >> 5;
    const int tb = w >> 2, jb = w & 3;
    const int j = 32 * jb + r, ch = n * 128 + j;
    LAS float* XCF = (LAS float*)(L + R_XCF);
    bf16x8 Br[8], Bi[8];
    rg_load_gates(c, l, n, tid, j, hh, Br, Bi);
    const float sp = softplus(-c.in[I_LAM][l * 1024 + ch]), brv = c.in[I_BR][(l * 8 + n) * 128 + j], biv = c.in[I_BI][(l * 8 + n) * 128 + j];
    float cw[4][2], cb[2];
#pragma unroll
    for (int e = 0; e < 2; ++e) {
#pragma unroll
        for (int m = 0; m < 4; ++m) cw[m][e] = c.in[I_RCW][l * 4 * 1024 + m * 1024 + n * 128 + 2 * lane + e];
        cb[e] = c.in[I_RCB][l * 1024 + n * 128 + 2 * lane + e]; }
    for (int chunk = 0; chunk < 2; ++chunk) {
        __syncthreads();
#pragma unroll
        for (int i = 0; i < 8; ++i) { const int t = 8 * w + i, s = 64 * chunk + t;
            const float* buf = c.in[I_SRGC] + ((size_t)l * DEC + s) * 3 * 1024 + n * 128 + 2 * lane;
            const f32x2 b0 = *(const f32x2*)buf, b1 = *(const f32x2*)(buf + 1024), b2 = *(const f32x2*)(buf + 2048), xn = (f32x2){ps4(c.projs + (size_t)s * LDP + C_RGX + n * 128 + 2 * lane), ps4(c.projs + (size_t)s * LDP + C_RGX + n * 128 + 2 * lane + 1)} * row_rstd(c.rowsq + (size_t)l * M_PAD, TP + s);
            const float x0 = cb[0] + cw[0][0] * b0.x + cw[1][0] * b1.x + cw[2][0] * b2.x + cw[3][0] * xn.x;
            const float x1 = cb[1] + cw[0][1] * b0.y + cw[1][1] * b1.y + cw[2][1] * b2.y + cw[3][1] * xn.y;
            *(LAS f32x2*)(XCF + t * 128 + 2 * lane) = (f32x2){x0, x1}; *(LAS unsigned*)(L + R_XCB + t * SQ + 4 * lane) = pk2(x0, x1); }
        __syncthreads();
        f32x16 R, I; ZERO16(R); ZERO16(I);
#pragma unroll
        for (int ks = 0; ks < 8; ++ks) { const bf16x8 a = ldfrag(L + R_XCB + (32 * tb + r) * SQ + (16 * ks + 8 * hh) * 2); R = mfma32(a, Br[ks], R); I = mfma32(a, Bi[ks], I); }
#pragma unroll
        for (int i = 0; i < 16; ++i) { const int t = 32 * tb + crow(i, hh), s = 64 * chunk + t;
            const float rr = sigm(R[i] + brv), ii = sigm(I[i] + biv), xc = XCF[t * 128 + j];
            const float la = -8.0f * rr * sp, a = fexp(la);
            const float hn = a * c.in[I_SRG][((size_t)l * DEC + s) * 1024 + ch] + sqrtf(fmaxf(neg_expm1(2.0f * la), 0.f)) * (ii * xc);
            c.mix[(size_t)(TP + s) * D_MIX + 1024 + ch] = (bf16_t)f2bf(hn * silu(ps4(c.projs + (size_t)s * LDP + C_RGG + ch) * row_rstd(c.rowsq + (size_t)l * M_PAD, TP + s)));
            c.out[O_RG_S + ((size_t)l * DEC + s) * 1024 + ch] = hn; }
    }
}

#ifndef PROBE_REP_LONG
#define PROBE_REP_LONG 1
#endif
#ifndef PROBE_G1_REP
#define PROBE_G1_REP 1
#endif
#ifndef PROBE_REP_SHORT
#define PROBE_REP_SHORT 1
#endif
DI void xbc_prepass_item(const Ctx& c, int l, int it) {
    const int tid = get_tid(c.wave);
    const float* scw = c.in[I_SCW] + (size_t)l * 4 * 1536; const float* scb = c.in[I_SCB] + (size_t)l * 1536;
    const int r0 = it * 32; const bool head = (r0 & (SEQ - 1)) == 0;
    for (int p = tid; p < 768; p += 512) {
        float cw[4][2], cb[2];
#pragma unroll
        for (int e = 0; e < 2; ++e) { cb[e] = scb[2 * p + e];
#pragma unroll
            for (int m = 0; m < 4; ++m) cw[m][e] = scw[m * 1536 + 2 * p + e]; }
        const bf16_t* src = c.proj + (size_t)r0 * LDP + C_XBC + 2 * p; bf16_t* dst = c.xbcs + (size_t)r0 * 1536 + 2 * p;
        unsigned u0 = head ? 0u : *(const unsigned*)(src - 3 * (ptrdiff_t)LDP), u1 = head ? 0u : *(const unsigned*)(src - 2 * (ptrdiff_t)LDP), u2 = head ? 0u : *(const unsigned*)(src - (ptrdiff_t)LDP);
#pragma unroll 8
        for (int i = 0; i < 32; ++i) { const unsigned u3 = *(const unsigned*)(src + (size_t)i * LDP);
            const float a = silu(cb[0] + cw[0][0] * bflo(u0) + cw[1][0] * bflo(u1) + cw[2][0] * bflo(u2) + cw[3][0] * bflo(u3));
            const float b = silu(cb[1] + cw[0][1] * bfhi(u0) + cw[1][1] * bfhi(u1) + cw[2][1] * bfhi(u2) + cw[3][1] * bfhi(u3));
            *(unsigned*)(dst + (size_t)i * 1536) = pk2(a, b); u0 = u1; u1 = u2; u2 = u3; }
    }
}
DI void phase_mixer(int l, int wv) {
    const Ctx c = make_ctx(wv);
    constexpr int PER_B = 8 + 8 + 8 + 8;
    constexpr int N_LONG = NB * PER_B, N_SHORT = 8 + DEC * 3;
    constexpr int NREP = 1;
    volatile LAS int* slot = (volatile LAS int*)(c.lds + MISC_OFF + 64);
    unsigned* xpre = c.ctl + CW_XPRE + 64 * l;
    if (c.wg >= N_LONG || c.G <= N_LONG) {
        const int nfree = c.G > N_LONG ? c.G - N_LONG : c.G, first = c.G > N_LONG ? c.wg - N_LONG : c.wg; int done = 0;
        for (int it = first; it < TP / 32; it += nfree) { xbc_prepass_item(c, l, it); ++done; }
        asm volatile("s_waitcnt vmcnt(0)" ::: "memory"); __syncthreads();
        if (c.tid == 0) { __builtin_amdgcn_fence(__ATOMIC_RELEASE, "agent"); asm volatile("s_waitcnt vmcnt(0)" ::: "memory"); __hip_atomic_fetch_add(xpre, (unsigned)done, __ATOMIC_RELAXED, __HIP_MEMORY_SCOPE_AGENT); }
    }
    for (int rep = 0; rep < NREP; ++rep) {
    unsigned* ctr = c.ctl + CW_QCTR + 64 * (l * 4 + rep);
    int cur = c.wg; bool dyn = false;
    for (;;) {
        int item;
        if (!dyn) { if (cur < N_LONG) { item = cur; cur += c.G; } else { dyn = true; continue; } }
        else {
            __syncthreads();
            if (c.tid == 0) *slot = (int)atomicAdd(ctr, 1u);
            __syncthreads();
            item = N_LONG + *slot;
            if (item >= N_LONG + N_SHORT) break;
        }
        if (item < N_LONG) {
            const int b = item & 3, u = item >> 2;
            if (u < 8) la_head_unit<1>(c, l, b, u); else if (u < 16) la_head_unit<0>(c, l, b, u - 8); else if (u < 24) {
                if (c.tid == 0) { unsigned sp = 0; while (__hip_atomic_load(xpre, __ATOMIC_RELAXED, __HIP_MEMORY_SCOPE_AGENT) < (unsigned)(TP / 32)) { __builtin_amdgcn_s_sleep(8); if (++sp > (1u << 22)) break; }
                    __builtin_amdgcn_fence(__ATOMIC_ACQUIRE, "agent"); asm volatile("s_waitcnt vmcnt(0)" ::: "memory"); }
                __syncthreads();
                la_head_unit<2>(c, l, b, u - 16); } else rg_chunk_unit(c, l, b, u - 24);
            __syncthreads();
        } else { const int it = item - N_LONG;
            for (int rp = 0; rp < PROBE_REP_SHORT; ++rp) { if (it < 8) rg_sample_unit(c, l, it); else sample_item(c, l, (it - 8) / 3, (it - 8) % 3); } }
    }
    __syncthreads();
    }
}

DI void phase_finalize(int l, int wv) {
    const Ctx c = make_ctx(wv);
    const int gw = c.wg * 8 + c.wave, NGW = c.G * 8, lane = c.lane;
    const float* ssn = c.in[I_SSN] + (size_t)l * 1024;
    const float* stats = (const float*)(c.ctl + CW_STATS) + (size_t)l * TP * 6;
    for (int r = gw; r < TP; r += NGW) {
        bf16_t* mrow = c.mix + (size_t)r * D_MIX;
        const float rs = rsqrtf(stats[(size_t)r * 6 + (lane >> 5)] * (1.0f / 512.0f) + EPS), rg = rsqrtf(stats[(size_t)r * 6 + 2 + (lane >> 4)] * (1.0f / 256.0f) + EPS);
        u32x4* ps = (u32x4*)(mrow + 3072 + lane * 16); u32x4* pgl = (u32x4*)(mrow + 2048 + lane * 16);
#pragma unroll
        for (int q = 0; q < 2; ++q) { const u32x4 ov = ps[q]; const f32x4 w0 = *(const f32x4*)(ssn + lane * 16 + 8 * q), w1 = *(const f32x4*)(ssn + lane * 16 + 8 * q + 4); u32x4 nv;
            nv.x = pk2(bflo(ov.x) * rs * w0.x, bfhi(ov.x) * rs * w0.y); nv.y = pk2(bflo(ov.y) * rs * w0.z, bfhi(ov.y) * rs * w0.w);
            nv.z = pk2(bflo(ov.z) * rs * w1.x, bfhi(ov.z) * rs * w1.y); nv.w = pk2(bflo(ov.w) * rs * w1.z, bfhi(ov.w) * rs * w1.w); ps[q] = nv;
            const u32x4 gv = pgl[q]; u32x4 ng;
            ng.x = pk2(bflo(gv.x) * rg, bfhi(gv.x) * rg); ng.y = pk2(bflo(gv.y) * rg, bfhi(gv.y) * rg); ng.z = pk2(bflo(gv.z) * rg, bfhi(gv.z) * rg); ng.w = pk2(bflo(gv.w) * rg, bfhi(gv.w) * rg); pgl[q] = ng; }
    }
    const int gt = c.wg * 512 + c.tid, NGT = c.G * 512;
    constexpr int PER_SEQ = 3 * 1024 + 3 * 1536;
    for (int i = gt; i < (NB + DEC) * PER_SEQ; i += NGT) {
        const int q = i / PER_SEQ, e = i % PER_SEQ; const bool prompt = q < NB; const int s = q - NB;
        const bool isrg = e < 3072; const int e2 = isrg ? e : e - 3072; const int nch = isrg ? 1024 : 1536; const int j = e2 / nch, ch = e2 % nch;
        const int col = (isrg ? C_RGX : C_XBC) + ch;
        float v;
        if (prompt) v = bf1(c.proj[(size_t)(q * SEQ + SEQ - 3 + j) * LDP + col]);
        else if (j == 2) v = ps4(c.projs + (size_t)s * LDP + col) * row_rstd(c.rowsq + (size_t)l * M_PAD, TP + s);
        else v = (isrg ? c.in[I_SRGC] + ((size_t)l * DEC + s) * 3072 : c.in[I_SSSDC] + ((size_t)l * DEC + s) * 4608)[(j + 1) * nch + ch];
        float* o = c.out + (isrg ? (prompt ? O_RGC_P + ((size_t)l * NB + q) * 3072 : O_RGC_S + ((size_t)l * DEC + s) * 3072)
                                 : (prompt ? O_SSDC_P + ((size_t)l * NB + q) * 4608 : O_SSDC_S + ((size_t)l * DEC + s) * 4608));
        o[j * nch + ch] = v;
    }
}

DI void phase_dt(const Ctx& c, int l) {
    LAS float* PT = (LAS float*)c.lds;
    const int tid = get_tid(c.wave), lane = tid & 63, w = c.wave, r = lane & 31, hh = lane >> 5;
    for (int rt = c.wg; rt < TP / 32; rt += c.G) {
        const bf16_t* pa = c.xb + (size_t)(rt * 32 + r) * D_MODEL + w * 256 + 8 * hh;
        const bf16_t* pb = c.win + ((size_t)l * LDP + C_DT + r) * D_MODEL + w * 256 + 8 * hh;
        f32x16 acc; ZERO16(acc);
#pragma unroll
        for (int k4 = 0; k4 < 16; k4 += 8) { bf16x8 fa[8], fb[8];
#pragma unroll
            for (int u = 0; u < 8; ++u) { fa[u] = *(const bf16x8*)(pa + 16 * (k4 + u)); fb[u] = *(const bf16x8*)(pb + 16 * (k4 + u)); }
#pragma unroll
            for (int u = 0; u < 8; ++u) acc = mfma32(fa[u], fb[u], acc); }
        __syncthreads();
#pragma unroll
        for (int i = 0; i < 16; ++i) PT[w * 1024 + crow(i, hh) * 32 + r] = acc[i];
        __syncthreads();
        { const int row = tid >> 4, col = tid & 15; float s = 0.f;
#pragma unroll
          for (int q = 0; q < 8; ++q) s += PT[q * 1024 + row * 32 + col];
          c.dtb[(size_t)(rt * 32 + row) * 16 + col] = softplus(s * row_rstd(c.rowsq + (size_t)l * M_PAD, rt * 32 + row) + c.in[I_DTB][l * 16 + col]); }
    }
}

DI void g2_sample(const Ctx& c, int l) {
    LAS float* PT = (LAS float*)c.lds;
    const int tid = get_tid(c.wave), lane = tid & 63, w = c.wave, rr = lane & 15, quad = lane >> 4;
    float* rsq_next = c.rowsq + (size_t)(l + 1) * M_PAD;
    for (int ct = c.wg; ct < D_MODEL / 8; ct += c.G) {
        const bf16_t* pa = c.mix + (size_t)(TP + rr) * D_MIX + 512 * w + 8 * quad;
        const bf16_t* pb = c.wout + (size_t)l * D_MODEL * D_MIX + (size_t)(8 * ct + (rr & 7)) * D_MIX + 512 * w + 8 * quad;
        f32x4 acc[8];
#pragma unroll
        for (int rt = 0; rt < 8; ++rt) acc[rt] = (f32x4){0.f, 0.f, 0.f, 0.f};
#pragma unroll 1
        for (int k2 = 0; k2 < 16; k2 += 2) { bf16x8 fa[2][8], fb[2];
#pragma unroll
            for (int u = 0; u < 2; ++u) { fb[u] = *(const bf16x8*)(pb + 32 * (k2 + u));
#pragma unroll
                for (int rt = 0; rt < 8; ++rt) fa[u][rt] = *(const bf16x8*)(pa + (size_t)16 * rt * D_MIX + 32 * (k2 + u)); }
#pragma unroll
            for (int u = 0; u < 2; ++u) { const bf16x8 z = {0, 0, 0, 0, 0, 0, 0, 0}; const bf16x8 bb = rr < 8 ? fb[u] : z;
#pragma unroll
                for (int rt = 0; rt < 8; ++rt) acc[rt] = __builtin_amdgcn_mfma_f32_16x16x32_bf16(fa[u][rt], bb, acc[rt], 0, 0, 0); } }
        __syncthreads();
#pragma unroll
        for (int rt = 0; rt < 8; ++rt)
#pragma unroll
            for (int j = 0; j < 4; ++j) PT[(w * 128 + 16 * rt + 4 * quad + j) * 16 + rr] = acc[rt][j];
        __syncthreads();
        { const int row = tid >> 2, c2 = 2 * (tid & 3); float x0 = 0.f, x1 = 0.f;
#pragma unroll
          for (int q = 0; q < 8; ++q) { const f32x2 t = *(const LAS f32x2*)(PT + (q * 128 + row) * 16 + c2); x0 += t.x; x1 += t.y; }
          unsigned* xp = (unsigned*)(c.xb + (size_t)(TP + row) * D_MODEL + 8 * ct + c2); const unsigned o = *xp;
          x0 += bflo(o); x1 += bfhi(o); *xp = pk2(x0, x1);
          float ss = x0 * x0 + x1 * x1; ss += shx(ss, 1, lane); ss += shx(ss, 2, lane);
          if ((tid & 3) == 0) atomicAdd(rsq_next + TP + row, ss); }
    }
}

__global__ void __launch_bounds__(512, 2) mk_fwd(Params p) {
    extern __shared__ __attribute__((aligned(16))) unsigned char lds_raw[];
    LAS unsigned char* lds = (LAS unsigned char*)lds_raw;
    volatile LAS unsigned* misc = (volatile LAS unsigned*)(lds + MISC_OFF);
    const int wv = __builtin_amdgcn_readfirstlane(threadIdx.x >> 6);
    if (threadIdx.x < 32) misc[threadIdx.x] = 0u;
    __syncthreads();
    const int lo = p.ph_lo, hi = p.ph_hi;
    unsigned* barw = (unsigned*)(p.ws + WS_CTL) + CW_BAR;
    XcdBarrier bar; bar.bar = barw; bar.x = 0; bar.st = misc;
    if (hi - lo > 1) bar = xcd_barrier_post(barw, misc, get_tid(wv));
#define PH_IN(k) (lo <= (k) && (k) < hi)
#define SEAM(k) do { if (PH_IN(k) && PH_IN((k) + 1)) xcd_barrier(bar, wv); } while (0)
    if (PH_IN(0)) { phase_prologue(wv); }
    SEAM(0);
    for (int l = 0; l < DEPTH; ++l) {
        const int pb = 1 + 4 * l;
        if (PH_IN(pb)) {
            __syncthreads();
            const Ctx c = make_ctx(wv);
            {
                pg8::Gemm g{c.xb, c.win + (size_t)l * LDP * D_MODEL, TP, N_MAIN, D_MODEL, D_MODEL, D_MODEL}; pg8::StaticOrder S; S.init(TP, N_MAIN, c.G, c.wg); S.rep = PROBE_G1;
                pg8::EpiProj E{c.proj, c.lb + (size_t)l * 1024, c.in[I_HGN] + (size_t)l * 1024, c.in[I_GLN] + (size_t)l * 1024, c.in[I_GBU] + (size_t)l * 512, c.rowsq + (size_t)l * M_PAD};
                pg8::gemm_phase<pg8::EpiProj, pg8::StaticOrder>(c.lds, g, S, E, wv); }
            __syncthreads();
            {
                const int pn = c.wg % 49, ks = c.wg / 49;
                pg8::Gemm g{c.xb + (size_t)TP * D_MODEL + ks * 512, c.win + (size_t)l * LDP * D_MODEL + ks * 512, 256, LDP, 512, D_MODEL, D_MODEL};
                pg8::OneUnit S{0, pn, c.wg < 196 ? 1 : 0};
                pg8::EpiSample E{c.projs + (size_t)ks * PST};
                pg8::gemm_phase<pg8::EpiSample, pg8::OneUnit>(c.lds, g, S, E, wv); }
            __syncthreads();
            phase_dt(c, l);
            __syncthreads();
        }
        SEAM(pb);
        if (PH_IN(pb + 1)) phase_mixer(l, wv);
        SEAM(pb + 1);
        if (PH_IN(pb + 2)) phase_finalize(l, wv);
        SEAM(pb + 2);
        if (PH_IN(pb + 3)) {
            __syncthreads();
            const Ctx c = make_ctx(wv);
            {
                pg8::Gemm g{c.mix, c.wout + (size_t)l * D_MODEL * D_MIX, TP, D_MODEL, D_MIX, D_MIX, D_MIX}; pg8::StaticOrder S; S.init(TP, D_MODEL, c.G, c.wg);
                pg8::EpiResid E{c.xb, c.rowsq + (size_t)(l + 1) * M_PAD};
                pg8::gemm_phase<pg8::EpiResid, pg8::StaticOrder>(c.lds, g, S, E, wv); }
            __syncthreads();
            g2_sample(c, l);
            __syncthreads();
        }
        SEAM(pb + 3);
    }
    if (PH_IN(NPHASE - 1)) phase_final_norm(wv);
#undef PH_IN
#undef SEAM
}

extern "C" void kernel_launch(void* const* d_in, const int* in_sizes, int n_in, void* d_out, int out_size, void* d_ws, size_t ws_size, hipStream_t stream) {
    static int grid = 0;
    if (grid == 0) {
        if (n_in != N_INPUTS || (size_t)out_size != O_END || ws_size < WS_END) { fprintf(stderr, "kernel_launch: unexpected shapes (n_in %d out %d ws %zu)\n", n_in, out_size, ws_size); grid = -1; return; }
        int dev = 0, cus = 0;
        if (hipGetDevice(&dev) != hipSuccess || hipDeviceGetAttribute(&cus, hipDeviceAttributeMultiprocessorCount, dev) != hipSuccess) { grid = -1; return; }
        if (hipFuncSetAttribute((const void*)mk_fwd, hipFuncAttributeMaxDynamicSharedMemorySize, LDS_BYTES) != hipSuccess) { fprintf(stderr, "kernel_launch: hipFuncSetAttribute failed\n"); grid = -1; return; }
        int per_cu = 0;
        if (hipOccupancyMaxActiveBlocksPerMultiprocessor(&per_cu, (const void*)mk_fwd, 512, LDS_BYTES) != hipSuccess || per_cu < 1) fprintf(stderr, "kernel_launch: occupancy query says %d\n", per_cu);
        (void)hipGetLastError();
        grid = cus;
    }
    if (grid < 0) return;
    (void)hipMemsetAsync((char*)d_ws + WS_CTL, 0, CTL_ZERO_BYTES, stream);
    Params p{};
    for (int i = 0; i < N_INPUTS; ++i) p.in[i] = (const float*)d_in[i];
    p.out = (float*)d_out; p.ws = (unsigned char*)d_ws;
#if MK_ONE_LAUNCH
    p.ph_lo = 0; p.ph_hi = NPHASE;
    hipLaunchKernelGGL(mk_fwd, dim3(grid), dim3(512), LDS_BYTES, stream, p);
#else
    for (int ph = 0; ph < NPHASE; ++ph) { p.ph_lo = ph; p.ph_hi = ph + 1; hipLaunchKernelGGL(mk_fwd, dim3(grid), dim3(512), LDS_BYTES, stream, p); }
#endif
}
```

```cpp
#include <hip/hip_runtime.h>
#include <cstdio>
#include <cstdint>

#ifndef MK_ONE_LAUNCH
#define MK_ONE_LAUNCH 1
#endif

#ifndef PROBE_LONG_REP
#define PROBE_LONG_REP 1
#endif
#ifndef PROBE_RG_REP
#define PROBE_RG_REP PROBE_LONG_REP
#endif
#ifndef PROBE_G1_NOEPI
#define PROBE_G1_NOEPI 0
#endif
#ifndef PROBE_G2
#define PROBE_G2 0
#endif
#ifndef PROBE_G1
#define PROBE_G1 1
#endif
#define LAS __attribute__((address_space(3)))
#define DI __device__ __forceinline__

constexpr int D_MODEL = 2048, NB = 4, SEQ = 2048, DEPTH = 4, DEC = 128;
constexpr int BRANCH = 1024, D_MIX = 4096;
constexpr int TP = NB * SEQ;
constexpr int TT = TP + DEC;
constexpr int M_PAD = 8448;
constexpr int N_IN = 11808;
constexpr int LDP = 12544;
constexpr int N_MAIN = 12288;
constexpr int PST = 128 * LDP;
constexpr float EPS = 1e-6f, TINY = 1e-30f;
constexpr int C_HGQ = 0, C_HGF = 1024, C_HGI = 2048, C_HGG = 3072, C_RGX = 4096, C_RGG = 5120, C_GLQ = 6144, C_GLK = 6656, C_GLV = 7168, C_GLG = 8192,
              C_GLF = 9216, C_SSZ = 9728, C_XBC = 10752, C_DT = 12288;
constexpr int SRC_GLA = 9216, SRC_SSZ = 9232, SRC_DT = 11792;
enum { I_XP = 0, I_XS, I_SHG, I_SRG, I_SRGC, I_SGLA, I_SSSD, I_SSSDC, I_RMS, I_WIN, I_LB, I_HGN, I_RCW, I_RCB, I_WR, I_BR, I_WI, I_BI, I_LAM,
       I_GWU, I_GBU, I_GLN, I_SCW, I_SCB, I_DTB, I_ALOG, I_SD, I_SSN, I_WOUT, I_RMSF, N_INPUTS };
constexpr size_t O_YP = 0, O_YS = (size_t)TP * D_MODEL, O_HG_P = O_YS + (size_t)DEC * D_MODEL,
    O_RG_P = O_HG_P + (size_t)DEPTH * NB * 131072, O_RGC_P = O_RG_P + (size_t)DEPTH * NB * 1024, O_GLA_P = O_RGC_P + (size_t)DEPTH * NB * 3072,
    O_SSD_P = O_GLA_P + (size_t)DEPTH * NB * 131072, O_SSDC_P = O_SSD_P + (size_t)DEPTH * NB * 131072, O_HG_S = O_SSDC_P + (size_t)DEPTH * NB * 4608,
    O_RG_S = O_HG_S + (size_t)DEPTH * DEC * 131072, O_RGC_S = O_RG_S + (size_t)DEPTH * DEC * 1024, O_GLA_S = O_RGC_S + (size_t)DEPTH * DEC * 3072,
    O_SSD_S = O_GLA_S + (size_t)DEPTH * DEC * 131072, O_SSDC_S = O_SSD_S + (size_t)DEPTH * DEC * 131072, O_END = O_SSDC_S + (size_t)DEPTH * DEC * 4608;
constexpr size_t MiB = 1u << 20;
constexpr size_t WS_CTL = 0, CTL_ZERO_BYTES = 2 * MiB, WS_LB = 2 * MiB, WS_WIN = 3 * MiB, WS_WOUT = 199 * MiB, WS_XB = 263 * MiB, WS_PROJ = 296 * MiB,
    WS_DTB = 492 * MiB, WS_MIX = 493 * MiB, WS_PROJS = 559 * MiB, WS_XBCS = 584 * MiB, WS_END = 608 * MiB;
static_assert(WS_WIN + (size_t)DEPTH * LDP * D_MODEL * 2 <= WS_WOUT && WS_WOUT + (size_t)DEPTH * D_MODEL * D_MIX * 2 <= WS_XB && WS_XB + (size_t)M_PAD * D_MODEL * 2 <= WS_PROJ &&
              WS_PROJ + (size_t)TP * LDP * 2 <= WS_DTB && WS_DTB + (size_t)TP * 16 * 4 <= WS_MIX &&
              WS_MIX + (size_t)M_PAD * D_MIX * 2 <= WS_PROJS && WS_PROJS + (size_t)4 * DEC * LDP * 4 <= WS_XBCS && WS_XBCS + (size_t)TP * 1536 * 2 <= WS_END, "ws map");
constexpr int CW_BAR = 4096, CW_QCTR = 16384, CW_XPRE = 24576  , CW_STATS = 32768, CW_ROWSQ = 262144;
static_assert(CW_STATS + DEPTH * TP * 6 <= CW_ROWSQ && (size_t)(CW_ROWSQ + (DEPTH + 1) * M_PAD) * 4 <= CTL_ZERO_BYTES, "ctl map");
constexpr int LDS_BYTES = 147456, MISC_OFF = LDS_BYTES - 256;
constexpr int NPHASE = 2 + 4 * DEPTH;

typedef unsigned short bf16_t;
typedef short bf16x8 __attribute__((ext_vector_type(8)));
typedef float f32x4 __attribute__((ext_vector_type(4)));
typedef float f32x2 __attribute__((ext_vector_type(2)));
typedef float f32x16 __attribute__((ext_vector_type(16)));
typedef unsigned u32x4 __attribute__((ext_vector_type(4)));
typedef unsigned u32x2 __attribute__((ext_vector_type(2)));
typedef __bf16 bf16v2 __attribute__((ext_vector_type(2)));

DI unsigned pk2(float lo, float hi) { const f32x2 v = {lo, hi}; return __builtin_bit_cast(unsigned, __builtin_convertvector(v, bf16v2)); }
DI unsigned f2bf(float f) { return pk2(f, 0.f) & 0xffffu; }
DI float bflo(unsigned u) { return __builtin_bit_cast(float, u << 16); }
DI float bfhi(unsigned u) { return __builtin_bit_cast(float, u & 0xffff0000u); }
DI float bf1(bf16_t u) { return __builtin_bit_cast(float, (unsigned)u << 16); }
DI float ex2(float x) { return __builtin_amdgcn_exp2f(x); }
DI float lg2(float x) { return __builtin_amdgcn_logf(x); }
DI float rcp(float x) { return __builtin_amdgcn_rcpf(x); }
constexpr float LOG2E = 1.4426950408889634f, LN2 = 0.6931471805599453f;
DI float fexp(float x) { return ex2(x * LOG2E); }
DI float flog(float x) { return lg2(x) * LN2; }
DI float sigm(float x) { return rcp(1.0f + fexp(-x)); }
DI float silu(float x) { return x * sigm(x); }
DI float sigm_fast(float x) { return sigm(x); }
DI float silu_fast(float x) { return silu(x); }
DI float log1p_pos(float e) { const float a = e * (1.0f - e * (0.5f - e * (0.33333334f - 0.25f * e))), b = flog(1.0f + e); return e < 0.03f ? a : b; }
DI float softplus(float x) { return fmaxf(x, 0.f) + log1p_pos(fexp(-fabsf(x))); }
DI float neg_expm1(float x) { const float a = -x * (1.0f + 0.5f * x * (1.0f + 0.33333334f * x * (1.0f + 0.25f * x * (1.0f + 0.2f * x)))), b = 1.0f - fexp(x); return fabsf(x) < 0.25f ? a : b; }
DI float row_rstd(const float* rowsq, int row) { return __builtin_amdgcn_rsqf(rowsq[row] * (1.0f / D_MODEL) + EPS); }
DI float clampf(float x, float lo, float hi) { return fminf(fmaxf(x, lo), hi); }
DI float shx(float v, int mask, int lane) { return __builtin_bit_cast(float, __builtin_amdgcn_ds_bpermute((lane ^ mask) << 2, __builtin_bit_cast(int, v))); }
DI float shup(float v, int o, int lane) { return __builtin_bit_cast(float, __builtin_amdgcn_ds_bpermute((lane >= o ? lane - o : lane) << 2, __builtin_bit_cast(int, v))); }
DI float wave_sum(float v, int lane) {
#pragma unroll
    for (int o = 1; o < 64; o <<= 1) v += shx(v, o, lane);
    return v;
}

struct Params { const float* in[N_INPUTS]; float* out; unsigned char* ws; int ph_lo, ph_hi; };
static_assert(sizeof(Params) == N_INPUTS * 8 + 8 + 8 + 8, "no padding holes in Params");
typedef const __attribute__((address_space(4))) Params* KP;
DI KP get_params() { auto kp = __builtin_amdgcn_kernarg_segment_ptr(); asm volatile("" : "+s"(kp)); return (KP)kp; }
DI int get_tid(int wv) { int ln; asm volatile("v_mbcnt_lo_u32_b32 %0, -1, 0\n\tv_mbcnt_hi_u32_b32 %0, -1, %0" : "=v"(ln)); return (wv << 6) | ln; }

#define XB_TMO      128
#define XB_XCNT(j)  (256  + 64 * (j))
#define XB_XSUB(j)  (1280 + 64 * (j))
#define XB_XGEN(j)  (2304 + 64 * (j))
#define XB_TOP      3328
#define XB_TOPGEN   3392
#define XCD_BAR_WORDS 3456
#define XB_SPIN_CAP (1u << 20)
DI unsigned xb_ld(unsigned* p)              { return __hip_atomic_load(p, __ATOMIC_RELAXED, __HIP_MEMORY_SCOPE_AGENT); }
DI unsigned xb_add(unsigned* p, unsigned v) { return __hip_atomic_fetch_add(p, v, __ATOMIC_RELAXED, __HIP_MEMORY_SCOPE_AGENT); }
DI unsigned xb_xcc_id() { return (unsigned)__builtin_amdgcn_s_getreg((3 << 11) | 20) & 0xFu; }
#define XB_SPIN(cond, bar) do { unsigned _sp = 0; while (cond) { __builtin_amdgcn_s_sleep(1); \
    if ((++_sp & 255u) == 0u) { if (xb_ld(&(bar)[XB_TMO])) break; if (_sp > XB_SPIN_CAP) { atomicAdd(&(bar)[XB_TMO], 1u); break; } } } } while (0)
struct XcdBarrier { unsigned* bar; unsigned x; volatile LAS unsigned* st; };
DI XcdBarrier xcd_barrier_post(unsigned* bar, volatile LAS unsigned* st, int tid) {
    XcdBarrier b; b.bar = bar; b.x = xb_xcc_id(); b.st = st;
    if (tid == 0) (void)xb_add(&bar[XB_XCNT(b.x)], 1u);
    return b;
}
DI void xcd_barrier_complete(unsigned* bar, unsigned x, unsigned& nloc, unsigned& nx) {
    const unsigned G = gridDim.x * gridDim.y * gridDim.z;
    unsigned sum, cnt, mine, sp = 0u;
    for (;;) {
        sum = 0u; cnt = 0u; mine = 0u;
#pragma unroll
        for (unsigned j = 0; j < 16; ++j) { const unsigned c = xb_ld(&bar[XB_XCNT(j)]); sum += c; cnt += (c > 0u) ? 1u : 0u; mine = (j == x) ? c : mine; }
        if (sum == G) break;
        __builtin_amdgcn_s_sleep(1);
        if ((++sp & 255u) == 0u) { if (xb_ld(&bar[XB_TMO])) break; if (sp > XB_SPIN_CAP) { atomicAdd(&bar[XB_TMO], 1u); break; } }
    }
    nloc = mine > 0u ? mine : 1u; nx = cnt > 0u ? cnt : 1u;
}
DI void xcd_barrier(const XcdBarrier& b, int wv) {
    asm volatile("s_waitcnt vmcnt(0)" ::: "memory");
    __syncthreads();
    if (get_tid(wv) == 0) {
        unsigned* bar = b.bar;
        __builtin_amdgcn_s_waitcnt(0);
        unsigned nloc = b.st[0], nx = b.st[1];
        if (nloc == 0u) { xcd_barrier_complete(bar, b.x, nloc, nx); b.st[0] = nloc; b.st[1] = nx; }
        const unsigned old = xb_add(&bar[XB_XSUB(b.x)], 1u);
        const unsigned gen = old / nloc;
        if (old + 1u == (gen + 1u) * nloc) {
            __builtin_amdgcn_fence(__ATOMIC_RELEASE, "agent");
            asm volatile("s_waitcnt vmcnt(0)" ::: "memory");
            const unsigned og = xb_add(&bar[XB_TOP], 1u);
            const unsigned tg = og / nx;
            if (og + 1u == (tg + 1u) * nx) xb_add(&bar[XB_TOPGEN], 1u);
            else XB_SPIN(xb_ld(&bar[XB_TOPGEN]) == tg, bar);
            __builtin_amdgcn_fence(__ATOMIC_ACQUIRE, "agent");
            xb_add(&bar[XB_XGEN(b.x)], 1u);
            asm volatile("s_waitcnt vmcnt(0)" ::: "memory");
        } else {
            XB_SPIN(xb_ld(&bar[XB_XGEN(b.x)]) == gen, bar);
            __builtin_amdgcn_fence(__ATOMIC_ACQUIRE, "agent");
            asm volatile("s_waitcnt vmcnt(0)" ::: "memory");
        }
    }
    __syncthreads();
}

namespace pg8 {
constexpr int BM = 256, BK = 64, HALF = 128, HTB = HALF * BK * 2, STAGE_BYTES = 8 * HTB, NXCD = 8, WGM = 8;
DI int lds_byte(int r, int c) { const int st = (r >> 4) * 2 + (c >> 5), rr = r & 15, cc = c & 31, ob = rr * 64 + cc * 2; return st * 1024 + (ob ^ (((ob >> 9) & 1) << 5)); }
DI void stage_rc(int b, int& R, int& C) { const int st = b / 1024, sb = b % 1024, swz = sb ^ (((sb >> 9) & 1) << 5); R = (st >> 1) * 16 + swz / 64; C = (st & 1) * 32 + (swz % 64) / 2; }
DI int perm32(int rho) { const int n = rho >> 4, i = rho & 15; return 8 * (i >> 2) + 4 * n + (i & 3); }
struct Unit { int pm, pn; };
struct Gemm { const bf16_t* A; const bf16_t* Bt; int M, N, K, lda, ldb; };
struct StaticOrder {
    int nM, nN, nwg, G, c, rep = 1;
    DI void init(int M, int N, int G_, int c_) { nM = M / BM; nN = N / BM; nwg = nM * nN; G = G_; c = c_; }
    DI bool next(int i, Unit& u) const {
        const long L = (long)(i / rep) * G + c; if (L >= nwg) return false;
        int wgid = (int)L; { const int q = nwg / NXCD, r = nwg % NXCD, xcd = wgid % NXCD, off = wgid / NXCD; wgid = (xcd < r ? xcd * (q + 1) : r * (q + 1) + (xcd - r) * q) + off; }
        const int nig = WGM * nN, gid = wgid / nig, fm = gid * WGM, gsz = (nM - fm) < WGM ? (nM - fm) : WGM;
        u.pm = fm + ((wgid % nig) % gsz); u.pn = (wgid % nig) / gsz; return true;
    }
    DI void a_ready(const Unit&) const {}
    DI void done(const Unit&) const {}
};
struct EpiProj {
    static constexpr bool PERM = true, TWICE = PROBE_G1_NOEPI != 0;
    bf16_t* P; const float* lb; const float* hgn; const float* gln; const float* bup; const float* rsq;
    template <int MODE>
    DI void body(const f32x4 (&acc)[2][2][4][2], bf16_t* prow, const float* vec, float scale, const float (&rs)[2][4]) const {
        f32x4 cv[2][2];
#pragma unroll
        for (int bj = 0; bj < 2; ++bj) { cv[bj][0] = (f32x4){1.f, 1.f, 1.f, 1.f}; cv[bj][1] = cv[bj][0];
            if constexpr (MODE >= 2) { cv[bj][0] = *(const f32x4*)(vec + bj * HALF); cv[bj][1] = *(const f32x4*)(vec + bj * HALF + 4); } }
#pragma unroll
        for (int bj = 0; bj < 2; ++bj) {
            const f32x4 c0 = cv[bj][0], c1 = cv[bj][1];
#pragma unroll
            for (int ai = 0; ai < 2; ++ai)
#pragma unroll
                for (int m = 0; m < 4; ++m) {
                    f32x4 a = acc[ai][bj][m][0] * rs[ai][m], b = acc[ai][bj][m][1] * rs[ai][m];
                    if constexpr (MODE == 0) { a = a * scale; b = b * scale; }
                    else if constexpr (MODE == 1) { a = (f32x4){silu(a.x), silu(a.y), silu(a.z), silu(a.w)}; b = (f32x4){silu(b.x), silu(b.y), silu(b.z), silu(b.w)}; }
                    else if constexpr (MODE == 2) { a = (f32x4){silu(a.x), silu(a.y), silu(a.z), silu(a.w)} * c0; b = (f32x4){silu(b.x), silu(b.y), silu(b.z), silu(b.w)} * c1; }
                    else if constexpr (MODE == 3) {
#define LOGF(x, l) flog(fmaxf((l) + (1.0f - (l)) * sigm(x), TINY))
                        a = (f32x4){LOGF(a.x, c0.x), LOGF(a.y, c0.y), LOGF(a.z, c0.z), LOGF(a.w, c0.w)}; b = (f32x4){LOGF(b.x, c1.x), LOGF(b.y, c1.y), LOGF(b.z, c1.z), LOGF(b.w, c1.w)};
#undef LOGF
                    } else {
#define LSIG(x, bb) (-0.0625f * (fmaxf(-((x) + (bb)), 0.f) + flog(1.0f + fexp(-fabsf((x) + (bb))))))
                        a = (f32x4){LSIG(a.x, c0.x), LSIG(a.y, c0.y), LSIG(a.z, c0.z), LSIG(a.w, c0.w)}; b = (f32x4){LSIG(b.x, c1.x), LSIG(b.y, c1.y), LSIG(b.z, c1.z), LSIG(b.w, c1.w)};
#undef LSIG
                    }
                    u32x4 w4; w4.x = pk2(a.x, a.y); w4.y = pk2(a.z, a.w); w4.z = pk2(b.x, b.y); w4.w = pk2(b.z, b.w);
                    *(u32x4*)(prow + (size_t)(ai * HALF + m * 16) * LDP + bj * HALF) = w4;
                }
        }
    }
    DI void operator()(const f32x4 (&acc)[2][2][4][2], const Unit& u, int wr, int wc, int fr, int fq) const {
        const int col = u.pn * BM + wc * 32 + 8 * fq;
        bf16_t* prow = P + (size_t)(u.pm * BM + wr * 64 + fr) * LDP + col;
        float rs[2][4];
#pragma unroll
        for (int ai = 0; ai < 2; ++ai)
#pragma unroll
            for (int m = 0; m < 4; ++m) rs[ai][m] = rsq[u.pm * BM + wr * 64 + fr + ai * HALF + m * 16];
#pragma unroll
        for (int ai = 0; ai < 2; ++ai)
#pragma unroll
            for (int m = 0; m < 4; ++m) rs[ai][m] = __builtin_amdgcn_rsqf(rs[ai][m] * (1.0f / D_MODEL) + EPS);
        const int pn = u.pn;
        if (pn < 4) body<1>(acc, prow, nullptr, 1.f, rs);
        else if (pn < 8) body<3>(acc, prow, lb + (col - C_HGF), 1.f, rs);
        else if (pn < 12) body<0>(acc, prow, nullptr, 1.f, rs);
        else if (pn < 16) body<2>(acc, prow, hgn + (col - C_HGG), 1.f, rs);
        else if (pn < 20) body<0>(acc, prow, nullptr, 1.f, rs);
        else if (pn < 24) body<1>(acc, prow, nullptr, 1.f, rs);
        else if (pn < 26) body<0>(acc, prow, nullptr, 0.08838834764831845f, rs);
        else if (pn < 32) body<0>(acc, prow, nullptr, 1.f, rs);
        else if (pn < 36) body<2>(acc, prow, gln + (col - C_GLG), 1.f, rs);
        else if (pn < 38) body<4>(acc, prow, bup + (col - C_GLF), 1.f, rs);
        else if (pn < 42) body<1>(acc, prow, nullptr, 1.f, rs);
        else body<0>(acc, prow, nullptr, 1.f, rs);
    }
};
struct EpiSample {
    static constexpr bool PERM = false, TWICE = false;
    float* PS;
    DI void operator()(const f32x4 (&acc)[2][2][4][2], const Unit& u, int wr, int wc, int fr, int fq) const {
        const int row0 = wr * 64 + fr, col0 = u.pn * BM + wc * 32 + 4 * fq;
#pragma unroll
        for (int m = 0; m < 4; ++m) { float* op = PS + (size_t)(row0 + m * 16) * LDP + col0;
#pragma unroll
            for (int bj = 0; bj < 2; ++bj)
#pragma unroll
                for (int n = 0; n < 2; ++n) *(f32x4*)(op + bj * HALF + n * 16) = acc[0][bj][m][n]; }
    }
};
struct EpiResid {
    static constexpr bool PERM = true, TWICE = false;
    bf16_t* xb; float* rsq_next;
    DI void operator()(const f32x4 (&acc)[2][2][4][2], const Unit& u, int wr, int wc, int fr, int fq) const {
        const int row0 = u.pm * BM + wr * 64 + fr, col0 = u.pn * BM + wc * 32 + 8 * fq;
#pragma unroll
        for (int ai = 0; ai < 2; ++ai) {
            u32x4 ob[4][2];
#pragma unroll
            for (int m = 0; m < 4; ++m)
#pragma unroll
                for (int bj = 0; bj < 2; ++bj) ob[m][bj] = *(const u32x4*)(xb + (size_t)(row0 + ai * HALF + m * 16) * D_MODEL + col0 + bj * HALF);
#pragma unroll
            for (int m = 0; m < 4; ++m) { const int row = row0 + ai * HALF + m * 16; bf16_t* xp = xb + (size_t)row * D_MODEL + col0; float ss = 0.f;
#pragma unroll
                for (int bj = 0; bj < 2; ++bj) { const u32x4 o = ob[m][bj]; const f32x4 a = acc[ai][bj][m][0], b = acc[ai][bj][m][1];
                    const float x0 = bflo(o.x) + a.x, x1 = bfhi(o.x) + a.y, x2 = bflo(o.y) + a.z, x3 = bfhi(o.y) + a.w, x4 = bflo(o.z) + b.x, x5 = bfhi(o.z) + b.y, x6 = bflo(o.w) + b.z, x7 = bfhi(o.w) + b.w;
                    ss += ((x0 * x0 + x1 * x1) + (x2 * x2 + x3 * x3)) + ((x4 * x4 + x5 * x5) + (x6 * x6 + x7 * x7));
                    u32x4 n4; n4.x = pk2(x0, x1); n4.y = pk2(x2, x3); n4.z = pk2(x4, x5); n4.w = pk2(x6, x7); *(u32x4*)(xp + bj * HALF) = n4; }
                const int lane = fq * 16 + fr; ss += shx(ss, 16, lane); ss += shx(ss, 32, lane);
                if (fq == 0) atomicAdd(rsq_next + row, ss); }
        }
    }
};
struct OneUnit {
    int pm, pn, have;
    DI bool next(int i, Unit& u) const { if (i != 0 || !have) return false; u.pm = pm; u.pn = pn; return true; }
    DI void a_ready(const Unit&) const {}
    DI void done(const Unit&) const {}
};
template <class Epi, class Sched>
DI void gemm_phase(LAS unsigned char* lds, const Gemm g, const Sched& S, const Epi& E, int wv) {
    const int tid = get_tid(wv), wid = wv, lane = tid & 63, wr = wid >> 2, wc = wid & 3, fr = lane & 15, fq = lane >> 4;
    const int K = g.K, nt = K / BK;
    unsigned voffA[2], voffB[2];
#pragma unroll
    for (int i = 0; i < 2; ++i) { int R, C; stage_rc(tid * 16 + i * 8192, R, C); const int Rb = Epi::PERM ? ((R & ~31) + perm32(R & 31)) : R;
        voffA[i] = (unsigned)(R * g.lda + C) * 2u; voffB[i] = (unsigned)(Rb * g.ldb + C) * 2u; }
    const size_t kstep = (size_t)(BK * 2);
    const size_t hstepA = (size_t)HALF * g.lda * 2, hstepB = (size_t)HALF * g.ldb * 2;
    const size_t tstepA = 2 * hstepA, tstepB = 2 * hstepB;
    const unsigned ldsw = (unsigned)wid * 1024u;
    const int aoff = lds_byte(wr * 64 + fr, fq * 8), boff = lds_byte(wc * 32 + fr, fq * 8);
#define PG8_SA(b, h) (((b) * 2 + (h)) * HTB)
#define PG8_SB(b, h) ((4 + (b) * 2 + (h)) * HTB)
#define PG8_STAGE(bufoff, gbase, voff) do { _Pragma("unroll") for (int _i = 0; _i < 2; ++_i) \
        __builtin_amdgcn_global_load_lds((const unsigned*)((const char*)(gbase) + (voff)[_i]), (LAS unsigned*)(lds + (bufoff) + ldsw + _i * 8192), 16, 0, 0); } while (0)
#define PG8_LDA(dst, b, h) do { _Pragma("unroll") for (int m = 0; m < 4; ++m) _Pragma("unroll") for (int k = 0; k < 2; ++k) dst[m][k] = *(const LAS bf16x8*)(lds + PG8_SA(b, h) + aoff + m * 2048 + k * 1024); } while (0)
#define PG8_LDB(dst, b, h) do { _Pragma("unroll") for (int n = 0; n < 2; ++n) _Pragma("unroll") for (int k = 0; k < 2; ++k) dst[n][k] = *(const LAS bf16x8*)(lds + PG8_SB(b, h) + boff + n * 2048 + k * 1024); } while (0)
#define PG8_MMA(ai, bj, At, Bt) do { __builtin_amdgcn_s_setprio(1); _Pragma("unroll") for (int m = 0; m < 4; ++m) _Pragma("unroll") for (int n = 0; n < 2; ++n) _Pragma("unroll") for (int k = 0; k < 2; ++k) \
        acc[ai][bj][m][n] = __builtin_amdgcn_mfma_f32_16x16x32_bf16(Bt[n][k], At[m][k], acc[ai][bj][m][n], 0, 0, 0); __builtin_amdgcn_s_setprio(0); } while (0)
#define PG8_WAIT_V(n) asm volatile("s_waitcnt vmcnt(" #n ")" ::: "memory")
#define PG8_WAIT_L(n) asm volatile("s_waitcnt lgkmcnt(" #n ")" ::: "memory")
#define PG8_BAR __builtin_amdgcn_s_barrier()
#define PG8_SCHED __builtin_amdgcn_sched_barrier(0)
    Unit cur, nxt; int ui = 0;
    if (!S.next(0, cur)) return;
    f32x4 acc[2][2][4][2];
#pragma unroll
    for (int a = 0; a < 2; ++a)
#pragma unroll
        for (int b = 0; b < 2; ++b)
#pragma unroll
            for (int m = 0; m < 4; ++m)
#pragma unroll
                for (int n = 0; n < 2; ++n) acc[a][b][m][n] = (f32x4){0.f, 0.f, 0.f, 0.f};
    bf16x8 At[4][2], B0[2][2], B1[2][2];
    const char* cA = (const char*)g.A + (size_t)cur.pm * tstepA; const char* cB = (const char*)g.Bt + (size_t)cur.pn * tstepB;
    S.a_ready(cur);
    PG8_STAGE(PG8_SB(0, 0), cB, voffB); PG8_STAGE(PG8_SA(0, 0), cA, voffA); PG8_STAGE(PG8_SB(0, 1), cB + hstepB, voffB); PG8_STAGE(PG8_SA(0, 1), cA + hstepA, voffA);
    if (wr == 1) PG8_BAR;
    PG8_WAIT_V(4); PG8_BAR;
    PG8_STAGE(PG8_SB(1, 0), cB + kstep, voffB); PG8_STAGE(PG8_SA(1, 0), cA + kstep, voffA); PG8_STAGE(PG8_SB(1, 1), cB + hstepB + kstep, voffB);
    PG8_WAIT_V(6); PG8_BAR;
    for (;;) {
        const bool has_next = S.next(ui + 1, nxt);
        const char* nA = has_next ? (const char*)g.A + (size_t)nxt.pm * tstepA : cA; const char* nB = has_next ? (const char*)g.Bt + (size_t)nxt.pn * tstepB : cB;
        for (int t = 0; t < nt; t += 2) {
            const bool last = (t == nt - 2);
            const char* a1 = cA + (size_t)(t + 1) * kstep;
            const char* a2 = last ? nA : cA + (size_t)(t + 2) * kstep; const char* b2 = last ? nB : cB + (size_t)(t + 2) * kstep;
            const char* a3 = a2 + kstep; const char* b3 = b2 + kstep;
            if (last && has_next) S.a_ready(nxt);
            PG8_LDB(B0, 0, 0); PG8_SCHED; PG8_LDA(At, 0, 0); PG8_STAGE(PG8_SA(1, 1), a1 + hstepA, voffA);
            PG8_WAIT_L(8); PG8_BAR; PG8_WAIT_L(0); PG8_MMA(0, 0, At, B0); PG8_BAR; PG8_SCHED;
            PG8_LDB(B1, 0, 1); PG8_STAGE(PG8_SB(0, 0), b2, voffB);
            PG8_BAR; PG8_WAIT_L(0); PG8_MMA(0, 1, At, B1); PG8_BAR;
            PG8_LDA(At, 0, 1); PG8_STAGE(PG8_SA(0, 0), a2, voffA);
            PG8_BAR; PG8_WAIT_L(0); PG8_MMA(1, 0, At, B0); PG8_BAR; PG8_SCHED;
            PG8_STAGE(PG8_SB(0, 1), b2 + hstepB, voffB);
            PG8_WAIT_V(6); PG8_BAR; PG8_MMA(1, 1, At, B1); PG8_BAR;
            PG8_LDB(B0, 1, 0); PG8_SCHED; PG8_LDA(At, 1, 0); PG8_STAGE(PG8_SA(0, 1), a2 + hstepA, voffA);
            PG8_WAIT_L(8); PG8_BAR; PG8_WAIT_L(0); PG8_MMA(0, 0, At, B0); PG8_BAR; PG8_SCHED;
            PG8_LDB(B1, 1, 1); PG8_STAGE(PG8_SB(1, 0), b3, voffB);
            PG8_BAR; PG8_WAIT_L(0); PG8_MMA(0, 1, At, B1); PG8_BAR;
            PG8_LDA(At, 1, 1); PG8_STAGE(PG8_SA(1, 0), a3, voffA);
            PG8_BAR; PG8_WAIT_L(0); PG8_MMA(1, 0, At, B0); PG8_BAR; PG8_SCHED;
            PG8_STAGE(PG8_SB(1, 1), b3 + hstepB, voffB);
            PG8_WAIT_V(6); PG8_BAR; PG8_MMA(1, 1, At, B1); PG8_BAR;
        }
        E(acc, cur, wr, wc, fr, fq);
        if constexpr (Epi::TWICE) {
#pragma unroll
            for (int a = 0; a < 2; ++a)
#pragma unroll
                for (int b = 0; b < 2; ++b) asm volatile("" : "+v"(acc[a][b][0][0]), "+v"(acc[a][b][0][1]), "+v"(acc[a][b][1][0]), "+v"(acc[a][b][1][1]), "+v"(acc[a][b][2][0]), "+v"(acc[a][b][2][1]), "+v"(acc[a][b][3][0]), "+v"(acc[a][b][3][1]) :: "memory");
            E(acc, cur, wr, wc, fr, fq); }
        S.done(cur);
        if (!has_next) break;
#pragma unroll
        for (int a = 0; a < 2; ++a)
#pragma unroll
            for (int b = 0; b < 2; ++b)
#pragma unroll
                for (int m = 0; m < 4; ++m)
#pragma unroll
                    for (int n = 0; n < 2; ++n) acc[a][b][m][n] = (f32x4){0.f, 0.f, 0.f, 0.f};
        cur = nxt; cA = nA; cB = nB; ++ui;
    }
    PG8_WAIT_V(0);
    if (wr == 0) PG8_BAR;
    PG8_BAR;
#undef PG8_SA
#undef PG8_SB
#undef PG8_STAGE
#undef PG8_LDA
#undef PG8_LDB
#undef PG8_MMA
#undef PG8_WAIT_V
#undef PG8_WAIT_L
#undef PG8_BAR
#undef PG8_SCHED
}
}

struct Ctx {
    KP kp; const float* const __attribute__((address_space(4)))* in; float* out; unsigned char* ws;
    LAS unsigned char* lds;
    int tid, lane, wave, G, wg;
    float* lb; bf16_t* win; bf16_t* wout; bf16_t* xb; bf16_t* proj; float* projs; float* dtb; bf16_t* mix; bf16_t* xbcs; float* rowsq; unsigned* ctl;
};
DI Ctx make_ctx(int wv) {
    extern __shared__ __attribute__((aligned(16))) unsigned char lds_raw[];
    Ctx c; c.kp = get_params(); c.in = c.kp->in; c.out = c.kp->out; c.ws = c.kp->ws;
    c.lds = (LAS unsigned char*)lds_raw;
    asm volatile("" : "+s"(wv));
    int wg = blockIdx.x; asm volatile("" : "+s"(wg));
    c.tid = get_tid(wv); c.lane = c.tid & 63; c.wave = wv; c.G = gridDim.x; c.wg = wg;
    unsigned char* ws = c.ws;
    c.ctl = (unsigned*)(ws + WS_CTL); c.lb = (float*)(ws + WS_LB); c.win = (bf16_t*)(ws + WS_WIN); c.wout = (bf16_t*)(ws + WS_WOUT); c.xb = (bf16_t*)(ws + WS_XB);
    c.proj = (bf16_t*)(ws + WS_PROJ); c.projs = (float*)(ws + WS_PROJS); c.dtb = (float*)(ws + WS_DTB); c.mix = (bf16_t*)(ws + WS_MIX); c.xbcs = (bf16_t*)(ws + WS_XBCS); c.rowsq = (float*)(c.ctl + CW_ROWSQ);
    return c;
}

DI void p0_transpose_item(const float* W, int ldw, int k0, int n0, bf16_t* WT, int K, int drow0, LAS float* scr, int lane, const float* ksc) {
    float t[32];
#pragma unroll
    for (int i = 0; i < 32; ++i) t[i] = W[(size_t)(k0 + 2 * i + (lane >> 5)) * ldw + n0 + (lane & 31)];
#pragma unroll
    for (int i = 0; i < 32; ++i) scr[(2 * i + (lane >> 5)) * 33 + (lane & 31)] = t[i];
    const int c = lane & 7;
    f32x4 s0 = (f32x4){1.f, 1.f, 1.f, 1.f}, s1 = s0;
    if (ksc) { s0 = *(const f32x4*)(ksc + k0 + 8 * c); s1 = *(const f32x4*)(ksc + k0 + 8 * c + 4); }
    asm volatile("s_waitcnt lgkmcnt(0)" ::: "memory");
#pragma unroll
    for (int j = 0; j < 4; ++j) { const int n = (lane >> 3) + 8 * j; const LAS float* s = scr + (8 * c) * 33 + n;
        u32x4 o; o.x = pk2(s[0 * 33] * s0.x, s[1 * 33] * s0.y); o.y = pk2(s[2 * 33] * s0.z, s[3 * 33] * s0.w); o.z = pk2(s[4 * 33] * s1.x, s[5 * 33] * s1.y); o.w = pk2(s[6 * 33] * s1.z, s[7 * 33] * s1.w);
        *(u32x4*)(WT + (size_t)(drow0 + n) * K + k0 + 8 * c) = o; }
    asm volatile("s_waitcnt lgkmcnt(0)" ::: "memory");
}
DI void phase_prologue(int wv) {
    const Ctx c = make_ctx(wv);
    LAS float* scr = (LAS float*)(c.lds + c.wave * 16384);
    const int gw = c.wg * 8 + c.wave, NGW = c.G * 8;
    constexpr int NB1 = SRC_GLA / 32, NB2 = (SRC_DT - SRC_SSZ) / 32;
    constexpr int I_A = (D_MODEL / 64) * NB1, I_B = (D_MODEL / 64) * NB2, I_O = (D_MIX / 64) * (D_MODEL / 32), I_L = I_A + I_B + I_O;
    for (int it = gw; it < DEPTH * I_L; it += NGW) {
        const int l = it / I_L; int r = it % I_L;
        const float* win = c.in[I_WIN] + (size_t)l * D_MODEL * N_IN; bf16_t* wt = c.win + (size_t)l * LDP * D_MODEL; const float* rmsw = c.in[I_RMS] + (size_t)l * D_MODEL;
        if (r < I_A) { const int kb = r / NB1, nb = r % NB1; p0_transpose_item(win, N_IN, 64 * kb, 32 * nb, wt, D_MODEL, 32 * nb, scr, c.lane, rmsw); }
        else if (r < I_A + I_B) { r -= I_A; const int kb = r / NB2, nb = r % NB2; p0_transpose_item(win, N_IN, 64 * kb, SRC_SSZ + 32 * nb, wt, D_MODEL, C_SSZ + 32 * nb, scr, c.lane, rmsw); }
        else { r -= I_A + I_B; const int kb = r / (D_MODEL / 32), nb = r % (D_MODEL / 32);
            p0_transpose_item(c.in[I_WOUT] + (size_t)l * D_MIX * D_MODEL, D_MODEL, 64 * kb, 32 * nb, c.wout + (size_t)l * D_MODEL * D_MIX, D_MIX, 32 * nb, scr, c.lane, nullptr); }
    }
    const int gt = c.wg * 512 + c.tid, NGT = c.G * 512;
    for (int it = gw; it < DEPTH * 32 * 8; it += NGW) {
        const int l = it >> 8, kb = (it >> 3) & 31, nb = it & 7, k = kb * 64 + c.lane;
        const float* wr = c.in[I_WIN] + ((size_t)l * D_MODEL + k) * N_IN + SRC_GLA; const float* up = c.in[I_GWU] + (size_t)l * 16 * 512 + nb * 64;
        const f32x4 a0 = *(const f32x4*)wr, a1 = *(const f32x4*)(wr + 4), a2 = *(const f32x4*)(wr + 8), a3 = *(const f32x4*)(wr + 12);
        const float rk = c.in[I_RMS][(size_t)l * D_MODEL + k];
        bf16_t* dst = c.win + ((size_t)l * LDP + C_GLF + nb * 64) * D_MODEL + k;
#pragma unroll 4
        for (int n = 0; n < 64; ++n) {
            const float s = a0.x * up[n] + a0.y * up[512 + n] + a0.z * up[1024 + n] + a0.w * up[1536 + n] + a1.x * up[2048 + n] + a1.y * up[2560 + n] + a1.z * up[3072 + n] + a1.w * up[3584 + n]
                          + a2.x * up[4096 + n] + a2.y * up[4608 + n] + a2.z * up[5120 + n] + a2.w * up[5632 + n] + a3.x * up[6144 + n] + a3.y * up[6656 + n] + a3.z * up[7168 + n] + a3.w * up[7680 + n];
            dst[(size_t)n * D_MODEL] = (bf16_t)f2bf(s * rk); }
    }
    for (int i = gt; i < DEPTH * 16 * D_MODEL; i += NGT) {
        const int l = i / (16 * D_MODEL), e = i % (16 * D_MODEL), n = e / D_MODEL, k = e % D_MODEL;
        c.win[((size_t)l * LDP + C_DT + n) * D_MODEL + k] = (bf16_t)f2bf(c.in[I_WIN][((size_t)l * D_MODEL + k) * N_IN + SRC_DT + n] * c.in[I_RMS][(size_t)l * D_MODEL + k]);
    }
    constexpr int PADW = (LDP - C_DT - 16) * D_MODEL * 2 / 16;
    for (int i = gt; i < DEPTH * PADW; i += NGT) { const int l = i / PADW, r = i % PADW;
        ((u32x4*)(c.win + ((size_t)l * LDP + C_DT + 16) * D_MODEL))[r] = (u32x4){0u, 0u, 0u, 0u}; }
    constexpr int PADX = (M_PAD - TT) * D_MODEL * 2 / 16;
    for (int i = gt; i < PADX; i += NGT) ((u32x4*)(c.xb + (size_t)TT * D_MODEL))[i] = (u32x4){0u, 0u, 0u, 0u};
    for (int r = gw; r < TT; r += NGW) {
        const f32x4* x4 = (const f32x4*)(r < TP ? c.in[I_XP] + (size_t)r * D_MODEL : c.in[I_XS] + (size_t)(r - TP) * D_MODEL);
        u32x2* o = (u32x2*)(c.xb + (size_t)r * D_MODEL); float s = 0.f;
#pragma unroll
        for (int j = 0; j < 8; ++j) { const f32x4 v = x4[c.lane + 64 * j]; s += (v.x * v.x + v.y * v.y) + (v.z * v.z + v.w * v.w); u32x2 p; p.x = pk2(v.x, v.y); p.y = pk2(v.z, v.w); o[c.lane + 64 * j] = p; }
        s = wave_sum(s, c.lane);
        if (c.lane == 0) c.rowsq[r] = s;
    }
    for (int i = gt; i < 1024; i += NGT) {
        const float* p = c.in[I_LB];
        const float a0 = p[i], a1 = p[1024 + i], a2 = p[2048 + i], a3 = p[3072 + i];
        const float mx = fmaxf(fmaxf(a0, a1), fmaxf(a2, a3));
        const float e0 = expf(a0 - mx), e1 = expf(a1 - mx), e2 = expf(a2 - mx), e3 = expf(a3 - mx);
        const float inv = 1.0f / (e0 + e1 + e2 + e3);
        c.lb[i] = 0.f; c.lb[1024 + i] = e1 * inv; c.lb[2048 + i] = (e1 + e2) * inv; c.lb[3072 + i] = (e1 + e2 + e3) * inv;
    }
}

DI void phase_final_norm(int wv) {
    const Ctx c = make_ctx(wv);
    const int gw = c.wg * 8 + c.wave, NGW = c.G * 8;
    const f32x4* w4 = (const f32x4*)c.in[I_RMSF];
    for (int r = gw; r < TT; r += NGW) {
        const u32x2* x2 = (const u32x2*)(c.xb + (size_t)r * D_MODEL);
        const float rstd = row_rstd(c.rowsq + DEPTH * M_PAD, r);
        f32x4* o = (f32x4*)(c.out + O_YP + (size_t)r * D_MODEL);
#pragma unroll
        for (int j = 0; j < 8; ++j) { const u32x2 p = x2[c.lane + 64 * j]; const f32x4 w = w4[c.lane + 64 * j];
            o[c.lane + 64 * j] = (f32x4){bflo(p.x) * rstd * w.x, bfhi(p.x) * rstd * w.y, bflo(p.y) * rstd * w.z, bfhi(p.y) * rstd * w.w}; }
    }
}

DI float ps4(const float* p) { return (p[0] + p[PST]) + (p[2 * PST] + p[3 * PST]); }
DI float conv1(const float* prow, float rs, int col, int ch, int nch, const float* cw, const float* cb, const float* buf) {
    return cb[ch] + cw[ch] * buf[ch] + cw[nch + ch] * buf[nch + ch] + cw[2 * nch + ch] * buf[2 * nch + ch] + cw[3 * nch + ch] * (ps4(prow + col + ch) * rs);
}
constexpr int SM_Q = 0, SM_K = 1024, SM_F = 2048, SM_V = 3072, SM_O = 4096, SM_WS = 5120, SM_PART = 5376;
DI void sample_item(const Ctx& c, int l, int s, int type) {
    LAS float* sm = (LAS float*)c.lds;
    LAS float* QS = sm + SM_Q; LAS float* KS = sm + SM_K; LAS float* FS = sm + SM_F; LAS float* VS = sm + SM_V; LAS float* OS_ = sm + SM_O; LAS float* WSUM = sm + SM_WS;
    const int tid = get_tid(c.wave), lane = tid & 63, w = c.wave;
    const float* pr = c.projs + (size_t)s * LDP; const float rs = row_rstd(c.rowsq + (size_t)l * M_PAD, TP + s);
    __syncthreads();
    if (type == 0) {
#pragma unroll
        for (int e = 0; e < 2; ++e) { const int ch = 2 * tid + e; const float qraw = (ps4(pr + C_HGQ + ch) * rs), fraw = (ps4(pr + C_HGF + ch) * rs), lbv = c.lb[(size_t)l * 1024 + ch];
            QS[ch] = silu(qraw); FS[ch] = fmaxf(lbv + (1.0f - lbv) * sigm(fraw), TINY); KS[ch] = (1.0f - lbv) * sigm(-fraw); VS[ch] = (ps4(pr + C_HGI + ch) * rs); }
    } else if (type == 1) {
#pragma unroll
        for (int e = 0; e < 2; ++e) { const int ch = 2 * tid + e; VS[ch] = (ps4(pr + C_GLV + ch) * rs);
            if (tid < 256) { QS[ch] = (ps4(pr + C_GLQ + ch) * rs) * 0.08838834764831845f; KS[ch] = (ps4(pr + C_GLK + ch) * rs);
                const float z = (ps4(pr + C_GLF + ch) * rs) + c.in[I_GBU][(size_t)l * 512 + ch]; FS[ch] = fexp(-softplus(-z) * (1.0f / 16.0f)); } }
    } else {
        const float* scw = c.in[I_SCW] + (size_t)l * 4 * 1536; const float* scb = c.in[I_SCB] + (size_t)l * 1536;
        const float* sbuf = c.in[I_SSSDC] + ((size_t)l * DEC + s) * 3 * 1536;
#pragma unroll
        for (int e = 0; e < 2; ++e) { const int ch = 2 * tid + e; VS[ch] = silu(conv1(pr, rs, C_XBC, ch, 1536, scw, scb, sbuf)); }
        if (tid < 256) { KS[tid] = silu(conv1(pr, rs, C_XBC, 1024 + tid, 1536, scw, scb, sbuf)); QS[tid] = silu(conv1(pr, rs, C_XBC, 1280 + tid, 1536, scw, scb, sbuf)); }
        if (tid < 16) { const float dt = softplus((ps4(pr + C_DT + tid) * rs) + c.in[I_DTB][l * 16 + tid]); FS[tid] = dt; FS[16 + tid] = fexp(-dt * expf(c.in[I_ALOG][l * 16 + tid])); }
    }
    __syncthreads();
    if (type < 2) {
        const int h = type == 0 ? w : (w >> 1), RS = type == 0 ? 128 : 256, voff = type == 0 ? 0 : 128 * (w & 1);
        const size_t sb = type == 0 ? (((size_t)l * DEC + s) * 8 + h) * 16384 : (((size_t)l * DEC + s) * 4 + h) * 32768;
        const float* s0 = (type == 0 ? c.in[I_SHG] : c.in[I_SGLA]) + sb; float* so = c.out + (type == 0 ? O_HG_S : O_GLA_S) + sb;
        const int vq = lane & 31, kh = lane >> 5, vb = (type == 0 ? h * 128 : h * 256 + voff) + 4 * vq, qb = h * 128;
        const f32x4 vv = *(const LAS f32x4*)(VS + vb); f32x4 o4 = (f32x4){0.f, 0.f, 0.f, 0.f};
        const int eo = kh * RS + voff + 4 * vq;
#pragma unroll 2
        for (int k8 = 0; k8 < 64; k8 += 8) {
            f32x4 st[8];
#pragma unroll
            for (int u = 0; u < 8; ++u) st[u] = *(const f32x4*)(s0 + (size_t)(2 * (k8 + u)) * RS + eo);
#pragma unroll
            for (int u = 0; u < 8; ++u) { const int k = 2 * (k8 + u) + kh; const float fk = FS[qb + k], kk = KS[qb + k], qk = QS[qb + k];
                st[u] = st[u] * fk + vv * kk; o4 += st[u] * qk; *(f32x4*)(so + (size_t)(2 * (k8 + u)) * RS + eo) = st[u]; }
        }
        o4.x += shx(o4.x, 32, lane); o4.y += shx(o4.y, 32, lane); o4.z += shx(o4.z, 32, lane); o4.w += shx(o4.w, 32, lane);
        if (kh == 0) *(LAS f32x4*)(OS_ + vb) = o4;
    } else {
        LAS float* PART = sm + SM_PART + w * 2304;
        const int nq = lane & 31, ph = lane >> 5, g = w >> 2;
        const f32x4 B4 = *(const LAS f32x4*)(KS + g * 128 + 4 * nq), C4 = *(const LAS f32x4*)(QS + g * 128 + 4 * nq);
#pragma unroll 1
        for (int hx = 0; hx < 2; ++hx) { const int h = 2 * w + hx;
            const size_t sb = (((size_t)l * DEC + s) * 16 + h) * 8192;
            const float* s0 = c.in[I_SSSD] + sb; float* so = c.out + O_SSD_S + sb;
            const float dt = FS[h], dA = FS[16 + h];
            const int eo = ph * 128 + 4 * nq;
#pragma unroll 2
            for (int p8 = 0; p8 < 32; p8 += 8) {
                f32x4 st[8];
#pragma unroll
                for (int u = 0; u < 8; ++u) st[u] = *(const f32x4*)(s0 + (size_t)(2 * (p8 + u)) * 128 + eo);
#pragma unroll
                for (int u = 0; u < 8; ++u) { const int p = 2 * (p8 + u) + ph; const float xv = VS[h * 64 + p] * dt;
                    st[u] = st[u] * dA + B4 * xv; *(f32x4*)(so + (size_t)(2 * (p8 + u)) * 128 + eo) = st[u];
                    PART[p * 36 + nq] = (st[u].x * C4.x + st[u].y * C4.y) + (st[u].z * C4.z + st[u].w * C4.w); }
            }
            asm volatile("s_waitcnt lgkmcnt(0)" ::: "memory");
            { float o = 0.f;
#pragma unroll
              for (int q = 0; q < 8; ++q) { const f32x4 t = *(const LAS f32x4*)(PART + lane * 36 + 4 * q); o += (t.x + t.y) + (t.z + t.w); }
              const float x = VS[h * 64 + lane], z = (ps4(pr + C_SSZ + h * 64 + lane) * rs);
              OS_[h * 64 + lane] = (o + c.in[I_SD][l * 16 + h] * x) * silu(z); }
            asm volatile("s_waitcnt lgkmcnt(0)" ::: "memory");
        }
    }
    __syncthreads();
    { const f32x2 o2 = *(const LAS f32x2*)(OS_ + 2 * tid);
      const float ssw = wave_sum(o2.x * o2.x + o2.y * o2.y, lane);
      if (lane == 0) WSUM[w] = ssw;
      __syncthreads();
      float ss, gsz; const float* nw; int mcol, gcol = 0;
      if (type == 0) { ss = WSUM[w]; gsz = 128.f; nw = c.in[I_HGN] + (size_t)l * 1024; mcol = 0; gcol = C_HGG; }
      else if (type == 1) { ss = WSUM[w & ~1] + WSUM[w | 1]; gsz = 256.f; nw = c.in[I_GLN] + (size_t)l * 1024; mcol = 2048; gcol = C_GLG; }
      else { const int b4 = w & ~3; ss = (WSUM[b4] + WSUM[b4 + 1]) + (WSUM[b4 + 2] + WSUM[b4 + 3]); gsz = 512.f; nw = c.in[I_SSN] + (size_t)l * 1024; mcol = 3072; }
      const float rstd = rsqrtf(ss / gsz + EPS);
      float y0 = o2.x * rstd * nw[2 * tid], y1 = o2.y * rstd * nw[2 * tid + 1];
      if (type < 2) { y0 *= silu((ps4(pr + gcol + 2 * tid) * rs)); y1 *= silu((ps4(pr + gcol + 2 * tid + 1) * rs)); }
      *(unsigned*)(c.mix + (size_t)(TP + s) * D_MIX + mcol + 2 * tid) = pk2(y0, y1); }
}

DI void lds_barrier() { asm volatile("s_waitcnt lgkmcnt(0)\n\ts_barrier" ::: "memory"); }
DI f32x16 mfma32(bf16x8 a, bf16x8 b, f32x16 c) { return __builtin_amdgcn_mfma_f32_32x32x16_bf16(a, b, c, 0, 0, 0); }
DI bf16x8 ldfrag(const LAS unsigned char* p) { return *(const LAS bf16x8*)p; }
DI int crow(int i, int hh) { return (i & 3) + 8 * (i >> 2) + 4 * hh; }
constexpr int L_QP = 0, L_KP = 17408, L_KPT = 34816, L_VT = 53248, L_VT2 = 71680, L_AM = 90112, L_TOT = 108544, L_E1 = 112640, L_E2 = 113152, L_CUM = 113664;
constexpr int SQ = 272, SV = 144;
#define ZERO16(x) do { _Pragma("unroll") for (int _i = 0; _i < 16; ++_i) (x)[_i] = 0.f; } while (0)

template <int TYPE>
DI void la_head_unit(const Ctx& c, int l, int b, int hu) {
    constexpr int DV = 128, NSW = DV / 32, OS = DV * 2 + 16, NC = DV / 8;
    LAS unsigned char* L = c.lds;
    const int tid = get_tid(c.wave), lane = tid & 63, w = c.wave;
    const int r = lane & 31, hh = lane >> 5;
    const int row0 = b * SEQ;
    const bf16_t* P = TYPE == 2 ? c.xbcs : c.proj;
    constexpr int LDR = TYPE == 2 ? 1536 : LDP;
    LAS float* TOT = (LAS float*)(L + L_TOT); LAS float* E1 = (LAS float*)(L + L_E1); LAS float* E2 = (LAS float*)(L + L_E2);
    int colQ, colK, colG, colV, colGate, colOut, sidx; const int grp = hu >> 2;
    if constexpr (TYPE == 0) { colQ = C_HGQ + hu * 128; colK = 0; colG = C_HGF + hu * 128; colV = C_HGI + hu * 128; colGate = C_HGG + hu * 128; colOut = hu * 128; sidx = 0; }
    else if constexpr (TYPE == 1) { const int hd = hu >> 1; colQ = C_GLQ + hd * 128; colK = C_GLK + hd * 128; colG = C_GLF + hd * 128; colV = C_GLV + hu * 128; colGate = C_GLG + hu * 128; colOut = 2048 + hu * 128; sidx = 2 + hd; }
    else { colK = 1024 + grp * 128; colQ = 1280 + grp * 128; colG = 0; colV = hu * 128; colGate = C_SSZ + hu * 128; colOut = 3072 + hu * 128; sidx = grp; }
    float Ah[2], Dh[2];
    if constexpr (TYPE == 2) {
#pragma unroll
        for (int e = 0; e < 2; ++e) { Ah[e] = -expf(c.in[I_ALOG][l * 16 + 2 * hu + e]); Dh[e] = c.in[I_SD][l * 16 + 2 * hu + e]; }
    }
    unsigned r0[8], r1[8], r2[8], r3[8]; float dtn = 0.f;
#define LOAD_CHUNK(tn) do { const bf16_t* pq_ = P + (size_t)(row0 + (tn) + 8 * w) * LDR + 2 * lane; \
        if constexpr (TYPE == 0) { _Pragma("unroll") for (int i = 0; i < 8; ++i) { r0[i] = *(const unsigned*)(pq_ + (size_t)i * LDR + colQ); r1[i] = *(const unsigned*)(pq_ + (size_t)i * LDR + colG); r2[i] = *(const unsigned*)(pq_ + (size_t)i * LDR + colV); } } \
        else if constexpr (TYPE == 1) { _Pragma("unroll") for (int i = 0; i < 8; ++i) { r0[i] = *(const unsigned*)(pq_ + (size_t)i * LDR + colQ); r1[i] = *(const unsigned*)(pq_ + (size_t)i * LDR + colK); \
                                                                                       r2[i] = *(const unsigned*)(pq_ + (size_t)i * LDR + colG); r3[i] = *(const unsigned*)(pq_ + (size_t)i * LDR + colV); } } \
        else { _Pragma("unroll") for (int i = 0; i < 8; ++i) { r0[i] = *(const unsigned*)(pq_ + (size_t)i * LDR + colQ); r1[i] = *(const unsigned*)(pq_ + (size_t)i * LDR + colK); r2[i] = *(const unsigned*)(pq_ + (size_t)i * LDR + colV); } \
            if (w < 2) dtn = c.dtb[(size_t)(row0 + (tn) + lane) * 16 + 2 * hu + w]; } } while (0)
    f32x16 S[4];
#pragma unroll
    for (int kt = 0; kt < 4; ++kt) ZERO16(S[kt]);
    float e2pa = 1.f, e2pb = 1.f;
    constexpr bool PF = true;
    if constexpr (PF) LOAD_CHUNK(0);
    for (int ck = -(SEQ / 64) * (PROBE_LONG_REP - 1); ck < SEQ / 64; ++ck) {
        if (PROBE_LONG_REP > 1 && ck == 0) { e2pa = 1.f; e2pb = 1.f;
#pragma unroll
            for (int kt = 0; kt < 4; ++kt) ZERO16(S[kt]); }
        const int t0 = (ck & (SEQ / 64 - 1)) * 64;
        LAS float* CUM = (LAS float*)(L + L_CUM + (ck & 1) * 1536);
        if constexpr (!PF) LOAD_CHUNK(t0);
        float qa[8], qb[8], ka[8], kb[8], ga[8], gb[8], xa[8], xb[8]; unsigned uv[8];
        if constexpr (TYPE == 0) {
            float ta = 0.f, tb = 0.f;
#pragma unroll
            for (int i = 0; i < 8; ++i) { qa[i] = bflo(r0[i]); qb[i] = bfhi(r0[i]); const float g0 = bflo(r1[i]), g1 = bfhi(r1[i]); uv[i] = r2[i];
                ka[i] = 1.0f - fexp(g0); kb[i] = 1.0f - fexp(g1); ta += g0; tb += g1; ga[i] = ta; gb[i] = tb; }
            *(LAS f32x2*)(TOT + w * 128 + 2 * lane) = (f32x2){ta, tb};
        } else if constexpr (TYPE == 1) {
            float ta = 0.f, tb = 0.f;
#pragma unroll
            for (int i = 0; i < 8; ++i) { qa[i] = bflo(r0[i]); qb[i] = bfhi(r0[i]); ka[i] = bflo(r1[i]); kb[i] = bfhi(r1[i]); ta += bflo(r2[i]); tb += bfhi(r2[i]); ga[i] = ta; gb[i] = tb; uv[i] = r3[i]; }
            *(LAS f32x2*)(TOT + w * 128 + 2 * lane) = (f32x2){ta, tb};
        } else {
#pragma unroll
            for (int i = 0; i < 8; ++i) { qa[i] = bflo(r0[i]); qb[i] = bfhi(r0[i]); ka[i] = bflo(r1[i]); kb[i] = bfhi(r1[i]); xa[i] = bflo(r2[i]); xb[i] = bfhi(r2[i]); }
            if (w < 2) {
                const float dt = dtn; float x = dt * (w == 0 ? Ah[0] : Ah[1]);
#pragma unroll
                for (int o = 1; o < 64; o <<= 1) { const float y = shup(x, o, lane); if (lane >= o) x += y; }
                CUM[w * 192 + lane] = x; CUM[w * 192 + 64 + lane] = fmaxf(dt, 1e-30f); CUM[w * 192 + 128 + lane] = fexp(x);
            }
        }
        lds_barrier();
        if constexpr (TYPE < 2) {
            float offa = 0.f, offb = 0.f, brefa = 0.f, brefb = 0.f, bla = 0.f, blb = 0.f;
#pragma unroll
            for (int g = 0; g < 8; ++g) { const f32x2 t = *(const LAS f32x2*)(TOT + g * 128 + 2 * lane);
                if (g < w) { offa += t.x; offb += t.y; }
                if (g < 4) { brefa += t.x; brefb += t.y; }
                bla += t.x; blb += t.y; }
#pragma unroll
            for (int i = 0; i < 8; ++i) { const float da = clampf(ga[i] + offa - brefa, -80.f, 80.f), db = clampf(gb[i] + offb - brefb, -80.f, 80.f);
                qa[i] *= fexp(da); ka[i] *= fexp(-da); qb[i] *= fexp(db); kb[i] *= fexp(-db); }
            if (w == 0) {
                const float e2a = fexp(bla - brefa), e2b = fexp(blb - brefb);
                *(LAS f32x2*)(E1 + 2 * lane) = (f32x2){fexp(brefa) * e2pa, fexp(brefb) * e2pb}; *(LAS f32x2*)(E2 + 2 * lane) = (f32x2){e2a, e2b}; e2pa = e2a; e2pb = e2b; }
        }
#pragma unroll
        for (int i = 0; i < 8; ++i) { *(LAS unsigned*)(L + L_QP + (8 * w + i) * SQ + 4 * lane) = pk2(qa[i], qb[i]); *(LAS unsigned*)(L + L_KP + (8 * w + i) * SQ + 4 * lane) = pk2(ka[i], kb[i]); }
        { u32x4 a, bq; a.x = pk2(ka[0], ka[1]); a.y = pk2(ka[2], ka[3]); a.z = pk2(ka[4], ka[5]); a.w = pk2(ka[6], ka[7]);
          bq.x = pk2(kb[0], kb[1]); bq.y = pk2(kb[2], kb[3]); bq.z = pk2(kb[4], kb[5]); bq.w = pk2(kb[6], kb[7]);
          *(LAS u32x4*)(L + L_KPT + (2 * lane) * SV + 16 * w) = a; *(LAS u32x4*)(L + L_KPT + (2 * lane + 1) * SV + 16 * w) = bq; }
        if constexpr (TYPE < 2) {
            u32x4 a, bq;
            a.x = (uv[0] & 0xffffu) | (uv[1] << 16); a.y = (uv[2] & 0xffffu) | (uv[3] << 16); a.z = (uv[4] & 0xffffu) | (uv[5] << 16); a.w = (uv[6] & 0xffffu) | (uv[7] << 16);
            bq.x = (uv[0] >> 16) | (uv[1] & 0xffff0000u); bq.y = (uv[2] >> 16) | (uv[3] & 0xffff0000u); bq.z = (uv[4] >> 16) | (uv[5] & 0xffff0000u); bq.w = (uv[6] >> 16) | (uv[7] & 0xffff0000u);
            *(LAS u32x4*)(L + L_VT + (2 * lane) * SV + 16 * w) = a; *(LAS u32x4*)(L + L_VT + (2 * lane + 1) * SV + 16 * w) = bq;
        } else {
            const int hs = lane >> 5;
            const LAS float* cm = CUM + hs * 192; const float cl = cm[63];
            float v1a[8], v1b[8], v2a[8], v2b[8];
#pragma unroll
            for (int j = 0; j < 8; ++j) { const int s = 8 * w + j; const float dt = cm[64 + s], wgt = fexp(fminf(cl - cm[s], 0.f));
                v1a[j] = dt * xa[j]; v1b[j] = dt * xb[j]; v2a[j] = v1a[j] * wgt; v2b[j] = v1b[j] * wgt; }
            u32x4 a, bq;
            a.x = pk2(v1a[0], v1a[1]); a.y = pk2(v1a[2], v1a[3]); a.z = pk2(v1a[4], v1a[5]); a.w = pk2(v1a[6], v1a[7]);
            bq.x = pk2(v1b[0], v1b[1]); bq.y = pk2(v1b[2], v1b[3]); bq.z = pk2(v1b[4], v1b[5]); bq.w = pk2(v1b[6], v1b[7]);
            *(LAS u32x4*)(L + L_VT + (2 * lane) * SV + 16 * w) = a; *(LAS u32x4*)(L + L_VT + (2 * lane + 1) * SV + 16 * w) = bq;
            a.x = pk2(v2a[0], v2a[1]); a.y = pk2(v2a[2], v2a[3]); a.z = pk2(v2a[4], v2a[5]); a.w = pk2(v2a[6], v2a[7]);
            bq.x = pk2(v2b[0], v2b[1]); bq.y = pk2(v2b[2], v2b[3]); bq.z = pk2(v2b[4], v2b[5]); bq.w = pk2(v2b[6], v2b[7]);
            *(LAS u32x4*)(L + L_VT2 + (2 * lane) * SV + 16 * w) = a; *(LAS u32x4*)(L + L_VT2 + (2 * lane + 1) * SV + 16 * w) = bq;
        }
        lds_barrier();
        if constexpr (PF) { if (ck + 1 < SEQ / 64) LOAD_CHUNK(((ck + 1) & (SEQ / 64 - 1)) * 64); }
        if (w >= 5) {
            const int sb = (w == 7) ? 1 : 0, tb = (w == 5) ? 0 : 1;
            f32x16 X; ZERO16(X);
#pragma unroll
            for (int k4 = 0; k4 < 8; k4 += 4) { bf16x8 fk[4], fq[4];
#pragma unroll
                for (int u = 0; u < 4; ++u) { fk[u] = ldfrag(L + L_KP + (32 * sb + r) * SQ + (16 * (k4 + u) + 8 * hh) * 2); fq[u] = ldfrag(L + L_QP + (32 * tb + r) * SQ + (16 * (k4 + u) + 8 * hh) * 2); }
#pragma unroll
                for (int u = 0; u < 4; ++u) X = mfma32(fk[u], fq[u], X); }
            const int t = 32 * tb + r;
#pragma unroll
            for (int hs = 0; hs < (TYPE == 2 ? 2 : 1); ++hs) {
                float ct = 0.f, ddt = 0.f;
                if constexpr (TYPE == 2) { ct = CUM[hs * 192 + t]; ddt = (hs == 0 ? Dh[0] : Dh[1]) / CUM[hs * 192 + 64 + t]; }
#pragma unroll
                for (int g = 0; g < 4; ++g) { const int s0 = 32 * sb + 8 * g + 4 * hh;
                    float x0 = X[4 * g], x1 = X[4 * g + 1], x2 = X[4 * g + 2], x3 = X[4 * g + 3];
                    if constexpr (TYPE == 2) { const f32x4 cs = *(const LAS f32x4*)(CUM + hs * 192 + s0);
                        x0 *= fexp(fminf(ct - cs.x, 0.f)); x1 *= fexp(fminf(ct - cs.y, 0.f)); x2 *= fexp(fminf(ct - cs.z, 0.f)); x3 *= fexp(fminf(ct - cs.w, 0.f));
                        x0 += (s0 == t) ? ddt : 0.f; x1 += (s0 + 1 == t) ? ddt : 0.f; x2 += (s0 + 2 == t) ? ddt : 0.f; x3 += (s0 + 3 == t) ? ddt : 0.f; }
                    x0 = (s0 <= t) ? x0 : 0.f; x1 = (s0 + 1 <= t) ? x1 : 0.f; x2 = (s0 + 2 <= t) ? x2 : 0.f; x3 = (s0 + 3 <= t) ? x3 : 0.f;
                    u32x2 p; p.x = pk2(x0, x1); p.y = pk2(x2, x3);
                    *(LAS u32x2*)(L + L_AM + hs * 9216 + t * SV + s0 * 2) = p; }
            }
        }
        f32x16 O[2]; bf16x8 Bv[4];
        const int hsw = w >> 1;
        if (w < NSW) {
            if constexpr (TYPE < 2) {
#pragma unroll
                for (int kt = 0; kt < 4; ++kt)
#pragma unroll
                    for (int g = 0; g < 4; ++g) { const f32x4 e = *(const LAS f32x4*)(E1 + 32 * kt + 8 * g + 4 * hh);
                        S[kt][4 * g] *= e.x; S[kt][4 * g + 1] *= e.y; S[kt][4 * g + 2] *= e.z; S[kt][4 * g + 3] *= e.w; }
            }
            ZERO16(O[0]); ZERO16(O[1]);
#pragma unroll
            for (int kt = 0; kt < 4; ++kt) {
                u32x2 ql[2][2], qh[2][2];
#pragma unroll
                for (int s = 0; s < 2; ++s)
#pragma unroll
                    for (int tt = 0; tt < 2; ++tt) { const LAS unsigned char* qp = L + L_QP + (32 * tt + r) * SQ + (32 * kt + 16 * s + 4 * hh) * 2;
                        ql[s][tt] = *(const LAS u32x2*)qp; qh[s][tt] = *(const LAS u32x2*)(qp + 16); }
#pragma unroll
                for (int s = 0; s < 2; ++s) {
                    u32x4 pa; pa.x = pk2(S[kt][8 * s], S[kt][8 * s + 1]); pa.y = pk2(S[kt][8 * s + 2], S[kt][8 * s + 3]); pa.z = pk2(S[kt][8 * s + 4], S[kt][8 * s + 5]); pa.w = pk2(S[kt][8 * s + 6], S[kt][8 * s + 7]);
                    const bf16x8 A = __builtin_bit_cast(bf16x8, pa);
#pragma unroll
                    for (int tt = 0; tt < 2; ++tt) O[tt] = mfma32(A, __builtin_bit_cast(bf16x8, (u32x4){ql[s][tt].x, ql[s][tt].y, qh[s][tt].x, qh[s][tt].y}), O[tt]);
                }
            }
            if constexpr (TYPE == 2) {
                const LAS float* cm = CUM + hsw * 192; const float e0 = cm[128 + r], e1 = cm[128 + 32 + r], sc = cm[128 + 63];
#pragma unroll
                for (int i = 0; i < 16; ++i) { O[0][i] *= e0; O[1][i] *= e1; }
#pragma unroll
                for (int kt = 0; kt < 4; ++kt)
#pragma unroll
                    for (int i = 0; i < 16; ++i) S[kt][i] *= sc;
            }
#pragma unroll
            for (int st = 0; st < 4; ++st) { bf16x8 kf[4];
                Bv[st] = ldfrag(L + (TYPE == 2 ? L_VT2 : L_VT) + (32 * w + r) * SV + (16 * st + 8 * hh) * 2);
#pragma unroll
                for (int kt = 0; kt < 4; ++kt) kf[kt] = ldfrag(L + L_KPT + (32 * kt + r) * SV + (16 * st + 8 * hh) * 2);
#pragma unroll
                for (int kt = 0; kt < 4; ++kt) S[kt] = mfma32(kf[kt], Bv[st], S[kt]); }
        }
        const int nt_ = tid >> 3, nseg = tid & 7;
        u32x4 gq[NC / 8];
        { const bf16_t* pg = c.proj + (size_t)(row0 + t0 + nt_) * LDP + colGate + nseg * NC;
#pragma unroll
          for (int q = 0; q < NC / 8; ++q) gq[q] = *(const u32x4*)(pg + 8 * q); }
        lds_barrier();
        if (w < NSW) {
#pragma unroll
            for (int st = 0; st < 4; ++st) { bf16x8 Av = Bv[st];
                if constexpr (TYPE == 2) Av = ldfrag(L + L_VT + (32 * w + r) * SV + (16 * st + 8 * hh) * 2);
#pragma unroll
                for (int tt = 0; tt < 2; ++tt) if (st < 2 || tt == 1)
                    O[tt] = mfma32(Av, ldfrag(L + L_AM + (TYPE == 2 ? hsw * 9216 : 0) + (32 * tt + r) * SV + (16 * st + 8 * hh) * 2), O[tt]); }
#pragma unroll
            for (int tt = 0; tt < 2; ++tt)
#pragma unroll
                for (int g = 0; g < 4; ++g) { u32x2 p; p.x = pk2(O[tt][4 * g], O[tt][4 * g + 1]); p.y = pk2(O[tt][4 * g + 2], O[tt][4 * g + 3]);
                    *(LAS u32x2*)(L + (32 * tt + r) * OS + (32 * w + 8 * g + 4 * hh) * 2) = p; }
        }
        lds_barrier();
        {
            float o[NC], gv[NC]; float ss = 0.f;
#pragma unroll
            for (int q = 0; q < NC / 8; ++q) { const u32x4 ov = *(const LAS u32x4*)(L + nt_ * OS + (nseg * NC + 8 * q) * 2);
                o[8 * q] = bflo(ov.x); o[8 * q + 1] = bfhi(ov.x); o[8 * q + 2] = bflo(ov.y); o[8 * q + 3] = bfhi(ov.y); o[8 * q + 4] = bflo(ov.z); o[8 * q + 5] = bfhi(ov.z); o[8 * q + 6] = bflo(ov.w); o[8 * q + 7] = bfhi(ov.w);
                gv[8 * q] = bflo(gq[q].x); gv[8 * q + 1] = bfhi(gq[q].x); gv[8 * q + 2] = bflo(gq[q].y); gv[8 * q + 3] = bfhi(gq[q].y); gv[8 * q + 4] = bflo(gq[q].z); gv[8 * q + 5] = bfhi(gq[q].z); gv[8 * q + 6] = bflo(gq[q].w); gv[8 * q + 7] = bfhi(gq[q].w); }
            if constexpr (TYPE == 2) {
#pragma unroll
                for (int e = 0; e < NC; ++e) o[e] *= gv[e];
            }
#pragma unroll
            for (int e = 0; e < NC; ++e) ss += o[e] * o[e];
            ss += shx(ss, 1, lane); ss += shx(ss, 2, lane); ss += shx(ss, 4, lane);
            float mul = 1.0f;
            if constexpr (TYPE == 0) mul = rsqrtf(ss * (1.0f / DV) + EPS);
            else { if (nseg == 0 && ck >= 0) atomicAdd((float*)(c.ctl + CW_STATS) + ((size_t)l * TP + row0 + t0 + nt_) * 6 + sidx, ss); }
            if constexpr (TYPE < 2) {
#pragma unroll
                for (int e = 0; e < NC; ++e) o[e] *= mul * gv[e];
            }
            bf16_t* pm = c.mix + (size_t)(row0 + t0 + nt_) * D_MIX + colOut + nseg * NC;
#pragma unroll
            for (int q = 0; q < NC / 8; ++q) { u32x4 ov; ov.x = pk2(o[8 * q], o[8 * q + 1]); ov.y = pk2(o[8 * q + 2], o[8 * q + 3]); ov.z = pk2(o[8 * q + 4], o[8 * q + 5]); ov.w = pk2(o[8 * q + 6], o[8 * q + 7]);
                *(u32x4*)(pm + 8 * q) = ov; }
        }
    }
#undef LOAD_CHUNK
    if (w < NSW) {
        const int lane2 = get_tid(c.wave) & 63, r = lane2 & 31, hh = lane2 >> 5;
        if constexpr (TYPE < 2) {
#pragma unroll
            for (int kt = 0; kt < 4; ++kt)
#pragma unroll
                for (int g = 0; g < 4; ++g) { const f32x4 e = *(const LAS f32x4*)(E2 + 32 * kt + 8 * g + 4 * hh);
                    S[kt][4 * g] *= e.x; S[kt][4 * g + 1] *= e.y; S[kt][4 * g + 2] *= e.z; S[kt][4 * g + 3] *= e.w; }
        }
        float* sout; int sk, sv, vb;
        if constexpr (TYPE == 0) { sout = c.out + O_HG_P + (((size_t)l * NB + b) * 8 + hu) * 16384; sk = 128; sv = 1; vb = 32 * w; }
        else if constexpr (TYPE == 1) { sout = c.out + O_GLA_P + (((size_t)l * NB + b) * 4 + (hu >> 1)) * 32768; sk = 256; sv = 1; vb = 128 * (hu & 1) + 32 * w; }
        else { sout = c.out + O_SSD_P + (((size_t)l * NB + b) * 16 + 2 * hu + (w >> 1)) * 8192; sk = 1; sv = 128; vb = 32 * (w & 1); }
#pragma unroll
        for (int kt = 0; kt < 4; ++kt)
#pragma unroll
            for (int i = 0; i < 16; ++i) sout[(32 * kt + crow(i, hh)) * sk + (vb + r) * sv] = S[kt][i];
    }
}

constexpr int R_WT = 74752;
DI void rg_load_gates(const Ctx& c, int l, int n, int tid, int j, int hh, bf16x8 (&Br)[8], bf16x8 (&Bi)[8]) {
    LAS unsigned char* L = c.lds;
    const float* wr = c.in[I_WR] + (size_t)(l * 8 + n) * 128 * 128; const float* wi = c.in[I_WI] + (size_t)(l * 8 + n) * 128 * 128;
    __syncthreads();
    f32x4 v[16];
#pragma unroll
    for (int q = 0; q < 16; ++q) { const int e = tid + 512 * q, mat = e >> 12, rem = e & 4095; v[q] = *(const f32x4*)((mat ? wi : wr) + rem * 4); }
#pragma unroll
    for (int q = 0; q < 16; ++q) { const int e = tid + 512 * q, mat = e >> 12, rem = e & 4095, i = rem >> 5, j4 = (rem & 31) * 4;
        LAS unsigned char* p = L + R_WT + mat * 34816 + j4 * SQ + i * 2;
        *(LAS bf16_t*)(p) = (bf16_t)f2bf(v[q].x); *(LAS bf16_t*)(p + SQ) = (bf16_t)f2bf(v[q].y); *(LAS bf16_t*)(p + 2 * SQ) = (bf16_t)f2bf(v[q].z); *(LAS bf16_t*)(p + 3 * SQ) = (bf16_t)f2bf(v[q].w); }
    __syncthreads();
#pragma unroll
    for (int ks = 0; ks < 8; ++ks) { Br[ks] = ldfrag(L + R_WT + j * SQ + (16 * ks + 8 * hh) * 2); Bi[ks] = ldfrag(L + R_WT + 34816 + j * SQ + (16 * ks + 8 * hh) * 2); }
}
constexpr int R_XCB = 0, R_XCF = 17408, R_SUMA = 50176, R_SUMU = 58368, R_HIN = 66560;
DI void rg_chunk_unit(const Ctx& c, int l, int b, int n) {
    LAS unsigned char* L = c.lds;
    const int tid = get_tid(c.wave), lane = tid & 63, w = c.wave, r = lane & 31, hh = lane >> 5;
    const int tb = w >> 2, jb = w & 3;
    const int j = 32 * jb + r, ch = n * 128 + j;
    const int row0 = b * SEQ;
    const bf16_t* P = c.proj;
    LAS float* XCF = (LAS float*)(L + R_XCF); LAS float* SUMA = (LAS float*)(L + R_SUMA); LAS float* SUMU = (LAS float*)(L + R_SUMU); LAS float* HIN = (LAS float*)(L + R_HIN);
    bf16x8 Br[8], Bi[8];
    rg_load_gates(c, l, n, tid, j, hh, Br, Bi);
    const float sp = softplus(-c.in[I_LAM][l * 1024 + ch]), brv = c.in[I_BR][(l * 8 + n) * 128 + j], biv = c.in[I_BI][(l * 8 + n) * 128 + j];
    float cw[4][2], cb[2];
#pragma unroll
    for (int e = 0; e < 2; ++e) {
#pragma unroll
        for (int m = 0; m < 4; ++m) cw[m][e] = c.in[I_RCW][l * 4 * 1024 + m * 1024 + n * 128 + 2 * lane + e];
        cb[e] = c.in[I_RCB][l * 1024 + n * 128 + 2 * lane + e]; }
    float hcarry = 0.f;
    for (int ck = -(SEQ / 64) * (PROBE_RG_REP - 1); ck < SEQ / 64; ++ck) {
        if (PROBE_RG_REP > 1 && ck == 0) hcarry = 0.f;
        const int t0 = (ck & (SEQ / 64 - 1)) * 64;
        { const bf16_t* pq = P + (size_t)(row0 + t0 + 8 * w) * LDP + C_RGX + n * 128 + 2 * lane; const bool first = (t0 == 0 && w == 0);
          unsigned ux[11];
#pragma unroll
          for (int jx = 0; jx < 11; ++jx) ux[jx] = (first && jx < 3) ? 0u : *(const unsigned*)(pq + (ptrdiff_t)(jx - 3) * LDP);
#pragma unroll
          for (int i = 0; i < 8; ++i) { const int t = 8 * w + i;
              const float x0 = cb[0] + cw[0][0] * bflo(ux[i]) + cw[1][0] * bflo(ux[i + 1]) + cw[2][0] * bflo(ux[i + 2]) + cw[3][0] * bflo(ux[i + 3]);
              const float x1 = cb[1] + cw[0][1] * bfhi(ux[i]) + cw[1][1] * bfhi(ux[i + 1]) + cw[2][1] * bfhi(ux[i + 2]) + cw[3][1] * bfhi(ux[i + 3]);
              *(LAS f32x2*)(XCF + t * 128 + 2 * lane) = (f32x2){x0, x1}; *(LAS unsigned*)(L + R_XCB + t * SQ + 4 * lane) = pk2(x0, x1); } }
        float gt[16];
        { const bf16_t* pg = P + (size_t)(row0 + t0 + 32 * tb) * LDP; const int goff = 4 * hh * LDP + C_RGG + ch;
#pragma unroll
          for (int i = 0; i < 16; ++i) gt[i] = bf1((pg + (size_t)((i & 3) + 8 * (i >> 2)) * LDP)[goff]); }
        lds_barrier();
        f32x16 R, I; ZERO16(R); ZERO16(I);
#pragma unroll
        for (int ks = 0; ks < 8; ++ks) { const bf16x8 a = ldfrag(L + R_XCB + (32 * tb + r) * SQ + (16 * ks + 8 * hh) * 2); R = mfma32(a, Br[ks], R); I = mfma32(a, Bi[ks], I); }
        float av[16], uv[16];
#pragma unroll
        for (int i = 0; i < 16; ++i) { const int t = 32 * tb + crow(i, hh); const float rr = sigm_fast(R[i] + brv), ii = sigm_fast(I[i] + biv), xc = XCF[t * 128 + j];
            const float la = -8.0f * rr * sp; av[i] = fexp(la); uv[i] = sqrtf(fmaxf(neg_expm1(2.0f * la), 0.f)) * (ii * xc); }
#pragma unroll
        for (int g = 0; g < 4; ++g) { float A = 1.f, U = 0.f;
#pragma unroll
            for (int m = 0; m < 4; ++m) { U = av[4 * g + m] * U + uv[4 * g + m]; A *= av[4 * g + m]; }
            const int gi = 8 * tb + 2 * g + hh; SUMA[gi * 128 + j] = A; SUMU[gi * 128 + j] = U; }
        lds_barrier();
        if (tid < 128) { float hc = hcarry;
#pragma unroll
            for (int gi = 0; gi < 16; ++gi) { HIN[gi * 128 + tid] = hc; hc = SUMA[gi * 128 + tid] * hc + SUMU[gi * 128 + tid]; }
            hcarry = hc; }
        lds_barrier();
        { bf16_t* pm = c.mix + (size_t)(row0 + t0 + 32 * tb) * D_MIX; const int moff = 4 * hh * D_MIX + 1024 + ch;
#pragma unroll
          for (int g = 0; g < 4; ++g) { float hc = HIN[(8 * tb + 2 * g + hh) * 128 + j];
#pragma unroll
            for (int m = 0; m < 4; ++m) { const int i = 4 * g + m; hc = av[i] * hc + uv[i];
                (pm + (size_t)((i & 3) + 8 * (i >> 2)) * D_MIX)[moff] = (bf16_t)f2bf(hc * gt[i]); } } }
    }
    if (tid < 128) c.out[O_RG_P + ((size_t)l * NB + b) * 1024 + n * 128 + tid] = hcarry;
}

DI void rg_sample_unit(const Ctx& c, int l, int n) {
    LAS unsigned char* L = c.lds;
    const int tid = get_tid(c.wave), lane = tid & 63, w = c.wave, r = lane & 31, hh = lane >> 5;
    const int tb = w >> 2, jb = w & 3;
    const int j = 32 * jb + r, ch = n * 128 + j;
    LAS float* XCF = (LAS float*)(L + R_XCF);
    bf16x8 Br[8], Bi[8];
    rg_load_gates(c, l, n, tid, j, hh, Br, Bi);
    const float sp = softplus(-c.in[I_LAM][l * 1024 + ch]), brv = c.in[I_BR][(l * 8 + n) * 128 + j], biv = c.in[I_BI][(l * 8 + n) * 128 + j];
    float cw[4][2], cb[2];
#pragma unroll
    for (int e = 0; e < 2; ++e) {
#pragma unroll
        for (int m = 0; m < 4; ++m) cw[m][e] = c.in[I_RCW][l * 4 * 1024 + m * 1024 + n * 128 + 2 * lane + e];
        cb[e] = c.in[I_RCB][l * 1024 + n * 128 + 2 * lane + e]; }
    for (int chunk = 0; chunk < 2; ++chunk) {
        __syncthreads();
#pragma unroll
        for (int i = 0; i < 8; ++i) { const int t = 8 * w + i, s = 64 * chunk + t;
            const float* buf = c.in[I_SRGC] + ((size_t)l * DEC + s) * 3 * 1024 + n * 128 + 2 * lane;
            const f32x2 b0 = *(const f32x2*)buf, b1 = *(const f32x2*)(buf + 1024), b2 = *(const f32x2*)(buf + 2048), xn = (f32x2){ps4(c.projs + (size_t)s * LDP + C_RGX + n * 128 + 2 * lane), ps4(c.projs + (size_t)s * LDP + C_RGX + n * 128 + 2 * lane + 1)} * row_rstd(c.rowsq + (size_t)l * M_PAD, TP + s);
            const float x0 = cb[0] + cw[0][0] * b0.x + cw[1][0] * b1.x + cw[2][0] * b2.x + cw[3][0] * xn.x;
            const float x1 = cb[1] + cw[0][1] * b0.y + cw[1][1] * b1.y + cw[2][1] * b2.y + cw[3][1] * xn.y;
            *(LAS f32x2*)(XCF + t * 128 + 2 * lane) = (f32x2){x0, x1}; *(LAS unsigned*)(L + R_XCB + t * SQ + 4 * lane) = pk2(x0, x1); }
        __syncthreads();
        f32x16 R, I; ZERO16(R); ZERO16(I);
#pragma unroll
        for (int ks = 0; ks < 8; ++ks) { const bf16x8 a = ldfrag(L + R_XCB + (32 * tb + r) * SQ + (16 * ks + 8 * hh) * 2); R = mfma32(a, Br[ks], R); I = mfma32(a, Bi[ks], I); }
#pragma unroll
        for (int i = 0; i < 16; ++i) { const int t = 32 * tb + crow(i, hh), s = 64 * chunk + t;
            const float rr = sigm(R[i] + brv), ii = sigm(I[i] + biv), xc = XCF[t * 128 + j];
            const float la = -8.0f * rr * sp, a = fexp(la);
            const float hn = a * c.in[I_SRG][((size_t)l * DEC + s) * 1024 + ch] + sqrtf(fmaxf(neg_expm1(2.0f * la), 0.f)) * (ii * xc);
            c.mix[(size_t)(TP + s) * D_MIX + 1024 + ch] = (bf16_t)f2bf(hn * silu(ps4(c.projs + (size_t)s * LDP + C_RGG + ch) * row_rstd(c.rowsq + (size_t)l * M_PAD, TP + s)));
            c.out[O_RG_S + ((size_t)l * DEC + s) * 1024 + ch] = hn; }
    }
}

#ifndef PROBE_REP_LONG
#define PROBE_REP_LONG 1
#endif
#ifndef PROBE_G1_REP
#define PROBE_G1_REP 1
#endif
#ifndef PROBE_REP_SHORT
#define PROBE_REP_SHORT 1
#endif
DI void xbc_prepass_item(const Ctx& c, int l, int it) {
    const int tid = get_tid(c.wave);
    const float* scw = c.in[I_SCW] + (size_t)l * 4 * 1536; const float* scb = c.in[I_SCB] + (size_t)l * 1536;
    const int r0 = it * 32; const bool head = (r0 & (SEQ - 1)) == 0;
    for (int p = tid; p < 768; p += 512) {
        float cw[4][2], cb[2];
#pragma unroll
        for (int e = 0; e < 2; ++e) { cb[e] = scb[2 * p + e];
#pragma unroll
            for (int m = 0; m < 4; ++m) cw[m][e] = scw[m * 1536 + 2 * p + e]; }
        const bf16_t* src = c.proj + (size_t)r0 * LDP + C_XBC + 2 * p; bf16_t* dst = c.xbcs + (size_t)r0 * 1536 + 2 * p;
        unsigned u[35];
#pragma unroll
        for (int i = 0; i < 35; ++i) u[i] = (head && i < 3) ? 0u : *(const unsigned*)(src + (ptrdiff_t)(i - 3) * LDP);
#pragma unroll
        for (int i = 0; i < 32; ++i) {
            const float a = silu(cb[0] + cw[0][0] * bflo(u[i]) + cw[1][0] * bflo(u[i + 1]) + cw[2][0] * bflo(u[i + 2]) + cw[3][0] * bflo(u[i + 3]));
            const float b = silu(cb[1] + cw[0][1] * bfhi(u[i]) + cw[1][1] * bfhi(u[i + 1]) + cw[2][1] * bfhi(u[i + 2]) + cw[3][1] * bfhi(u[i + 3]));
            *(unsigned*)(dst + (size_t)i * 1536) = pk2(a, b); }
    }
}
DI void phase_mixer(int l, int wv) {
    const Ctx c = make_ctx(wv);
    constexpr int PER_B = 8 + 8 + 8 + 8;
    constexpr int N_LONG = NB * PER_B, N_SHORT = 8 + DEC * 3;
    constexpr int NREP = 1;
    volatile LAS int* slot = (volatile LAS int*)(c.lds + MISC_OFF + 64);
    unsigned* xpre = c.ctl + CW_XPRE + 64 * l;
    if (c.wg >= N_LONG || c.G <= N_LONG) {
        const int nfree = c.G > N_LONG ? c.G - N_LONG : c.G, first = c.G > N_LONG ? c.wg - N_LONG : c.wg; int done = 0;
        for (int it = first; it < TP / 32; it += nfree) { xbc_prepass_item(c, l, it); ++done; }
        asm volatile("s_waitcnt vmcnt(0)" ::: "memory"); __syncthreads();
        if (c.tid == 0) { __builtin_amdgcn_fence(__ATOMIC_RELEASE, "agent"); asm volatile("s_waitcnt vmcnt(0)" ::: "memory"); __hip_atomic_fetch_add(xpre, (unsigned)done, __ATOMIC_RELAXED, __HIP_MEMORY_SCOPE_AGENT); }
    }
    for (int rep = 0; rep < NREP; ++rep) {
    unsigned* ctr = c.ctl + CW_QCTR + 64 * (l * 4 + rep);
    int cur = c.wg; bool dyn = false;
    for (;;) {
        int item;
        if (!dyn) { if (cur < N_LONG) { item = cur; cur += c.G; } else { dyn = true; continue; } }
        else {
            __syncthreads();
            if (c.tid == 0) *slot = (int)atomicAdd(ctr, 1u);
            __syncthreads();
            item = N_LONG + *slot;
            if (item >= N_LONG + N_SHORT) break;
        }
        if (item < N_LONG) {
            const int b = item & 3, u = item >> 2;
            if (u < 8) la_head_unit<1>(c, l, b, u); else if (u < 16) la_head_unit<0>(c, l, b, u - 8); else if (u < 24) {
                if (c.tid == 0) { unsigned sp = 0; while (__hip_atomic_load(xpre, __ATOMIC_RELAXED, __HIP_MEMORY_SCOPE_AGENT) < (unsigned)(TP / 32)) { __builtin_amdgcn_s_sleep(8); if (++sp > (1u << 22)) break; }
                    __builtin_amdgcn_fence(__ATOMIC_ACQUIRE, "agent"); asm volatile("s_waitcnt vmcnt(0)" ::: "memory"); }
                __syncthreads();
                la_head_unit<2>(c, l, b, u - 16); } else rg_chunk_unit(c, l, b, u - 24);
            __syncthreads();
        } else { const int it = item - N_LONG;
            for (int rp = 0; rp < PROBE_REP_SHORT; ++rp) { if (it < 8) rg_sample_unit(c, l, it); else sample_item(c, l, (it - 8) / 3, (it - 8) % 3); } }
    }
    __syncthreads();
    }
}

DI void phase_finalize(int l, int wv) {
    const Ctx c = make_ctx(wv);
    const int gw = c.wg * 8 + c.wave, NGW = c.G * 8, lane = c.lane;
    const float* ssn = c.in[I_SSN] + (size_t)l * 1024;
    const float* stats = (const float*)(c.ctl + CW_STATS) + (size_t)l * TP * 6;
    const f32x4 w00 = *(const f32x4*)(ssn + lane * 16), w01 = *(const f32x4*)(ssn + lane * 16 + 4), w10 = *(const f32x4*)(ssn + lane * 16 + 8), w11 = *(const f32x4*)(ssn + lane * 16 + 12);
    for (int r0 = gw; r0 < TP; r0 += 4 * NGW) {
        u32x4 sv[4][2], gv[4][2]; float rs[4], rg[4];
#pragma unroll
        for (int i = 0; i < 4; ++i) { const int r = r0 + i * NGW;
            if (r < TP) { const bf16_t* mrow = c.mix + (size_t)r * D_MIX;
                rs[i] = stats[(size_t)r * 6 + (lane >> 5)]; rg[i] = stats[(size_t)r * 6 + 2 + (lane >> 4)];
                sv[i][0] = *(const u32x4*)(mrow + 3072 + lane * 16); sv[i][1] = *(const u32x4*)(mrow + 3072 + lane * 16 + 8);
                gv[i][0] = *(const u32x4*)(mrow + 2048 + lane * 16); gv[i][1] = *(const u32x4*)(mrow + 2048 + lane * 16 + 8); } }
#pragma unroll
        for (int i = 0; i < 4; ++i) { const int r = r0 + i * NGW;
            if (r < TP) { bf16_t* mrow = c.mix + (size_t)r * D_MIX;
                const float s = rsqrtf(rs[i] * (1.0f / 512.0f) + EPS), g = rsqrtf(rg[i] * (1.0f / 256.0f) + EPS);
#pragma unroll
                for (int q = 0; q < 2; ++q) { const u32x4 ov = sv[i][q]; const f32x4 w0 = q ? w10 : w00, w1 = q ? w11 : w01; u32x4 nv;
                    nv.x = pk2(bflo(ov.x) * s * w0.x, bfhi(ov.x) * s * w0.y); nv.y = pk2(bflo(ov.y) * s * w0.z, bfhi(ov.y) * s * w0.w);
                    nv.z = pk2(bflo(ov.z) * s * w1.x, bfhi(ov.z) * s * w1.y); nv.w = pk2(bflo(ov.w) * s * w1.z, bfhi(ov.w) * s * w1.w); *(u32x4*)(mrow + 3072 + lane * 16 + 8 * q) = nv;
                    const u32x4 gg = gv[i][q]; u32x4 ng;
                    ng.x = pk2(bflo(gg.x) * g, bfhi(gg.x) * g); ng.y = pk2(bflo(gg.y) * g, bfhi(gg.y) * g); ng.z = pk2(bflo(gg.z) * g, bfhi(gg.z) * g); ng.w = pk2(bflo(gg.w) * g, bfhi(gg.w) * g); *(u32x4*)(mrow + 2048 + lane * 16 + 8 * q) = ng; } } }
    }
    const int gt = c.wg * 512 + c.tid, NGT = c.G * 512;
    for (int i = gt; i < NB * 3 * 2560; i += NGT) {
        const int q = i / 7680, e = i % 7680, j = e / 2560, ch = e % 2560; const bool isrg = ch < 1024; const int chh = isrg ? ch : ch - 1024;
        const float v = bf1(c.proj[(size_t)(q * SEQ + SEQ - 3 + j) * LDP + (isrg ? C_RGX : C_XBC) + chh]);
        c.out[isrg ? O_RGC_P + ((size_t)l * NB + q) * 3072 + j * 1024 + chh : O_SSDC_P + ((size_t)l * NB + q) * 4608 + j * 1536 + chh] = v;
    }
    for (int i = gt; i < DEC * 1280; i += NGT) {
        const int s = i / 1280, e = i % 1280;
        if (e < 512) ((f32x4*)(c.out + O_RGC_S + ((size_t)l * DEC + s) * 3072))[e] = ((const f32x4*)(c.in[I_SRGC] + ((size_t)l * DEC + s) * 3072 + 1024))[e];
        else ((f32x4*)(c.out + O_SSDC_S + ((size_t)l * DEC + s) * 4608))[e - 512] = ((const f32x4*)(c.in[I_SSSDC] + ((size_t)l * DEC + s) * 4608 + 1536))[e - 512];
    }
    for (int i = gt; i < DEC * 2560; i += NGT) {
        const int s = i / 2560, ch = i % 2560; const bool isrg = ch < 1024; const int chh = isrg ? ch : ch - 1024;
        const float v = ps4(c.projs + (size_t)s * LDP + (isrg ? C_RGX : C_XBC) + chh) * row_rstd(c.rowsq + (size_t)l * M_PAD, TP + s);
        c.out[isrg ? O_RGC_S + ((size_t)l * DEC + s) * 3072 + 2048 + chh : O_SSDC_S + ((size_t)l * DEC + s) * 4608 + 3072 + chh] = v;
    }
}

DI void phase_dt(const Ctx& c, int l) {
    LAS float* PT = (LAS float*)c.lds;
    const int tid = get_tid(c.wave), lane = tid & 63, w = c.wave, r = lane & 31, hh = lane >> 5;
    for (int rt = c.wg; rt < TP / 32; rt += c.G) {
        const bf16_t* pa = c.xb + (size_t)(rt * 32 + r) * D_MODEL + w * 256 + 8 * hh;
        const bf16_t* pb = c.win + ((size_t)l * LDP + C_DT + r) * D_MODEL + w * 256 + 8 * hh;
        f32x16 acc; ZERO16(acc);
#pragma unroll
        for (int k4 = 0; k4 < 16; k4 += 8) { bf16x8 fa[8], fb[8];
#pragma unroll
            for (int u = 0; u < 8; ++u) { fa[u] = *(const bf16x8*)(pa + 16 * (k4 + u)); fb[u] = *(const bf16x8*)(pb + 16 * (k4 + u)); }
#pragma unroll
            for (int u = 0; u < 8; ++u) acc = mfma32(fa[u], fb[u], acc); }
        __syncthreads();
#pragma unroll
        for (int i = 0; i < 16; ++i) PT[w * 1024 + crow(i, hh) * 32 + r] = acc[i];
        __syncthreads();
        { const int row = tid >> 4, col = tid & 15; float s = 0.f;
#pragma unroll
          for (int q = 0; q < 8; ++q) s += PT[q * 1024 + row * 32 + col];
          c.dtb[(size_t)(rt * 32 + row) * 16 + col] = softplus(s * row_rstd(c.rowsq + (size_t)l * M_PAD, rt * 32 + row) + c.in[I_DTB][l * 16 + col]); }
    }
}

DI void g2_sample(const Ctx& c, int l) {
    LAS float* PT = (LAS float*)c.lds;
    const int tid = get_tid(c.wave), lane = tid & 63, w = c.wave, rr = lane & 15, quad = lane >> 4;
    float* rsq_next = c.rowsq + (size_t)(l + 1) * M_PAD;
    for (int ct = c.wg; ct < D_MODEL / 8; ct += c.G) {
        const bf16_t* pa = c.mix + (size_t)(TP + rr) * D_MIX + 512 * w + 8 * quad;
        const bf16_t* pb = c.wout + (size_t)l * D_MODEL * D_MIX + (size_t)(8 * ct + (rr & 7)) * D_MIX + 512 * w + 8 * quad;
        f32x4 acc[8];
#pragma unroll
        for (int rt = 0; rt < 8; ++rt) acc[rt] = (f32x4){0.f, 0.f, 0.f, 0.f};
#pragma unroll 1
        for (int k2 = 0; k2 < 16; k2 += 2) { bf16x8 fa[2][8], fb[2];
#pragma unroll
            for (int u = 0; u < 2; ++u) { fb[u] = *(const bf16x8*)(pb + 32 * (k2 + u));
#pragma unroll
                for (int rt = 0; rt < 8; ++rt) fa[u][rt] = *(const bf16x8*)(pa + (size_t)16 * rt * D_MIX + 32 * (k2 + u)); }
#pragma unroll
            for (int u = 0; u < 2; ++u) { const bf16x8 z = {0, 0, 0, 0, 0, 0, 0, 0}; const bf16x8 bb = rr < 8 ? fb[u] : z;
#pragma unroll
                for (int rt = 0; rt < 8; ++rt) acc[rt] = __builtin_amdgcn_mfma_f32_16x16x32_bf16(fa[u][rt], bb, acc[rt], 0, 0, 0); } }
        __syncthreads();
#pragma unroll
        for (int rt = 0; rt < 8; ++rt)
#pragma unroll
            for (int j = 0; j < 4; ++j) PT[(w * 128 + 16 * rt + 4 * quad + j) * 16 + rr] = acc[rt][j];
        __syncthreads();
        { const int row = tid >> 2, c2 = 2 * (tid & 3); float x0 = 0.f, x1 = 0.f;
#pragma unroll
          for (int q = 0; q < 8; ++q) { const f32x2 t = *(const LAS f32x2*)(PT + (q * 128 + row) * 16 + c2); x0 += t.x; x1 += t.y; }
          unsigned* xp = (unsigned*)(c.xb + (size_t)(TP + row) * D_MODEL + 8 * ct + c2); const unsigned o = *xp;
          x0 += bflo(o); x1 += bfhi(o); *xp = pk2(x0, x1);
          float ss = x0 * x0 + x1 * x1; ss += shx(ss, 1, lane); ss += shx(ss, 2, lane);
          if ((tid & 3) == 0) atomicAdd(rsq_next + TP + row, ss); }
    }
}

__global__ void __launch_bounds__(512, 2) mk_fwd(Params p) {
    extern __shared__ __attribute__((aligned(16))) unsigned char lds_raw[];
    LAS unsigned char* lds = (LAS unsigned char*)lds_raw;
    volatile LAS unsigned* misc = (volatile LAS unsigned*)(lds + MISC_OFF);
    const int wv = __builtin_amdgcn_readfirstlane(threadIdx.x >> 6);
    if (threadIdx.x < 32) misc[threadIdx.x] = 0u;
    __syncthreads();
    const int lo = p.ph_lo, hi = p.ph_hi;
    unsigned* barw = (unsigned*)(p.ws + WS_CTL) + CW_BAR;
    XcdBarrier bar; bar.bar = barw; bar.x = 0; bar.st = misc;
    if (hi - lo > 1) bar = xcd_barrier_post(barw, misc, get_tid(wv));
#define PH_IN(k) (lo <= (k) && (k) < hi)
#define SEAM(k) do { if (PH_IN(k) && PH_IN((k) + 1)) xcd_barrier(bar, wv); } while (0)
    if (PH_IN(0)) { phase_prologue(wv); }
    SEAM(0);
    for (int l = 0; l < DEPTH; ++l) {
        const int pb = 1 + 4 * l;
        if (PH_IN(pb)) {
            __syncthreads();
            const Ctx c = make_ctx(wv);
            {
                pg8::Gemm g{c.xb, c.win + (size_t)l * LDP * D_MODEL, TP, N_MAIN, D_MODEL, D_MODEL, D_MODEL}; pg8::StaticOrder S; S.init(TP, N_MAIN, c.G, c.wg); S.rep = PROBE_G1;
                pg8::EpiProj E{c.proj, c.lb + (size_t)l * 1024, c.in[I_HGN] + (size_t)l * 1024, c.in[I_GLN] + (size_t)l * 1024, c.in[I_GBU] + (size_t)l * 512, c.rowsq + (size_t)l * M_PAD};
                pg8::gemm_phase<pg8::EpiProj, pg8::StaticOrder>(c.lds, g, S, E, wv); }
            __syncthreads();
            {
                const int pn = c.wg % 49, ks = c.wg / 49;
                pg8::Gemm g{c.xb + (size_t)TP * D_MODEL + ks * 512, c.win + (size_t)l * LDP * D_MODEL + ks * 512, 256, LDP, 512, D_MODEL, D_MODEL};
                pg8::OneUnit S{0, pn, c.wg < 196 ? 1 : 0};
                pg8::EpiSample E{c.projs + (size_t)ks * PST};
                pg8::gemm_phase<pg8::EpiSample, pg8::OneUnit>(c.lds, g, S, E, wv); }
            __syncthreads();
            phase_dt(c, l);
            __syncthreads();
        }
        SEAM(pb);
        if (PH_IN(pb + 1)) phase_mixer(l, wv);
        SEAM(pb + 1);
        if (PH_IN(pb + 2)) phase_finalize(l, wv);
        SEAM(pb + 2);
        if (PH_IN(pb + 3)) {
            __syncthreads();
            const Ctx c = make_ctx(wv);
            {
                pg8::Gemm g{c.mix, c.wout + (size_t)l * D_MODEL * D_MIX, TP, D_MODEL, D_MIX, D_MIX, D_MIX}; pg8::StaticOrder S; S.init(TP, D_MODEL, c.G, c.wg);
                pg8::EpiResid E{c.xb, c.rowsq + (size_t)(l + 1) * M_PAD};
                pg8::gemm_phase<pg8::EpiResid, pg8::StaticOrder>(c.lds, g, S, E, wv); }
            __syncthreads();
            g2_sample(c, l);
            __syncthreads();
        }
        SEAM(pb + 3);
    }
    if (PH_IN(NPHASE - 1)) phase_final_norm(wv);
#undef PH_IN
#undef SEAM
}

extern "C" void kernel_launch(void* const* d_in, const int* in_sizes, int n_in, void* d_out, int out_size, void* d_ws, size_t ws_size, hipStream_t stream) {
    static int grid = 0;
    if (grid == 0) {
        if (n_in != N_INPUTS || (size_t)out_size != O_END || ws_size < WS_END) { fprintf(stderr, "kernel_launch: unexpected shapes (n_in %d out %d ws %zu)\n", n_in, out_size, ws_size); grid = -1; return; }
        int dev = 0, cus = 0;
        if (hipGetDevice(&dev) != hipSuccess || hipDeviceGetAttribute(&cus, hipDeviceAttributeMultiprocessorCount, dev) != hipSuccess) { grid = -1; return; }
        if (hipFuncSetAttribute((const void*)mk_fwd, hipFuncAttributeMaxDynamicSharedMemorySize, LDS_BYTES) != hipSuccess) { fprintf(stderr, "kernel_launch: hipFuncSetAttribute failed\n"); grid = -1; return; }
        int per_cu = 0;
        if (hipOccupancyMaxActiveBlocksPerMultiprocessor(&per_cu, (const void*)mk_fwd, 512, LDS_BYTES) != hipSuccess || per_cu < 1) fprintf(stderr, "kernel_launch: occupancy query says %d\n", per_cu);
        (void)hipGetLastError();
        grid = cus;
    }
    if (grid < 0) return;
    (void)hipMemsetAsync((char*)d_ws + WS_CTL, 0, CTL_ZERO_BYTES, stream);
    Params p{};
    for (int i = 0; i < N_INPUTS; ++i) p.in[i] = (const float*)d_in[i];
    p.out = (float*)d_out; p.ws = (unsigned char*)d_ws;
#if MK_ONE_LAUNCH
    p.ph_lo = 0; p.ph_hi = NPHASE;
    hipLaunchKernelGGL(mk_fwd, dim3(grid), dim3(512), LDS_BYTES, stream, p);
#else
    for (int ph = 0; ph < NPHASE; ++ph) { p.ph_lo = ph; p.ph_hi = ph + 1; hipLaunchKernelGGL(mk_fwd, dim3(grid), dim3(512), LDS_BYTES, stream, p); }
#endif
}
```

```cpp
#include <hip/hip_runtime.h>
#include <cstdio>
#include <cstdint>

#ifndef MK_ONE_LAUNCH
#define MK_ONE_LAUNCH 1
#endif

#ifndef PROBE_LONG_REP
#define PROBE_LONG_REP 1
#endif
#ifndef PROBE_RG_REP
#define PROBE_RG_REP PROBE_LONG_REP
#endif
#ifndef PROBE_G1_NOEPI
#define PROBE_G1_NOEPI 0
#endif
#ifndef PROBE_G2
#define PROBE_G2 0
#endif
#ifndef PROBE_G1
#define PROBE_G1 1
#endif
#define LAS __attribute__((address_space(3)))
#define DI __device__ __forceinline__

constexpr int D_MODEL = 2048, NB = 4, SEQ = 2048, DEPTH = 4, DEC = 128;
constexpr int BRANCH = 1024, D_MIX = 4096;
constexpr int TP = NB * SEQ;
constexpr int TT = TP + DEC;
constexpr int M_PAD = 8448;
constexpr int N_IN = 11808;
constexpr int LDP = 12544;
constexpr int N_MAIN = 12288;
constexpr int PST = 128 * LDP;
constexpr float EPS = 1e-6f, TINY = 1e-30f;
constexpr int C_HGQ = 0, C_HGF = 1024, C_HGI = 2048, C_HGG = 3072, C_RGX = 4096, C_RGG = 5120, C_GLQ = 6144, C_GLK = 6656, C_GLV = 7168, C_GLG = 8192,
              C_GLF = 9216, C_SSZ = 9728, C_XBC = 10752, C_DT = 12288;
constexpr int SRC_GLA = 9216, SRC_SSZ = 9232, SRC_DT = 11792;
enum { I_XP = 0, I_XS, I_SHG, I_SRG, I_SRGC, I_SGLA, I_SSSD, I_SSSDC, I_RMS, I_WIN, I_LB, I_HGN, I_RCW, I_RCB, I_WR, I_BR, I_WI, I_BI, I_LAM,
       I_GWU, I_GBU, I_GLN, I_SCW, I_SCB, I_DTB, I_ALOG, I_SD, I_SSN, I_WOUT, I_RMSF, N_INPUTS };
constexpr size_t O_YP = 0, O_YS = (size_t)TP * D_MODEL, O_HG_P = O_YS + (size_t)DEC * D_MODEL,
    O_RG_P = O_HG_P + (size_t)DEPTH * NB * 131072, O_RGC_P = O_RG_P + (size_t)DEPTH * NB * 1024, O_GLA_P = O_RGC_P + (size_t)DEPTH * NB * 3072,
    O_SSD_P = O_GLA_P + (size_t)DEPTH * NB * 131072, O_SSDC_P = O_SSD_P + (size_t)DEPTH * NB * 131072, O_HG_S = O_SSDC_P + (size_t)DEPTH * NB * 4608,
    O_RG_S = O_HG_S + (size_t)DEPTH * DEC * 131072, O_RGC_S = O_RG_S + (size_t)DEPTH * DEC * 1024, O_GLA_S = O_RGC_S + (size_t)DEPTH * DEC * 3072,
    O_SSD_S = O_GLA_S + (size_t)DEPTH * DEC * 131072, O_SSDC_S = O_SSD_S + (size_t)DEPTH * DEC * 131072, O_END = O_SSDC_S + (size_t)DEPTH * DEC * 4608;
constexpr size_t MiB = 1u << 20;
constexpr size_t WS_CTL = 0, CTL_ZERO_BYTES = 2 * MiB, WS_LB = 2 * MiB, WS_WIN = 3 * MiB, WS_WOUT = 199 * MiB, WS_XB = 263 * MiB, WS_PROJ = 296 * MiB,
    WS_DTB = 492 * MiB, WS_MIX = 493 * MiB, WS_PROJS = 559 * MiB, WS_XBCS = 584 * MiB, WS_END = 608 * MiB;
static_assert(WS_WIN + (size_t)DEPTH * LDP * D_MODEL * 2 <= WS_WOUT && WS_WOUT + (size_t)DEPTH * D_MODEL * D_MIX * 2 <= WS_XB && WS_XB + (size_t)M_PAD * D_MODEL * 2 <= WS_PROJ &&
              WS_PROJ + (size_t)TP * LDP * 2 <= WS_DTB && WS_DTB + (size_t)TP * 16 * 4 <= WS_MIX &&
              WS_MIX + (size_t)M_PAD * D_MIX * 2 <= WS_PROJS && WS_PROJS + (size_t)4 * DEC * LDP * 4 <= WS_XBCS && WS_XBCS + (size_t)TP * 1536 * 2 <= WS_END, "ws map");
constexpr int CW_BAR = 4096, CW_QCTR = 16384, CW_XPRE = 24576  , CW_STATS = 32768, CW_ROWSQ = 262144;
static_assert(CW_STATS + DEPTH * TP * 6 <= CW_ROWSQ && (size_t)(CW_ROWSQ + (DEPTH + 1) * M_PAD) * 4 <= CTL_ZERO_BYTES, "ctl map");
constexpr int LDS_BYTES = 147456, MISC_OFF = LDS_BYTES - 256;
constexpr int NPHASE = 2 + 4 * DEPTH;

typedef unsigned short bf16_t;
typedef short bf16x8 __attribute__((ext_vector_type(8)));
typedef float f32x4 __attribute__((ext_vector_type(4)));
typedef float f32x2 __attribute__((ext_vector_type(2)));
typedef float f32x16 __attribute__((ext_vector_type(16)));
typedef unsigned u32x4 __attribute__((ext_vector_type(4)));
typedef unsigned u32x2 __attribute__((ext_vector_type(2)));
typedef __bf16 bf16v2 __attribute__((ext_vector_type(2)));

DI unsigned pk2(float lo, float hi) { const f32x2 v = {lo, hi}; return __builtin_bit_cast(unsigned, __builtin_convertvector(v, bf16v2)); }
DI unsigned f2bf(float f) { return pk2(f, 0.f) & 0xffffu; }
DI float bflo(unsigned u) { return __builtin_bit_cast(float, u << 16); }
DI float bfhi(unsigned u) { return __builtin_bit_cast(float, u & 0xffff0000u); }
DI float bf1(bf16_t u) { return __builtin_bit_cast(float, (unsigned)u << 16); }
DI float ex2(float x) { return __builtin_amdgcn_exp2f(x); }
DI float lg2(float x) { return __builtin_amdgcn_logf(x); }
DI float rcp(float x) { return __builtin_amdgcn_rcpf(x); }
constexpr float LOG2E = 1.4426950408889634f, LN2 = 0.6931471805599453f;
DI float fexp(float x) { return ex2(x * LOG2E); }
DI float flog(float x) { return lg2(x) * LN2; }
DI float sigm(float x) { return rcp(1.0f + fexp(-x)); }
DI float silu(float x) { return x * sigm(x); }
DI float sigm_fast(float x) { return sigm(x); }
DI float silu_fast(float x) { return silu(x); }
DI float log1p_pos(float e) { const float a = e * (1.0f - e * (0.5f - e * (0.33333334f - 0.25f * e))), b = flog(1.0f + e); return e < 0.03f ? a : b; }
DI float softplus(float x) { return fmaxf(x, 0.f) + log1p_pos(fexp(-fabsf(x))); }
DI float neg_expm1(float x) { const float a = -x * (1.0f + 0.5f * x * (1.0f + 0.33333334f * x * (1.0f + 0.25f * x * (1.0f + 0.2f * x)))), b = 1.0f - fexp(x); return fabsf(x) < 0.25f ? a : b; }
DI float row_rstd(const float* rowsq, int row) { return __builtin_amdgcn_rsqf(rowsq[row] * (1.0f / D_MODEL) + EPS); }
DI float clampf(float x, float lo, float hi) { return fminf(fmaxf(x, lo), hi); }
DI float shx(float v, int mask, int lane) { return __builtin_bit_cast(float, __builtin_amdgcn_ds_bpermute((lane ^ mask) << 2, __builtin_bit_cast(int, v))); }
DI float shup(float v, int o, int lane) { return __builtin_bit_cast(float, __builtin_amdgcn_ds_bpermute((lane >= o ? lane - o : lane) << 2, __builtin_bit_cast(int, v))); }
DI float wave_sum(float v, int lane) {
#pragma unroll
    for (int o = 1; o < 64; o <<= 1) v += shx(v, o, lane);
    return v;
}

struct Params { const float* in[N_INPUTS]; float* out; unsigned char* ws; int ph_lo, ph_hi; };
static_assert(sizeof(Params) == N_INPUTS * 8 + 8 + 8 + 8, "no padding holes in Params");
typedef const __attribute__((address_space(4))) Params* KP;
DI KP get_params() { auto kp = __builtin_amdgcn_kernarg_segment_ptr(); asm volatile("" : "+s"(kp)); return (KP)kp; }
DI int get_tid(int wv) { int ln; asm volatile("v_mbcnt_lo_u32_b32 %0, -1, 0\n\tv_mbcnt_hi_u32_b32 %0, -1, %0" : "=v"(ln)); return (wv << 6) | ln; }

#define XB_TMO      128
#define XB_XCNT(j)  (256  + 64 * (j))
#define XB_XSUB(j)  (1280 + 64 * (j))
#define XB_XGEN(j)  (2304 + 64 * (j))
#define XB_TOP      3328
#define XB_TOPGEN   3392
#define XCD_BAR_WORDS 3456
#define XB_SPIN_CAP (1u << 20)
DI unsigned xb_ld(unsigned* p)              { return __hip_atomic_load(p, __ATOMIC_RELAXED, __HIP_MEMORY_SCOPE_AGENT); }
DI unsigned xb_add(unsigned* p, unsigned v) { return __hip_atomic_fetch_add(p, v, __ATOMIC_RELAXED, __HIP_MEMORY_SCOPE_AGENT); }
DI unsigned xb_xcc_id() { return (unsigned)__builtin_amdgcn_s_getreg((3 << 11) | 20) & 0xFu; }
#define XB_SPIN(cond, bar) do { unsigned _sp = 0; while (cond) { __builtin_amdgcn_s_sleep(1); \
    if ((++_sp & 255u) == 0u) { if (xb_ld(&(bar)[XB_TMO])) break; if (_sp > XB_SPIN_CAP) { atomicAdd(&(bar)[XB_TMO], 1u); break; } } } } while (0)
struct XcdBarrier { unsigned* bar; unsigned x; volatile LAS unsigned* st; };
DI XcdBarrier xcd_barrier_post(unsigned* bar, volatile LAS unsigned* st, int tid) {
    XcdBarrier b; b.bar = bar; b.x = xb_xcc_id(); b.st = st;
    if (tid == 0) (void)xb_add(&bar[XB_XCNT(b.x)], 1u);
    return b;
}
DI void xcd_barrier_complete(unsigned* bar, unsigned x, unsigned& nloc, unsigned& nx) {
    const unsigned G = gridDim.x * gridDim.y * gridDim.z;
    unsigned sum, cnt, mine, sp = 0u;
    for (;;) {
        sum = 0u; cnt = 0u; mine = 0u;
#pragma unroll
        for (unsigned j = 0; j < 16; ++j) { const unsigned c = xb_ld(&bar[XB_XCNT(j)]); sum += c; cnt += (c > 0u) ? 1u : 0u; mine = (j == x) ? c : mine; }
        if (sum == G) break;
        __builtin_amdgcn_s_sleep(1);
        if ((++sp & 255u) == 0u) { if (xb_ld(&bar[XB_TMO])) break; if (sp > XB_SPIN_CAP) { atomicAdd(&bar[XB_TMO], 1u); break; } }
    }
    nloc = mine > 0u ? mine : 1u; nx = cnt > 0u ? cnt : 1u;
}
DI void xcd_barrier(const XcdBarrier& b, int wv) {
    asm volatile("s_waitcnt vmcnt(0)" ::: "memory");
    __syncthreads();
    if (get_tid(wv) == 0) {
        unsigned* bar = b.bar;
        __builtin_amdgcn_s_waitcnt(0);
        unsigned nloc = b.st[0], nx = b.st[1];
        if (nloc == 0u) { xcd_barrier_complete(bar, b.x, nloc, nx); b.st[0] = nloc; b.st[1] = nx; }
        const unsigned old = xb_add(&bar[XB_XSUB(b.x)], 1u);
        const unsigned gen = old / nloc;
        if (old + 1u == (gen + 1u) * nloc) {
            __builtin_amdgcn_fence(__ATOMIC_RELEASE, "agent");
            asm volatile("s_waitcnt vmcnt(0)" ::: "memory");
            const unsigned og = xb_add(&bar[XB_TOP], 1u);
            const unsigned tg = og / nx;
            if (og + 1u == (tg + 1u) * nx) xb_add(&bar[XB_TOPGEN], 1u);
            else XB_SPIN(xb_ld(&bar[XB_TOPGEN]) == tg, bar);
            __builtin_amdgcn_fence(__ATOMIC_ACQUIRE, "agent");
            xb_add(&bar[XB_XGEN(b.x)], 1u);
            asm volatile("s_waitcnt vmcnt(0)" ::: "memory");
        } else {
            XB_SPIN(xb_ld(&bar[XB_XGEN(b.x)]) == gen, bar);
            __builtin_amdgcn_fence(__ATOMIC_ACQUIRE, "agent");
            asm volatile("s_waitcnt vmcnt(0)" ::: "memory");
        }
    }
    __syncthreads();
}

namespace pg8 {
constexpr int BM = 256, BK = 64, HALF = 128, HTB = HALF * BK * 2, STAGE_BYTES = 8 * HTB, NXCD = 8, WGM = 8;
DI int lds_byte(int r, int c) { const int st = (r >> 4) * 2 + (c >> 5), rr = r & 15, cc = c & 31, ob = rr * 64 + cc * 2; return st * 1024 + (ob ^ (((ob >> 9) & 1) << 5)); }
DI void stage_rc(int b, int& R, int& C) { const int st = b / 1024, sb = b % 1024, swz = sb ^ (((sb >> 9) & 1) << 5); R = (st >> 1) * 16 + swz / 64; C = (st & 1) * 32 + (swz % 64) / 2; }
DI int perm32(int rho) { const int n = rho >> 4, i = rho & 15; return 8 * (i >> 2) + 4 * n + (i & 3); }
struct Unit { int pm, pn; };
struct Gemm { const bf16_t* A; const bf16_t* Bt; int M, N, K, lda, ldb; };
struct StaticOrder {
    int nM, nN, nwg, G, c, rep = 1;
    DI void init(int M, int N, int G_, int c_) { nM = M / BM; nN = N / BM; nwg = nM * nN; G = G_; c = c_; }
    DI bool next(int i, Unit& u) const {
        const long L = (long)(i / rep) * G + c; if (L >= nwg) return false;
        int wgid = (int)L; { const int q = nwg / NXCD, r = nwg % NXCD, xcd = wgid % NXCD, off = wgid / NXCD; wgid = (xcd < r ? xcd * (q + 1) : r * (q + 1) + (xcd - r) * q) + off; }
        const int nig = WGM * nN, gid = wgid / nig, fm = gid * WGM, gsz = (nM - fm) < WGM ? (nM - fm) : WGM;
        u.pm = fm + ((wgid % nig) % gsz); u.pn = (wgid % nig) / gsz; return true;
    }
    DI void a_ready(const Unit&) const {}
    DI void done(const Unit&) const {}
};
struct EpiProj {
    static constexpr bool PERM = true, TWICE = PROBE_G1_NOEPI != 0;
    bf16_t* P; const float* lb; const float* hgn; const float* gln; const float* bup; const float* rsq;
    template <int MODE>
    DI void body(const f32x4 (&acc)[2][2][4][2], bf16_t* prow, const float* vec, float scale, const float (&rs)[2][4]) const {
        f32x4 cv[2][2];
#pragma unroll
        for (int bj = 0; bj < 2; ++bj) { cv[bj][0] = (f32x4){1.f, 1.f, 1.f, 1.f}; cv[bj][1] = cv[bj][0];
            if constexpr (MODE >= 2) { cv[bj][0] = *(const f32x4*)(vec + bj * HALF); cv[bj][1] = *(const f32x4*)(vec + bj * HALF + 4); } }
#pragma unroll
        for (int bj = 0; bj < 2; ++bj) {
            const f32x4 c0 = cv[bj][0], c1 = cv[bj][1];
#pragma unroll
            for (int ai = 0; ai < 2; ++ai)
#pragma unroll
                for (int m = 0; m < 4; ++m) {
                    f32x4 a = acc[ai][bj][m][0] * rs[ai][m], b = acc[ai][bj][m][1] * rs[ai][m];
                    if constexpr (MODE == 0) { a = a * scale; b = b * scale; }
                    else if constexpr (MODE == 1) { a = (f32x4){silu(a.x), silu(a.y), silu(a.z), silu(a.w)}; b = (f32x4){silu(b.x), silu(b.y), silu(b.z), silu(b.w)}; }
                    else if constexpr (MODE == 2) { a = (f32x4){silu(a.x), silu(a.y), silu(a.z), silu(a.w)} * c0; b = (f32x4){silu(b.x), silu(b.y), silu(b.z), silu(b.w)} * c1; }
                    else if constexpr (MODE == 3) {
#define LOGF(x, l) flog(fmaxf((l) + (1.0f - (l)) * sigm(x), TINY))
                        a = (f32x4){LOGF(a.x, c0.x), LOGF(a.y, c0.y), LOGF(a.z, c0.z), LOGF(a.w, c0.w)}; b = (f32x4){LOGF(b.x, c1.x), LOGF(b.y, c1.y), LOGF(b.z, c1.z), LOGF(b.w, c1.w)};
#undef LOGF
                    } else {
#define LSIG(x, bb) (-0.0625f * (fmaxf(-((x) + (bb)), 0.f) + flog(1.0f + fexp(-fabsf((x) + (bb))))))
                        a = (f32x4){LSIG(a.x, c0.x), LSIG(a.y, c0.y), LSIG(a.z, c0.z), LSIG(a.w, c0.w)}; b = (f32x4){LSIG(b.x, c1.x), LSIG(b.y, c1.y), LSIG(b.z, c1.z), LSIG(b.w, c1.w)};
#undef LSIG
                    }
                    u32x4 w4; w4.x = pk2(a.x, a.y); w4.y = pk2(a.z, a.w); w4.z = pk2(b.x, b.y); w4.w = pk2(b.z, b.w);
                    *(u32x4*)(prow + (size_t)(ai * HALF + m * 16) * LDP + bj * HALF) = w4;
                }
        }
    }
    DI void operator()(const f32x4 (&acc)[2][2][4][2], const Unit& u, int wr, int wc, int fr, int fq) const {
        const int col = u.pn * BM + wc * 32 + 8 * fq;
        bf16_t* prow = P + (size_t)(u.pm * BM + wr * 64 + fr) * LDP + col;
        float rs[2][4];
#pragma unroll
        for (int ai = 0; ai < 2; ++ai)
#pragma unroll
            for (int m = 0; m < 4; ++m) rs[ai][m] = rsq[u.pm * BM + wr * 64 + fr + ai * HALF + m * 16];
#pragma unroll
        for (int ai = 0; ai < 2; ++ai)
#pragma unroll
            for (int m = 0; m < 4; ++m) rs[ai][m] = __builtin_amdgcn_rsqf(rs[ai][m] * (1.0f / D_MODEL) + EPS);
        const int pn = u.pn;
        if (pn < 4) body<1>(acc, prow, nullptr, 1.f, rs);
        else if (pn < 8) body<3>(acc, prow, lb + (col - C_HGF), 1.f, rs);
        else if (pn < 12) body<0>(acc, prow, nullptr, 1.f, rs);
        else if (pn < 16) body<2>(acc, prow, hgn + (col - C_HGG), 1.f, rs);
        else if (pn < 20) body<0>(acc, prow, nullptr, 1.f, rs);
        else if (pn < 24) body<1>(acc, prow, nullptr, 1.f, rs);
        else if (pn < 26) body<0>(acc, prow, nullptr, 0.08838834764831845f, rs);
        else if (pn < 32) body<0>(acc, prow, nullptr, 1.f, rs);
        else if (pn < 36) body<2>(acc, prow, gln + (col - C_GLG), 1.f, rs);
        else if (pn < 38) body<4>(acc, prow, bup + (col - C_GLF), 1.f, rs);
        else if (pn < 42) body<1>(acc, prow, nullptr, 1.f, rs);
        else body<0>(acc, prow, nullptr, 1.f, rs);
    }
};
struct EpiSample {
    static constexpr bool PERM = false, TWICE = false;
    float* PS;
    DI void operator()(const f32x4 (&acc)[2][2][4][2], const Unit& u, int wr, int wc, int fr, int fq) const {
        const int row0 = wr * 64 + fr, col0 = u.pn * BM + wc * 32 + 4 * fq;
#pragma unroll
        for (int m = 0; m < 4; ++m) { float* op = PS + (size_t)(row0 + m * 16) * LDP + col0;
#pragma unroll
            for (int bj = 0; bj < 2; ++bj)
#pragma unroll
                for (int n = 0; n < 2; ++n) *(f32x4*)(op + bj * HALF + n * 16) = acc[0][bj][m][n]; }
    }
};
struct EpiResid {
    static constexpr bool PERM = true, TWICE = false;
    bf16_t* xb; float* rsq_next;
    DI void operator()(const f32x4 (&acc)[2][2][4][2], const Unit& u, int wr, int wc, int fr, int fq) const {
        const int row0 = u.pm * BM + wr * 64 + fr, col0 = u.pn * BM + wc * 32 + 8 * fq;
#pragma unroll
        for (int ai = 0; ai < 2; ++ai) {
            u32x4 ob[4][2];
#pragma unroll
            for (int m = 0; m < 4; ++m)
#pragma unroll
                for (int bj = 0; bj < 2; ++bj) ob[m][bj] = *(const u32x4*)(xb + (size_t)(row0 + ai * HALF + m * 16) * D_MODEL + col0 + bj * HALF);
#pragma unroll
            for (int m = 0; m < 4; ++m) { const int row = row0 + ai * HALF + m * 16; bf16_t* xp = xb + (size_t)row * D_MODEL + col0; float ss = 0.f;
#pragma unroll
                for (int bj = 0; bj < 2; ++bj) { const u32x4 o = ob[m][bj]; const f32x4 a = acc[ai][bj][m][0], b = acc[ai][bj][m][1];
                    const float x0 = bflo(o.x) + a.x, x1 = bfhi(o.x) + a.y, x2 = bflo(o.y) + a.z, x3 = bfhi(o.y) + a.w, x4 = bflo(o.z) + b.x, x5 = bfhi(o.z) + b.y, x6 = bflo(o.w) + b.z, x7 = bfhi(o.w) + b.w;
                    ss += ((x0 * x0 + x1 * x1) + (x2 * x2 + x3 * x3)) + ((x4 * x4 + x5 * x5) + (x6 * x6 + x7 * x7));
                    u32x4 n4; n4.x = pk2(x0, x1); n4.y = pk2(x2, x3); n4.z = pk2(x4, x5); n4.w = pk2(x6, x7); *(u32x4*)(xp + bj * HALF) = n4; }
                const int lane = fq * 16 + fr; ss += shx(ss, 16, lane); ss += shx(ss, 32, lane);
                if (fq == 0) atomicAdd(rsq_next + row, ss); }
        }
    }
};
struct OneUnit {
    int pm, pn, have;
    DI bool next(int i, Unit& u) const { if (i != 0 || !have) return false; u.pm = pm; u.pn = pn; return true; }
    DI void a_ready(const Unit&) const {}
    DI void done(const Unit&) const {}
};
template <class Epi, class Sched>
DI void gemm_phase(LAS unsigned char* lds, const Gemm g, const Sched& S, const Epi& E, int wv) {
    const int tid = get_tid(wv), wid = wv, lane = tid & 63, wr = wid >> 2, wc = wid & 3, fr = lane & 15, fq = lane >> 4;
    const int K = g.K, nt = K / BK;
    unsigned voffA[2], voffB[2];
#pragma unroll
    for (int i = 0; i < 2; ++i) { int R, C; stage_rc(tid * 16 + i * 8192, R, C); const int Rb = Epi::PERM ? ((R & ~31) + perm32(R & 31)) : R;
        voffA[i] = (unsigned)(R * g.lda + C) * 2u; voffB[i] = (unsigned)(Rb * g.ldb + C) * 2u; }
    const size_t kstep = (size_t)(BK * 2);
    const size_t hstepA = (size_t)HALF * g.lda * 2, hstepB = (size_t)HALF * g.ldb * 2;
    const size_t tstepA = 2 * hstepA, tstepB = 2 * hstepB;
    const unsigned ldsw = (unsigned)wid * 1024u;
    const int aoff = lds_byte(wr * 64 + fr, fq * 8), boff = lds_byte(wc * 32 + fr, fq * 8);
#define PG8_SA(b, h) (((b) * 2 + (h)) * HTB)
#define PG8_SB(b, h) ((4 + (b) * 2 + (h)) * HTB)
#define PG8_STAGE(bufoff, gbase, voff) do { _Pragma("unroll") for (int _i = 0; _i < 2; ++_i) \
        __builtin_amdgcn_global_load_lds((const unsigned*)((const char*)(gbase) + (voff)[_i]), (LAS unsigned*)(lds + (bufoff) + ldsw + _i * 8192), 16, 0, 0); } while (0)
#define PG8_LDA(dst, b, h) do { _Pragma("unroll") for (int m = 0; m < 4; ++m) _Pragma("unroll") for (int k = 0; k < 2; ++k) dst[m][k] = *(const LAS bf16x8*)(lds + PG8_SA(b, h) + aoff + m * 2048 + k * 1024); } while (0)
#define PG8_LDB(dst, b, h) do { _Pragma("unroll") for (int n = 0; n < 2; ++n) _Pragma("unroll") for (int k = 0; k < 2; ++k) dst[n][k] = *(const LAS bf16x8*)(lds + PG8_SB(b, h) + boff + n * 2048 + k * 1024); } while (0)
#define PG8_MMA(ai, bj, At, Bt) do { __builtin_amdgcn_s_setprio(1); _Pragma("unroll") for (int m = 0; m < 4; ++m) _Pragma("unroll") for (int n = 0; n < 2; ++n) _Pragma("unroll") for (int k = 0; k < 2; ++k) \
        acc[ai][bj][m][n] = __builtin_amdgcn_mfma_f32_16x16x32_bf16(Bt[n][k], At[m][k], acc[ai][bj][m][n], 0, 0, 0); __builtin_amdgcn_s_setprio(0); } while (0)
#define PG8_WAIT_V(n) asm volatile("s_waitcnt vmcnt(" #n ")" ::: "memory")
#define PG8_WAIT_L(n) asm volatile("s_waitcnt lgkmcnt(" #n ")" ::: "memory")
#define PG8_BAR __builtin_amdgcn_s_barrier()
#define PG8_SCHED __builtin_amdgcn_sched_barrier(0)
    Unit cur, nxt; int ui = 0;
    if (!S.next(0, cur)) return;
    f32x4 acc[2][2][4][2];
#pragma unroll
    for (int a = 0; a < 2; ++a)
#pragma unroll
        for (int b = 0; b < 2; ++b)
#pragma unroll
            for (int m = 0; m < 4; ++m)
#pragma unroll
                for (int n = 0; n < 2; ++n) acc[a][b][m][n] = (f32x4){0.f, 0.f, 0.f, 0.f};
    bf16x8 At[4][2], B0[2][2], B1[2][2];
    const char* cA = (const char*)g.A + (size_t)cur.pm * tstepA; const char* cB = (const char*)g.Bt + (size_t)cur.pn * tstepB;
    S.a_ready(cur);
    PG8_STAGE(PG8_SB(0, 0), cB, voffB); PG8_STAGE(PG8_SA(0, 0), cA, voffA); PG8_STAGE(PG8_SB(0, 1), cB + hstepB, voffB); PG8_STAGE(PG8_SA(0, 1), cA + hstepA, voffA);
    if (wr == 1) PG8_BAR;
    PG8_WAIT_V(4); PG8_BAR;
    PG8_STAGE(PG8_SB(1, 0), cB + kstep, voffB); PG8_STAGE(PG8_SA(1, 0), cA + kstep, voffA); PG8_STAGE(PG8_SB(1, 1), cB + hstepB + kstep, voffB);
    PG8_WAIT_V(6); PG8_BAR;
    for (;;) {
        const bool has_next = S.next(ui + 1, nxt);
        const char* nA = has_next ? (const char*)g.A + (size_t)nxt.pm * tstepA : cA; const char* nB = has_next ? (const char*)g.Bt + (size_t)nxt.pn * tstepB : cB;
        for (int t = 0; t < nt; t += 2) {
            const bool last = (t == nt - 2);
            const char* a1 = cA + (size_t)(t + 1) * kstep;
            const char* a2 = last ? nA : cA + (size_t)(t + 2) * kstep; const char* b2 = last ? nB : cB + (size_t)(t + 2) * kstep;
            const char* a3 = a2 + kstep; const char* b3 = b2 + kstep;
            if (last && has_next) S.a_ready(nxt);
            PG8_LDB(B0, 0, 0); PG8_SCHED; PG8_LDA(At, 0, 0); PG8_STAGE(PG8_SA(1, 1), a1 + hstepA, voffA);
            PG8_WAIT_L(8); PG8_BAR; PG8_WAIT_L(0); PG8_MMA(0, 0, At, B0); PG8_BAR; PG8_SCHED;
            PG8_LDB(B1, 0, 1); PG8_STAGE(PG8_SB(0, 0), b2, voffB);
            PG8_BAR; PG8_WAIT_L(0); PG8_MMA(0, 1, At, B1); PG8_BAR;
            PG8_LDA(At, 0, 1); PG8_STAGE(PG8_SA(0, 0), a2, voffA);
            PG8_BAR; PG8_WAIT_L(0); PG8_MMA(1, 0, At, B0); PG8_BAR; PG8_SCHED;
            PG8_STAGE(PG8_SB(0, 1), b2 + hstepB, voffB);
            PG8_WAIT_V(6); PG8_BAR; PG8_MMA(1, 1, At, B1); PG8_BAR;
            PG8_LDB(B0, 1, 0); PG8_SCHED; PG8_LDA(At, 1, 0); PG8_STAGE(PG8_SA(0, 1), a2 + hstepA, voffA);
            PG8_WAIT_L(8); PG8_BAR; PG8_WAIT_L(0); PG8_MMA(0, 0, At, B0); PG8_BAR; PG8_SCHED;
            PG8_LDB(B1, 1, 1); PG8_STAGE(PG8_SB(1, 0), b3, voffB);
            PG8_BAR; PG8_WAIT_L(0); PG8_MMA(0, 1, At, B1); PG8_BAR;
            PG8_LDA(At, 1, 1); PG8_STAGE(PG8_SA(1, 0), a3, voffA);
            PG8_BAR; PG8_WAIT_L(0); PG8_MMA(1, 0, At, B0); PG8_BAR; PG8_SCHED;
            PG8_STAGE(PG8_SB(1, 1), b3 + hstepB, voffB);
            PG8_WAIT_V(6); PG8_BAR; PG8_MMA(1, 1, At, B1); PG8_BAR;
        }
        E(acc, cur, wr, wc, fr, fq);
        if constexpr (Epi::TWICE) {
#pragma unroll
            for (int a = 0; a < 2; ++a)
#pragma unroll
                for (int b = 0; b < 2; ++b) asm volatile("" : "+v"(acc[a][b][0][0]), "+v"(acc[a][b][0][1]), "+v"(acc[a][b][1][0]), "+v"(acc[a][b][1][1]), "+v"(acc[a][b][2][0]), "+v"(acc[a][b][2][1]), "+v"(acc[a][b][3][0]), "+v"(acc[a][b][3][1]) :: "memory");
            E(acc, cur, wr, wc, fr, fq); }
        S.done(cur);
        if (!has_next) break;
#pragma unroll
        for (int a = 0; a < 2; ++a)
#pragma unroll
            for (int b = 0; b < 2; ++b)
#pragma unroll
                for (int m = 0; m < 4; ++m)
#pragma unroll
                    for (int n = 0; n < 2; ++n) acc[a][b][m][n] = (f32x4){0.f, 0.f, 0.f, 0.f};
        cur = nxt; cA = nA; cB = nB; ++ui;
    }
    PG8_WAIT_V(0);
    if (wr == 0) PG8_BAR;
    PG8_BAR;
#undef PG8_SA
#undef PG8_SB
#undef PG8_STAGE
#undef PG8_LDA
#undef PG8_LDB
#undef PG8_MMA
#undef PG8_WAIT_V
#undef PG8_WAIT_L
#undef PG8_BAR
#undef PG8_SCHED
}
}

struct Ctx {
    KP kp; const float* const __attribute__((address_space(4)))* in; float* out; unsigned char* ws;
    LAS unsigned char* lds;
    int tid, lane, wave, G, wg;
    float* lb; bf16_t* win; bf16_t* wout; bf16_t* xb; bf16_t* proj; float* projs; float* dtb; bf16_t* mix; bf16_t* xbcs; float* rowsq; unsigned* ctl;
};
DI Ctx make_ctx(int wv) {
    extern __shared__ __attribute__((aligned(16))) unsigned char lds_raw[];
    Ctx c; c.kp = get_params(); c.in = c.kp->in; c.out = c.kp->out; c.ws = c.kp->ws;
    c.lds = (LAS unsigned char*)lds_raw;
    asm volatile("" : "+s"(wv));
    int wg = blockIdx.x; asm volatile("" : "+s"(wg));
    c.tid = get_tid(wv); c.lane = c.tid & 63; c.wave = wv; c.G = gridDim.x; c.wg = wg;
    unsigned char* ws = c.ws;
    c.ctl = (unsigned*)(ws + WS_CTL); c.lb = (float*)(ws + WS_LB); c.win = (bf16_t*)(ws + WS_WIN); c.wout = (bf16_t*)(ws + WS_WOUT); c.xb = (bf16_t*)(ws + WS_XB);
    c.proj = (bf16_t*)(ws + WS_PROJ); c.projs = (float*)(ws + WS_PROJS); c.dtb = (float*)(ws + WS_DTB); c.mix = (bf16_t*)(ws + WS_MIX); c.xbcs = (bf16_t*)(ws + WS_XBCS); c.rowsq = (float*)(c.ctl + CW_ROWSQ);
    return c;
}

DI void p0_transpose_item(const float* W, int ldw, int k0, int n0, bf16_t* WT, int K, int drow0, LAS float* scr, int lane, const float* ksc) {
    float t[32];
#pragma unroll
    for (int i = 0; i < 32; ++i) t[i] = W[(size_t)(k0 + 2 * i + (lane >> 5)) * ldw + n0 + (lane & 31)];
#pragma unroll
    for (int i = 0; i < 32; ++i) scr[(2 * i + (lane >> 5)) * 33 + (lane & 31)] = t[i];
    const int c = lane & 7;
    f32x4 s0 = (f32x4){1.f, 1.f, 1.f, 1.f}, s1 = s0;
    if (ksc) { s0 = *(const f32x4*)(ksc + k0 + 8 * c); s1 = *(const f32x4*)(ksc + k0 + 8 * c + 4); }
    asm volatile("s_waitcnt lgkmcnt(0)" ::: "memory");
#pragma unroll
    for (int j = 0; j < 4; ++j) { const int n = (lane >> 3) + 8 * j; const LAS float* s = scr + (8 * c) * 33 + n;
        u32x4 o; o.x = pk2(s[0 * 33] * s0.x, s[1 * 33] * s0.y); o.y = pk2(s[2 * 33] * s0.z, s[3 * 33] * s0.w); o.z = pk2(s[4 * 33] * s1.x, s[5 * 33] * s1.y); o.w = pk2(s[6 * 33] * s1.z, s[7 * 33] * s1.w);
        *(u32x4*)(WT + (size_t)(drow0 + n) * K + k0 + 8 * c) = o; }
    asm volatile("s_waitcnt lgkmcnt(0)" ::: "memory");
}
DI void phase_prologue(int wv) {
    const Ctx c = make_ctx(wv);
    LAS float* scr = (LAS float*)(c.lds + c.wave * 16384);
    const int gw = c.wg * 8 + c.wave, NGW = c.G * 8;
    constexpr int NB1 = SRC_GLA / 32, NB2 = (SRC_DT - SRC_SSZ) / 32;
    constexpr int I_A = (D_MODEL / 64) * NB1, I_B = (D_MODEL / 64) * NB2, I_O = (D_MIX / 64) * (D_MODEL / 32), I_L = I_A + I_B + I_O;
    for (int it = gw; it < DEPTH * I_L; it += NGW) {
        const int l = it / I_L; int r = it % I_L;
        const float* win = c.in[I_WIN] + (size_t)l * D_MODEL * N_IN; bf16_t* wt = c.win + (size_t)l * LDP * D_MODEL; const float* rmsw = c.in[I_RMS] + (size_t)l * D_MODEL;
        if (r < I_A) { const int kb = r / NB1, nb = r % NB1; p0_transpose_item(win, N_IN, 64 * kb, 32 * nb, wt, D_MODEL, 32 * nb, scr, c.lane, rmsw); }
        else if (r < I_A + I_B) { r -= I_A; const int kb = r / NB2, nb = r % NB2; p0_transpose_item(win, N_IN, 64 * kb, SRC_SSZ + 32 * nb, wt, D_MODEL, C_SSZ + 32 * nb, scr, c.lane, rmsw); }
        else { r -= I_A + I_B; const int kb = r / (D_MODEL / 32), nb = r % (D_MODEL / 32);
            p0_transpose_item(c.in[I_WOUT] + (size_t)l * D_MIX * D_MODEL, D_MODEL, 64 * kb, 32 * nb, c.wout + (size_t)l * D_MODEL * D_MIX, D_MIX, 32 * nb, scr, c.lane, nullptr); }
    }
    const int gt = c.wg * 512 + c.tid, NGT = c.G * 512;
    for (int it = gw; it < DEPTH * 32 * 8; it += NGW) {
        const int l = it >> 8, kb = (it >> 3) & 31, nb = it & 7, k = kb * 64 + c.lane;
        const float* wr = c.in[I_WIN] + ((size_t)l * D_MODEL + k) * N_IN + SRC_GLA; const float* up = c.in[I_GWU] + (size_t)l * 16 * 512 + nb * 64;
        const f32x4 a0 = *(const f32x4*)wr, a1 = *(const f32x4*)(wr + 4), a2 = *(const f32x4*)(wr + 8), a3 = *(const f32x4*)(wr + 12);
        const float rk = c.in[I_RMS][(size_t)l * D_MODEL + k];
        bf16_t* dst = c.win + ((size_t)l * LDP + C_GLF + nb * 64) * D_MODEL + k;
#pragma unroll 4
        for (int n = 0; n < 64; ++n) {
            const float s = a0.x * up[n] + a0.y * up[512 + n] + a0.z * up[1024 + n] + a0.w * up[1536 + n] + a1.x * up[2048 + n] + a1.y * up[2560 + n] + a1.z * up[3072 + n] + a1.w * up[3584 + n]
                          + a2.x * up[4096 + n] + a2.y * up[4608 + n] + a2.z * up[5120 + n] + a2.w * up[5632 + n] + a3.x * up[6144 + n] + a3.y * up[6656 + n] + a3.z * up[7168 + n] + a3.w * up[7680 + n];
            dst[(size_t)n * D_MODEL] = (bf16_t)f2bf(s * rk); }
    }
    for (int i = gt; i < DEPTH * 16 * D_MODEL; i += NGT) {
        const int l = i / (16 * D_MODEL), e = i % (16 * D_MODEL), n = e / D_MODEL, k = e % D_MODEL;
        c.win[((size_t)l * LDP + C_DT + n) * D_MODEL + k] = (bf16_t)f2bf(c.in[I_WIN][((size_t)l * D_MODEL + k) * N_IN + SRC_DT + n] * c.in[I_RMS][(size_t)l * D_MODEL + k]);
    }
    constexpr int PADW = (LDP - C_DT - 16) * D_MODEL * 2 / 16;
    for (int i = gt; i < DEPTH * PADW; i += NGT) { const int l = i / PADW, r = i % PADW;
        ((u32x4*)(c.win + ((size_t)l * LDP + C_DT + 16) * D_MODEL))[r] = (u32x4){0u, 0u, 0u, 0u}; }
    constexpr int PADX = (M_PAD - TT) * D_MODEL * 2 / 16;
    for (int i = gt; i < PADX; i += NGT) ((u32x4*)(c.xb + (size_t)TT * D_MODEL))[i] = (u32x4){0u, 0u, 0u, 0u};
    for (int r = gw; r < TT; r += NGW) {
        const f32x4* x4 = (const f32x4*)(r < TP ? c.in[I_XP] + (size_t)r * D_MODEL : c.in[I_XS] + (size_t)(r - TP) * D_MODEL);
        u32x2* o = (u32x2*)(c.xb + (size_t)r * D_MODEL); float s = 0.f;
#pragma unroll
        for (int j = 0; j < 8; ++j) { const f32x4 v = x4[c.lane + 64 * j]; s += (v.x * v.x + v.y * v.y) + (v.z * v.z + v.w * v.w); u32x2 p; p.x = pk2(v.x, v.y); p.y = pk2(v.z, v.w); o[c.lane + 64 * j] = p; }
        s = wave_sum(s, c.lane);
        if (c.lane == 0) c.rowsq[r] = s;
    }
    for (int i = gt; i < 1024; i += NGT) {
        const float* p = c.in[I_LB];
        const float a0 = p[i], a1 = p[1024 + i], a2 = p[2048 + i], a3 = p[3072 + i];
        const float mx = fmaxf(fmaxf(a0, a1), fmaxf(a2, a3));
        const float e0 = expf(a0 - mx), e1 = expf(a1 - mx), e2 = expf(a2 - mx), e3 = expf(a3 - mx);
        const float inv = 1.0f / (e0 + e1 + e2 + e3);
        c.lb[i] = 0.f; c.lb[1024 + i] = e1 * inv; c.lb[2048 + i] = (e1 + e2) * inv; c.lb[3072 + i] = (e1 + e2 + e3) * inv;
    }
}

DI void phase_final_norm(int wv) {
    const Ctx c = make_ctx(wv);
    const int gw = c.wg * 8 + c.wave, NGW = c.G * 8;
    const f32x4* w4 = (const f32x4*)c.in[I_RMSF];
    for (int r = gw; r < TT; r += NGW) {
        const u32x2* x2 = (const u32x2*)(c.xb + (size_t)r * D_MODEL);
        const float rstd = row_rstd(c.rowsq + DEPTH * M_PAD, r);
        f32x4* o = (f32x4*)(c.out + O_YP + (size_t)r * D_MODEL);
#pragma unroll
        for (int j = 0; j < 8; ++j) { const u32x2 p = x2[c.lane + 64 * j]; const f32x4 w = w4[c.lane + 64 * j];
            o[c.lane + 64 * j] = (f32x4){bflo(p.x) * rstd * w.x, bfhi(p.x) * rstd * w.y, bflo(p.y) * rstd * w.z, bfhi(p.y) * rstd * w.w}; }
    }
}

DI float ps4(const float* p) { return (p[0] + p[PST]) + (p[2 * PST] + p[3 * PST]); }
DI float conv1(const float* prow, float rs, int col, int ch, int nch, const float* cw, const float* cb, const float* buf) {
    return cb[ch] + cw[ch] * buf[ch] + cw[nch + ch] * buf[nch + ch] + cw[2 * nch + ch] * buf[2 * nch + ch] + cw[3 * nch + ch] * (ps4(prow + col + ch) * rs);
}
constexpr int SM_Q = 0, SM_K = 1024, SM_F = 2048, SM_V = 3072, SM_O = 4096, SM_WS = 5120, SM_PART = 5376;
DI void sample_item(const Ctx& c, int l, int s, int type) {
    LAS float* sm = (LAS float*)c.lds;
    LAS float* QS = sm + SM_Q; LAS float* KS = sm + SM_K; LAS float* FS = sm + SM_F; LAS float* VS = sm + SM_V; LAS float* OS_ = sm + SM_O; LAS float* WSUM = sm + SM_WS;
    const int tid = get_tid(c.wave), lane = tid & 63, w = c.wave;
    const float* pr = c.projs + (size_t)s * LDP; const float rs = row_rstd(c.rowsq + (size_t)l * M_PAD, TP + s);
    __syncthreads();
    if (type == 0) {
#pragma unroll
        for (int e = 0; e < 2; ++e) { const int ch = 2 * tid + e; const float qraw = (ps4(pr + C_HGQ + ch) * rs), fraw = (ps4(pr + C_HGF + ch) * rs), lbv = c.lb[(size_t)l * 1024 + ch];
            QS[ch] = silu(qraw); FS[ch] = fmaxf(lbv + (1.0f - lbv) * sigm(fraw), TINY); KS[ch] = (1.0f - lbv) * sigm(-fraw); VS[ch] = (ps4(pr + C_HGI + ch) * rs); }
    } else if (type == 1) {
#pragma unroll
        for (int e = 0; e < 2; ++e) { const int ch = 2 * tid + e; VS[ch] = (ps4(pr + C_GLV + ch) * rs);
            if (tid < 256) { QS[ch] = (ps4(pr + C_GLQ + ch) * rs) * 0.08838834764831845f; KS[ch] = (ps4(pr + C_GLK + ch) * rs);
                const float z = (ps4(pr + C_GLF + ch) * rs) + c.in[I_GBU][(size_t)l * 512 + ch]; FS[ch] = fexp(-softplus(-z) * (1.0f / 16.0f)); } }
    } else {
        const float* scw = c.in[I_SCW] + (size_t)l * 4 * 1536; const float* scb = c.in[I_SCB] + (size_t)l * 1536;
        const float* sbuf = c.in[I_SSSDC] + ((size_t)l * DEC + s) * 3 * 1536;
#pragma unroll
        for (int e = 0; e < 2; ++e) { const int ch = 2 * tid + e; VS[ch] = silu(conv1(pr, rs, C_XBC, ch, 1536, scw, scb, sbuf)); }
        if (tid < 256) { KS[tid] = silu(conv1(pr, rs, C_XBC, 1024 + tid, 1536, scw, scb, sbuf)); QS[tid] = silu(conv1(pr, rs, C_XBC, 1280 + tid, 1536, scw, scb, sbuf)); }
        if (tid < 16) { const float dt = softplus((ps4(pr + C_DT + tid) * rs) + c.in[I_DTB][l * 16 + tid]); FS[tid] = dt; FS[16 + tid] = fexp(-dt * expf(c.in[I_ALOG][l * 16 + tid])); }
    }
    __syncthreads();
    if (type < 2) {
        const int h = type == 0 ? w : (w >> 1), RS = type == 0 ? 128 : 256, voff = type == 0 ? 0 : 128 * (w & 1);
        const size_t sb = type == 0 ? (((size_t)l * DEC + s) * 8 + h) * 16384 : (((size_t)l * DEC + s) * 4 + h) * 32768;
        const float* s0 = (type == 0 ? c.in[I_SHG] : c.in[I_SGLA]) + sb; float* so = c.out + (type == 0 ? O_HG_S : O_GLA_S) + sb;
        const int vq = lane & 31, kh = lane >> 5, vb = (type == 0 ? h * 128 : h * 256 + voff) + 4 * vq, qb = h * 128;
        const f32x4 vv = *(const LAS f32x4*)(VS + vb); f32x4 o4 = (f32x4){0.f, 0.f, 0.f, 0.f};
        const int eo = kh * RS + voff + 4 * vq;
#pragma unroll 2
        for (int k8 = 0; k8 < 64; k8 += 8) {
            f32x4 st[8];
#pragma unroll
            for (int u = 0; u < 8; ++u) st[u] = *(const f32x4*)(s0 + (size_t)(2 * (k8 + u)) * RS + eo);
#pragma unroll
            for (int u = 0; u < 8; ++u) { const int k = 2 * (k8 + u) + kh; const float fk = FS[qb + k], kk = KS[qb + k], qk = QS[qb + k];
                st[u] = st[u] * fk + vv * kk; o4 += st[u] * qk; *(f32x4*)(so + (size_t)(2 * (k8 + u)) * RS + eo) = st[u]; }
        }
        o4.x += shx(o4.x, 32, lane); o4.y += shx(o4.y, 32, lane); o4.z += shx(o4.z, 32, lane); o4.w += shx(o4.w, 32, lane);
        if (kh == 0) *(LAS f32x4*)(OS_ + vb) = o4;
    } else {
        LAS float* PART = sm + SM_PART + w * 2304;
        const int nq = lane & 31, ph = lane >> 5, g = w >> 2;
        const f32x4 B4 = *(const LAS f32x4*)(KS + g * 128 + 4 * nq), C4 = *(const LAS f32x4*)(QS + g * 128 + 4 * nq);
#pragma unroll 1
        for (int hx = 0; hx < 2; ++hx) { const int h = 2 * w + hx;
            const size_t sb = (((size_t)l * DEC + s) * 16 + h) * 8192;
            const float* s0 = c.in[I_SSSD] + sb; float* so = c.out + O_SSD_S + sb;
            const float dt = FS[h], dA = FS[16 + h];
            const int eo = ph * 128 + 4 * nq;
#pragma unroll 2
            for (int p8 = 0; p8 < 32; p8 += 8) {
                f32x4 st[8];
#pragma unroll
                for (int u = 0; u < 8; ++u) st[u] = *(const f32x4*)(s0 + (size_t)(2 * (p8 + u)) * 128 + eo);
#pragma unroll
                for (int u = 0; u < 8; ++u) { const int p = 2 * (p8 + u) + ph; const float xv = VS[h * 64 + p] * dt;
                    st[u] = st[u] * dA + B4 * xv; *(f32x4*)(so + (size_t)(2 * (p8 + u)) * 128 + eo) = st[u];
                    PART[p * 36 + nq] = (st[u].x * C4.x + st[u].y * C4.y) + (st[u].z * C4.z + st[u].w * C4.w); }
            }
            asm volatile("s_waitcnt lgkmcnt(0)" ::: "memory");
            { float o = 0.f;
#pragma unroll
              for (int q = 0; q < 8; ++q) { const f32x4 t = *(const LAS f32x4*)(PART + lane * 36 + 4 * q); o += (t.x + t.y) + (t.z + t.w); }
              const float x = VS[h * 64 + lane], z = (ps4(pr + C_SSZ + h * 64 + lane) * rs);
              OS_[h * 64 + lane] = (o + c.in[I_SD][l * 16 + h] * x) * silu(z); }
            asm volatile("s_waitcnt lgkmcnt(0)" ::: "memory");
        }
    }
    __syncthreads();
    { const f32x2 o2 = *(const LAS f32x2*)(OS_ + 2 * tid);
      const float ssw = wave_sum(o2.x * o2.x + o2.y * o2.y, lane);
      if (lane == 0) WSUM[w] = ssw;
      __syncthreads();
      float ss, gsz; const float* nw; int mcol, gcol = 0;
      if (type == 0) { ss = WSUM[w]; gsz = 128.f; nw = c.in[I_HGN] + (size_t)l * 1024; mcol = 0; gcol = C_HGG; }
      else if (type == 1) { ss = WSUM[w & ~1] + WSUM[w | 1]; gsz = 256.f; nw = c.in[I_GLN] + (size_t)l * 1024; mcol = 2048; gcol = C_GLG; }
      else { const int b4 = w & ~3; ss = (WSUM[b4] + WSUM[b4 + 1]) + (WSUM[b4 + 2] + WSUM[b4 + 3]); gsz = 512.f; nw = c.in[I_SSN] + (size_t)l * 1024; mcol = 3072; }
      const float rstd = rsqrtf(ss / gsz + EPS);
      float y0 = o2.x * rstd * nw[2 * tid], y1 = o2.y * rstd * nw[2 * tid + 1];
      if (type < 2) { y0 *= silu((ps4(pr + gcol + 2 * tid) * rs)); y1 *= silu((ps4(pr + gcol + 2 * tid + 1) * rs)); }
      *(unsigned*)(c.mix + (size_t)(TP + s) * D_MIX + mcol + 2 * tid) = pk2(y0, y1); }
}

DI void lds_barrier() { asm volatile("s_waitcnt lgkmcnt(0)\n\ts_barrier" ::: "memory"); }
DI f32x16 mfma32(bf16x8 a, bf16x8 b, f32x16 c) { return __builtin_amdgcn_mfma_f32_32x32x16_bf16(a, b, c, 0, 0, 0); }
DI bf16x8 ldfrag(const LAS unsigned char* p) { return *(const LAS bf16x8*)p; }
DI int crow(int i, int hh) { return (i & 3) + 8 * (i >> 2) + 4 * hh; }
constexpr int L_QP = 0, L_KP = 17408, L_KPT = 34816, L_VT = 53248, L_VT2 = 71680, L_AM = 90112, L_TOT = 108544, L_E1 = 112640, L_E2 = 113152, L_CUM = 113664;
constexpr int SQ = 272, SV = 144;
#define ZERO16(x) do { _Pragma("unroll") for (int _i = 0; _i < 16; ++_i) (x)[_i] = 0.f; } while (0)

template <int TYPE>
DI void la_head_unit(const Ctx& c, int l, int b, int hu) {
    constexpr int DV = 128, NSW = DV / 32, OS = DV * 2 + 16, NC = DV / 8;
    LAS unsigned char* L = c.lds;
    const int tid = get_tid(c.wave), lane = tid & 63, w = c.wave;
    const int r = lane & 31, hh = lane >> 5;
    const int row0 = b * SEQ;
    const bf16_t* P = TYPE == 2 ? c.xbcs : c.proj;
    constexpr int LDR = TYPE == 2 ? 1536 : LDP;
    LAS float* TOT = (LAS float*)(L + L_TOT); LAS float* E1 = (LAS float*)(L + L_E1); LAS float* E2 = (LAS float*)(L + L_E2);
    int colQ, colK, colG, colV, colGate, colOut, sidx; const int grp = hu >> 2;
    if constexpr (TYPE == 0) { colQ = C_HGQ + hu * 128; colK = 0; colG = C_HGF + hu * 128; colV = C_HGI + hu * 128; colGate = C_HGG + hu * 128; colOut = hu * 128; sidx = 0; }
    else if constexpr (TYPE == 1) { const int hd = hu >> 1; colQ = C_GLQ + hd * 128; colK = C_GLK + hd * 128; colG = C_GLF + hd * 128; colV = C_GLV + hu * 128; colGate = C_GLG + hu * 128; colOut = 2048 + hu * 128; sidx = 2 + hd; }
    else { colK = 1024 + grp * 128; colQ = 1280 + grp * 128; colG = 0; colV = hu * 128; colGate = C_SSZ + hu * 128; colOut = 3072 + hu * 128; sidx = grp; }
    float Ah[2], Dh[2];
    if constexpr (TYPE == 2) {
#pragma unroll
        for (int e = 0; e < 2; ++e) { Ah[e] = -expf(c.in[I_ALOG][l * 16 + 2 * hu + e]); Dh[e] = c.in[I_SD][l * 16 + 2 * hu + e]; }
    }
    unsigned r0[8], r1[8], r2[8], r3[8]; float dtn = 0.f;
#define LOAD_CHUNK(tn) do { const bf16_t* pq_ = P + (size_t)(row0 + (tn) + 8 * w) * LDR + 2 * lane; \
        if constexpr (TYPE == 0) { _Pragma("unroll") for (int i = 0; i < 8; ++i) { r0[i] = *(const unsigned*)(pq_ + (size_t)i * LDR + colQ); r1[i] = *(const unsigned*)(pq_ + (size_t)i * LDR + colG); r2[i] = *(const unsigned*)(pq_ + (size_t)i * LDR + colV); } } \
        else if constexpr (TYPE == 1) { _Pragma("unroll") for (int i = 0; i < 8; ++i) { r0[i] = *(const unsigned*)(pq_ + (size_t)i * LDR + colQ); r1[i] = *(const unsigned*)(pq_ + (size_t)i * LDR + colK); \
                                                                                       r2[i] = *(const unsigned*)(pq_ + (size_t)i * LDR + colG); r3[i] = *(const unsigned*)(pq_ + (size_t)i * LDR + colV); } } \
        else { _Pragma("unroll") for (int i = 0; i < 8; ++i) { r0[i] = *(const unsigned*)(pq_ + (size_t)i * LDR + colQ); r1[i] = *(const unsigned*)(pq_ + (size_t)i * LDR + colK); r2[i] = *(const unsigned*)(pq_ + (size_t)i * LDR + colV); } \
            if (w < 2) dtn = c.dtb[(size_t)(row0 + (tn) + lane) * 16 + 2 * hu + w]; } } while (0)
    f32x16 S[4];
#pragma unroll
    for (int kt = 0; kt < 4; ++kt) ZERO16(S[kt]);
    float e2pa = 1.f, e2pb = 1.f;
    constexpr bool PF = true;
    if constexpr (PF) LOAD_CHUNK(0);
    for (int ck = -(SEQ / 64) * (PROBE_LONG_REP - 1); ck < SEQ / 64; ++ck) {
        if (PROBE_LONG_REP > 1 && ck == 0) { e2pa = 1.f; e2pb = 1.f;
#pragma unroll
            for (int kt = 0; kt < 4; ++kt) ZERO16(S[kt]); }
        const int t0 = (ck & (SEQ / 64 - 1)) * 64;
        LAS float* CUM = (LAS float*)(L + L_CUM + (ck & 1) * 1536);
        if constexpr (!PF) LOAD_CHUNK(t0);
        float qa[8], qb[8], ka[8], kb[8], ga[8], gb[8], xa[8], xb[8]; unsigned uv[8];
        if constexpr (TYPE == 0) {
            float ta = 0.f, tb = 0.f;
#pragma unroll
            for (int i = 0; i < 8; ++i) { qa[i] = bflo(r0[i]); qb[i] = bfhi(r0[i]); const float g0 = bflo(r1[i]), g1 = bfhi(r1[i]); uv[i] = r2[i];
                ka[i] = 1.0f - fexp(g0); kb[i] = 1.0f - fexp(g1); ta += g0; tb += g1; ga[i] = ta; gb[i] = tb; }
            *(LAS f32x2*)(TOT + w * 128 + 2 * lane) = (f32x2){ta, tb};
        } else if constexpr (TYPE == 1) {
            float ta = 0.f, tb = 0.f;
#pragma unroll
            for (int i = 0; i < 8; ++i) { qa[i] = bflo(r0[i]); qb[i] = bfhi(r0[i]); ka[i] = bflo(r1[i]); kb[i] = bfhi(r1[i]); ta += bflo(r2[i]); tb += bfhi(r2[i]); ga[i] = ta; gb[i] = tb; uv[i] = r3[i]; }
            *(LAS f32x2*)(TOT + w * 128 + 2 * lane) = (f32x2){ta, tb};
        } else {
#pragma unroll
            for (int i = 0; i < 8; ++i) { qa[i] = bflo(r0[i]); qb[i] = bfhi(r0[i]); ka[i] = bflo(r1[i]); kb[i] = bfhi(r1[i]); xa[i] = bflo(r2[i]); xb[i] = bfhi(r2[i]); }
            if (w < 2) {
                const float dt = dtn; float x = dt * (w == 0 ? Ah[0] : Ah[1]);
#pragma unroll
                for (int o = 1; o < 64; o <<= 1) { const float y = shup(x, o, lane); if (lane >= o) x += y; }
                CUM[w * 192 + lane] = x; CUM[w * 192 + 64 + lane] = fmaxf(dt, 1e-30f); CUM[w * 192 + 128 + lane] = fexp(x);
            }
        }
        lds_barrier();
        if constexpr (TYPE < 2) {
            float offa = 0.f, offb = 0.f, brefa = 0.f, brefb = 0.f, bla = 0.f, blb = 0.f;
#pragma unroll
            for (int g = 0; g < 8; ++g) { const f32x2 t = *(const LAS f32x2*)(TOT + g * 128 + 2 * lane);
                if (g < w) { offa += t.x; offb += t.y; }
                if (g < 4) { brefa += t.x; brefb += t.y; }
                bla += t.x; blb += t.y; }
#pragma unroll
            for (int i = 0; i < 8; ++i) { const float da = clampf(ga[i] + offa - brefa, -80.f, 80.f), db = clampf(gb[i] + offb - brefb, -80.f, 80.f);
                qa[i] *= fexp(da); ka[i] *= fexp(-da); qb[i] *= fexp(db); kb[i] *= fexp(-db); }
            if (w == 0) {
                const float e2a = fexp(bla - brefa), e2b = fexp(blb - brefb);
                *(LAS f32x2*)(E1 + 2 * lane) = (f32x2){fexp(brefa) * e2pa, fexp(brefb) * e2pb}; *(LAS f32x2*)(E2 + 2 * lane) = (f32x2){e2a, e2b}; e2pa = e2a; e2pb = e2b; }
        }
#pragma unroll
        for (int i = 0; i < 8; ++i) { *(LAS unsigned*)(L + L_QP + (8 * w + i) * SQ + 4 * lane) = pk2(qa[i], qb[i]); *(LAS unsigned*)(L + L_KP + (8 * w + i) * SQ + 4 * lane) = pk2(ka[i], kb[i]); }
        { u32x4 a, bq; a.x = pk2(ka[0], ka[1]); a.y = pk2(ka[2], ka[3]); a.z = pk2(ka[4], ka[5]); a.w = pk2(ka[6], ka[7]);
          bq.x = pk2(kb[0], kb[1]); bq.y = pk2(kb[2], kb[3]); bq.z = pk2(kb[4], kb[5]); bq.w = pk2(kb[6], kb[7]);
          *(LAS u32x4*)(L + L_KPT + (2 * lane) * SV + 16 * w) = a; *(LAS u32x4*)(L + L_KPT + (2 * lane + 1) * SV + 16 * w) = bq; }
        if constexpr (TYPE < 2) {
            u32x4 a, bq;
            a.x = (uv[0] & 0xffffu) | (uv[1] << 16); a.y = (uv[2] & 0xffffu) | (uv[3] << 16); a.z = (uv[4] & 0xffffu) | (uv[5] << 16); a.w = (uv[6] & 0xffffu) | (uv[7] << 16);
            bq.x = (uv[0] >> 16) | (uv[1] & 0xffff0000u); bq.y = (uv[2] >> 16) | (uv[3] & 0xffff0000u); bq.z = (uv[4] >> 16) | (uv[5] & 0xffff0000u); bq.w = (uv[6] >> 16) | (uv[7] & 0xffff0000u);
            *(LAS u32x4*)(L + L_VT + (2 * lane) * SV + 16 * w) = a; *(LAS u32x4*)(L + L_VT + (2 * lane + 1) * SV + 16 * w) = bq;
        } else {
            const int hs = lane >> 5;
            const LAS float* cm = CUM + hs * 192; const float cl = cm[63];
            float v1a[8], v1b[8], v2a[8], v2b[8];
#pragma unroll
            for (int j = 0; j < 8; ++j) { const int s = 8 * w + j; const float dt = cm[64 + s], wgt = fexp(fminf(cl - cm[s], 0.f));
                v1a[j] = dt * xa[j]; v1b[j] = dt * xb[j]; v2a[j] = v1a[j] * wgt; v2b[j] = v1b[j] * wgt; }
            u32x4 a, bq;
            a.x = pk2(v1a[0], v1a[1]); a.y = pk2(v1a[2], v1a[3]); a.z = pk2(v1a[4], v1a[5]); a.w = pk2(v1a[6], v1a[7]);
            bq.x = pk2(v1b[0], v1b[1]); bq.y = pk2(v1b[2], v1b[3]); bq.z = pk2(v1b[4], v1b[5]); bq.w = pk2(v1b[6], v1b[7]);
            *(LAS u32x4*)(L + L_VT + (2 * lane) * SV + 16 * w) = a; *(LAS u32x4*)(L + L_VT + (2 * lane + 1) * SV + 16 * w) = bq;
            a.x = pk2(v2a[0], v2a[1]); a.y = pk2(v2a[2], v2a[3]); a.z = pk2(v2a[4], v2a[5]); a.w = pk2(v2a[6], v2a[7]);
            bq.x = pk2(v2b[0], v2b[1]); bq.y = pk2(v2b[2], v2b[3]); bq.z = pk2(v2b[4], v2b[5]); bq.w = pk2(v2b[6], v2b[7]);
            *(LAS u32x4*)(L + L_VT2 + (2 * lane) * SV + 16 * w) = a; *(LAS u32x4*)(L + L_VT2 + (2 * lane + 1) * SV + 16 * w) = bq;
        }
        lds_barrier();
        if constexpr (PF) { if (ck + 1 < SEQ / 64) LOAD_CHUNK(((ck + 1) & (SEQ / 64 - 1)) * 64); }
        if (w >= 5) {
            const int sb = (w == 7) ? 1 : 0, tb = (w == 5) ? 0 : 1;
            f32x16 X; ZERO16(X);
#pragma unroll
            for (int k4 = 0; k4 < 8; k4 += 4) { bf16x8 fk[4], fq[4];
#pragma unroll
                for (int u = 0; u < 4; ++u) { fk[u] = ldfrag(L + L_KP + (32 * sb + r) * SQ + (16 * (k4 + u) + 8 * hh) * 2); fq[u] = ldfrag(L + L_QP + (32 * tb + r) * SQ + (16 * (k4 + u) + 8 * hh) * 2); }
#pragma unroll
                for (int u = 0; u < 4; ++u) X = mfma32(fk[u], fq[u], X); }
            const int t = 32 * tb + r;
#pragma unroll
            for (int hs = 0; hs < (TYPE == 2 ? 2 : 1); ++hs) {
                float ct = 0.f, ddt = 0.f;
                if constexpr (TYPE == 2) { ct = CUM[hs * 192 + t]; ddt = (hs == 0 ? Dh[0] : Dh[1]) / CUM[hs * 192 + 64 + t]; }
#pragma unroll
                for (int g = 0; g < 4; ++g) { const int s0 = 32 * sb + 8 * g + 4 * hh;
                    float x0 = X[4 * g], x1 = X[4 * g + 1], x2 = X[4 * g + 2], x3 = X[4 * g + 3];
                    if constexpr (TYPE == 2) { const f32x4 cs = *(const LAS f32x4*)(CUM + hs * 192 + s0);
                        x0 *= fexp(fminf(ct - cs.x, 0.f)); x1 *= fexp(fminf(ct - cs.y, 0.f)); x2 *= fexp(fminf(ct - cs.z, 0.f)); x3 *= fexp(fminf(ct - cs.w, 0.f));
                        x0 += (s0 == t) ? ddt : 0.f; x1 += (s0 + 1 == t) ? ddt : 0.f; x2 += (s0 + 2 == t) ? ddt : 0.f; x3 += (s0 + 3 == t) ? ddt : 0.f; }
                    x0 = (s0 <= t) ? x0 : 0.f; x1 = (s0 + 1 <= t) ? x1 : 0.f; x2 = (s0 + 2 <= t) ? x2 : 0.f; x3 = (s0 + 3 <= t) ? x3 : 0.f;
                    u32x2 p; p.x = pk2(x0, x1); p.y = pk2(x2, x3);
                    *(LAS u32x2*)(L + L_AM + hs * 9216 + t * SV + s0 * 2) = p; }
            }
        }
        f32x16 O[2]; bf16x8 Bv[4];
        const int hsw = w >> 1;
        if (w < NSW) {
            if constexpr (TYPE < 2) {
#pragma unroll
                for (int kt = 0; kt < 4; ++kt)
#pragma unroll
                    for (int g = 0; g < 4; ++g) { const f32x4 e = *(const LAS f32x4*)(E1 + 32 * kt + 8 * g + 4 * hh);
                        S[kt][4 * g] *= e.x; S[kt][4 * g + 1] *= e.y; S[kt][4 * g + 2] *= e.z; S[kt][4 * g + 3] *= e.w; }
            }
            ZERO16(O[0]); ZERO16(O[1]);
#pragma unroll
            for (int kt = 0; kt < 4; ++kt) {
                u32x2 ql[2][2], qh[2][2];
#pragma unroll
                for (int s = 0; s < 2; ++s)
#pragma unroll
                    for (int tt = 0; tt < 2; ++tt) { const LAS unsigned char* qp = L + L_QP + (32 * tt + r) * SQ + (32 * kt + 16 * s + 4 * hh) * 2;
                        ql[s][tt] = *(const LAS u32x2*)qp; qh[s][tt] = *(const LAS u32x2*)(qp + 16); }
#pragma unroll
                for (int s = 0; s < 2; ++s) {
                    u32x4 pa; pa.x = pk2(S[kt][8 * s], S[kt][8 * s + 1]); pa.y = pk2(S[kt][8 * s + 2], S[kt][8 * s + 3]); pa.z = pk2(S[kt][8 * s + 4], S[kt][8 * s + 5]); pa.w = pk2(S[kt][8 * s + 6], S[kt][8 * s + 7]);
                    const bf16x8 A = __builtin_bit_cast(bf16x8, pa);
#pragma unroll
                    for (int tt = 0; tt < 2; ++tt) O[tt] = mfma32(A, __builtin_bit_cast(bf16x8, (u32x4){ql[s][tt].x, ql[s][tt].y, qh[s][tt].x, qh[s][tt].y}), O[tt]);
                }
            }
            if constexpr (TYPE == 2) {
                const LAS float* cm = CUM + hsw * 192; const float e0 = cm[128 + r], e1 = cm[128 + 32 + r], sc = cm[128 + 63];
#pragma unroll
                for (int i = 0; i < 16; ++i) { O[0][i] *= e0; O[1][i] *= e1; }
#pragma unroll
                for (int kt = 0; kt < 4; ++kt)
#pragma unroll
                    for (int i = 0; i < 16; ++i) S[kt][i] *= sc;
            }
#pragma unroll
            for (int st = 0; st < 4; ++st) { bf16x8 kf[4];
                Bv[st] = ldfrag(L + (TYPE == 2 ? L_VT2 : L_VT) + (32 * w + r) * SV + (16 * st + 8 * hh) * 2);
#pragma unroll
                for (int kt = 0; kt < 4; ++kt) kf[kt] = ldfrag(L + L_KPT + (32 * kt + r) * SV + (16 * st + 8 * hh) * 2);
#pragma unroll
                for (int kt = 0; kt < 4; ++kt) S[kt] = mfma32(kf[kt], Bv[st], S[kt]); }
        }
        const int nt_ = tid >> 3, nseg = tid & 7;
        u32x4 gq[NC / 8];
        { const bf16_t* pg = c.proj + (size_t)(row0 + t0 + nt_) * LDP + colGate + nseg * NC;
#pragma unroll
          for (int q = 0; q < NC / 8; ++q) gq[q] = *(const u32x4*)(pg + 8 * q); }
        lds_barrier();
        if (w < NSW) {
#pragma unroll
            for (int st = 0; st < 4; ++st) { bf16x8 Av = Bv[st];
                if constexpr (TYPE == 2) Av = ldfrag(L + L_VT + (32 * w + r) * SV + (16 * st + 8 * hh) * 2);
#pragma unroll
                for (int tt = 0; tt < 2; ++tt) if (st < 2 || tt == 1)
                    O[tt] = mfma32(Av, ldfrag(L + L_AM + (TYPE == 2 ? hsw * 9216 : 0) + (32 * tt + r) * SV + (16 * st + 8 * hh) * 2), O[tt]); }
#pragma unroll
            for (int tt = 0; tt < 2; ++tt)
#pragma unroll
                for (int g = 0; g < 4; ++g) { u32x2 p; p.x = pk2(O[tt][4 * g], O[tt][4 * g + 1]); p.y = pk2(O[tt][4 * g + 2], O[tt][4 * g + 3]);
                    *(LAS u32x2*)(L + (32 * tt + r) * OS + (32 * w + 8 * g + 4 * hh) * 2) = p; }
        }
        lds_barrier();
        {
            float o[NC], gv[NC]; float ss = 0.f;
#pragma unroll
            for (int q = 0; q < NC / 8; ++q) { const u32x4 ov = *(const LAS u32x4*)(L + nt_ * OS + (nseg * NC + 8 * q) * 2);
                o[8 * q] = bflo(ov.x); o[8 * q + 1] = bfhi(ov.x); o[8 * q + 2] = bflo(ov.y); o[8 * q + 3] = bfhi(ov.y); o[8 * q + 4] = bflo(ov.z); o[8 * q + 5] = bfhi(ov.z); o[8 * q + 6] = bflo(ov.w); o[8 * q + 7] = bfhi(ov.w);
                gv[8 * q] = bflo(gq[q].x); gv[8 * q + 1] = bfhi(gq[q].x); gv[8 * q + 2] = bflo(gq[q].y); gv[8 * q + 3] = bfhi(gq[q].y); gv[8 * q + 4] = bflo(gq[q].z); gv[8 * q + 5] = bfhi(gq[q].z); gv[8 * q + 6] = bflo(gq[q].w); gv[8 * q + 7] = bfhi(gq[q].w); }
            if constexpr (TYPE == 2) {
#pragma unroll
                for (int e = 0; e < NC; ++e) o[e] *= gv[e];
            }
#pragma unroll
            for (int e = 0; e < NC; ++e) ss += o[e] * o[e];
            ss += shx(ss, 1, lane); ss += shx(ss, 2, lane); ss += shx(ss, 4, lane);
            float mul = 1.0f;
            if constexpr (TYPE == 0) mul = rsqrtf(ss * (1.0f / DV) + EPS);
            else { if (nseg == 0 && ck >= 0) atomicAdd((float*)(c.ctl + CW_STATS) + ((size_t)l * TP + row0 + t0 + nt_) * 6 + sidx, ss); }
            if constexpr (TYPE < 2) {
#pragma unroll
                for (int e = 0; e < NC; ++e) o[e] *= mul * gv[e];
            }
            bf16_t* pm = c.mix + (size_t)(row0 + t0 + nt_) * D_MIX + colOut + nseg * NC;
#pragma unroll
            for (int q = 0; q < NC / 8; ++q) { u32x4 ov; ov.x = pk2(o[8 * q], o[8 * q + 1]); ov.y = pk2(o[8 * q + 2], o[8 * q + 3]); ov.z = pk2(o[8 * q + 4], o[8 * q + 5]); ov.w = pk2(o[8 * q + 6], o[8 * q + 7]);
                *(u32x4*)(pm + 8 * q) = ov; }
        }
    }
#undef LOAD_CHUNK
    if (w < NSW) {
        const int lane2 = get_tid(c.wave) & 63, r = lane2 & 31, hh = lane2 >> 5;
        if constexpr (TYPE < 2) {
#pragma unroll
            for (int kt = 0; kt < 4; ++kt)
#pragma unroll
                for (int g = 0; g < 4; ++g) { const f32x4 e = *(const LAS f32x4*)(E2 + 32 * kt + 8 * g + 4 * hh);
                    S[kt][4 * g] *= e.x; S[kt][4 * g + 1] *= e.y; S[kt][4 * g + 2] *= e.z; S[kt][4 * g + 3] *= e.w; }
        }
        float* sout; int sk, sv, vb;
        if constexpr (TYPE == 0) { sout = c.out + O_HG_P + (((size_t)l * NB + b) * 8 + hu) * 16384; sk = 128; sv = 1; vb = 32 * w; }
        else if constexpr (TYPE == 1) { sout = c.out + O_GLA_P + (((size_t)l * NB + b) * 4 + (hu >> 1)) * 32768; sk = 256; sv = 1; vb = 128 * (hu & 1) + 32 * w; }
        else { sout = c.out + O_SSD_P + (((size_t)l * NB + b) * 16 + 2 * hu + (w >> 1)) * 8192; sk = 1; sv = 128; vb = 32 * (w & 1); }
#pragma unroll
        for (int kt = 0; kt < 4; ++kt)
#pragma unroll
            for (int i = 0; i < 16; ++i) sout[(32 * kt + crow(i, hh)) * sk + (vb + r) * sv] = S[kt][i];
    }
}

constexpr int R_WT = 74752;
DI void rg_load_gates(const Ctx& c, int l, int n, int tid, int j, int hh, bf16x8 (&Br)[8], bf16x8 (&Bi)[8]) {
    LAS unsigned char* L = c.lds;
    const float* wr = c.in[I_WR] + (size_t)(l * 8 + n) * 128 * 128; const float* wi = c.in[I_WI] + (size_t)(l * 8 + n) * 128 * 128;
    __syncthreads();
    f32x4 v[16];
#pragma unroll
    for (int q = 0; q < 16; ++q) { const int e = tid + 512 * q, mat = e >> 12, rem = e & 4095; v[q] = *(const f32x4*)((mat ? wi : wr) + rem * 4); }
#pragma unroll
    for (int q = 0; q < 16; ++q) { const int e = tid + 512 * q, mat = e >> 12, rem = e & 4095, i = rem >> 5, j4 = (rem & 31) * 4;
        LAS unsigned char* p = L + R_WT + mat * 34816 + j4 * SQ + i * 2;
        *(LAS bf16_t*)(p) = (bf16_t)f2bf(v[q].x); *(LAS bf16_t*)(p + SQ) = (bf16_t)f2bf(v[q].y); *(LAS bf16_t*)(p + 2 * SQ) = (bf16_t)f2bf(v[q].z); *(LAS bf16_t*)(p + 3 * SQ) = (bf16_t)f2bf(v[q].w); }
    __syncthreads();
#pragma unroll
    for (int ks = 0; ks < 8; ++ks) { Br[ks] = ldfrag(L + R_WT + j * SQ + (16 * ks + 8 * hh) * 2); Bi[ks] = ldfrag(L + R_WT + 34816 + j * SQ + (16 * ks + 8 * hh) * 2); }
}
constexpr int R_XCB = 0, R_XCF = 17408, R_SUMA = 50176, R_SUMU = 58368, R_HIN = 66560;
DI void rg_chunk_unit(const Ctx& c, int l, int b, int n) {
    LAS unsigned char* L = c.lds;
    const int tid = get_tid(c.wave), lane = tid & 63, w = c.wave, r = lane & 31, hh = lane >> 5;
    const int tb = w >> 2, jb = w & 3;
    const int j = 32 * jb + r, ch = n * 128 + j;
    const int row0 = b * SEQ;
    const bf16_t* P = c.proj;
    LAS float* XCF = (LAS float*)(L + R_XCF); LAS float* SUMA = (LAS float*)(L + R_SUMA); LAS float* SUMU = (LAS float*)(L + R_SUMU); LAS float* HIN = (LAS float*)(L + R_HIN);
    bf16x8 Br[8], Bi[8];
    rg_load_gates(c, l, n, tid, j, hh, Br, Bi);
    const float sp = softplus(-c.in[I_LAM][l * 1024 + ch]), brv = c.in[I_BR][(l * 8 + n) * 128 + j], biv = c.in[I_BI][(l * 8 + n) * 128 + j];
    float cw[4][2], cb[2];
#pragma unroll
    for (int e = 0; e < 2; ++e) {
#pragma unroll
        for (int m = 0; m < 4; ++m) cw[m][e] = c.in[I_RCW][l * 4 * 1024 + m * 1024 + n * 128 + 2 * lane + e];
        cb[e] = c.in[I_RCB][l * 1024 + n * 128 + 2 * lane + e]; }
    float hcarry = 0.f;
    unsigned ux[11]; bf16_t gtr[16];
#define RG_LOAD(tn) do { const bf16_t* pq_ = P + (size_t)(row0 + (tn) + 8 * w) * LDP + C_RGX + n * 128 + 2 * lane; const bool first_ = ((tn) == 0 && w == 0); \
        _Pragma("unroll") for (int jx = 0; jx < 11; ++jx) ux[jx] = (first_ && jx < 3) ? 0u : *(const unsigned*)(pq_ + (ptrdiff_t)(jx - 3) * LDP); \
        const bf16_t* pg_ = P + (size_t)(row0 + (tn) + 32 * tb) * LDP; const int goff_ = 4 * hh * LDP + C_RGG + ch; \
        _Pragma("unroll") for (int i = 0; i < 16; ++i) gtr[i] = (pg_ + (size_t)((i & 3) + 8 * (i >> 2)) * LDP)[goff_]; } while (0)
    RG_LOAD(0);
    for (int ck = -(SEQ / 64) * (PROBE_RG_REP - 1); ck < SEQ / 64; ++ck) {
        if (PROBE_RG_REP > 1 && ck == 0) hcarry = 0.f;
        const int t0 = (ck & (SEQ / 64 - 1)) * 64;
#pragma unroll
        for (int i = 0; i < 8; ++i) { const int t = 8 * w + i;
            const float x0 = cb[0] + cw[0][0] * bflo(ux[i]) + cw[1][0] * bflo(ux[i + 1]) + cw[2][0] * bflo(ux[i + 2]) + cw[3][0] * bflo(ux[i + 3]);
            const float x1 = cb[1] + cw[0][1] * bfhi(ux[i]) + cw[1][1] * bfhi(ux[i + 1]) + cw[2][1] * bfhi(ux[i + 2]) + cw[3][1] * bfhi(ux[i + 3]);
            *(LAS f32x2*)(XCF + t * 128 + 2 * lane) = (f32x2){x0, x1}; *(LAS unsigned*)(L + R_XCB + t * SQ + 4 * lane) = pk2(x0, x1); }
        float gt[16];
#pragma unroll
        for (int i = 0; i < 16; ++i) gt[i] = bf1(gtr[i]);
        lds_barrier();
        if (ck + 1 < SEQ / 64) RG_LOAD(((ck + 1) & (SEQ / 64 - 1)) * 64);
        f32x16 R, I; ZERO16(R); ZERO16(I);
#pragma unroll
        for (int ks = 0; ks < 8; ++ks) { const bf16x8 a = ldfrag(L + R_XCB + (32 * tb + r) * SQ + (16 * ks + 8 * hh) * 2); R = mfma32(a, Br[ks], R); I = mfma32(a, Bi[ks], I); }
        float av[16], uv[16];
#pragma unroll
        for (int i = 0; i < 16; ++i) { const int t = 32 * tb + crow(i, hh); const float xc = XCF[t * 128 + j];
            const float e1 = fexp(fminf(-(R[i] + brv), 40.f)), e2 = fexp(fminf(-(I[i] + biv), 40.f)), p1 = 1.0f + e1, p2 = 1.0f + e2, inv = rcp(p1 * p2);
            const float rr = p2 * inv, ii = p1 * inv;
            const float la = -8.0f * rr * sp, a = fexp(la), x2 = 2.0f * la;
            const float ser = -x2 * (1.0f + 0.5f * x2 * (1.0f + 0.33333334f * x2 * (1.0f + 0.25f * x2 * (1.0f + 0.2f * x2))));
            const float om = fabsf(x2) < 0.25f ? ser : 1.0f - a * a;
            av[i] = a; uv[i] = __builtin_amdgcn_sqrtf(fmaxf(om, 0.f)) * (ii * xc); }
#pragma unroll
        for (int g = 0; g < 4; ++g) { float A = 1.f, U = 0.f;
#pragma unroll
            for (int m = 0; m < 4; ++m) { U = av[4 * g + m] * U + uv[4 * g + m]; A *= av[4 * g + m]; }
            const int gi = 8 * tb + 2 * g + hh; SUMA[gi * 128 + j] = A; SUMU[gi * 128 + j] = U; }
        lds_barrier();
        if (tid < 128) { float hc = hcarry;
#pragma unroll
            for (int gi = 0; gi < 16; ++gi) { HIN[gi * 128 + tid] = hc; hc = SUMA[gi * 128 + tid] * hc + SUMU[gi * 128 + tid]; }
            hcarry = hc; }
        lds_barrier();
        { bf16_t* pm = c.mix + (size_t)(row0 + t0 + 32 * tb) * D_MIX; const int moff = 4 * hh * D_MIX + 1024 + ch;
#pragma unroll
          for (int g = 0; g < 4; ++g) { float hc = HIN[(8 * tb + 2 * g + hh) * 128 + j];
#pragma unroll
            for (int m = 0; m < 4; ++m) { const int i = 4 * g + m; hc = av[i] * hc + uv[i];
                (pm + (size_t)((i & 3) + 8 * (i >> 2)) * D_MIX)[moff] = (bf16_t)f2bf(hc * gt[i]); } } }
    }
#undef RG_LOAD
    if (tid < 128) c.out[O_RG_P + ((size_t)l * NB + b) * 1024 + n * 128 + tid] = hcarry;
}

DI void rg_sample_unit(const Ctx& c, int l, int n) {
    LAS unsigned char* L = c.lds;
    const int tid = get_tid(c.wave), lane = tid & 63, w = c.wave, r = lane & 31, hh = lane >> 5;
    const int tb = w >> 2, jb = w & 3;
    const int j = 32 * jb + r, ch = n * 128 + j;
    LAS float* XCF = (LAS float*)(L + R_XCF);
    bf16x8 Br[8], Bi[8];
    rg_load_gates(c, l, n, tid, j, hh, Br, Bi);
    const float sp = softplus(-c.in[I_LAM][l * 1024 + ch]), brv = c.in[I_BR][(l * 8 + n) * 128 + j], biv = c.in[I_BI][(l * 8 + n) * 128 + j];
    float cw[4][2], cb[2];
#pragma unroll
    for (int e = 0; e < 2; ++e) {
#pragma unroll
        for (int m = 0; m < 4; ++m) cw[m][e] = c.in[I_RCW][l * 4 * 1024 + m * 1024 + n * 128 + 2 * lane + e];
        cb[e] = c.in[I_RCB][l * 1024 + n * 128 + 2 * lane + e]; }
    for (int chunk = 0; chunk < 2; ++chunk) {
        __syncthreads();
#pragma unroll
        for (int i = 0; i < 8; ++i) { const int t = 8 * w + i, s = 64 * chunk + t;
            const float* buf = c.in[I_SRGC] + ((size_t)l * DEC + s) * 3 * 1024 + n * 128 + 2 * lane;
            const f32x2 b0 = *(const f32x2*)buf, b1 = *(const f32x2*)(buf + 1024), b2 = *(const f32x2*)(buf + 2048), xn = (f32x2){ps4(c.projs + (size_t)s * LDP + C_RGX + n * 128 + 2 * lane), ps4(c.projs + (size_t)s * LDP + C_RGX + n * 128 + 2 * lane + 1)} * row_rstd(c.rowsq + (size_t)l * M_PAD, TP + s);
            const float x0 = cb[0] + cw[0][0] * b0.x + cw[1][0] * b1.x + cw[2][0] * b2.x + cw[3][0] * xn.x;
            const float x1 = cb[1] + cw[0][1] * b0.y + cw[1][1] * b1.y + cw[2][1] * b2.y + cw[3][1] * xn.y;
            *(LAS f32x2*)(XCF + t * 128 + 2 * lane) = (f32x2){x0, x1}; *(LAS unsigned*)(L + R_XCB + t * SQ + 4 * lane) = pk2(x0, x1); }
        __syncthreads();
        f32x16 R, I; ZERO16(R); ZERO16(I);
#pragma unroll
        for (int ks = 0; ks < 8; ++ks) { const bf16x8 a = ldfrag(L + R_XCB + (32 * tb + r) * SQ + (16 * ks + 8 * hh) * 2); R = mfma32(a, Br[ks], R); I = mfma32(a, Bi[ks], I); }
#pragma unroll
        for (int i = 0; i < 16; ++i) { const int t = 32 * tb + crow(i, hh), s = 64 * chunk + t;
            const float rr = sigm(R[i] + brv), ii = sigm(I[i] + biv), xc = XCF[t * 128 + j];
            const float la = -8.0f * rr * sp, a = fexp(la);
            const float hn = a * c.in[I_SRG][((size_t)l * DEC + s) * 1024 + ch] + sqrtf(fmaxf(neg_expm1(2.0f * la), 0.f)) * (ii * xc);
            c.mix[(size_t)(TP + s) * D_MIX + 1024 + ch] = (bf16_t)f2bf(hn * silu(ps4(c.projs + (size_t)s * LDP + C_RGG + ch) * row_rstd(c.rowsq + (size_t)l * M_PAD, TP + s)));
            c.out[O_RG_S + ((size_t)l * DEC + s) * 1024 + ch] = hn; }
    }
}

#ifndef PROBE_REP_LONG
#define PROBE_REP_LONG 1
#endif
#ifndef PROBE_G1_REP
#define PROBE_G1_REP 1
#endif
#ifndef PROBE_REP_SHORT
#define PROBE_REP_SHORT 1
#endif
DI void xbc_prepass_item(const Ctx& c, int l, int it) {
    const int tid = get_tid(c.wave);
    const float* scw = c.in[I_SCW] + (size_t)l * 4 * 1536; const float* scb = c.in[I_SCB] + (size_t)l * 1536;
    const int r0 = it * 32; const bool head = (r0 & (SEQ - 1)) == 0;
    for (int p = tid; p < 768; p += 512) {
        float cw[4][2], cb[2];
#pragma unroll
        for (int e = 0; e < 2; ++e) { cb[e] = scb[2 * p + e];
#pragma unroll
            for (int m = 0; m < 4; ++m) cw[m][e] = scw[m * 1536 + 2 * p + e]; }
        const bf16_t* src = c.proj + (size_t)r0 * LDP + C_XBC + 2 * p; bf16_t* dst = c.xbcs + (size_t)r0 * 1536 + 2 * p;
        unsigned u[35];
#pragma unroll
        for (int i = 0; i < 35; ++i) u[i] = (head && i < 3) ? 0u : *(const unsigned*)(src + (ptrdiff_t)(i - 3) * LDP);
#pragma unroll
        for (int i = 0; i < 32; ++i) {
            const float a = silu(cb[0] + cw[0][0] * bflo(u[i]) + cw[1][0] * bflo(u[i + 1]) + cw[2][0] * bflo(u[i + 2]) + cw[3][0] * bflo(u[i + 3]));
            const float b = silu(cb[1] + cw[0][1] * bfhi(u[i]) + cw[1][1] * bfhi(u[i + 1]) + cw[2][1] * bfhi(u[i + 2]) + cw[3][1] * bfhi(u[i + 3]));
            *(unsigned*)(dst + (size_t)i * 1536) = pk2(a, b); }
    }
}
DI void phase_mixer(int l, int wv) {
    const Ctx c = make_ctx(wv);
    constexpr int PER_B = 8 + 8 + 8 + 8;
    constexpr int N_LONG = NB * PER_B, N_SHORT = 8 + DEC * 3;
    constexpr int NREP = 1;
    volatile LAS int* slot = (volatile LAS int*)(c.lds + MISC_OFF + 64);
    unsigned* xpre = c.ctl + CW_XPRE + 64 * l;
    if (c.wg >= N_LONG || c.G <= N_LONG) {
        const int nfree = c.G > N_LONG ? c.G - N_LONG : c.G, first = c.G > N_LONG ? c.wg - N_LONG : c.wg; int done = 0;
        for (int it = first; it < TP / 32; it += nfree) { xbc_prepass_item(c, l, it); ++done; }
        asm volatile("s_waitcnt vmcnt(0)" ::: "memory"); __syncthreads();
        if (c.tid == 0) { __builtin_amdgcn_fence(__ATOMIC_RELEASE, "agent"); asm volatile("s_waitcnt vmcnt(0)" ::: "memory"); __hip_atomic_fetch_add(xpre, (unsigned)done, __ATOMIC_RELAXED, __HIP_MEMORY_SCOPE_AGENT); }
    }
    for (int rep = 0; rep < NREP; ++rep) {
    unsigned* ctr = c.ctl + CW_QCTR + 64 * (l * 4 + rep);
    int cur = c.wg; bool dyn = false;
    for (;;) {
        int item;
        if (!dyn) { if (cur < N_LONG) { item = cur; cur += c.G; } else { dyn = true; continue; } }
        else {
            __syncthreads();
            if (c.tid == 0) *slot = (int)atomicAdd(ctr, 1u);
            __syncthreads();
            item = N_LONG + *slot;
            if (item >= N_LONG + N_SHORT) break;
        }
        if (item < N_LONG) {
            const int b = item & 3, u = item >> 2;
            if (u < 8) la_head_unit<1>(c, l, b, u); else if (u < 16) la_head_unit<0>(c, l, b, u - 8); else if (u < 24) {
                if (c.tid == 0) { unsigned sp = 0; while (__hip_atomic_load(xpre, __ATOMIC_RELAXED, __HIP_MEMORY_SCOPE_AGENT) < (unsigned)(TP / 32)) { __builtin_amdgcn_s_sleep(8); if (++sp > (1u << 22)) break; }
                    __builtin_amdgcn_fence(__ATOMIC_ACQUIRE, "agent"); asm volatile("s_waitcnt vmcnt(0)" ::: "memory"); }
                __syncthreads();
                la_head_unit<2>(c, l, b, u - 16); } else rg_chunk_unit(c, l, b, u - 24);
            __syncthreads();
        } else { const int it = item - N_LONG;
            for (int rp = 0; rp < PROBE_REP_SHORT; ++rp) { if (it < 8) rg_sample_unit(c, l, it); else sample_item(c, l, (it - 8) / 3, (it - 8) % 3); } }
    }
    __syncthreads();
    }
}

DI void phase_finalize(int l, int wv) {
    const Ctx c = make_ctx(wv);
    const int gw = c.wg * 8 + c.wave, NGW = c.G * 8, lane = c.lane;
    const float* ssn = c.in[I_SSN] + (size_t)l * 1024;
    const float* stats = (const float*)(c.ctl + CW_STATS) + (size_t)l * TP * 6;
    const f32x4 w00 = *(const f32x4*)(ssn + lane * 16), w01 = *(const f32x4*)(ssn + lane * 16 + 4), w10 = *(const f32x4*)(ssn + lane * 16 + 8), w11 = *(const f32x4*)(ssn + lane * 16 + 12);
    for (int r0 = gw; r0 < TP; r0 += 4 * NGW) {
        u32x4 sv[4][2], gv[4][2]; float rs[4], rg[4];
#pragma unroll
        for (int i = 0; i < 4; ++i) { const int r = r0 + i * NGW;
            if (r < TP) { const bf16_t* mrow = c.mix + (size_t)r * D_MIX;
                rs[i] = stats[(size_t)r * 6 + (lane >> 5)]; rg[i] = stats[(size_t)r * 6 + 2 + (lane >> 4)];
                sv[i][0] = *(const u32x4*)(mrow + 3072 + lane * 16); sv[i][1] = *(const u32x4*)(mrow + 3072 + lane * 16 + 8);
                gv[i][0] = *(const u32x4*)(mrow + 2048 + lane * 16); gv[i][1] = *(const u32x4*)(mrow + 2048 + lane * 16 + 8); } }
#pragma unroll
        for (int i = 0; i < 4; ++i) { const int r = r0 + i * NGW;
            if (r < TP) { bf16_t* mrow = c.mix + (size_t)r * D_MIX;
                const float s = rsqrtf(rs[i] * (1.0f / 512.0f) + EPS), g = rsqrtf(rg[i] * (1.0f / 256.0f) + EPS);
#pragma unroll
                for (int q = 0; q < 2; ++q) { const u32x4 ov = sv[i][q]; const f32x4 w0 = q ? w10 : w00, w1 = q ? w11 : w01; u32x4 nv;
                    nv.x = pk2(bflo(ov.x) * s * w0.x, bfhi(ov.x) * s * w0.y); nv.y = pk2(bflo(ov.y) * s * w0.z, bfhi(ov.y) * s * w0.w);
                    nv.z = pk2(bflo(ov.z) * s * w1.x, bfhi(ov.z) * s * w1.y); nv.w = pk2(bflo(ov.w) * s * w1.z, bfhi(ov.w) * s * w1.w); *(u32x4*)(mrow + 3072 + lane * 16 + 8 * q) = nv;
                    const u32x4 gg = gv[i][q]; u32x4 ng;
                    ng.x = pk2(bflo(gg.x) * g, bfhi(gg.x) * g); ng.y = pk2(bflo(gg.y) * g, bfhi(gg.y) * g); ng.z = pk2(bflo(gg.z) * g, bfhi(gg.z) * g); ng.w = pk2(bflo(gg.w) * g, bfhi(gg.w) * g); *(u32x4*)(mrow + 2048 + lane * 16 + 8 * q) = ng; } } }
    }
    const int gt = c.wg * 512 + c.tid, NGT = c.G * 512;
    for (int i = gt; i < NB * 3 * 2560; i += NGT) {
        const int q = i / 7680, e = i % 7680, j = e / 2560, ch = e % 2560; const bool isrg = ch < 1024; const int chh = isrg ? ch : ch - 1024;
        const float v = bf1(c.proj[(size_t)(q * SEQ + SEQ - 3 + j) * LDP + (isrg ? C_RGX : C_XBC) + chh]);
        c.out[isrg ? O_RGC_P + ((size_t)l * NB + q) * 3072 + j * 1024 + chh : O_SSDC_P + ((size_t)l * NB + q) * 4608 + j * 1536 + chh] = v;
    }
    for (int i = gt; i < DEC * 1280; i += NGT) {
        const int s = i / 1280, e = i % 1280;
        if (e < 512) ((f32x4*)(c.out + O_RGC_S + ((size_t)l * DEC + s) * 3072))[e] = ((const f32x4*)(c.in[I_SRGC] + ((size_t)l * DEC + s) * 3072 + 1024))[e];
        else ((f32x4*)(c.out + O_SSDC_S + ((size_t)l * DEC + s) * 4608))[e - 512] = ((const f32x4*)(c.in[I_SSSDC] + ((size_t)l * DEC + s) * 4608 + 1536))[e - 512];
    }
    for (int i = gt; i < DEC * 2560; i += NGT) {
        const int s = i / 2560, ch = i % 2560; const bool isrg = ch < 1024; const int chh = isrg ? ch : ch - 1024;
        const float v = ps4(c.projs + (size_t)s * LDP + (isrg ? C_RGX : C_XBC) + chh) * row_rstd(c.rowsq + (size_t)l * M_PAD, TP + s);
        c.out[isrg ? O_RGC_S + ((size_t)l * DEC + s) * 3072 + 2048 + chh : O_SSDC_S + ((size_t)l * DEC + s) * 4608 + 3072 + chh] = v;
    }
}

DI void phase_dt(const Ctx& c, int l) {
    LAS float* PT = (LAS float*)c.lds;
    const int tid = get_tid(c.wave), lane = tid & 63, w = c.wave, r = lane & 31, hh = lane >> 5;
    for (int rt = c.wg; rt < TP / 32; rt += c.G) {
        const bf16_t* pa = c.xb + (size_t)(rt * 32 + r) * D_MODEL + w * 256 + 8 * hh;
        const bf16_t* pb = c.win + ((size_t)l * LDP + C_DT + r) * D_MODEL + w * 256 + 8 * hh;
        f32x16 acc; ZERO16(acc);
#pragma unroll
        for (int k4 = 0; k4 < 16; k4 += 8) { bf16x8 fa[8], fb[8];
#pragma unroll
            for (int u = 0; u < 8; ++u) { fa[u] = *(const bf16x8*)(pa + 16 * (k4 + u)); fb[u] = *(const bf16x8*)(pb + 16 * (k4 + u)); }
#pragma unroll
            for (int u = 0; u < 8; ++u) acc = mfma32(fa[u], fb[u], acc); }
        __syncthreads();
#pragma unroll
        for (int i = 0; i < 16; ++i) PT[w * 1024 + crow(i, hh) * 32 + r] = acc[i];
        __syncthreads();
        { const int row = tid >> 4, col = tid & 15; float s = 0.f;
#pragma unroll
          for (int q = 0; q < 8; ++q) s += PT[q * 1024 + row * 32 + col];
          c.dtb[(size_t)(rt * 32 + row) * 16 + col] = softplus(s * row_rstd(c.rowsq + (size_t)l * M_PAD, rt * 32 + row) + c.in[I_DTB][l * 16 + col]); }
    }
}

DI void g2_sample(const Ctx& c, int l) {
    LAS float* PT = (LAS float*)c.lds;
    const int tid = get_tid(c.wave), lane = tid & 63, w = c.wave, rr = lane & 15, quad = lane >> 4;
    float* rsq_next = c.rowsq + (size_t)(l + 1) * M_PAD;
    for (int ct = c.wg; ct < D_MODEL / 8; ct += c.G) {
        const bf16_t* pa = c.mix + (size_t)(TP + rr) * D_MIX + 512 * w + 8 * quad;
        const bf16_t* pb = c.wout + (size_t)l * D_MODEL * D_MIX + (size_t)(8 * ct + (rr & 7)) * D_MIX + 512 * w + 8 * quad;
        f32x4 acc[8];
#pragma unroll
        for (int rt = 0; rt < 8; ++rt) acc[rt] = (f32x4){0.f, 0.f, 0.f, 0.f};
#pragma unroll 1
        for (int k2 = 0; k2 < 16; k2 += 2) { bf16x8 fa[2][8], fb[2];
#pragma unroll
            for (int u = 0; u < 2; ++u) { fb[u] = *(const bf16x8*)(pb + 32 * (k2 + u));
#pragma unroll
                for (int rt = 0; rt < 8; ++rt) fa[u][rt] = *(const bf16x8*)(pa + (size_t)16 * rt * D_MIX + 32 * (k2 + u)); }
#pragma unroll
            for (int u = 0; u < 2; ++u) { const bf16x8 z = {0, 0, 0, 0, 0, 0, 0, 0}; const bf16x8 bb = rr < 8 ? fb[u] : z;
#pragma unroll
                for (int rt = 0; rt < 8; ++rt) acc[rt] = __builtin_amdgcn_mfma_f32_16x16x32_bf16(fa[u][rt], bb, acc[rt], 0, 0, 0); } }
        __syncthreads();
#pragma unroll
        for (int rt = 0; rt < 8; ++rt)
#pragma unroll
            for (int j = 0; j < 4; ++j) PT[(w * 128 + 16 * rt + 4 * quad + j) * 16 + rr] = acc[rt][j];
        __syncthreads();
        { const int row = tid >> 2, c2 = 2 * (tid & 3); float x0 = 0.f, x1 = 0.f;
#pragma unroll
          for (int q = 0; q < 8; ++q) { const f32x2 t = *(const LAS f32x2*)(PT + (q * 128 + row) * 16 + c2); x0 += t.x; x1 += t.y; }
          unsigned* xp = (unsigned*)(c.xb + (size_t)(TP + row) * D_MODEL + 8 * ct + c2); const unsigned o = *xp;
          x0 += bflo(o); x1 += bfhi(o); *xp = pk2(x0, x1);
          float ss = x0 * x0 + x1 * x1; ss += shx(ss, 1, lane); ss += shx(ss, 2, lane);
          if ((tid & 3) == 0) atomicAdd(rsq_next + TP + row, ss); }
    }
}

__global__ void __launch_bounds__(512, 2) mk_fwd(Params p) {
    extern __shared__ __attribute__((aligned(16))) unsigned char lds_raw[];
    LAS unsigned char* lds = (LAS unsigned char*)lds_raw;
    volatile LAS unsigned* misc = (volatile LAS unsigned*)(lds + MISC_OFF);
    const int wv = __builtin_amdgcn_readfirstlane(threadIdx.x >> 6);
    if (threadIdx.x < 32) misc[threadIdx.x] = 0u;
    __syncthreads();
    const int lo = p.ph_lo, hi = p.ph_hi;
    unsigned* barw = (unsigned*)(p.ws + WS_CTL) + CW_BAR;
    XcdBarrier bar; bar.bar = barw; bar.x = 0; bar.st = misc;
    if (hi - lo > 1) bar = xcd_barrier_post(barw, misc, get_tid(wv));
#define PH_IN(k) (lo <= (k) && (k) < hi)
#define SEAM(k) do { if (PH_IN(k) && PH_IN((k) + 1)) xcd_barrier(bar, wv); } while (0)
    if (PH_IN(0)) { phase_prologue(wv); }
    SEAM(0);
    for (int l = 0; l < DEPTH; ++l) {
        const int pb = 1 + 4 * l;
        if (PH_IN(pb)) {
            __syncthreads();
            const Ctx c = make_ctx(wv);
            {
                pg8::Gemm g{c.xb, c.win + (size_t)l * LDP * D_MODEL, TP, N_MAIN, D_MODEL, D_MODEL, D_MODEL}; pg8::StaticOrder S; S.init(TP, N_MAIN, c.G, c.wg); S.rep = PROBE_G1;
                pg8::EpiProj E{c.proj, c.lb + (size_t)l * 1024, c.in[I_HGN] + (size_t)l * 1024, c.in[I_GLN] + (size_t)l * 1024, c.in[I_GBU] + (size_t)l * 512, c.rowsq + (size_t)l * M_PAD};
                pg8::gemm_phase<pg8::EpiProj, pg8::StaticOrder>(c.lds, g, S, E, wv); }
            __syncthreads();
            {
                const int pn = c.wg % 49, ks = c.wg / 49;
                pg8::Gemm g{c.xb + (size_t)TP * D_MODEL + ks * 512, c.win + (size_t)l * LDP * D_MODEL + ks * 512, 256, LDP, 512, D_MODEL, D_MODEL};
                pg8::OneUnit S{0, pn, c.wg < 196 ? 1 : 0};
                pg8::EpiSample E{c.projs + (size_t)ks * PST};
                pg8::gemm_phase<pg8::EpiSample, pg8::OneUnit>(c.lds, g, S, E, wv); }
            __syncthreads();
            phase_dt(c, l);
            __syncthreads();
        }
        SEAM(pb);
        if (PH_IN(pb + 1)) phase_mixer(l, wv);
        SEAM(pb + 1);
        if (PH_IN(pb + 2)) phase_finalize(l, wv);
        SEAM(pb + 2);
        if (PH_IN(pb + 3)) {
            __syncthreads();
            const Ctx c = make_ctx(wv);
            {
                pg8::Gemm g{c.mix, c.wout + (size_t)l * D_MODEL * D_MIX, TP, D_MODEL, D_MIX, D_MIX, D_MIX}; pg8::StaticOrder S; S.init(TP, D_MODEL, c.G, c.wg);
                pg8::EpiResid E{c.xb, c.rowsq + (size_t)(l + 1) * M_PAD};
                pg8::gemm_phase<pg8::EpiResid, pg8::StaticOrder>(c.lds, g, S, E, wv); }
            __syncthreads();
            g2_sample(c, l);
            __syncthreads();
        }
        SEAM(pb + 3);
    }
    if (PH_IN(NPHASE - 1)) phase_final_norm(wv);
#undef PH_IN
#undef SEAM
}

extern "C" void kernel_launch(void* const* d_in, const int* in_sizes, int n_in, void* d_out, int out_size, void* d_ws, size_t ws_size, hipStream_t stream) {
    static int grid = 0;
    if (grid == 0) {
        if (n_in != N_INPUTS || (size_t)out_size != O_END || ws_size < WS_END) { fprintf(stderr, "kernel_launch: unexpected shapes (n_in %d out %d ws %zu)\n", n_in, out_size, ws_size); grid = -1; return; }
        int dev = 0, cus = 0;
        if (hipGetDevice(&dev) != hipSuccess || hipDeviceGetAttribute(&cus, hipDeviceAttributeMultiprocessorCount, dev) != hipSuccess) { grid = -1; return; }
        if (hipFuncSetAttribute((const void*)mk_fwd, hipFuncAttributeMaxDynamicSharedMemorySize, LDS_BYTES) != hipSuccess) { fprintf(stderr, "kernel_launch: hipFuncSetAttribute failed\n"); grid = -1; return; }
        int per_cu = 0;
        if (hipOccupancyMaxActiveBlocksPerMultiprocessor(&per_cu, (const void*)mk_fwd, 512, LDS_BYTES) != hipSuccess || per_cu < 1) fprintf(stderr, "kernel_launch: occupancy query says %d\n", per_cu);
        (void)hipGetLastError();
        grid = cus;
    }
    if (grid < 0) return;
    (void)hipMemsetAsync((char*)d_ws + WS_CTL, 0, CTL_ZERO_BYTES, stream);
    Params p{};
    for (int i = 0; i < N_INPUTS; ++i) p.in[i] = (const float*)d_in[i];
    p.out = (float*)d_out; p.ws = (unsigned char*)d_ws;
#if MK_ONE_LAUNCH
    p.ph_lo = 0; p.ph_hi = NPHASE;
    hipLaunchKernelGGL(mk_fwd, dim3(grid), dim3(512), LDS_BYTES, stream, p);
#else
    for (int ph = 0; ph < NPHASE; ++ph) { p.ph_lo = ph; p.ph_hi = ph + 1; hipLaunchKernelGGL(mk_fwd, dim3(grid), dim3(512), LDS_BYTES, stream, p); }
#endif
}
```

```cpp
#include <hip/hip_runtime.h>
#include <cstdio>
#include <cstdint>

#ifndef MK_ONE_LAUNCH
#define MK_ONE_LAUNCH 1
#endif

#ifndef PROBE_LONG_REP
#define PROBE_LONG_REP 1
#endif
#ifndef PROBE_RG_REP
#define PROBE_RG_REP PROBE_LONG_REP
#endif
#ifndef PROBE_G1_NOEPI
#define PROBE_G1_NOEPI 0
#endif
#ifndef PROBE_G2
#define PROBE_G2 0
#endif
#ifndef PROBE_G1
#define PROBE_G1 1
#endif
#define LAS __attribute__((address_space(3)))
#define DI __device__ __forceinline__

constexpr int D_MODEL = 2048, NB = 4, SEQ = 2048, DEPTH = 4, DEC = 128;
constexpr int BRANCH = 1024, D_MIX = 4096;
constexpr int TP = NB * SEQ;
constexpr int TT = TP + DEC;
constexpr int M_PAD = 8448;
constexpr int N_IN = 11808;
constexpr int LDP = 12544;
constexpr int N_MAIN = 12288;
constexpr int PST = 128 * LDP;
constexpr float EPS = 1e-6f, TINY = 1e-30f;
constexpr int C_HGQ = 0, C_HGF = 1024, C_HGI = 2048, C_HGG = 3072, C_RGX = 4096, C_RGG = 5120, C_GLQ = 6144, C_GLK = 6656, C_GLV = 7168, C_GLG = 8192,
              C_GLF = 9216, C_SSZ = 9728, C_XBC = 10752, C_DT = 12288;
constexpr int SRC_GLA = 9216, SRC_SSZ = 9232, SRC_DT = 11792;
enum { I_XP = 0, I_XS, I_SHG, I_SRG, I_SRGC, I_SGLA, I_SSSD, I_SSSDC, I_RMS, I_WIN, I_LB, I_HGN, I_RCW, I_RCB, I_WR, I_BR, I_WI, I_BI, I_LAM,
       I_GWU, I_GBU, I_GLN, I_SCW, I_SCB, I_DTB, I_ALOG, I_SD, I_SSN, I_WOUT, I_RMSF, N_INPUTS };
constexpr size_t O_YP = 0, O_YS = (size_t)TP * D_MODEL, O_HG_P = O_YS + (size_t)DEC * D_MODEL,
    O_RG_P = O_HG_P + (size_t)DEPTH * NB * 131072, O_RGC_P = O_RG_P + (size_t)DEPTH * NB * 1024, O_GLA_P = O_RGC_P + (size_t)DEPTH * NB * 3072,
    O_SSD_P = O_GLA_P + (size_t)DEPTH * NB * 131072, O_SSDC_P = O_SSD_P + (size_t)DEPTH * NB * 131072, O_HG_S = O_SSDC_P + (size_t)DEPTH * NB * 4608,
    O_RG_S = O_HG_S + (size_t)DEPTH * DEC * 131072, O_RGC_S = O_RG_S + (size_t)DEPTH * DEC * 1024, O_GLA_S = O_RGC_S + (size_t)DEPTH * DEC * 3072,
    O_SSD_S = O_GLA_S + (size_t)DEPTH * DEC * 131072, O_SSDC_S = O_SSD_S + (size_t)DEPTH * DEC * 131072, O_END = O_SSDC_S + (size_t)DEPTH * DEC * 4608;
constexpr size_t MiB = 1u << 20;
constexpr size_t WS_CTL = 0, CTL_ZERO_BYTES = 2 * MiB, WS_LB = 2 * MiB, WS_WIN = 3 * MiB, WS_WOUT = 199 * MiB, WS_XB = 263 * MiB, WS_PROJ = 296 * MiB,
    WS_DTB = 492 * MiB, WS_MIX = 493 * MiB, WS_PROJS = 559 * MiB, WS_XBCS = 584 * MiB, WS_END = 608 * MiB;
static_assert(WS_WIN + (size_t)DEPTH * LDP * D_MODEL * 2 <= WS_WOUT && WS_WOUT + (size_t)DEPTH * D_MODEL * D_MIX * 2 <= WS_XB && WS_XB + (size_t)M_PAD * D_MODEL * 2 <= WS_PROJ &&
              WS_PROJ + (size_t)TP * LDP * 2 <= WS_DTB && WS_DTB + (size_t)TP * 16 * 4 <= WS_MIX &&
              WS_MIX + (size_t)M_PAD * D_MIX * 2 <= WS_PROJS && WS_PROJS + (size_t)4 * DEC * LDP * 4 <= WS_XBCS && WS_XBCS + (size_t)TP * 1536 * 2 <= WS_END, "ws map");
constexpr int CW_BAR = 4096, CW_QCTR = 16384, CW_XPRE = 24576  , CW_STATS = 32768, CW_ROWSQ = 262144;
static_assert(CW_STATS + DEPTH * TP * 6 <= CW_ROWSQ && (size_t)(CW_ROWSQ + (DEPTH + 1) * M_PAD) * 4 <= CTL_ZERO_BYTES, "ctl map");
constexpr int LDS_BYTES = 147456, MISC_OFF = LDS_BYTES - 256;
constexpr int NPHASE = 2 + 3 * DEPTH;

typedef unsigned short bf16_t;
typedef short bf16x8 __attribute__((ext_vector_type(8)));
typedef float f32x4 __attribute__((ext_vector_type(4)));
typedef float f32x2 __attribute__((ext_vector_type(2)));
typedef float f32x16 __attribute__((ext_vector_type(16)));
typedef unsigned u32x4 __attribute__((ext_vector_type(4)));
typedef unsigned u32x2 __attribute__((ext_vector_type(2)));
typedef __bf16 bf16v2 __attribute__((ext_vector_type(2)));

DI unsigned pk2(float lo, float hi) { const f32x2 v = {lo, hi}; return __builtin_bit_cast(unsigned, __builtin_convertvector(v, bf16v2)); }
DI unsigned f2bf(float f) { return pk2(f, 0.f) & 0xffffu; }
DI float bflo(unsigned u) { return __builtin_bit_cast(float, u << 16); }
DI float bfhi(unsigned u) { return __builtin_bit_cast(float, u & 0xffff0000u); }
DI float bf1(bf16_t u) { return __builtin_bit_cast(float, (unsigned)u << 16); }
DI float ex2(float x) { return __builtin_amdgcn_exp2f(x); }
DI float lg2(float x) { return __builtin_amdgcn_logf(x); }
DI float rcp(float x) { return __builtin_amdgcn_rcpf(x); }
constexpr float LOG2E = 1.4426950408889634f, LN2 = 0.6931471805599453f;
DI float fexp(float x) { return ex2(x * LOG2E); }
DI float flog(float x) { return lg2(x) * LN2; }
DI float sigm(float x) { return rcp(1.0f + fexp(-x)); }
DI float silu(float x) { return x * sigm(x); }
DI float sigm_fast(float x) { return sigm(x); }
DI float silu_fast(float x) { return silu(x); }
DI float log1p_pos(float e) { const float a = e * (1.0f - e * (0.5f - e * (0.33333334f - 0.25f * e))), b = flog(1.0f + e); return e < 0.03f ? a : b; }
DI float softplus(float x) { return fmaxf(x, 0.f) + log1p_pos(fexp(-fabsf(x))); }
DI float neg_expm1(float x) { const float a = -x * (1.0f + 0.5f * x * (1.0f + 0.33333334f * x * (1.0f + 0.25f * x * (1.0f + 0.2f * x)))), b = 1.0f - fexp(x); return fabsf(x) < 0.25f ? a : b; }
DI float row_rstd(const float* rowsq, int row) { return __builtin_amdgcn_rsqf(rowsq[row] * (1.0f / D_MODEL) + EPS); }
DI float clampf(float x, float lo, float hi) { return fminf(fmaxf(x, lo), hi); }
DI float shx(float v, int mask, int lane) { return __builtin_bit_cast(float, __builtin_amdgcn_ds_bpermute((lane ^ mask) << 2, __builtin_bit_cast(int, v))); }
DI float shup(float v, int o, int lane) { return __builtin_bit_cast(float, __builtin_amdgcn_ds_bpermute((lane >= o ? lane - o : lane) << 2, __builtin_bit_cast(int, v))); }
DI float wave_sum(float v, int lane) {
#pragma unroll
    for (int o = 1; o < 64; o <<= 1) v += shx(v, o, lane);
    return v;
}

struct Params { const float* in[N_INPUTS]; float* out; unsigned char* ws; int ph_lo, ph_hi; };
static_assert(sizeof(Params) == N_INPUTS * 8 + 8 + 8 + 8, "no padding holes in Params");
typedef const __attribute__((address_space(4))) Params* KP;
DI KP get_params() { auto kp = __builtin_amdgcn_kernarg_segment_ptr(); asm volatile("" : "+s"(kp)); return (KP)kp; }
DI int get_tid(int wv) { int ln; asm volatile("v_mbcnt_lo_u32_b32 %0, -1, 0\n\tv_mbcnt_hi_u32_b32 %0, -1, %0" : "=v"(ln)); return (wv << 6) | ln; }

#define XB_TMO      128
#define XB_XCNT(j)  (256  + 64 * (j))
#define XB_XSUB(j)  (1280 + 64 * (j))
#define XB_XGEN(j)  (2304 + 64 * (j))
#define XB_TOP      3328
#define XB_TOPGEN   3392
#define XCD_BAR_WORDS 3456
#define XB_SPIN_CAP (1u << 20)
DI unsigned xb_ld(unsigned* p)              { return __hip_atomic_load(p, __ATOMIC_RELAXED, __HIP_MEMORY_SCOPE_AGENT); }
DI unsigned xb_add(unsigned* p, unsigned v) { return __hip_atomic_fetch_add(p, v, __ATOMIC_RELAXED, __HIP_MEMORY_SCOPE_AGENT); }
DI unsigned xb_xcc_id() { return (unsigned)__builtin_amdgcn_s_getreg((3 << 11) | 20) & 0xFu; }
#define XB_SPIN(cond, bar) do { unsigned _sp = 0; while (cond) { __builtin_amdgcn_s_sleep(1); \
    if ((++_sp & 255u) == 0u) { if (xb_ld(&(bar)[XB_TMO])) break; if (_sp > XB_SPIN_CAP) { atomicAdd(&(bar)[XB_TMO], 1u); break; } } } } while (0)
struct XcdBarrier { unsigned* bar; unsigned x; volatile LAS unsigned* st; };
DI XcdBarrier xcd_barrier_post(unsigned* bar, volatile LAS unsigned* st, int tid) {
    XcdBarrier b; b.bar = bar; b.x = xb_xcc_id(); b.st = st;
    if (tid == 0) (void)xb_add(&bar[XB_XCNT(b.x)], 1u);
    return b;
}
DI void xcd_barrier_complete(unsigned* bar, unsigned x, unsigned& nloc, unsigned& nx) {
    const unsigned G = gridDim.x * gridDim.y * gridDim.z;
    unsigned sum, cnt, mine, sp = 0u;
    for (;;) {
        sum = 0u; cnt = 0u; mine = 0u;
#pragma unroll
        for (unsigned j = 0; j < 16; ++j) { const unsigned c = xb_ld(&bar[XB_XCNT(j)]); sum += c; cnt += (c > 0u) ? 1u : 0u; mine = (j == x) ? c : mine; }
        if (sum == G) break;
        __builtin_amdgcn_s_sleep(1);
        if ((++sp & 255u) == 0u) { if (xb_ld(&bar[XB_TMO])) break; if (sp > XB_SPIN_CAP) { atomicAdd(&bar[XB_TMO], 1u); break; } }
    }
    nloc = mine > 0u ? mine : 1u; nx = cnt > 0u ? cnt : 1u;
}
DI void xcd_barrier(const XcdBarrier& b, int wv) {
    asm volatile("s_waitcnt vmcnt(0)" ::: "memory");
    __syncthreads();
    if (get_tid(wv) == 0) {
        unsigned* bar = b.bar;
        __builtin_amdgcn_s_waitcnt(0);
        unsigned nloc = b.st[0], nx = b.st[1];
        if (nloc == 0u) { xcd_barrier_complete(bar, b.x, nloc, nx); b.st[0] = nloc; b.st[1] = nx; }
        const unsigned old = xb_add(&bar[XB_XSUB(b.x)], 1u);
        const unsigned gen = old / nloc;
        if (old + 1u == (gen + 1u) * nloc) {
            __builtin_amdgcn_fence(__ATOMIC_RELEASE, "agent");
            asm volatile("s_waitcnt vmcnt(0)" ::: "memory");
            const unsigned og = xb_add(&bar[XB_TOP], 1u);
            const unsigned tg = og / nx;
            if (og + 1u == (tg + 1u) * nx) xb_add(&bar[XB_TOPGEN], 1u);
            else XB_SPIN(xb_ld(&bar[XB_TOPGEN]) == tg, bar);
            __builtin_amdgcn_fence(__ATOMIC_ACQUIRE, "agent");
            xb_add(&bar[XB_XGEN(b.x)], 1u);
            asm volatile("s_waitcnt vmcnt(0)" ::: "memory");
        } else {
            XB_SPIN(xb_ld(&bar[XB_XGEN(b.x)]) == gen, bar);
            __builtin_amdgcn_fence(__ATOMIC_ACQUIRE, "agent");
            asm volatile("s_waitcnt vmcnt(0)" ::: "memory");
        }
    }
    __syncthreads();
}

namespace pg8 {
constexpr int BM = 256, BK = 64, HALF = 128, HTB = HALF * BK * 2, STAGE_BYTES = 8 * HTB, NXCD = 8, WGM = 8;
DI int lds_byte(int r, int c) { const int st = (r >> 4) * 2 + (c >> 5), rr = r & 15, cc = c & 31, ob = rr * 64 + cc * 2; return st * 1024 + (ob ^ (((ob >> 9) & 1) << 5)); }
DI void stage_rc(int b, int& R, int& C) { const int st = b / 1024, sb = b % 1024, swz = sb ^ (((sb >> 9) & 1) << 5); R = (st >> 1) * 16 + swz / 64; C = (st & 1) * 32 + (swz % 64) / 2; }
DI int perm32(int rho) { const int n = rho >> 4, i = rho & 15; return 8 * (i >> 2) + 4 * n + (i & 3); }
struct Unit { int pm, pn; };
struct Gemm { const bf16_t* A; const bf16_t* Bt; int M, N, K, lda, ldb; };
struct StaticOrder {
    int nM, nN, nwg, G, c, rep = 1, balance = 0;
    DI void init(int M, int N, int G_, int c_) { nM = M / BM; nN = N / BM; nwg = nM * nN; G = G_; c = c_; }
    DI bool next(int i, Unit& u) const {
        const long L = (long)(i / rep) * G + c; if (L >= nwg) return false;
        int wgid = (int)L; { const int q = nwg / NXCD, r = nwg % NXCD, xcd = wgid % NXCD, off = wgid / NXCD; wgid = (xcd < r ? xcd * (q + 1) : r * (q + 1) + (xcd - r) * q) + off; }
        const int nig = WGM * nN, gid = wgid / nig, fm = gid * WGM, gsz = (nM - fm) < WGM ? (nM - fm) : WGM;
        u.pm = fm + ((wgid % nig) % gsz); u.pn = (wgid % nig) / gsz;
        if (balance) {
            const int p = u.pn / 24, r = u.pn % 24, i = r >> 2, j = r & 3;
            const unsigned long long T0 = 0x1810080c0004ull  , T1 = 0x2a1e1c161424ull  , T2 = 0x2e2c28262220ull  ;
            u.pn = p == 0 ? (int)((T0 >> (8 * i)) & 0xff) + j : j < 2 ? (int)((T1 >> (8 * i)) & 0xff) + j : (int)((T2 >> (8 * i)) & 0xff) + (j - 2);
        }
        return true;
    }
    DI void a_ready(const Unit&) const {}
    DI void done(const Unit&) const {}
};
struct EpiProj {
    static constexpr bool PERM = true, TWICE = PROBE_G1_NOEPI != 0, KSCALE = false;
    bf16_t* P; const float* lb; const float* hgn; const float* gln; const float* bup; const float* rsq;
    template <int MODE>
    DI void body(const f32x4 (&acc)[2][2][4][2], bf16_t* prow, const float* vec, float scale, const float (&rs)[2][4]) const {
        f32x4 cv[2][2];
#pragma unroll
        for (int bj = 0; bj < 2; ++bj) { cv[bj][0] = (f32x4){1.f, 1.f, 1.f, 1.f}; cv[bj][1] = cv[bj][0];
            if constexpr (MODE >= 2) { cv[bj][0] = *(const f32x4*)(vec + bj * HALF); cv[bj][1] = *(const f32x4*)(vec + bj * HALF + 4); } }
#pragma unroll
        for (int bj = 0; bj < 2; ++bj) {
            const f32x4 c0 = cv[bj][0], c1 = cv[bj][1];
#pragma unroll
            for (int ai = 0; ai < 2; ++ai)
#pragma unroll
                for (int m = 0; m < 4; ++m) {
                    f32x4 a = acc[ai][bj][m][0] * rs[ai][m], b = acc[ai][bj][m][1] * rs[ai][m];
                    if constexpr (MODE == 0) { a = a * scale; b = b * scale; }
                    else if constexpr (MODE == 1) { a = (f32x4){silu(a.x), silu(a.y), silu(a.z), silu(a.w)}; b = (f32x4){silu(b.x), silu(b.y), silu(b.z), silu(b.w)}; }
                    else if constexpr (MODE == 2) { a = (f32x4){silu(a.x), silu(a.y), silu(a.z), silu(a.w)} * c0; b = (f32x4){silu(b.x), silu(b.y), silu(b.z), silu(b.w)} * c1; }
                    else if constexpr (MODE == 3) {
#define LOGF(x, l) flog(fmaxf((l) + (1.0f - (l)) * sigm(x), TINY))
                        a = (f32x4){LOGF(a.x, c0.x), LOGF(a.y, c0.y), LOGF(a.z, c0.z), LOGF(a.w, c0.w)}; b = (f32x4){LOGF(b.x, c1.x), LOGF(b.y, c1.y), LOGF(b.z, c1.z), LOGF(b.w, c1.w)};
#undef LOGF
                    } else {
#define LSIG(x, bb) (-0.0625f * (fmaxf(-((x) + (bb)), 0.f) + flog(1.0f + fexp(-fabsf((x) + (bb))))))
                        a = (f32x4){LSIG(a.x, c0.x), LSIG(a.y, c0.y), LSIG(a.z, c0.z), LSIG(a.w, c0.w)}; b = (f32x4){LSIG(b.x, c1.x), LSIG(b.y, c1.y), LSIG(b.z, c1.z), LSIG(b.w, c1.w)};
#undef LSIG
                    }
                    u32x4 w4; w4.x = pk2(a.x, a.y); w4.y = pk2(a.z, a.w); w4.z = pk2(b.x, b.y); w4.w = pk2(b.z, b.w);
                    *(u32x4*)(prow + (size_t)(ai * HALF + m * 16) * LDP + bj * HALF) = w4;
                }
        }
    }
    DI void operator()(const f32x4 (&acc)[2][2][4][2], const Unit& u, int wr, int wc, int fr, int fq) const {
        const int col = u.pn * BM + wc * 32 + 8 * fq;
        bf16_t* prow = P + (size_t)(u.pm * BM + wr * 64 + fr) * LDP + col;
        float rs[2][4];
#pragma unroll
        for (int ai = 0; ai < 2; ++ai)
#pragma unroll
            for (int m = 0; m < 4; ++m) rs[ai][m] = rsq[u.pm * BM + wr * 64 + fr + ai * HALF + m * 16];
#pragma unroll
        for (int ai = 0; ai < 2; ++ai)
#pragma unroll
            for (int m = 0; m < 4; ++m) rs[ai][m] = __builtin_amdgcn_rsqf(rs[ai][m] * (1.0f / D_MODEL) + EPS);
        const int pn = u.pn;
        if (pn < 4) body<1>(acc, prow, nullptr, 1.f, rs);
        else if (pn < 8) body<3>(acc, prow, lb + (col - C_HGF), 1.f, rs);
        else if (pn < 12) body<0>(acc, prow, nullptr, 1.f, rs);
        else if (pn < 16) body<2>(acc, prow, hgn + (col - C_HGG), 1.f, rs);
        else if (pn < 20) body<0>(acc, prow, nullptr, 1.f, rs);
        else if (pn < 24) body<1>(acc, prow, nullptr, 1.f, rs);
        else if (pn < 26) body<0>(acc, prow, nullptr, 0.08838834764831845f, rs);
        else if (pn < 32) body<0>(acc, prow, nullptr, 1.f, rs);
        else if (pn < 36) body<2>(acc, prow, gln + (col - C_GLG), 1.f, rs);
        else if (pn < 38) body<4>(acc, prow, bup + (col - C_GLF), 1.f, rs);
        else if (pn < 42) body<1>(acc, prow, nullptr, 1.f, rs);
        else body<0>(acc, prow, nullptr, 1.f, rs);
    }
};
struct EpiSample {
    static constexpr bool PERM = false, TWICE = false, KSCALE = false;
    float* PS;
    DI void operator()(const f32x4 (&acc)[2][2][4][2], const Unit& u, int wr, int wc, int fr, int fq) const {
        const int row0 = wr * 64 + fr, col0 = u.pn * BM + wc * 32 + 4 * fq;
#pragma unroll
        for (int m = 0; m < 4; ++m) { float* op = PS + (size_t)(row0 + m * 16) * LDP + col0;
#pragma unroll
            for (int bj = 0; bj < 2; ++bj)
#pragma unroll
                for (int n = 0; n < 2; ++n) *(f32x4*)(op + bj * HALF + n * 16) = acc[0][bj][m][n]; }
    }
};
struct EpiResid {
    static constexpr bool PERM = true, TWICE = false, KSCALE = true;
    bf16_t* xb; float* rsq_next; const LAS float* tab;
    DI void rescale(f32x4 (&acc)[2][2][4][2], int seg, int wr, int fr) const {
#pragma unroll
        for (int ai = 0; ai < 2; ++ai)
#pragma unroll
            for (int m = 0; m < 4; ++m) { const float r = tab[seg * 256 + ai * HALF + wr * 64 + m * 16 + fr];
#pragma unroll
                for (int bj = 0; bj < 2; ++bj) { acc[ai][bj][m][0] = acc[ai][bj][m][0] * r; acc[ai][bj][m][1] = acc[ai][bj][m][1] * r; } }
    }
    DI void operator()(f32x4 (&acc)[2][2][4][2], const Unit& u, int wr, int wc, int fr, int fq) const {
        rescale(acc, 6, wr, fr);
        const int row0 = u.pm * BM + wr * 64 + fr, col0 = u.pn * BM + wc * 32 + 8 * fq;
#pragma unroll
        for (int ai = 0; ai < 2; ++ai) {
            u32x4 ob[4][2];
#pragma unroll
            for (int m = 0; m < 4; ++m)
#pragma unroll
                for (int bj = 0; bj < 2; ++bj) ob[m][bj] = *(const u32x4*)(xb + (size_t)(row0 + ai * HALF + m * 16) * D_MODEL + col0 + bj * HALF);
#pragma unroll
            for (int m = 0; m < 4; ++m) { const int row = row0 + ai * HALF + m * 16; bf16_t* xp = xb + (size_t)row * D_MODEL + col0; float ss = 0.f;
#pragma unroll
                for (int bj = 0; bj < 2; ++bj) { const u32x4 o = ob[m][bj]; const f32x4 a = acc[ai][bj][m][0], b = acc[ai][bj][m][1];
                    const float x0 = bflo(o.x) + a.x, x1 = bfhi(o.x) + a.y, x2 = bflo(o.y) + a.z, x3 = bfhi(o.y) + a.w, x4 = bflo(o.z) + b.x, x5 = bfhi(o.z) + b.y, x6 = bflo(o.w) + b.z, x7 = bfhi(o.w) + b.w;
                    ss += ((x0 * x0 + x1 * x1) + (x2 * x2 + x3 * x3)) + ((x4 * x4 + x5 * x5) + (x6 * x6 + x7 * x7));
                    u32x4 n4; n4.x = pk2(x0, x1); n4.y = pk2(x2, x3); n4.z = pk2(x4, x5); n4.w = pk2(x6, x7); *(u32x4*)(xp + bj * HALF) = n4; }
                const int lane = fq * 16 + fr; ss += shx(ss, 16, lane); ss += shx(ss, 32, lane);
                if (fq == 0) atomicAdd(rsq_next + row, ss); }
        }
    }
};
struct OneUnit {
    int pm, pn, have;
    DI bool next(int i, Unit& u) const { if (i != 0 || !have) return false; u.pm = pm; u.pn = pn; return true; }
    DI void a_ready(const Unit&) const {}
    DI void done(const Unit&) const {}
};
template <class Epi, class Sched>
DI void gemm_phase(LAS unsigned char* lds, const Gemm g, const Sched& S, const Epi& E, int wv) {
    const int tid = get_tid(wv), wid = wv, lane = tid & 63, wr = wid >> 2, wc = wid & 3, fr = lane & 15, fq = lane >> 4;
    const int K = g.K, nt = K / BK;
    unsigned voffA[2], voffB[2];
#pragma unroll
    for (int i = 0; i < 2; ++i) { int R, C; stage_rc(tid * 16 + i * 8192, R, C); const int Rb = Epi::PERM ? ((R & ~31) + perm32(R & 31)) : R;
        voffA[i] = (unsigned)(R * g.lda + C) * 2u; voffB[i] = (unsigned)(Rb * g.ldb + C) * 2u; }
    const size_t kstep = (size_t)(BK * 2);
    const size_t hstepA = (size_t)HALF * g.lda * 2, hstepB = (size_t)HALF * g.ldb * 2;
    const size_t tstepA = 2 * hstepA, tstepB = 2 * hstepB;
    const unsigned ldsw = (unsigned)wid * 1024u;
    const int aoff = lds_byte(wr * 64 + fr, fq * 8), boff = lds_byte(wc * 32 + fr, fq * 8);
#define PG8_SA(b, h) (((b) * 2 + (h)) * HTB)
#define PG8_SB(b, h) ((4 + (b) * 2 + (h)) * HTB)
#define PG8_STAGE(bufoff, gbase, voff) do { _Pragma("unroll") for (int _i = 0; _i < 2; ++_i) \
        __builtin_amdgcn_global_load_lds((const unsigned*)((const char*)(gbase) + (voff)[_i]), (LAS unsigned*)(lds + (bufoff) + ldsw + _i * 8192), 16, 0, 0); } while (0)
#define PG8_LDA(dst, b, h) do { _Pragma("unroll") for (int m = 0; m < 4; ++m) _Pragma("unroll") for (int k = 0; k < 2; ++k) dst[m][k] = *(const LAS bf16x8*)(lds + PG8_SA(b, h) + aoff + m * 2048 + k * 1024); } while (0)
#define PG8_LDB(dst, b, h) do { _Pragma("unroll") for (int n = 0; n < 2; ++n) _Pragma("unroll") for (int k = 0; k < 2; ++k) dst[n][k] = *(const LAS bf16x8*)(lds + PG8_SB(b, h) + boff + n * 2048 + k * 1024); } while (0)
#define PG8_MMA(ai, bj, At, Bt) do { __builtin_amdgcn_s_setprio(1); _Pragma("unroll") for (int m = 0; m < 4; ++m) _Pragma("unroll") for (int n = 0; n < 2; ++n) _Pragma("unroll") for (int k = 0; k < 2; ++k) \
        acc[ai][bj][m][n] = __builtin_amdgcn_mfma_f32_16x16x32_bf16(Bt[n][k], At[m][k], acc[ai][bj][m][n], 0, 0, 0); __builtin_amdgcn_s_setprio(0); } while (0)
#define PG8_WAIT_V(n) asm volatile("s_waitcnt vmcnt(" #n ")" ::: "memory")
#define PG8_WAIT_L(n) asm volatile("s_waitcnt lgkmcnt(" #n ")" ::: "memory")
#define PG8_BAR __builtin_amdgcn_s_barrier()
#define PG8_SCHED __builtin_amdgcn_sched_barrier(0)
    Unit cur, nxt; int ui = 0;
    if (!S.next(0, cur)) return;
    f32x4 acc[2][2][4][2];
#pragma unroll
    for (int a = 0; a < 2; ++a)
#pragma unroll
        for (int b = 0; b < 2; ++b)
#pragma unroll
            for (int m = 0; m < 4; ++m)
#pragma unroll
                for (int n = 0; n < 2; ++n) acc[a][b][m][n] = (f32x4){0.f, 0.f, 0.f, 0.f};
    bf16x8 At[4][2], B0[2][2], B1[2][2];
    const char* cA = (const char*)g.A + (size_t)cur.pm * tstepA; const char* cB = (const char*)g.Bt + (size_t)cur.pn * tstepB;
    S.a_ready(cur);
    PG8_STAGE(PG8_SB(0, 0), cB, voffB); PG8_STAGE(PG8_SA(0, 0), cA, voffA); PG8_STAGE(PG8_SB(0, 1), cB + hstepB, voffB); PG8_STAGE(PG8_SA(0, 1), cA + hstepA, voffA);
    if (wr == 1) PG8_BAR;
    PG8_WAIT_V(4); PG8_BAR;
    PG8_STAGE(PG8_SB(1, 0), cB + kstep, voffB); PG8_STAGE(PG8_SA(1, 0), cA + kstep, voffA); PG8_STAGE(PG8_SB(1, 1), cB + hstepB + kstep, voffB);
    PG8_WAIT_V(6); PG8_BAR;
    for (;;) {
        const bool has_next = S.next(ui + 1, nxt);
        const char* nA = has_next ? (const char*)g.A + (size_t)nxt.pm * tstepA : cA; const char* nB = has_next ? (const char*)g.Bt + (size_t)nxt.pn * tstepB : cB;
        for (int t = 0; t < nt; t += 2) {
            const bool last = (t == nt - 2);
            const char* a1 = cA + (size_t)(t + 1) * kstep;
            const char* a2 = last ? nA : cA + (size_t)(t + 2) * kstep; const char* b2 = last ? nB : cB + (size_t)(t + 2) * kstep;
            const char* a3 = a2 + kstep; const char* b3 = b2 + kstep;
            if (last && has_next) S.a_ready(nxt);
            if constexpr (Epi::KSCALE) { if (t >= 32 && (t & 3) == 0 && (t < 48 || (t & 7) == 0)) E.rescale(acc, t < 48 ? (t - 32) >> 2 : 4 + ((t - 48) >> 3), wr, fr); }
            PG8_LDB(B0, 0, 0); PG8_SCHED; PG8_LDA(At, 0, 0); PG8_STAGE(PG8_SA(1, 1), a1 + hstepA, voffA);
            PG8_WAIT_L(8); PG8_BAR; PG8_WAIT_L(0); PG8_MMA(0, 0, At, B0); PG8_BAR; PG8_SCHED;
            PG8_LDB(B1, 0, 1); PG8_STAGE(PG8_SB(0, 0), b2, voffB);
            PG8_BAR; PG8_WAIT_L(0); PG8_MMA(0, 1, At, B1); PG8_BAR;
            PG8_LDA(At, 0, 1); PG8_STAGE(PG8_SA(0, 0), a2, voffA);
            PG8_BAR; PG8_WAIT_L(0); PG8_MMA(1, 0, At, B0); PG8_BAR; PG8_SCHED;
            PG8_STAGE(PG8_SB(0, 1), b2 + hstepB, voffB);
            PG8_WAIT_V(6); PG8_BAR; PG8_MMA(1, 1, At, B1); PG8_BAR;
            PG8_LDB(B0, 1, 0); PG8_SCHED; PG8_LDA(At, 1, 0); PG8_STAGE(PG8_SA(0, 1), a2 + hstepA, voffA);
            PG8_WAIT_L(8); PG8_BAR; PG8_WAIT_L(0); PG8_MMA(0, 0, At, B0); PG8_BAR; PG8_SCHED;
            PG8_LDB(B1, 1, 1); PG8_STAGE(PG8_SB(1, 0), b3, voffB);
            PG8_BAR; PG8_WAIT_L(0); PG8_MMA(0, 1, At, B1); PG8_BAR;
            PG8_LDA(At, 1, 1); PG8_STAGE(PG8_SA(1, 0), a3, voffA);
            PG8_BAR; PG8_WAIT_L(0); PG8_MMA(1, 0, At, B0); PG8_BAR; PG8_SCHED;
            PG8_STAGE(PG8_SB(1, 1), b3 + hstepB, voffB);
            PG8_WAIT_V(6); PG8_BAR; PG8_MMA(1, 1, At, B1); PG8_BAR;
        }
        E(acc, cur, wr, wc, fr, fq);
        if constexpr (Epi::TWICE) {
#pragma unroll
            for (int a = 0; a < 2; ++a)
#pragma unroll
                for (int b = 0; b < 2; ++b) asm volatile("" : "+v"(acc[a][b][0][0]), "+v"(acc[a][b][0][1]), "+v"(acc[a][b][1][0]), "+v"(acc[a][b][1][1]), "+v"(acc[a][b][2][0]), "+v"(acc[a][b][2][1]), "+v"(acc[a][b][3][0]), "+v"(acc[a][b][3][1]) :: "memory");
            E(acc, cur, wr, wc, fr, fq); }
        S.done(cur);
        if (!has_next) break;
#pragma unroll
        for (int a = 0; a < 2; ++a)
#pragma unroll
            for (int b = 0; b < 2; ++b)
#pragma unroll
                for (int m = 0; m < 4; ++m)
#pragma unroll
                    for (int n = 0; n < 2; ++n) acc[a][b][m][n] = (f32x4){0.f, 0.f, 0.f, 0.f};
        cur = nxt; cA = nA; cB = nB; ++ui;
    }
    PG8_WAIT_V(0);
    if (wr == 0) PG8_BAR;
    PG8_BAR;
#undef PG8_SA
#undef PG8_SB
#undef PG8_STAGE
#undef PG8_LDA
#undef PG8_LDB
#undef PG8_MMA
#undef PG8_WAIT_V
#undef PG8_WAIT_L
#undef PG8_BAR
#undef PG8_SCHED
}
}

struct Ctx {
    KP kp; const float* const __attribute__((address_space(4)))* in; float* out; unsigned char* ws;
    LAS unsigned char* lds;
    int tid, lane, wave, G, wg;
    float* lb; bf16_t* win; bf16_t* wout; bf16_t* xb; bf16_t* proj; float* projs; float* dtb; bf16_t* mix; bf16_t* xbcs; float* rowsq; unsigned* ctl;
};
DI Ctx make_ctx(int wv) {
    extern __shared__ __attribute__((aligned(16))) unsigned char lds_raw[];
    Ctx c; c.kp = get_params(); c.in = c.kp->in; c.out = c.kp->out; c.ws = c.kp->ws;
    c.lds = (LAS unsigned char*)lds_raw;
    asm volatile("" : "+s"(wv));
    int wg = blockIdx.x; asm volatile("" : "+s"(wg));
    c.tid = get_tid(wv); c.lane = c.tid & 63; c.wave = wv; c.G = gridDim.x; c.wg = wg;
    unsigned char* ws = c.ws;
    c.ctl = (unsigned*)(ws + WS_CTL); c.lb = (float*)(ws + WS_LB); c.win = (bf16_t*)(ws + WS_WIN); c.wout = (bf16_t*)(ws + WS_WOUT); c.xb = (bf16_t*)(ws + WS_XB);
    c.proj = (bf16_t*)(ws + WS_PROJ); c.projs = (float*)(ws + WS_PROJS); c.dtb = (float*)(ws + WS_DTB); c.mix = (bf16_t*)(ws + WS_MIX); c.xbcs = (bf16_t*)(ws + WS_XBCS); c.rowsq = (float*)(c.ctl + CW_ROWSQ);
    return c;
}

DI void p0_transpose_item(const float* W, int ldw, int k0, int n0, bf16_t* WT, int K, int drow0, LAS float* scr, int lane, const float* ksc) {
    float t[32];
#pragma unroll
    for (int i = 0; i < 32; ++i) t[i] = W[(size_t)(k0 + 2 * i + (lane >> 5)) * ldw + n0 + (lane & 31)];
#pragma unroll
    for (int i = 0; i < 32; ++i) scr[(2 * i + (lane >> 5)) * 33 + (lane & 31)] = t[i];
    const int c = lane & 7;
    f32x4 s0 = (f32x4){1.f, 1.f, 1.f, 1.f}, s1 = s0;
    if (ksc) { s0 = *(const f32x4*)(ksc + k0 + 8 * c); s1 = *(const f32x4*)(ksc + k0 + 8 * c + 4); }
    asm volatile("s_waitcnt lgkmcnt(0)" ::: "memory");
#pragma unroll
    for (int j = 0; j < 4; ++j) { const int n = (lane >> 3) + 8 * j; const LAS float* s = scr + (8 * c) * 33 + n;
        u32x4 o; o.x = pk2(s[0 * 33] * s0.x, s[1 * 33] * s0.y); o.y = pk2(s[2 * 33] * s0.z, s[3 * 33] * s0.w); o.z = pk2(s[4 * 33] * s1.x, s[5 * 33] * s1.y); o.w = pk2(s[6 * 33] * s1.z, s[7 * 33] * s1.w);
        *(u32x4*)(WT + (size_t)(drow0 + n) * K + k0 + 8 * c) = o; }
    asm volatile("s_waitcnt lgkmcnt(0)" ::: "memory");
}
DI void phase_prologue(int wv) {
    const Ctx c = make_ctx(wv);
    LAS float* scr = (LAS float*)(c.lds + c.wave * 16384);
    const int gw = c.wg * 8 + c.wave, NGW = c.G * 8;
    constexpr int NB1 = SRC_GLA / 32, NB2 = (SRC_DT - SRC_SSZ) / 32;
    constexpr int I_A = (D_MODEL / 64) * NB1, I_B = (D_MODEL / 64) * NB2, I_O = (D_MIX / 64) * (D_MODEL / 32), I_L = I_A + I_B + I_O;
    for (int it = gw; it < DEPTH * I_L; it += NGW) {
        const int l = it / I_L; int r = it % I_L;
        const float* win = c.in[I_WIN] + (size_t)l * D_MODEL * N_IN; bf16_t* wt = c.win + (size_t)l * LDP * D_MODEL; const float* rmsw = c.in[I_RMS] + (size_t)l * D_MODEL;
        if (r < I_A) { const int kb = r / NB1, nb = r % NB1; p0_transpose_item(win, N_IN, 64 * kb, 32 * nb, wt, D_MODEL, 32 * nb, scr, c.lane, rmsw); }
        else if (r < I_A + I_B) { r -= I_A; const int kb = r / NB2, nb = r % NB2; p0_transpose_item(win, N_IN, 64 * kb, SRC_SSZ + 32 * nb, wt, D_MODEL, C_SSZ + 32 * nb, scr, c.lane, rmsw); }
        else { r -= I_A + I_B; const int kb = r / (D_MODEL / 32), nb = r % (D_MODEL / 32);
            p0_transpose_item(c.in[I_WOUT] + (size_t)l * D_MIX * D_MODEL, D_MODEL, 64 * kb, 32 * nb, c.wout + (size_t)l * D_MODEL * D_MIX, D_MIX, 32 * nb, scr, c.lane, kb >= 48 ? c.in[I_SSN] + (size_t)l * 1024 - 3072 : nullptr); }
    }
    const int gt = c.wg * 512 + c.tid, NGT = c.G * 512;
    for (int it = gw; it < DEPTH * 32 * 8; it += NGW) {
        const int l = it >> 8, kb = (it >> 3) & 31, nb = it & 7, k = kb * 64 + c.lane;
        const float* wr = c.in[I_WIN] + ((size_t)l * D_MODEL + k) * N_IN + SRC_GLA; const float* up = c.in[I_GWU] + (size_t)l * 16 * 512 + nb * 64;
        const f32x4 a0 = *(const f32x4*)wr, a1 = *(const f32x4*)(wr + 4), a2 = *(const f32x4*)(wr + 8), a3 = *(const f32x4*)(wr + 12);
        const float rk = c.in[I_RMS][(size_t)l * D_MODEL + k];
        bf16_t* dst = c.win + ((size_t)l * LDP + C_GLF + nb * 64) * D_MODEL + k;
#pragma unroll 4
        for (int n = 0; n < 64; ++n) {
            const float s = a0.x * up[n] + a0.y * up[512 + n] + a0.z * up[1024 + n] + a0.w * up[1536 + n] + a1.x * up[2048 + n] + a1.y * up[2560 + n] + a1.z * up[3072 + n] + a1.w * up[3584 + n]
                          + a2.x * up[4096 + n] + a2.y * up[4608 + n] + a2.z * up[5120 + n] + a2.w * up[5632 + n] + a3.x * up[6144 + n] + a3.y * up[6656 + n] + a3.z * up[7168 + n] + a3.w * up[7680 + n];
            dst[(size_t)n * D_MODEL] = (bf16_t)f2bf(s * rk); }
    }
    for (int i = gt; i < DEPTH * 16 * D_MODEL; i += NGT) {
        const int l = i / (16 * D_MODEL), e = i % (16 * D_MODEL), n = e / D_MODEL, k = e % D_MODEL;
        c.win[((size_t)l * LDP + C_DT + n) * D_MODEL + k] = (bf16_t)f2bf(c.in[I_WIN][((size_t)l * D_MODEL + k) * N_IN + SRC_DT + n] * c.in[I_RMS][(size_t)l * D_MODEL + k]);
    }
    constexpr int PADW = (LDP - C_DT - 16) * D_MODEL * 2 / 16;
    for (int i = gt; i < DEPTH * PADW; i += NGT) { const int l = i / PADW, r = i % PADW;
        ((u32x4*)(c.win + ((size_t)l * LDP + C_DT + 16) * D_MODEL))[r] = (u32x4){0u, 0u, 0u, 0u}; }
    constexpr int PADX = (M_PAD - TT) * D_MODEL * 2 / 16;
    for (int i = gt; i < PADX; i += NGT) ((u32x4*)(c.xb + (size_t)TT * D_MODEL))[i] = (u32x4){0u, 0u, 0u, 0u};
    for (int r = gw; r < TT; r += NGW) {
        const f32x4* x4 = (const f32x4*)(r < TP ? c.in[I_XP] + (size_t)r * D_MODEL : c.in[I_XS] + (size_t)(r - TP) * D_MODEL);
        u32x2* o = (u32x2*)(c.xb + (size_t)r * D_MODEL); float s = 0.f;
#pragma unroll
        for (int j = 0; j < 8; ++j) { const f32x4 v = x4[c.lane + 64 * j]; s += (v.x * v.x + v.y * v.y) + (v.z * v.z + v.w * v.w); u32x2 p; p.x = pk2(v.x, v.y); p.y = pk2(v.z, v.w); o[c.lane + 64 * j] = p; }
        s = wave_sum(s, c.lane);
        if (c.lane == 0) c.rowsq[r] = s;
    }
    for (int i = gt; i < 1024; i += NGT) {
        const float* p = c.in[I_LB];
        const float a0 = p[i], a1 = p[1024 + i], a2 = p[2048 + i], a3 = p[3072 + i];
        const float mx = fmaxf(fmaxf(a0, a1), fmaxf(a2, a3));
        const float e0 = expf(a0 - mx), e1 = expf(a1 - mx), e2 = expf(a2 - mx), e3 = expf(a3 - mx);
        const float inv = 1.0f / (e0 + e1 + e2 + e3);
        c.lb[i] = 0.f; c.lb[1024 + i] = e1 * inv; c.lb[2048 + i] = (e1 + e2) * inv; c.lb[3072 + i] = (e1 + e2 + e3) * inv;
    }
}

DI void phase_final_norm(int wv) {
    const Ctx c = make_ctx(wv);
    const int gw = c.wg * 8 + c.wave, NGW = c.G * 8;
    const f32x4* w4 = (const f32x4*)c.in[I_RMSF];
    for (int r = gw; r < TT; r += NGW) {
        const u32x2* x2 = (const u32x2*)(c.xb + (size_t)r * D_MODEL);
        const float rstd = row_rstd(c.rowsq + DEPTH * M_PAD, r);
        f32x4* o = (f32x4*)(c.out + O_YP + (size_t)r * D_MODEL);
#pragma unroll
        for (int j = 0; j < 8; ++j) { const u32x2 p = x2[c.lane + 64 * j]; const f32x4 w = w4[c.lane + 64 * j];
            o[c.lane + 64 * j] = (f32x4){bflo(p.x) * rstd * w.x, bfhi(p.x) * rstd * w.y, bflo(p.y) * rstd * w.z, bfhi(p.y) * rstd * w.w}; }
    }
}

DI float ps4(const float* p) { return (p[0] + p[PST]) + (p[2 * PST] + p[3 * PST]); }
DI float conv1(const float* prow, float rs, int col, int ch, int nch, const float* cw, const float* cb, const float* buf) {
    return cb[ch] + cw[ch] * buf[ch] + cw[nch + ch] * buf[nch + ch] + cw[2 * nch + ch] * buf[2 * nch + ch] + cw[3 * nch + ch] * (ps4(prow + col + ch) * rs);
}
constexpr int SM_Q = 0, SM_K = 1024, SM_F = 2048, SM_V = 3072, SM_O = 4096, SM_WS = 5120, SM_PART = 5376;
DI void sample_item(const Ctx& c, int l, int s, int type) {
    LAS float* sm = (LAS float*)c.lds;
    LAS float* QS = sm + SM_Q; LAS float* KS = sm + SM_K; LAS float* FS = sm + SM_F; LAS float* VS = sm + SM_V; LAS float* OS_ = sm + SM_O; LAS float* WSUM = sm + SM_WS;
    const int tid = get_tid(c.wave), lane = tid & 63, w = c.wave;
    const float* pr = c.projs + (size_t)s * LDP; const float rs = row_rstd(c.rowsq + (size_t)l * M_PAD, TP + s);
    __syncthreads();
    if (type == 0) {
#pragma unroll
        for (int e = 0; e < 2; ++e) { const int ch = 2 * tid + e; const float qraw = (ps4(pr + C_HGQ + ch) * rs), fraw = (ps4(pr + C_HGF + ch) * rs), lbv = c.lb[(size_t)l * 1024 + ch];
            QS[ch] = silu(qraw); FS[ch] = fmaxf(lbv + (1.0f - lbv) * sigm(fraw), TINY); KS[ch] = (1.0f - lbv) * sigm(-fraw); VS[ch] = (ps4(pr + C_HGI + ch) * rs); }
    } else if (type == 1) {
#pragma unroll
        for (int e = 0; e < 2; ++e) { const int ch = 2 * tid + e; VS[ch] = (ps4(pr + C_GLV + ch) * rs);
            if (tid < 256) { QS[ch] = (ps4(pr + C_GLQ + ch) * rs) * 0.08838834764831845f; KS[ch] = (ps4(pr + C_GLK + ch) * rs);
                const float z = (ps4(pr + C_GLF + ch) * rs) + c.in[I_GBU][(size_t)l * 512 + ch]; FS[ch] = fexp(-softplus(-z) * (1.0f / 16.0f)); } }
    } else {
        const float* scw = c.in[I_SCW] + (size_t)l * 4 * 1536; const float* scb = c.in[I_SCB] + (size_t)l * 1536;
        const float* sbuf = c.in[I_SSSDC] + ((size_t)l * DEC + s) * 3 * 1536;
#pragma unroll
        for (int e = 0; e < 2; ++e) { const int ch = 2 * tid + e; VS[ch] = silu(conv1(pr, rs, C_XBC, ch, 1536, scw, scb, sbuf)); }
        if (tid < 256) { KS[tid] = silu(conv1(pr, rs, C_XBC, 1024 + tid, 1536, scw, scb, sbuf)); QS[tid] = silu(conv1(pr, rs, C_XBC, 1280 + tid, 1536, scw, scb, sbuf)); }
        if (tid < 16) { const float dt = softplus((ps4(pr + C_DT + tid) * rs) + c.in[I_DTB][l * 16 + tid]); FS[tid] = dt; FS[16 + tid] = fexp(-dt * expf(c.in[I_ALOG][l * 16 + tid])); }
    }
    __syncthreads();
    if (type < 2) {
        const int h = type == 0 ? w : (w >> 1), RS = type == 0 ? 128 : 256, voff = type == 0 ? 0 : 128 * (w & 1);
        const size_t sb = type == 0 ? (((size_t)l * DEC + s) * 8 + h) * 16384 : (((size_t)l * DEC + s) * 4 + h) * 32768;
        const float* s0 = (type == 0 ? c.in[I_SHG] : c.in[I_SGLA]) + sb; float* so = c.out + (type == 0 ? O_HG_S : O_GLA_S) + sb;
        const int vq = lane & 31, kh = lane >> 5, vb = (type == 0 ? h * 128 : h * 256 + voff) + 4 * vq, qb = h * 128;
        const f32x4 vv = *(const LAS f32x4*)(VS + vb); f32x4 o4 = (f32x4){0.f, 0.f, 0.f, 0.f};
        const int eo = kh * RS + voff + 4 * vq;
        f32x4 st[3][8];
#define SI_LOAD(bf, kb) do { _Pragma("unroll") for (int u = 0; u < 8; ++u) st[bf][u] = *(const f32x4*)(s0 + (size_t)(2 * (8 * (kb) + u)) * RS + eo); } while (0)
        SI_LOAD(0, 0); SI_LOAD(1, 1);
#pragma unroll
        for (int kb = 0; kb < 8; ++kb) {
            if (kb + 2 < 8) SI_LOAD((kb + 2) % 3, kb + 2);
#pragma unroll
            for (int u = 0; u < 8; ++u) { const int k = 2 * (8 * kb + u) + kh; const float fk = FS[qb + k], kk = KS[qb + k], qk = QS[qb + k];
                f32x4 t = st[kb % 3][u] * fk + vv * kk; o4 += t * qk; *(f32x4*)(so + (size_t)(2 * (8 * kb + u)) * RS + eo) = t; }
        }
#undef SI_LOAD
        o4.x += shx(o4.x, 32, lane); o4.y += shx(o4.y, 32, lane); o4.z += shx(o4.z, 32, lane); o4.w += shx(o4.w, 32, lane);
        if (kh == 0) *(LAS f32x4*)(OS_ + vb) = o4;
    } else {
        LAS float* PART = sm + SM_PART + w * 2304;
        const int nq = lane & 31, ph = lane >> 5, g = w >> 2;
        const f32x4 B4 = *(const LAS f32x4*)(KS + g * 128 + 4 * nq), C4 = *(const LAS f32x4*)(QS + g * 128 + 4 * nq);
        const float* s0 = c.in[I_SSSD] + (((size_t)l * DEC + s) * 16 + 2 * w) * 8192; float* so = c.out + O_SSD_S + (((size_t)l * DEC + s) * 16 + 2 * w) * 8192;
        const int eo = ph * 128 + 4 * nq;
        f32x4 st[3][8];
#define SI_LOAD(bf, kb) do { _Pragma("unroll") for (int u = 0; u < 8; ++u) st[bf][u] = *(const f32x4*)(s0 + (size_t)((kb) >> 2) * 8192 + (size_t)(2 * (8 * ((kb) & 3) + u)) * 128 + eo); } while (0)
        SI_LOAD(0, 0); SI_LOAD(1, 1);
#pragma unroll
        for (int kb = 0; kb < 8; ++kb) { const int h = 2 * w + (kb >> 2);
            if (kb + 2 < 8) SI_LOAD((kb + 2) % 3, kb + 2);
            const float dt = FS[h], dA = FS[16 + h];
#pragma unroll
            for (int u = 0; u < 8; ++u) { const int p = 2 * (8 * (kb & 3) + u) + ph; const float xv = VS[h * 64 + p] * dt;
                const f32x4 t = st[kb % 3][u] * dA + B4 * xv; *(f32x4*)(so + (size_t)(kb >> 2) * 8192 + (size_t)(2 * (8 * (kb & 3) + u)) * 128 + eo) = t;
                PART[p * 36 + nq] = (t.x * C4.x + t.y * C4.y) + (t.z * C4.z + t.w * C4.w); }
            if ((kb & 3) == 3) {
                asm volatile("s_waitcnt lgkmcnt(0)" ::: "memory");
                float o = 0.f;
#pragma unroll
                for (int q = 0; q < 8; ++q) { const f32x4 tt = *(const LAS f32x4*)(PART + lane * 36 + 4 * q); o += (tt.x + tt.y) + (tt.z + tt.w); }
                const float x = VS[h * 64 + lane], z = (ps4(pr + C_SSZ + h * 64 + lane) * rs);
                OS_[h * 64 + lane] = (o + c.in[I_SD][l * 16 + h] * x) * silu(z);
                asm volatile("s_waitcnt lgkmcnt(0)" ::: "memory"); }
        }
#undef SI_LOAD
    }
    __syncthreads();
    { const f32x2 o2 = *(const LAS f32x2*)(OS_ + 2 * tid);
      const float ssw = wave_sum(o2.x * o2.x + o2.y * o2.y, lane);
      if (lane == 0) WSUM[w] = ssw;
      __syncthreads();
      float ss, gsz; const float* nw; int mcol, gcol = 0;
      if (type == 0) { ss = WSUM[w]; gsz = 128.f; nw = c.in[I_HGN] + (size_t)l * 1024; mcol = 0; gcol = C_HGG; }
      else if (type == 1) { ss = WSUM[w & ~1] + WSUM[w | 1]; gsz = 256.f; nw = c.in[I_GLN] + (size_t)l * 1024; mcol = 2048; gcol = C_GLG; }
      else { const int b4 = w & ~3; ss = (WSUM[b4] + WSUM[b4 + 1]) + (WSUM[b4 + 2] + WSUM[b4 + 3]); gsz = 512.f; nw = c.in[I_SSN] + (size_t)l * 1024; mcol = 3072; }
      const float rstd = rsqrtf(ss / gsz + EPS);
      float y0 = o2.x * rstd, y1 = o2.y * rstd;
      if (type < 2) { y0 *= nw[2 * tid]; y1 *= nw[2 * tid + 1]; }
      if (type < 2) { y0 *= silu((ps4(pr + gcol + 2 * tid) * rs)); y1 *= silu((ps4(pr + gcol + 2 * tid + 1) * rs)); }
      *(unsigned*)(c.mix + (size_t)(TP + s) * D_MIX + mcol + 2 * tid) = pk2(y0, y1); }
}

DI void lds_barrier() { asm volatile("s_waitcnt lgkmcnt(0)\n\ts_barrier" ::: "memory"); }
DI f32x16 mfma32(bf16x8 a, bf16x8 b, f32x16 c) { return __builtin_amdgcn_mfma_f32_32x32x16_bf16(a, b, c, 0, 0, 0); }
DI bf16x8 ldfrag(const LAS unsigned char* p) { return *(const LAS bf16x8*)p; }
DI int crow(int i, int hh) { return (i & 3) + 8 * (i >> 2) + 4 * hh; }
constexpr int L_QP = 0, L_KP = 17408, L_KPT = 34816, L_VT = 53248, L_VT2 = 71680, L_AM = 90112, L_TOT = 108544, L_E1 = 112640, L_E2 = 113152, L_CUM = 113664;
constexpr int SQ = 272, SV = 144;
#define ZERO16(x) do { _Pragma("unroll") for (int _i = 0; _i < 16; ++_i) (x)[_i] = 0.f; } while (0)

template <int TYPE>
DI void la_head_unit(const Ctx& c, int l, int b, int hu) {
    constexpr int DV = 128, NSW = DV / 32, OS = DV * 2 + 16, NC = DV / 8;
    LAS unsigned char* L = c.lds;
    const int tid = get_tid(c.wave), lane = tid & 63, w = c.wave;
    const int r = lane & 31, hh = lane >> 5;
    const int row0 = b * SEQ;
    const bf16_t* P = TYPE == 2 ? c.xbcs : c.proj;
    constexpr int LDR = TYPE == 2 ? 1536 : LDP;
    LAS float* TOT = (LAS float*)(L + L_TOT); LAS float* E1 = (LAS float*)(L + L_E1); LAS float* E2 = (LAS float*)(L + L_E2);
    int colQ, colK, colG, colV, colGate, colOut, sidx; const int grp = hu >> 2;
    if constexpr (TYPE == 0) { colQ = C_HGQ + hu * 128; colK = 0; colG = C_HGF + hu * 128; colV = C_HGI + hu * 128; colGate = C_HGG + hu * 128; colOut = hu * 128; sidx = 0; }
    else if constexpr (TYPE == 1) { const int hd = hu >> 1; colQ = C_GLQ + hd * 128; colK = C_GLK + hd * 128; colG = C_GLF + hd * 128; colV = C_GLV + hu * 128; colGate = C_GLG + hu * 128; colOut = 2048 + hu * 128; sidx = 2 + hd; }
    else { colK = 1024 + grp * 128; colQ = 1280 + grp * 128; colG = 0; colV = hu * 128; colGate = C_SSZ + hu * 128; colOut = 3072 + hu * 128; sidx = grp; }
    float Ah[2], Dh[2];
    if constexpr (TYPE == 2) {
#pragma unroll
        for (int e = 0; e < 2; ++e) { Ah[e] = -expf(c.in[I_ALOG][l * 16 + 2 * hu + e]); Dh[e] = c.in[I_SD][l * 16 + 2 * hu + e]; }
    }
    unsigned r0[8], r1[8], r2[8], r3[8]; float dtn = 0.f;
#define LOAD_CHUNK(tn) do { const bf16_t* pq_ = P + (size_t)(row0 + (tn) + 8 * w) * LDR + 2 * lane; \
        if constexpr (TYPE == 0) { _Pragma("unroll") for (int i = 0; i < 8; ++i) { r0[i] = *(const unsigned*)(pq_ + (size_t)i * LDR + colQ); r1[i] = *(const unsigned*)(pq_ + (size_t)i * LDR + colG); r2[i] = *(const unsigned*)(pq_ + (size_t)i * LDR + colV); } } \
        else if constexpr (TYPE == 1) { _Pragma("unroll") for (int i = 0; i < 8; ++i) { r0[i] = *(const unsigned*)(pq_ + (size_t)i * LDR + colQ); r1[i] = *(const unsigned*)(pq_ + (size_t)i * LDR + colK); \
                                                                                       r2[i] = *(const unsigned*)(pq_ + (size_t)i * LDR + colG); r3[i] = *(const unsigned*)(pq_ + (size_t)i * LDR + colV); } } \
        else { _Pragma("unroll") for (int i = 0; i < 8; ++i) { r0[i] = *(const unsigned*)(pq_ + (size_t)i * LDR + colQ); r1[i] = *(const unsigned*)(pq_ + (size_t)i * LDR + colK); r2[i] = *(const unsigned*)(pq_ + (size_t)i * LDR + colV); } \
            if (w < 2) dtn = c.dtb[(size_t)(row0 + (tn) + lane) * 16 + 2 * hu + w]; } } while (0)
    f32x16 S[4];
#pragma unroll
    for (int kt = 0; kt < 4; ++kt) ZERO16(S[kt]);
    float e2pa = 1.f, e2pb = 1.f;
    constexpr bool PF = true;
    if constexpr (PF) LOAD_CHUNK(0);
    for (int ck = -(SEQ / 64) * (PROBE_LONG_REP - 1); ck < SEQ / 64; ++ck) {
        if (PROBE_LONG_REP > 1 && ck == 0) { e2pa = 1.f; e2pb = 1.f;
#pragma unroll
            for (int kt = 0; kt < 4; ++kt) ZERO16(S[kt]); }
        const int t0 = (ck & (SEQ / 64 - 1)) * 64;
        if constexpr (TYPE == 2) { if ((ck & (SEQ / 64 - 1)) == 15) {
            if (tid == 0) { unsigned* xp1 = c.ctl + CW_XPRE + 128 * l + 64; unsigned sp = 0;
                while (__hip_atomic_load(xp1, __ATOMIC_RELAXED, __HIP_MEMORY_SCOPE_AGENT) < 128u) { __builtin_amdgcn_s_sleep(8); if (++sp > (1u << 22)) break; }
                __builtin_amdgcn_fence(__ATOMIC_ACQUIRE, "agent"); asm volatile("s_waitcnt vmcnt(0)" ::: "memory"); }
            __syncthreads(); } }
        LAS float* CUM = (LAS float*)(L + L_CUM + (ck & 1) * 1536);
        if constexpr (!PF) LOAD_CHUNK(t0);
        float qa[8], qb[8], ka[8], kb[8], ga[8], gb[8], xa[8], xb[8]; unsigned uv[8];
        if constexpr (TYPE == 0) {
            float ta = 0.f, tb = 0.f;
#pragma unroll
            for (int i = 0; i < 8; ++i) { qa[i] = bflo(r0[i]); qb[i] = bfhi(r0[i]); const float g0 = bflo(r1[i]), g1 = bfhi(r1[i]); uv[i] = r2[i];
                ka[i] = 1.0f - fexp(g0); kb[i] = 1.0f - fexp(g1); ta += g0; tb += g1; ga[i] = ta; gb[i] = tb; }
            *(LAS f32x2*)(TOT + w * 128 + 2 * lane) = (f32x2){ta, tb};
        } else if constexpr (TYPE == 1) {
            float ta = 0.f, tb = 0.f;
#pragma unroll
            for (int i = 0; i < 8; ++i) { qa[i] = bflo(r0[i]); qb[i] = bfhi(r0[i]); ka[i] = bflo(r1[i]); kb[i] = bfhi(r1[i]); ta += bflo(r2[i]); tb += bfhi(r2[i]); ga[i] = ta; gb[i] = tb; uv[i] = r3[i]; }
            *(LAS f32x2*)(TOT + w * 128 + 2 * lane) = (f32x2){ta, tb};
        } else {
#pragma unroll
            for (int i = 0; i < 8; ++i) { qa[i] = bflo(r0[i]); qb[i] = bfhi(r0[i]); ka[i] = bflo(r1[i]); kb[i] = bfhi(r1[i]); xa[i] = bflo(r2[i]); xb[i] = bfhi(r2[i]); }
            if (w < 2) {
                const float dt = dtn; float x = dt * (w == 0 ? Ah[0] : Ah[1]);
#pragma unroll
                for (int o = 1; o < 64; o <<= 1) { const float y = shup(x, o, lane); if (lane >= o) x += y; }
                CUM[w * 192 + lane] = x; CUM[w * 192 + 64 + lane] = fmaxf(dt, 1e-30f); CUM[w * 192 + 128 + lane] = fexp(x);
            }
        }
        lds_barrier();
        if constexpr (TYPE < 2) {
            float offa = 0.f, offb = 0.f, brefa = 0.f, brefb = 0.f, bla = 0.f, blb = 0.f;
#pragma unroll
            for (int g = 0; g < 8; ++g) { const f32x2 t = *(const LAS f32x2*)(TOT + g * 128 + 2 * lane);
                if (g < w) { offa += t.x; offb += t.y; }
                if (g < 4) { brefa += t.x; brefb += t.y; }
                bla += t.x; blb += t.y; }
#pragma unroll
            for (int i = 0; i < 8; ++i) { const float da = clampf(ga[i] + offa - brefa, -80.f, 80.f), db = clampf(gb[i] + offb - brefb, -80.f, 80.f);
                qa[i] *= fexp(da); ka[i] *= fexp(-da); qb[i] *= fexp(db); kb[i] *= fexp(-db); }
            if (w == 0) {
                const float e2a = fexp(bla - brefa), e2b = fexp(blb - brefb);
                *(LAS f32x2*)(E1 + 2 * lane) = (f32x2){fexp(brefa) * e2pa, fexp(brefb) * e2pb}; *(LAS f32x2*)(E2 + 2 * lane) = (f32x2){e2a, e2b}; e2pa = e2a; e2pb = e2b; }
        }
#pragma unroll
        for (int i = 0; i < 8; ++i) { *(LAS unsigned*)(L + L_QP + (8 * w + i) * SQ + 4 * lane) = pk2(qa[i], qb[i]); *(LAS unsigned*)(L + L_KP + (8 * w + i) * SQ + 4 * lane) = pk2(ka[i], kb[i]); }
        { u32x4 a, bq; a.x = pk2(ka[0], ka[1]); a.y = pk2(ka[2], ka[3]); a.z = pk2(ka[4], ka[5]); a.w = pk2(ka[6], ka[7]);
          bq.x = pk2(kb[0], kb[1]); bq.y = pk2(kb[2], kb[3]); bq.z = pk2(kb[4], kb[5]); bq.w = pk2(kb[6], kb[7]);
          *(LAS u32x4*)(L + L_KPT + (2 * lane) * SV + 16 * w) = a; *(LAS u32x4*)(L + L_KPT + (2 * lane + 1) * SV + 16 * w) = bq; }
        if constexpr (TYPE < 2) {
            u32x4 a, bq;
            a.x = (uv[0] & 0xffffu) | (uv[1] << 16); a.y = (uv[2] & 0xffffu) | (uv[3] << 16); a.z = (uv[4] & 0xffffu) | (uv[5] << 16); a.w = (uv[6] & 0xffffu) | (uv[7] << 16);
            bq.x = (uv[0] >> 16) | (uv[1] & 0xffff0000u); bq.y = (uv[2] >> 16) | (uv[3] & 0xffff0000u); bq.z = (uv[4] >> 16) | (uv[5] & 0xffff0000u); bq.w = (uv[6] >> 16) | (uv[7] & 0xffff0000u);
            *(LAS u32x4*)(L + L_VT + (2 * lane) * SV + 16 * w) = a; *(LAS u32x4*)(L + L_VT + (2 * lane + 1) * SV + 16 * w) = bq;
        } else {
            const int hs = lane >> 5;
            const LAS float* cm = CUM + hs * 192; const float cl = cm[63];
            float v1a[8], v1b[8], v2a[8], v2b[8];
#pragma unroll
            for (int j = 0; j < 8; ++j) { const int s = 8 * w + j; const float dt = cm[64 + s], wgt = fexp(fminf(cl - cm[s], 0.f));
                v1a[j] = dt * xa[j]; v1b[j] = dt * xb[j]; v2a[j] = v1a[j] * wgt; v2b[j] = v1b[j] * wgt; }
            u32x4 a, bq;
            a.x = pk2(v1a[0], v1a[1]); a.y = pk2(v1a[2], v1a[3]); a.z = pk2(v1a[4], v1a[5]); a.w = pk2(v1a[6], v1a[7]);
            bq.x = pk2(v1b[0], v1b[1]); bq.y = pk2(v1b[2], v1b[3]); bq.z = pk2(v1b[4], v1b[5]); bq.w = pk2(v1b[6], v1b[7]);
            *(LAS u32x4*)(L + L_VT + (2 * lane) * SV + 16 * w) = a; *(LAS u32x4*)(L + L_VT + (2 * lane + 1) * SV + 16 * w) = bq;
            a.x = pk2(v2a[0], v2a[1]); a.y = pk2(v2a[2], v2a[3]); a.z = pk2(v2a[4], v2a[5]); a.w = pk2(v2a[6], v2a[7]);
            bq.x = pk2(v2b[0], v2b[1]); bq.y = pk2(v2b[2], v2b[3]); bq.z = pk2(v2b[4], v2b[5]); bq.w = pk2(v2b[6], v2b[7]);
            *(LAS u32x4*)(L + L_VT2 + (2 * lane) * SV + 16 * w) = a; *(LAS u32x4*)(L + L_VT2 + (2 * lane + 1) * SV + 16 * w) = bq;
        }
        lds_barrier();
        if constexpr (PF) { if (ck + 1 < SEQ / 64) LOAD_CHUNK(((ck + 1) & (SEQ / 64 - 1)) * 64); }
        if (w >= 5) {
            const int sb = (w == 7) ? 1 : 0, tb = (w == 5) ? 0 : 1;
            f32x16 X; ZERO16(X);
#pragma unroll
            for (int k4 = 0; k4 < 8; k4 += 4) { bf16x8 fk[4], fq[4];
#pragma unroll
                for (int u = 0; u < 4; ++u) { fk[u] = ldfrag(L + L_KP + (32 * sb + r) * SQ + (16 * (k4 + u) + 8 * hh) * 2); fq[u] = ldfrag(L + L_QP + (32 * tb + r) * SQ + (16 * (k4 + u) + 8 * hh) * 2); }
#pragma unroll
                for (int u = 0; u < 4; ++u) X = mfma32(fk[u], fq[u], X); }
            const int t = 32 * tb + r;
#pragma unroll
            for (int hs = 0; hs < (TYPE == 2 ? 2 : 1); ++hs) {
                float ct = 0.f, ddt = 0.f;
                if constexpr (TYPE == 2) { ct = CUM[hs * 192 + t]; ddt = (hs == 0 ? Dh[0] : Dh[1]) / CUM[hs * 192 + 64 + t]; }
#pragma unroll
                for (int g = 0; g < 4; ++g) { const int s0 = 32 * sb + 8 * g + 4 * hh;
                    float x0 = X[4 * g], x1 = X[4 * g + 1], x2 = X[4 * g + 2], x3 = X[4 * g + 3];
                    if constexpr (TYPE == 2) { const f32x4 cs = *(const LAS f32x4*)(CUM + hs * 192 + s0);
                        x0 *= fexp(fminf(ct - cs.x, 0.f)); x1 *= fexp(fminf(ct - cs.y, 0.f)); x2 *= fexp(fminf(ct - cs.z, 0.f)); x3 *= fexp(fminf(ct - cs.w, 0.f));
                        x0 += (s0 == t) ? ddt : 0.f; x1 += (s0 + 1 == t) ? ddt : 0.f; x2 += (s0 + 2 == t) ? ddt : 0.f; x3 += (s0 + 3 == t) ? ddt : 0.f; }
                    x0 = (s0 <= t) ? x0 : 0.f; x1 = (s0 + 1 <= t) ? x1 : 0.f; x2 = (s0 + 2 <= t) ? x2 : 0.f; x3 = (s0 + 3 <= t) ? x3 : 0.f;
                    u32x2 p; p.x = pk2(x0, x1); p.y = pk2(x2, x3);
                    *(LAS u32x2*)(L + L_AM + hs * 9216 + t * SV + s0 * 2) = p; }
            }
        }
        f32x16 O[2]; bf16x8 Bv[4];
        const int hsw = w >> 1;
        if (w < NSW) {
            if constexpr (TYPE < 2) {
#pragma unroll
                for (int kt = 0; kt < 4; ++kt)
#pragma unroll
                    for (int g = 0; g < 4; ++g) { const f32x4 e = *(const LAS f32x4*)(E1 + 32 * kt + 8 * g + 4 * hh);
                        S[kt][4 * g] *= e.x; S[kt][4 * g + 1] *= e.y; S[kt][4 * g + 2] *= e.z; S[kt][4 * g + 3] *= e.w; }
            }
            ZERO16(O[0]); ZERO16(O[1]);
#pragma unroll
            for (int kt = 0; kt < 4; ++kt) {
                u32x2 ql[2][2], qh[2][2];
#pragma unroll
                for (int s = 0; s < 2; ++s)
#pragma unroll
                    for (int tt = 0; tt < 2; ++tt) { const LAS unsigned char* qp = L + L_QP + (32 * tt + r) * SQ + (32 * kt + 16 * s + 4 * hh) * 2;
                        ql[s][tt] = *(const LAS u32x2*)qp; qh[s][tt] = *(const LAS u32x2*)(qp + 16); }
#pragma unroll
                for (int s = 0; s < 2; ++s) {
                    u32x4 pa; pa.x = pk2(S[kt][8 * s], S[kt][8 * s + 1]); pa.y = pk2(S[kt][8 * s + 2], S[kt][8 * s + 3]); pa.z = pk2(S[kt][8 * s + 4], S[kt][8 * s + 5]); pa.w = pk2(S[kt][8 * s + 6], S[kt][8 * s + 7]);
                    const bf16x8 A = __builtin_bit_cast(bf16x8, pa);
#pragma unroll
                    for (int tt = 0; tt < 2; ++tt) O[tt] = mfma32(A, __builtin_bit_cast(bf16x8, (u32x4){ql[s][tt].x, ql[s][tt].y, qh[s][tt].x, qh[s][tt].y}), O[tt]);
                }
            }
            if constexpr (TYPE == 2) {
                const LAS float* cm = CUM + hsw * 192; const float e0 = cm[128 + r], e1 = cm[128 + 32 + r], sc = cm[128 + 63];
#pragma unroll
                for (int i = 0; i < 16; ++i) { O[0][i] *= e0; O[1][i] *= e1; }
#pragma unroll
                for (int kt = 0; kt < 4; ++kt)
#pragma unroll
                    for (int i = 0; i < 16; ++i) S[kt][i] *= sc;
            }
#pragma unroll
            for (int st = 0; st < 4; ++st) { bf16x8 kf[4];
                Bv[st] = ldfrag(L + (TYPE == 2 ? L_VT2 : L_VT) + (32 * w + r) * SV + (16 * st + 8 * hh) * 2);
#pragma unroll
                for (int kt = 0; kt < 4; ++kt) kf[kt] = ldfrag(L + L_KPT + (32 * kt + r) * SV + (16 * st + 8 * hh) * 2);
#pragma unroll
                for (int kt = 0; kt < 4; ++kt) S[kt] = mfma32(kf[kt], Bv[st], S[kt]); }
        }
        const int nt_ = tid >> 3, nseg = tid & 7;
        u32x4 gq[NC / 8];
        { const bf16_t* pg = c.proj + (size_t)(row0 + t0 + nt_) * LDP + colGate + nseg * NC;
#pragma unroll
          for (int q = 0; q < NC / 8; ++q) gq[q] = *(const u32x4*)(pg + 8 * q); }
        lds_barrier();
        if (w < NSW) {
#pragma unroll
            for (int st = 0; st < 4; ++st) { bf16x8 Av = Bv[st];
                if constexpr (TYPE == 2) Av = ldfrag(L + L_VT + (32 * w + r) * SV + (16 * st + 8 * hh) * 2);
#pragma unroll
                for (int tt = 0; tt < 2; ++tt) if (st < 2 || tt == 1)
                    O[tt] = mfma32(Av, ldfrag(L + L_AM + (TYPE == 2 ? hsw * 9216 : 0) + (32 * tt + r) * SV + (16 * st + 8 * hh) * 2), O[tt]); }
#pragma unroll
            for (int tt = 0; tt < 2; ++tt)
#pragma unroll
                for (int g = 0; g < 4; ++g) { u32x2 p; p.x = pk2(O[tt][4 * g], O[tt][4 * g + 1]); p.y = pk2(O[tt][4 * g + 2], O[tt][4 * g + 3]);
                    *(LAS u32x2*)(L + (32 * tt + r) * OS + (32 * w + 8 * g + 4 * hh) * 2) = p; }
        }
        lds_barrier();
        {
            float o[NC], gv[NC]; float ss = 0.f;
#pragma unroll
            for (int q = 0; q < NC / 8; ++q) { const u32x4 ov = *(const LAS u32x4*)(L + nt_ * OS + (nseg * NC + 8 * q) * 2);
                o[8 * q] = bflo(ov.x); o[8 * q + 1] = bfhi(ov.x); o[8 * q + 2] = bflo(ov.y); o[8 * q + 3] = bfhi(ov.y); o[8 * q + 4] = bflo(ov.z); o[8 * q + 5] = bfhi(ov.z); o[8 * q + 6] = bflo(ov.w); o[8 * q + 7] = bfhi(ov.w);
                gv[8 * q] = bflo(gq[q].x); gv[8 * q + 1] = bfhi(gq[q].x); gv[8 * q + 2] = bflo(gq[q].y); gv[8 * q + 3] = bfhi(gq[q].y); gv[8 * q + 4] = bflo(gq[q].z); gv[8 * q + 5] = bfhi(gq[q].z); gv[8 * q + 6] = bflo(gq[q].w); gv[8 * q + 7] = bfhi(gq[q].w); }
            if constexpr (TYPE == 2) {
#pragma unroll
                for (int e = 0; e < NC; ++e) o[e] *= gv[e];
            }
#pragma unroll
            for (int e = 0; e < NC; ++e) ss += o[e] * o[e];
            ss += shx(ss, 1, lane); ss += shx(ss, 2, lane); ss += shx(ss, 4, lane);
            float mul = 1.0f;
            if constexpr (TYPE == 0) mul = rsqrtf(ss * (1.0f / DV) + EPS);
            else { if (nseg == 0 && ck >= 0) atomicAdd((float*)(c.ctl + CW_STATS) + ((size_t)l * TP + row0 + t0 + nt_) * 6 + sidx, ss); }
            if constexpr (TYPE < 2) {
#pragma unroll
                for (int e = 0; e < NC; ++e) o[e] *= mul * gv[e];
            }
            bf16_t* pm = c.mix + (size_t)(row0 + t0 + nt_) * D_MIX + colOut + nseg * NC;
#pragma unroll
            for (int q = 0; q < NC / 8; ++q) { u32x4 ov; ov.x = pk2(o[8 * q], o[8 * q + 1]); ov.y = pk2(o[8 * q + 2], o[8 * q + 3]); ov.z = pk2(o[8 * q + 4], o[8 * q + 5]); ov.w = pk2(o[8 * q + 6], o[8 * q + 7]);
                *(u32x4*)(pm + 8 * q) = ov; }
        }
    }
#undef LOAD_CHUNK
    if (w < NSW) {
        const int lane2 = get_tid(c.wave) & 63, r = lane2 & 31, hh = lane2 >> 5;
        if constexpr (TYPE < 2) {
#pragma unroll
            for (int kt = 0; kt < 4; ++kt)
#pragma unroll
                for (int g = 0; g < 4; ++g) { const f32x4 e = *(const LAS f32x4*)(E2 + 32 * kt + 8 * g + 4 * hh);
                    S[kt][4 * g] *= e.x; S[kt][4 * g + 1] *= e.y; S[kt][4 * g + 2] *= e.z; S[kt][4 * g + 3] *= e.w; }
        }
        float* sout; int sk, sv, vb;
        if constexpr (TYPE == 0) { sout = c.out + O_HG_P + (((size_t)l * NB + b) * 8 + hu) * 16384; sk = 128; sv = 1; vb = 32 * w; }
        else if constexpr (TYPE == 1) { sout = c.out + O_GLA_P + (((size_t)l * NB + b) * 4 + (hu >> 1)) * 32768; sk = 256; sv = 1; vb = 128 * (hu & 1) + 32 * w; }
        else { sout = c.out + O_SSD_P + (((size_t)l * NB + b) * 16 + 2 * hu + (w >> 1)) * 8192; sk = 1; sv = 128; vb = 32 * (w & 1); }
#pragma unroll
        for (int kt = 0; kt < 4; ++kt)
#pragma unroll
            for (int i = 0; i < 16; ++i) sout[(32 * kt + crow(i, hh)) * sk + (vb + r) * sv] = S[kt][i];
    }
}

constexpr int R_WT = 74752;
DI void rg_load_gates(const Ctx& c, int l, int n, int tid, int j, int hh, bf16x8 (&Br)[8], bf16x8 (&Bi)[8]) {
    LAS unsigned char* L = c.lds;
    const float* wr = c.in[I_WR] + (size_t)(l * 8 + n) * 128 * 128; const float* wi = c.in[I_WI] + (size_t)(l * 8 + n) * 128 * 128;
    __syncthreads();
    f32x4 v[16];
#pragma unroll
    for (int q = 0; q < 16; ++q) { const int e = tid + 512 * q, mat = e >> 12, rem = e & 4095; v[q] = *(const f32x4*)((mat ? wi : wr) + rem * 4); }
#pragma unroll
    for (int q = 0; q < 16; ++q) { const int e = tid + 512 * q, mat = e >> 12, rem = e & 4095, i = rem >> 5, j4 = (rem & 31) * 4;
        LAS unsigned char* p = L + R_WT + mat * 34816 + j4 * SQ + i * 2;
        *(LAS bf16_t*)(p) = (bf16_t)f2bf(v[q].x); *(LAS bf16_t*)(p + SQ) = (bf16_t)f2bf(v[q].y); *(LAS bf16_t*)(p + 2 * SQ) = (bf16_t)f2bf(v[q].z); *(LAS bf16_t*)(p + 3 * SQ) = (bf16_t)f2bf(v[q].w); }
    __syncthreads();
#pragma unroll
    for (int ks = 0; ks < 8; ++ks) { Br[ks] = ldfrag(L + R_WT + j * SQ + (16 * ks + 8 * hh) * 2); Bi[ks] = ldfrag(L + R_WT + 34816 + j * SQ + (16 * ks + 8 * hh) * 2); }
}
constexpr int R_XCB = 0, R_XCF = 17408, R_SUMA = 50176, R_SUMU = 58368, R_HIN = 66560;
DI void rg_chunk_unit(const Ctx& c, int l, int b, int n) {
    LAS unsigned char* L = c.lds;
    const int tid = get_tid(c.wave), lane = tid & 63, w = c.wave, r = lane & 31, hh = lane >> 5;
    const int tb = w >> 2, jb = w & 3;
    const int j = 32 * jb + r, ch = n * 128 + j;
    const int row0 = b * SEQ;
    const bf16_t* P = c.proj;
    LAS float* XCF = (LAS float*)(L + R_XCF); LAS float* SUMA = (LAS float*)(L + R_SUMA); LAS float* SUMU = (LAS float*)(L + R_SUMU); LAS float* HIN = (LAS float*)(L + R_HIN);
    bf16x8 Br[8], Bi[8];
    rg_load_gates(c, l, n, tid, j, hh, Br, Bi);
    const float sp = softplus(-c.in[I_LAM][l * 1024 + ch]), brv = c.in[I_BR][(l * 8 + n) * 128 + j], biv = c.in[I_BI][(l * 8 + n) * 128 + j];
    float cw[4][2], cb[2];
#pragma unroll
    for (int e = 0; e < 2; ++e) {
#pragma unroll
        for (int m = 0; m < 4; ++m) cw[m][e] = c.in[I_RCW][l * 4 * 1024 + m * 1024 + n * 128 + 2 * lane + e];
        cb[e] = c.in[I_RCB][l * 1024 + n * 128 + 2 * lane + e]; }
    float hcarry = 0.f;
    unsigned ux[11]; bf16_t gtr[16];
#define RG_LOAD(tn) do { const bf16_t* pq_ = P + (size_t)(row0 + (tn) + 8 * w) * LDP + C_RGX + n * 128 + 2 * lane; const bool first_ = ((tn) == 0 && w == 0); \
        _Pragma("unroll") for (int jx = 0; jx < 11; ++jx) ux[jx] = (first_ && jx < 3) ? 0u : *(const unsigned*)(pq_ + (ptrdiff_t)(jx - 3) * LDP); \
        const bf16_t* pg_ = P + (size_t)(row0 + (tn) + 32 * tb) * LDP; const int goff_ = 4 * hh * LDP + C_RGG + ch; \
        _Pragma("unroll") for (int i = 0; i < 16; ++i) gtr[i] = (pg_ + (size_t)((i & 3) + 8 * (i >> 2)) * LDP)[goff_]; } while (0)
    RG_LOAD(0);
    for (int ck = -(SEQ / 64) * (PROBE_RG_REP - 1); ck < SEQ / 64; ++ck) {
        if (PROBE_RG_REP > 1 && ck == 0) hcarry = 0.f;
        const int t0 = (ck & (SEQ / 64 - 1)) * 64;
#pragma unroll
        for (int i = 0; i < 8; ++i) { const int t = 8 * w + i;
            const float x0 = cb[0] + cw[0][0] * bflo(ux[i]) + cw[1][0] * bflo(ux[i + 1]) + cw[2][0] * bflo(ux[i + 2]) + cw[3][0] * bflo(ux[i + 3]);
            const float x1 = cb[1] + cw[0][1] * bfhi(ux[i]) + cw[1][1] * bfhi(ux[i + 1]) + cw[2][1] * bfhi(ux[i + 2]) + cw[3][1] * bfhi(ux[i + 3]);
            *(LAS f32x2*)(XCF + t * 128 + 2 * lane) = (f32x2){x0, x1}; *(LAS unsigned*)(L + R_XCB + t * SQ + 4 * lane) = pk2(x0, x1); }
        float gt[16];
#pragma unroll
        for (int i = 0; i < 16; ++i) gt[i] = bf1(gtr[i]);
        lds_barrier();
        if (ck + 1 < SEQ / 64) RG_LOAD(((ck + 1) & (SEQ / 64 - 1)) * 64);
        f32x16 R, I; ZERO16(R); ZERO16(I);
#pragma unroll
        for (int ks = 0; ks < 8; ++ks) { const bf16x8 a = ldfrag(L + R_XCB + (32 * tb + r) * SQ + (16 * ks + 8 * hh) * 2); R = mfma32(a, Br[ks], R); I = mfma32(a, Bi[ks], I); }
        float av[16], uv[16];
#pragma unroll
        for (int i = 0; i < 16; ++i) { const int t = 32 * tb + crow(i, hh); const float xc = XCF[t * 128 + j];
            const float e1 = fexp(fminf(-(R[i] + brv), 40.f)), e2 = fexp(fminf(-(I[i] + biv), 40.f)), p1 = 1.0f + e1, p2 = 1.0f + e2, inv = rcp(p1 * p2);
            const float rr = p2 * inv, ii = p1 * inv;
            const float la = -8.0f * rr * sp, a = fexp(la), x2 = 2.0f * la;
            const float ser = -x2 * (1.0f + 0.5f * x2 * (1.0f + 0.33333334f * x2 * (1.0f + 0.25f * x2 * (1.0f + 0.2f * x2))));
            const float om = fabsf(x2) < 0.25f ? ser : 1.0f - a * a;
            av[i] = a; uv[i] = __builtin_amdgcn_sqrtf(fmaxf(om, 0.f)) * (ii * xc); }
#pragma unroll
        for (int g = 0; g < 4; ++g) { float A = 1.f, U = 0.f;
#pragma unroll
            for (int m = 0; m < 4; ++m) { U = av[4 * g + m] * U + uv[4 * g + m]; A *= av[4 * g + m]; }
            const int gi = 8 * tb + 2 * g + hh; SUMA[gi * 128 + j] = A; SUMU[gi * 128 + j] = U; }
        lds_barrier();
        if (tid < 128) { float hc = hcarry, sa[16], su[16];
#pragma unroll
            for (int gi = 0; gi < 16; ++gi) { sa[gi] = SUMA[gi * 128 + tid]; su[gi] = SUMU[gi * 128 + tid]; }
#pragma unroll
            for (int gi = 0; gi < 16; ++gi) { HIN[gi * 128 + tid] = hc; hc = sa[gi] * hc + su[gi]; }
            hcarry = hc; }
        lds_barrier();
        { bf16_t* pm = c.mix + (size_t)(row0 + t0 + 32 * tb) * D_MIX; const int moff = 4 * hh * D_MIX + 1024 + ch;
#pragma unroll
          for (int g = 0; g < 4; ++g) { float hc = HIN[(8 * tb + 2 * g + hh) * 128 + j];
#pragma unroll
            for (int m = 0; m < 4; ++m) { const int i = 4 * g + m; hc = av[i] * hc + uv[i];
                (pm + (size_t)((i & 3) + 8 * (i >> 2)) * D_MIX)[moff] = (bf16_t)f2bf(hc * gt[i]); } } }
    }
#undef RG_LOAD
    if (tid < 128) c.out[O_RG_P + ((size_t)l * NB + b) * 1024 + n * 128 + tid] = hcarry;
}

DI void rg_sample_unit(const Ctx& c, int l, int n) {
    LAS unsigned char* L = c.lds;
    const int tid = get_tid(c.wave), lane = tid & 63, w = c.wave, r = lane & 31, hh = lane >> 5;
    const int tb = w >> 2, jb = w & 3;
    const int j = 32 * jb + r, ch = n * 128 + j;
    LAS float* XCF = (LAS float*)(L + R_XCF);
    bf16x8 Br[8], Bi[8];
    rg_load_gates(c, l, n, tid, j, hh, Br, Bi);
    const float sp = softplus(-c.in[I_LAM][l * 1024 + ch]), brv = c.in[I_BR][(l * 8 + n) * 128 + j], biv = c.in[I_BI][(l * 8 + n) * 128 + j];
    float cw[4][2], cb[2];
#pragma unroll
    for (int e = 0; e < 2; ++e) {
#pragma unroll
        for (int m = 0; m < 4; ++m) cw[m][e] = c.in[I_RCW][l * 4 * 1024 + m * 1024 + n * 128 + 2 * lane + e];
        cb[e] = c.in[I_RCB][l * 1024 + n * 128 + 2 * lane + e]; }
    for (int chunk = 0; chunk < 2; ++chunk) {
        __syncthreads();
#pragma unroll
        for (int i = 0; i < 8; ++i) { const int t = 8 * w + i, s = 64 * chunk + t;
            const float* buf = c.in[I_SRGC] + ((size_t)l * DEC + s) * 3 * 1024 + n * 128 + 2 * lane;
            const f32x2 b0 = *(const f32x2*)buf, b1 = *(const f32x2*)(buf + 1024), b2 = *(const f32x2*)(buf + 2048), xn = (f32x2){ps4(c.projs + (size_t)s * LDP + C_RGX + n * 128 + 2 * lane), ps4(c.projs + (size_t)s * LDP + C_RGX + n * 128 + 2 * lane + 1)} * row_rstd(c.rowsq + (size_t)l * M_PAD, TP + s);
            const float x0 = cb[0] + cw[0][0] * b0.x + cw[1][0] * b1.x + cw[2][0] * b2.x + cw[3][0] * xn.x;
            const float x1 = cb[1] + cw[0][1] * b0.y + cw[1][1] * b1.y + cw[2][1] * b2.y + cw[3][1] * xn.y;
            *(LAS f32x2*)(XCF + t * 128 + 2 * lane) = (f32x2){x0, x1}; *(LAS unsigned*)(L + R_XCB + t * SQ + 4 * lane) = pk2(x0, x1); }
        __syncthreads();
        f32x16 R, I; ZERO16(R); ZERO16(I);
#pragma unroll
        for (int ks = 0; ks < 8; ++ks) { const bf16x8 a = ldfrag(L + R_XCB + (32 * tb + r) * SQ + (16 * ks + 8 * hh) * 2); R = mfma32(a, Br[ks], R); I = mfma32(a, Bi[ks], I); }
#pragma unroll
        for (int i = 0; i < 16; ++i) { const int t = 32 * tb + crow(i, hh), s = 64 * chunk + t;
            const float rr = sigm(R[i] + brv), ii = sigm(I[i] + biv), xc = XCF[t * 128 + j];
            const float la = -8.0f * rr * sp, a = fexp(la);
            const float hn = a * c.in[I_SRG][((size_t)l * DEC + s) * 1024 + ch] + sqrtf(fmaxf(neg_expm1(2.0f * la), 0.f)) * (ii * xc);
            c.mix[(size_t)(TP + s) * D_MIX + 1024 + ch] = (bf16_t)f2bf(hn * silu(ps4(c.projs + (size_t)s * LDP + C_RGG + ch) * row_rstd(c.rowsq + (size_t)l * M_PAD, TP + s)));
            c.out[O_RG_S + ((size_t)l * DEC + s) * 1024 + ch] = hn; }
    }
}

#ifndef PROBE_REP_LONG
#define PROBE_REP_LONG 1
#endif
#ifndef PROBE_G1_REP
#define PROBE_G1_REP 1
#endif
#ifndef PROBE_REP_SHORT
#define PROBE_REP_SHORT 1
#endif
DI void xbc_prepass_item(const Ctx& c, int l, int it) {
    const int tid = get_tid(c.wave);
    const float* scw = c.in[I_SCW] + (size_t)l * 4 * 1536; const float* scb = c.in[I_SCB] + (size_t)l * 1536;
    const int r0 = ((it & 7) >> 1) * SEQ + (it >> 3) * 64 + (it & 1) * 32;
    const bool head = (r0 & (SEQ - 1)) == 0;
    for (int p = tid; p < 768; p += 512) {
        float cw[4][2], cb[2];
#pragma unroll
        for (int e = 0; e < 2; ++e) { cb[e] = scb[2 * p + e];
#pragma unroll
            for (int m = 0; m < 4; ++m) cw[m][e] = scw[m * 1536 + 2 * p + e]; }
        const bf16_t* src = c.proj + (size_t)r0 * LDP + C_XBC + 2 * p; bf16_t* dst = c.xbcs + (size_t)r0 * 1536 + 2 * p;
        unsigned u[35];
#pragma unroll
        for (int i = 0; i < 35; ++i) u[i] = (head && i < 3) ? 0u : *(const unsigned*)(src + (ptrdiff_t)(i - 3) * LDP);
#pragma unroll
        for (int i = 0; i < 32; ++i) {
            const float a = silu(cb[0] + cw[0][0] * bflo(u[i]) + cw[1][0] * bflo(u[i + 1]) + cw[2][0] * bflo(u[i + 2]) + cw[3][0] * bflo(u[i + 3]));
            const float b = silu(cb[1] + cw[0][1] * bfhi(u[i]) + cw[1][1] * bfhi(u[i + 1]) + cw[2][1] * bfhi(u[i + 2]) + cw[3][1] * bfhi(u[i + 3]));
            *(unsigned*)(dst + (size_t)i * 1536) = pk2(a, b); }
    }
}
DI void phase_mixer(int l, int wv) {
    const Ctx c = make_ctx(wv);
    constexpr int PER_B = 8 + 8 + 8 + 8;
    constexpr int N_LONG = NB * PER_B, N_SHORT = 8 + DEC * 3;
    constexpr int NREP = 1;
    volatile LAS int* slot = (volatile LAS int*)(c.lds + MISC_OFF + 64);
    unsigned* xpre = c.ctl + CW_XPRE + 128 * l;
    if (c.wg >= N_LONG || c.G <= N_LONG) {
        const int nfree = c.G > N_LONG ? c.G - N_LONG : c.G, first = c.G > N_LONG ? c.wg - N_LONG : c.wg;
        for (int it = first; it < TP / 32; it += nfree) {
            xbc_prepass_item(c, l, it);
            asm volatile("s_waitcnt vmcnt(0)" ::: "memory"); __syncthreads();
            if (c.tid == 0) { __builtin_amdgcn_fence(__ATOMIC_RELEASE, "agent"); asm volatile("s_waitcnt vmcnt(0)" ::: "memory");
                __hip_atomic_fetch_add(xpre + (it < 128 ? 0 : 64), 1u, __ATOMIC_RELAXED, __HIP_MEMORY_SCOPE_AGENT); }
        }
    }
    for (int rep = 0; rep < NREP; ++rep) {
    unsigned* ctr = c.ctl + CW_QCTR + 64 * (l * 4 + rep);
    int cur = c.wg; bool dyn = false;
    for (;;) {
        int item;
        if (!dyn) { if (cur < N_LONG) { item = cur; cur += c.G; } else { dyn = true; continue; } }
        else {
            __syncthreads();
            if (c.tid == 0) *slot = (int)atomicAdd(ctr, 1u);
            __syncthreads();
            item = N_LONG + *slot;
            if (item >= N_LONG + N_SHORT) break;
        }
        if (item < N_LONG) {
            const int b = item & 3, u = item >> 2;
            if (u < 8) la_head_unit<1>(c, l, b, u); else if (u < 16) la_head_unit<0>(c, l, b, u - 8); else if (u < 24) {
                if (c.tid == 0) { unsigned sp = 0; while (__hip_atomic_load(xpre, __ATOMIC_RELAXED, __HIP_MEMORY_SCOPE_AGENT) < 128u) { __builtin_amdgcn_s_sleep(8); if (++sp > (1u << 22)) break; }
                    __builtin_amdgcn_fence(__ATOMIC_ACQUIRE, "agent"); asm volatile("s_waitcnt vmcnt(0)" ::: "memory"); }
                __syncthreads();
                la_head_unit<2>(c, l, b, u - 16); } else rg_chunk_unit(c, l, b, u - 24);
            __syncthreads();
        } else { const int it = item - N_LONG;
            for (int rp = 0; rp < PROBE_REP_SHORT; ++rp) { if (it < 8) rg_sample_unit(c, l, it); else sample_item(c, l, (it - 8) / 3, (it - 8) % 3); } }
    }
    __syncthreads();
    }
}

DI void conv_states(const Ctx& c, int l) {
    const int gt = c.wg * 512 + get_tid(c.wave), NGT = c.G * 512;
    for (int i = gt; i < NB * 3 * 2560; i += NGT) {
        const int q = i / 7680, e = i % 7680, j = e / 2560, ch = e % 2560; const bool isrg = ch < 1024; const int chh = isrg ? ch : ch - 1024;
        const float v = bf1(c.proj[(size_t)(q * SEQ + SEQ - 3 + j) * LDP + (isrg ? C_RGX : C_XBC) + chh]);
        c.out[isrg ? O_RGC_P + ((size_t)l * NB + q) * 3072 + j * 1024 + chh : O_SSDC_P + ((size_t)l * NB + q) * 4608 + j * 1536 + chh] = v;
    }
    for (int i = gt; i < DEC * 1280; i += NGT) {
        const int s = i / 1280, e = i % 1280;
        if (e < 512) ((f32x4*)(c.out + O_RGC_S + ((size_t)l * DEC + s) * 3072))[e] = ((const f32x4*)(c.in[I_SRGC] + ((size_t)l * DEC + s) * 3072 + 1024))[e];
        else ((f32x4*)(c.out + O_SSDC_S + ((size_t)l * DEC + s) * 4608))[e - 512] = ((const f32x4*)(c.in[I_SSSDC] + ((size_t)l * DEC + s) * 4608 + 1536))[e - 512];
    }
    for (int i = gt; i < DEC * 2560; i += NGT) {
        const int s = i / 2560, ch = i % 2560; const bool isrg = ch < 1024; const int chh = isrg ? ch : ch - 1024;
        const float v = ps4(c.projs + (size_t)s * LDP + (isrg ? C_RGX : C_XBC) + chh) * row_rstd(c.rowsq + (size_t)l * M_PAD, TP + s);
        c.out[isrg ? O_RGC_S + ((size_t)l * DEC + s) * 3072 + 2048 + chh : O_SSDC_S + ((size_t)l * DEC + s) * 4608 + 3072 + chh] = v;
    }
}

DI void phase_dt(const Ctx& c, int l) {
    LAS float* PT = (LAS float*)c.lds;
    const int tid = get_tid(c.wave), lane = tid & 63, w = c.wave, r = lane & 31, hh = lane >> 5;
    for (int rt = c.wg; rt < TP / 32; rt += c.G) {
        const bf16_t* pa = c.xb + (size_t)(rt * 32 + r) * D_MODEL + w * 256 + 8 * hh;
        const bf16_t* pb = c.win + ((size_t)l * LDP + C_DT + r) * D_MODEL + w * 256 + 8 * hh;
        f32x16 acc; ZERO16(acc);
#pragma unroll
        for (int k4 = 0; k4 < 16; k4 += 8) { bf16x8 fa[8], fb[8];
#pragma unroll
            for (int u = 0; u < 8; ++u) { fa[u] = *(const bf16x8*)(pa + 16 * (k4 + u)); fb[u] = *(const bf16x8*)(pb + 16 * (k4 + u)); }
#pragma unroll
            for (int u = 0; u < 8; ++u) acc = mfma32(fa[u], fb[u], acc); }
        __syncthreads();
#pragma unroll
        for (int i = 0; i < 16; ++i) PT[w * 1024 + crow(i, hh) * 32 + r] = acc[i];
        __syncthreads();
        { const int row = tid >> 4, col = tid & 15; float s = 0.f;
#pragma unroll
          for (int q = 0; q < 8; ++q) s += PT[q * 1024 + row * 32 + col];
          c.dtb[(size_t)(rt * 32 + row) * 16 + col] = softplus(s * row_rstd(c.rowsq + (size_t)l * M_PAD, rt * 32 + row) + c.in[I_DTB][l * 16 + col]); }
    }
}

DI void g2_sample(const Ctx& c, int l) {
    LAS float* PT = (LAS float*)c.lds;
    const int tid = get_tid(c.wave), lane = tid & 63, w = c.wave, rr = lane & 15, quad = lane >> 4;
    float* rsq_next = c.rowsq + (size_t)(l + 1) * M_PAD;
    for (int ct = c.wg; ct < D_MODEL / 8; ct += c.G) {
        const bf16_t* pa = c.mix + (size_t)(TP + rr) * D_MIX + 512 * w + 8 * quad;
        const bf16_t* pb = c.wout + (size_t)l * D_MODEL * D_MIX + (size_t)(8 * ct + (rr & 7)) * D_MIX + 512 * w + 8 * quad;
        f32x4 acc[8];
#pragma unroll
        for (int rt = 0; rt < 8; ++rt) acc[rt] = (f32x4){0.f, 0.f, 0.f, 0.f};
#pragma unroll 1
        for (int k2 = 0; k2 < 16; k2 += 2) { bf16x8 fa[2][8], fb[2];
#pragma unroll
            for (int u = 0; u < 2; ++u) { fb[u] = *(const bf16x8*)(pb + 32 * (k2 + u));
#pragma unroll
                for (int rt = 0; rt < 8; ++rt) fa[u][rt] = *(const bf16x8*)(pa + (size_t)16 * rt * D_MIX + 32 * (k2 + u)); }
#pragma unroll
            for (int u = 0; u < 2; ++u) { const bf16x8 z = {0, 0, 0, 0, 0, 0, 0, 0}; const bf16x8 bb = rr < 8 ? fb[u] : z;
#pragma unroll
                for (int rt = 0; rt < 8; ++rt) acc[rt] = __builtin_amdgcn_mfma_f32_16x16x32_bf16(fa[u][rt], bb, acc[rt], 0, 0, 0); } }
        __syncthreads();
#pragma unroll
        for (int rt = 0; rt < 8; ++rt)
#pragma unroll
            for (int j = 0; j < 4; ++j) PT[(w * 128 + 16 * rt + 4 * quad + j) * 16 + rr] = acc[rt][j];
        __syncthreads();
        { const int row = tid >> 2, c2 = 2 * (tid & 3); float x0 = 0.f, x1 = 0.f;
#pragma unroll
          for (int q = 0; q < 8; ++q) { const f32x2 t = *(const LAS f32x2*)(PT + (q * 128 + row) * 16 + c2); x0 += t.x; x1 += t.y; }
          unsigned* xp = (unsigned*)(c.xb + (size_t)(TP + row) * D_MODEL + 8 * ct + c2); const unsigned o = *xp;
          x0 += bflo(o); x1 += bfhi(o); *xp = pk2(x0, x1);
          float ss = x0 * x0 + x1 * x1; ss += shx(ss, 1, lane); ss += shx(ss, 2, lane);
          if ((tid & 3) == 0) atomicAdd(rsq_next + TP + row, ss); }
    }
}

__global__ void __launch_bounds__(512, 2) mk_fwd(Params p) {
    extern __shared__ __attribute__((aligned(16))) unsigned char lds_raw[];
    LAS unsigned char* lds = (LAS unsigned char*)lds_raw;
    volatile LAS unsigned* misc = (volatile LAS unsigned*)(lds + MISC_OFF);
    const int wv = __builtin_amdgcn_readfirstlane(threadIdx.x >> 6);
    if (threadIdx.x < 32) misc[threadIdx.x] = 0u;
    __syncthreads();
    const int lo = p.ph_lo, hi = p.ph_hi;
    unsigned* barw = (unsigned*)(p.ws + WS_CTL) + CW_BAR;
    XcdBarrier bar; bar.bar = barw; bar.x = 0; bar.st = misc;
    if (hi - lo > 1) bar = xcd_barrier_post(barw, misc, get_tid(wv));
#define PH_IN(k) (lo <= (k) && (k) < hi)
#define SEAM(k) do { if (PH_IN(k) && PH_IN((k) + 1)) xcd_barrier(bar, wv); } while (0)
    if (PH_IN(0)) { phase_prologue(wv); }
    SEAM(0);
    for (int l = 0; l < DEPTH; ++l) {
        const int pb = 1 + 3 * l;
        if (PH_IN(pb)) {
            __syncthreads();
            const Ctx c = make_ctx(wv);
            {
                pg8::Gemm g{c.xb, c.win + (size_t)l * LDP * D_MODEL, TP, N_MAIN, D_MODEL, D_MODEL, D_MODEL}; pg8::StaticOrder S; S.init(TP, N_MAIN, c.G, c.wg); S.rep = PROBE_G1; S.balance = 1;
                pg8::EpiProj E{c.proj, c.lb + (size_t)l * 1024, c.in[I_HGN] + (size_t)l * 1024, c.in[I_GLN] + (size_t)l * 1024, c.in[I_GBU] + (size_t)l * 512, c.rowsq + (size_t)l * M_PAD};
                pg8::gemm_phase<pg8::EpiProj, pg8::StaticOrder>(c.lds, g, S, E, wv); }
            __syncthreads();
            {
                const int pn = c.wg % 49, ks = c.wg / 49;
                pg8::Gemm g{c.xb + (size_t)TP * D_MODEL + ks * 512, c.win + (size_t)l * LDP * D_MODEL + ks * 512, 256, LDP, 512, D_MODEL, D_MODEL};
                pg8::OneUnit S{0, pn, c.wg < 196 ? 1 : 0};
                pg8::EpiSample E{c.projs + (size_t)ks * PST};
                pg8::gemm_phase<pg8::EpiSample, pg8::OneUnit>(c.lds, g, S, E, wv); }
            __syncthreads();
            phase_dt(c, l);
            __syncthreads();
        }
        SEAM(pb);
        if (PH_IN(pb + 1)) phase_mixer(l, wv);
        SEAM(pb + 1);
        if (PH_IN(pb + 2)) {
            __syncthreads();
            const Ctx c = make_ctx(wv);
            {
                pg8::Gemm g{c.mix, c.wout + (size_t)l * D_MODEL * D_MIX, TP, D_MODEL, D_MIX, D_MIX, D_MIX}; pg8::StaticOrder S; S.init(TP, D_MODEL, c.G, c.wg);
                LAS float* tab = (LAS float*)(c.lds + pg8::STAGE_BYTES);
                pg8::EpiResid E{c.xb, c.rowsq + (size_t)(l + 1) * M_PAD, tab};
                const float* stats = (const float*)(c.ctl + CW_STATS) + (size_t)l * TP * 6;
                for (int i = 0; ; ++i) { pg8::Unit u; if (!S.next(i, u)) break;
                    __syncthreads();
                    { const int tid = get_tid(wv);
                      if (tid < 256) { const float* st = stats + (size_t)(u.pm * 256 + tid) * 6;
                        const f32x2 sa = *(const f32x2*)st, sb = *(const f32x2*)(st + 2), sc = *(const f32x2*)(st + 4);
                        const float d0 = __builtin_amdgcn_rsqf(sa.x * (1.0f / 512.0f) + EPS), d1 = __builtin_amdgcn_rsqf(sa.y * (1.0f / 512.0f) + EPS);
                        const float g0 = __builtin_amdgcn_rsqf(sb.x * (1.0f / 256.0f) + EPS), g1 = __builtin_amdgcn_rsqf(sb.y * (1.0f / 256.0f) + EPS), g2 = __builtin_amdgcn_rsqf(sc.x * (1.0f / 256.0f) + EPS), g3 = __builtin_amdgcn_rsqf(sc.y * (1.0f / 256.0f) + EPS);
                        tab[tid] = rcp(g0); tab[256 + tid] = g0 * rcp(g1); tab[512 + tid] = g1 * rcp(g2); tab[768 + tid] = g2 * rcp(g3); tab[1024 + tid] = g3 * rcp(d0); tab[1280 + tid] = d0 * rcp(d1); tab[1536 + tid] = d1; } }
                    __syncthreads();
                    pg8::OneUnit O{u.pm, u.pn, 1};
                    pg8::gemm_phase<pg8::EpiResid, pg8::OneUnit>(c.lds, g, O, E, wv); }
            }
            __syncthreads();
            g2_sample(c, l);
            __syncthreads();
            conv_states(c, l);
        }
        SEAM(pb + 2);
    }
    if (PH_IN(NPHASE - 1)) phase_final_norm(wv);
#undef PH_IN
#undef SEAM
}

extern "C" void kernel_launch(void* const* d_in, const int* in_sizes, int n_in, void* d_out, int out_size, void* d_ws, size_t ws_size, hipStream_t stream) {
    static int grid = 0;
    if (grid == 0) {
        if (n_in != N_INPUTS || (size_t)out_size != O_END || ws_size < WS_END) { fprintf(stderr, "kernel_launch: unexpected shapes (n_in %d out %d ws %zu)\n", n_in, out_size, ws_size); grid = -1; return; }
        int dev = 0, cus = 0;
        if (hipGetDevice(&dev) != hipSuccess || hipDeviceGetAttribute(&cus, hipDeviceAttributeMultiprocessorCount, dev) != hipSuccess) { grid = -1; return; }
        if (hipFuncSetAttribute((const void*)mk_fwd, hipFuncAttributeMaxDynamicSharedMemorySize, LDS_BYTES) != hipSuccess) { fprintf(stderr, "kernel_launch: hipFuncSetAttribute failed\n"); grid = -1; return; }
        int per_cu = 0;
        if (hipOccupancyMaxActiveBlocksPerMultiprocessor(&per_cu, (const void*)mk_fwd, 512, LDS_BYTES) != hipSuccess || per_cu < 1) fprintf(stderr, "kernel_launch: occupancy query says %d\n", per_cu);
        (void)hipGetLastError();
        grid = cus;
    }
    if (grid < 0) return;
    (void)hipMemsetAsync((char*)d_ws + WS_CTL, 0, CTL_ZERO_BYTES, stream);
    Params p{};
    for (int i = 0; i < N_INPUTS; ++i) p.in[i] = (const float*)d_in[i];
    p.out = (float*)d_out; p.ws = (unsigned char*)d_ws;
#if MK_ONE_LAUNCH
    p.ph_lo = 0; p.ph_hi = NPHASE;
    hipLaunchKernelGGL(mk_fwd, dim3(grid), dim3(512), LDS_BYTES, stream, p);
#else
    for (int ph = 0; ph < NPHASE; ++ph) { p.ph_lo = ph; p.ph_hi = ph + 1; hipLaunchKernelGGL(mk_fwd, dim3(grid), dim3(512), LDS_BYTES, stream, p); }
#endif
}
```

```cpp
#include <hip/hip_runtime.h>
#include <cstdio>
#include <cstdint>

#ifndef MK_ONE_LAUNCH
#define MK_ONE_LAUNCH 1
#endif

#ifndef PROBE_LONG_REP
#define PROBE_LONG_REP 1
#endif
#ifndef PROBE_RG_REP
#define PROBE_RG_REP PROBE_LONG_REP
#endif
#ifndef PROBE_G1_NOEPI
#define PROBE_G1_NOEPI 0
#endif
#ifndef PROBE_G2
#define PROBE_G2 0
#endif
#ifndef PROBE_G1
#define PROBE_G1 1
#endif
#define LAS __attribute__((address_space(3)))
#define DI __device__ __forceinline__

constexpr int D_MODEL = 2048, NB = 4, SEQ = 2048, DEPTH = 4, DEC = 128;
constexpr int BRANCH = 1024, D_MIX = 4096;
constexpr int TP = NB * SEQ;
constexpr int TT = TP + DEC;
constexpr int M_PAD = 8448;
constexpr int N_IN = 11808;
constexpr int LDP = 12544;
constexpr int N_MAIN = 12288;
constexpr int PST = 128 * LDP;
constexpr float EPS = 1e-6f, TINY = 1e-30f;
constexpr int C_HGQ = 0, C_HGF = 1024, C_HGI = 2048, C_HGG = 3072, C_RGX = 4096, C_RGG = 5120, C_GLQ = 6144, C_GLK = 6656, C_GLV = 7168, C_GLG = 8192,
              C_GLF = 9216, C_SSZ = 9728, C_XBC = 10752, C_DT = 12288;
constexpr int SRC_GLA = 9216, SRC_SSZ = 9232, SRC_DT = 11792;
enum { I_XP = 0, I_XS, I_SHG, I_SRG, I_SRGC, I_SGLA, I_SSSD, I_SSSDC, I_RMS, I_WIN, I_LB, I_HGN, I_RCW, I_RCB, I_WR, I_BR, I_WI, I_BI, I_LAM,
       I_GWU, I_GBU, I_GLN, I_SCW, I_SCB, I_DTB, I_ALOG, I_SD, I_SSN, I_WOUT, I_RMSF, N_INPUTS };
constexpr size_t O_YP = 0, O_YS = (size_t)TP * D_MODEL, O_HG_P = O_YS + (size_t)DEC * D_MODEL,
    O_RG_P = O_HG_P + (size_t)DEPTH * NB * 131072, O_RGC_P = O_RG_P + (size_t)DEPTH * NB * 1024, O_GLA_P = O_RGC_P + (size_t)DEPTH * NB * 3072,
    O_SSD_P = O_GLA_P + (size_t)DEPTH * NB * 131072, O_SSDC_P = O_SSD_P + (size_t)DEPTH * NB * 131072, O_HG_S = O_SSDC_P + (size_t)DEPTH * NB * 4608,
    O_RG_S = O_HG_S + (size_t)DEPTH * DEC * 131072, O_RGC_S = O_RG_S + (size_t)DEPTH * DEC * 1024, O_GLA_S = O_RGC_S + (size_t)DEPTH * DEC * 3072,
    O_SSD_S = O_GLA_S + (size_t)DEPTH * DEC * 131072, O_SSDC_S = O_SSD_S + (size_t)DEPTH * DEC * 131072, O_END = O_SSDC_S + (size_t)DEPTH * DEC * 4608;
constexpr size_t MiB = 1u << 20;
constexpr size_t WS_CTL = 0, CTL_ZERO_BYTES = 2 * MiB, WS_LB = 2 * MiB, WS_WIN = 3 * MiB, WS_WOUT = 199 * MiB, WS_XB = 263 * MiB, WS_PROJ = 296 * MiB,
    WS_DTB = 492 * MiB, WS_MIX = 493 * MiB, WS_PROJS = 559 * MiB, WS_XBCS = 584 * MiB, WS_END = 608 * MiB;
static_assert(WS_WIN + (size_t)DEPTH * LDP * D_MODEL * 2 <= WS_WOUT && WS_WOUT + (size_t)DEPTH * D_MODEL * D_MIX * 2 <= WS_XB && WS_XB + (size_t)M_PAD * D_MODEL * 2 <= WS_PROJ &&
              WS_PROJ + (size_t)TP * LDP * 2 <= WS_DTB && WS_DTB + (size_t)TP * 16 * 4 <= WS_MIX &&
              WS_MIX + (size_t)M_PAD * D_MIX * 2 <= WS_PROJS && WS_PROJS + (size_t)4 * DEC * LDP * 4 <= WS_XBCS && WS_XBCS + (size_t)TP * 1536 * 2 <= WS_END, "ws map");
constexpr int CW_BAR = 4096, CW_QCTR = 16384, CW_XPRE = 24576  , CW_STATS = 32768, CW_ROWSQ = 262144;
static_assert(CW_STATS + DEPTH * TP * 6 <= CW_ROWSQ && (size_t)(CW_ROWSQ + (DEPTH + 1) * M_PAD) * 4 <= CTL_ZERO_BYTES, "ctl map");
constexpr int LDS_BYTES = 147456, MISC_OFF = LDS_BYTES - 256;
constexpr int NPHASE = 2 + 3 * DEPTH;

typedef unsigned short bf16_t;
typedef short bf16x8 __attribute__((ext_vector_type(8)));
typedef float f32x4 __attribute__((ext_vector_type(4)));
typedef float f32x2 __attribute__((ext_vector_type(2)));
typedef float f32x16 __attribute__((ext_vector_type(16)));
typedef unsigned u32x4 __attribute__((ext_vector_type(4)));
typedef unsigned u32x2 __attribute__((ext_vector_type(2)));
typedef __bf16 bf16v2 __attribute__((ext_vector_type(2)));

DI unsigned pk2(float lo, float hi) { const f32x2 v = {lo, hi}; return __builtin_bit_cast(unsigned, __builtin_convertvector(v, bf16v2)); }
DI unsigned f2bf(float f) { return pk2(f, 0.f) & 0xffffu; }
DI float bflo(unsigned u) { return __builtin_bit_cast(float, u << 16); }
DI float bfhi(unsigned u) { return __builtin_bit_cast(float, u & 0xffff0000u); }
DI float bf1(bf16_t u) { return __builtin_bit_cast(float, (unsigned)u << 16); }
DI float ex2(float x) { return __builtin_amdgcn_exp2f(x); }
DI float lg2(float x) { return __builtin_amdgcn_logf(x); }
DI float rcp(float x) { return __builtin_amdgcn_rcpf(x); }
constexpr float LOG2E = 1.4426950408889634f, LN2 = 0.6931471805599453f;
DI float fexp(float x) { return ex2(x * LOG2E); }
DI float flog(float x) { return lg2(x) * LN2; }
DI float sigm(float x) { return rcp(1.0f + fexp(-x)); }
DI float silu(float x) { return x * sigm(x); }
DI float sigm_fast(float x) { return sigm(x); }
DI float silu_fast(float x) { return silu(x); }
DI float log1p_pos(float e) { const float a = e * (1.0f - e * (0.5f - e * (0.33333334f - 0.25f * e))), b = flog(1.0f + e); return e < 0.03f ? a : b; }
DI float softplus(float x) { return fmaxf(x, 0.f) + log1p_pos(fexp(-fabsf(x))); }
DI float neg_expm1(float x) { const float a = -x * (1.0f + 0.5f * x * (1.0f + 0.33333334f * x * (1.0f + 0.25f * x * (1.0f + 0.2f * x)))), b = 1.0f - fexp(x); return fabsf(x) < 0.25f ? a : b; }
DI float row_rstd(const float* rowsq, int row) { return __builtin_amdgcn_rsqf(rowsq[row] * (1.0f / D_MODEL) + EPS); }
DI float clampf(float x, float lo, float hi) { return fminf(fmaxf(x, lo), hi); }
DI float shx(float v, int mask, int lane) { return __builtin_bit_cast(float, __builtin_amdgcn_ds_bpermute((lane ^ mask) << 2, __builtin_bit_cast(int, v))); }
DI float shup(float v, int o, int lane) { return __builtin_bit_cast(float, __builtin_amdgcn_ds_bpermute((lane >= o ? lane - o : lane) << 2, __builtin_bit_cast(int, v))); }
DI float wave_sum(float v, int lane) {
#pragma unroll
    for (int o = 1; o < 64; o <<= 1) v += shx(v, o, lane);
    return v;
}

struct Params { const float* in[N_INPUTS]; float* out; unsigned char* ws; int ph_lo, ph_hi; };
static_assert(sizeof(Params) == N_INPUTS * 8 + 8 + 8 + 8, "no padding holes in Params");
typedef const __attribute__((address_space(4))) Params* KP;
DI KP get_params() { auto kp = __builtin_amdgcn_kernarg_segment_ptr(); asm volatile("" : "+s"(kp)); return (KP)kp; }
DI int get_tid(int wv) { int ln; asm volatile("v_mbcnt_lo_u32_b32 %0, -1, 0\n\tv_mbcnt_hi_u32_b32 %0, -1, %0" : "=v"(ln)); return (wv << 6) | ln; }

#define XB_TMO      128
#define XB_XCNT(j)  (256  + 64 * (j))
#define XB_XSUB(j)  (1280 + 64 * (j))
#define XB_XGEN(j)  (2304 + 64 * (j))
#define XB_TOP      3328
#define XB_TOPGEN   3392
#define XCD_BAR_WORDS 3456
#define XB_SPIN_CAP (1u << 20)
DI unsigned xb_ld(unsigned* p)              { return __hip_atomic_load(p, __ATOMIC_RELAXED, __HIP_MEMORY_SCOPE_AGENT); }
DI unsigned xb_add(unsigned* p, unsigned v) { return __hip_atomic_fetch_add(p, v, __ATOMIC_RELAXED, __HIP_MEMORY_SCOPE_AGENT); }
DI unsigned xb_xcc_id() { return (unsigned)__builtin_amdgcn_s_getreg((3 << 11) | 20) & 0xFu; }
#define XB_SPIN(cond, bar) do { unsigned _sp = 0; while (cond) { __builtin_amdgcn_s_sleep(1); \
    if ((++_sp & 255u) == 0u) { if (xb_ld(&(bar)[XB_TMO])) break; if (_sp > XB_SPIN_CAP) { atomicAdd(&(bar)[XB_TMO], 1u); break; } } } } while (0)
struct XcdBarrier { unsigned* bar; unsigned x; volatile LAS unsigned* st; };
DI XcdBarrier xcd_barrier_post(unsigned* bar, volatile LAS unsigned* st, int tid) {
    XcdBarrier b; b.bar = bar; b.x = xb_xcc_id(); b.st = st;
    if (tid == 0) (void)xb_add(&bar[XB_XCNT(b.x)], 1u);
    return b;
}
DI void xcd_barrier_complete(unsigned* bar, unsigned x, unsigned& nloc, unsigned& nx) {
    const unsigned G = gridDim.x * gridDim.y * gridDim.z;
    unsigned sum, cnt, mine, sp = 0u;
    for (;;) {
        sum = 0u; cnt = 0u; mine = 0u;
#pragma unroll
        for (unsigned j = 0; j < 16; ++j) { const unsigned c = xb_ld(&bar[XB_XCNT(j)]); sum += c; cnt += (c > 0u) ? 1u : 0u; mine = (j == x) ? c : mine; }
        if (sum == G) break;
        __builtin_amdgcn_s_sleep(1);
        if ((++sp & 255u) == 0u) { if (xb_ld(&bar[XB_TMO])) break; if (sp > XB_SPIN_CAP) { atomicAdd(&bar[XB_TMO], 1u); break; } }
    }
    nloc = mine > 0u ? mine : 1u; nx = cnt > 0u ? cnt : 1u;
}
DI void xcd_barrier(const XcdBarrier& b, int wv) {
    asm volatile("s_waitcnt vmcnt(0)" ::: "memory");
    __syncthreads();
    if (get_tid(wv) == 0) {
        unsigned* bar = b.bar;
        __builtin_amdgcn_s_waitcnt(0);
        unsigned nloc = b.st[0], nx = b.st[1];
        if (nloc == 0u) { xcd_barrier_complete(bar, b.x, nloc, nx); b.st[0] = nloc; b.st[1] = nx; }
        const unsigned old = xb_add(&bar[XB_XSUB(b.x)], 1u);
        const unsigned gen = old / nloc;
        if (old + 1u == (gen + 1u) * nloc) {
            __builtin_amdgcn_fence(__ATOMIC_RELEASE, "agent");
            asm volatile("s_waitcnt vmcnt(0)" ::: "memory");
            const unsigned og = xb_add(&bar[XB_TOP], 1u);
            const unsigned tg = og / nx;
            if (og + 1u == (tg + 1u) * nx) xb_add(&bar[XB_TOPGEN], 1u);
            else XB_SPIN(xb_ld(&bar[XB_TOPGEN]) == tg, bar);
            __builtin_amdgcn_fence(__ATOMIC_ACQUIRE, "agent");
            xb_add(&bar[XB_XGEN(b.x)], 1u);
            asm volatile("s_waitcnt vmcnt(0)" ::: "memory");
        } else {
            XB_SPIN(xb_ld(&bar[XB_XGEN(b.x)]) == gen, bar);
            __builtin_amdgcn_fence(__ATOMIC_ACQUIRE, "agent");
            asm volatile("s_waitcnt vmcnt(0)" ::: "memory");
        }
    }
    __syncthreads();
}

namespace pg8 {
constexpr int BM = 256, BK = 64, HALF = 128, HTB = HALF * BK * 2, STAGE_BYTES = 8 * HTB, NXCD = 8, WGM = 8;
DI int lds_byte(int r, int c) { const int st = (r >> 4) * 2 + (c >> 5), rr = r & 15, cc = c & 31, ob = rr * 64 + cc * 2; return st * 1024 + (ob ^ (((ob >> 9) & 1) << 5)); }
DI void stage_rc(int b, int& R, int& C) { const int st = b / 1024, sb = b % 1024, swz = sb ^ (((sb >> 9) & 1) << 5); R = (st >> 1) * 16 + swz / 64; C = (st & 1) * 32 + (swz % 64) / 2; }
DI int perm32(int rho) { const int n = rho >> 4, i = rho & 15; return 8 * (i >> 2) + 4 * n + (i & 3); }
struct Unit { int pm, pn; };
struct Gemm { const bf16_t* A; const bf16_t* Bt; int M, N, K, lda, ldb; };
struct StaticOrder {
    int nM, nN, nwg, G, c, rep = 1, balance = 0;
    DI void init(int M, int N, int G_, int c_) { nM = M / BM; nN = N / BM; nwg = nM * nN; G = G_; c = c_; }
    DI bool next(int i, Unit& u) const {
        const long L = (long)(i / rep) * G + c; if (L >= nwg) return false;
        int wgid = (int)L; { const int q = nwg / NXCD, r = nwg % NXCD, xcd = wgid % NXCD, off = wgid / NXCD; wgid = (xcd < r ? xcd * (q + 1) : r * (q + 1) + (xcd - r) * q) + off; }
        const int nig = WGM * nN, gid = wgid / nig, fm = gid * WGM, gsz = (nM - fm) < WGM ? (nM - fm) : WGM;
        u.pm = fm + ((wgid % nig) % gsz); u.pn = (wgid % nig) / gsz;
        if (balance) {
            const int p = u.pn / 24, r = u.pn % 24, i = r >> 2, j = r & 3;
            const unsigned long long T0 = 0x1810080c0004ull  , T1 = 0x2a1e1c161424ull  , T2 = 0x2e2c28262220ull  ;
            u.pn = p == 0 ? (int)((T0 >> (8 * i)) & 0xff) + j : j < 2 ? (int)((T1 >> (8 * i)) & 0xff) + j : (int)((T2 >> (8 * i)) & 0xff) + (j - 2);
        }
        return true;
    }
    DI void a_ready(const Unit&) const {}
    DI void done(const Unit&) const {}
};
struct EpiProj {
    static constexpr bool PERM = true, TWICE = PROBE_G1_NOEPI != 0, KSCALE = false;
    bf16_t* P; const float* lb; const float* hgn; const float* gln; const float* bup; const float* rsq;
    template <int MODE>
    DI void body(const f32x4 (&acc)[2][2][4][2], bf16_t* prow, const float* vec, float scale, const float (&rs)[2][4]) const {
        f32x4 cv[2][2];
#pragma unroll
        for (int bj = 0; bj < 2; ++bj) { cv[bj][0] = (f32x4){1.f, 1.f, 1.f, 1.f}; cv[bj][1] = cv[bj][0];
            if constexpr (MODE >= 2) { cv[bj][0] = *(const f32x4*)(vec + bj * HALF); cv[bj][1] = *(const f32x4*)(vec + bj * HALF + 4); } }
#pragma unroll
        for (int bj = 0; bj < 2; ++bj) {
            const f32x4 c0 = cv[bj][0], c1 = cv[bj][1];
#pragma unroll
            for (int ai = 0; ai < 2; ++ai)
#pragma unroll
                for (int m = 0; m < 4; ++m) {
                    f32x4 a = acc[ai][bj][m][0] * rs[ai][m], b = acc[ai][bj][m][1] * rs[ai][m];
                    if constexpr (MODE == 0) { a = a * scale; b = b * scale; }
                    else if constexpr (MODE == 1) { a = (f32x4){silu(a.x), silu(a.y), silu(a.z), silu(a.w)}; b = (f32x4){silu(b.x), silu(b.y), silu(b.z), silu(b.w)}; }
                    else if constexpr (MODE == 2) { a = (f32x4){silu(a.x), silu(a.y), silu(a.z), silu(a.w)} * c0; b = (f32x4){silu(b.x), silu(b.y), silu(b.z), silu(b.w)} * c1; }
                    else if constexpr (MODE == 3) {
#define LOGF(x, l) flog(fmaxf((l) + (1.0f - (l)) * sigm(x), TINY))
                        a = (f32x4){LOGF(a.x, c0.x), LOGF(a.y, c0.y), LOGF(a.z, c0.z), LOGF(a.w, c0.w)}; b = (f32x4){LOGF(b.x, c1.x), LOGF(b.y, c1.y), LOGF(b.z, c1.z), LOGF(b.w, c1.w)};
#undef LOGF
                    } else {
#define LSIG(x, bb) (-0.0625f * (fmaxf(-((x) + (bb)), 0.f) + flog(1.0f + fexp(-fabsf((x) + (bb))))))
                        a = (f32x4){LSIG(a.x, c0.x), LSIG(a.y, c0.y), LSIG(a.z, c0.z), LSIG(a.w, c0.w)}; b = (f32x4){LSIG(b.x, c1.x), LSIG(b.y, c1.y), LSIG(b.z, c1.z), LSIG(b.w, c1.w)};
#undef LSIG
                    }
                    u32x4 w4; w4.x = pk2(a.x, a.y); w4.y = pk2(a.z, a.w); w4.z = pk2(b.x, b.y); w4.w = pk2(b.z, b.w);
                    *(u32x4*)(prow + (size_t)(ai * HALF + m * 16) * LDP + bj * HALF) = w4;
                }
        }
    }
    DI void operator()(const f32x4 (&acc)[2][2][4][2], const Unit& u, int wr, int wc, int fr, int fq) const {
        const int col = u.pn * BM + wc * 32 + 8 * fq;
        bf16_t* prow = P + (size_t)(u.pm * BM + wr * 64 + fr) * LDP + col;
        float rs[2][4];
#pragma unroll
        for (int ai = 0; ai < 2; ++ai)
#pragma unroll
            for (int m = 0; m < 4; ++m) rs[ai][m] = rsq[u.pm * BM + wr * 64 + fr + ai * HALF + m * 16];
#pragma unroll
        for (int ai = 0; ai < 2; ++ai)
#pragma unroll
            for (int m = 0; m < 4; ++m) rs[ai][m] = __builtin_amdgcn_rsqf(rs[ai][m] * (1.0f / D_MODEL) + EPS);
        const int pn = u.pn;
        if (pn < 4) body<1>(acc, prow, nullptr, 1.f, rs);
        else if (pn < 8) body<3>(acc, prow, lb + (col - C_HGF), 1.f, rs);
        else if (pn < 12) body<0>(acc, prow, nullptr, 1.f, rs);
        else if (pn < 16) body<2>(acc, prow, hgn + (col - C_HGG), 1.f, rs);
        else if (pn < 20) body<0>(acc, prow, nullptr, 1.f, rs);
        else if (pn < 24) body<1>(acc, prow, nullptr, 1.f, rs);
        else if (pn < 26) body<0>(acc, prow, nullptr, 0.08838834764831845f, rs);
        else if (pn < 32) body<0>(acc, prow, nullptr, 1.f, rs);
        else if (pn < 36) body<2>(acc, prow, gln + (col - C_GLG), 1.f, rs);
        else if (pn < 38) body<4>(acc, prow, bup + (col - C_GLF), 1.f, rs);
        else if (pn < 42) body<1>(acc, prow, nullptr, 1.f, rs);
        else body<0>(acc, prow, nullptr, 1.f, rs);
    }
};
struct EpiSample {
    static constexpr bool PERM = false, TWICE = false, KSCALE = false;
    float* PS;
    DI void operator()(const f32x4 (&acc)[2][2][4][2], const Unit& u, int wr, int wc, int fr, int fq) const {
        const int row0 = wr * 64 + fr, col0 = u.pn * BM + wc * 32 + 4 * fq;
#pragma unroll
        for (int m = 0; m < 4; ++m) { float* op = PS + (size_t)(row0 + m * 16) * LDP + col0;
#pragma unroll
            for (int bj = 0; bj < 2; ++bj)
#pragma unroll
                for (int n = 0; n < 2; ++n) *(f32x4*)(op + bj * HALF + n * 16) = acc[0][bj][m][n]; }
    }
};
struct EpiResid {
    static constexpr bool PERM = true, TWICE = false, KSCALE = true;
    bf16_t* xb; float* rsq_next; const LAS float* tab;
    DI void rescale(f32x4 (&acc)[2][2][4][2], int seg, int wr, int fr) const {
#pragma unroll
        for (int ai = 0; ai < 2; ++ai)
#pragma unroll
            for (int m = 0; m < 4; ++m) { const float r = tab[seg * 256 + ai * HALF + wr * 64 + m * 16 + fr];
#pragma unroll
                for (int bj = 0; bj < 2; ++bj) { acc[ai][bj][m][0] = acc[ai][bj][m][0] * r; acc[ai][bj][m][1] = acc[ai][bj][m][1] * r; } }
    }
    DI void operator()(f32x4 (&acc)[2][2][4][2], const Unit& u, int wr, int wc, int fr, int fq) const {
        rescale(acc, 6, wr, fr);
        const int row0 = u.pm * BM + wr * 64 + fr, col0 = u.pn * BM + wc * 32 + 8 * fq;
#pragma unroll
        for (int ai = 0; ai < 2; ++ai) {
            u32x4 ob[4][2];
#pragma unroll
            for (int m = 0; m < 4; ++m)
#pragma unroll
                for (int bj = 0; bj < 2; ++bj) ob[m][bj] = *(const u32x4*)(xb + (size_t)(row0 + ai * HALF + m * 16) * D_MODEL + col0 + bj * HALF);
#pragma unroll
            for (int m = 0; m < 4; ++m) { const int row = row0 + ai * HALF + m * 16; bf16_t* xp = xb + (size_t)row * D_MODEL + col0; float ss = 0.f;
#pragma unroll
                for (int bj = 0; bj < 2; ++bj) { const u32x4 o = ob[m][bj]; const f32x4 a = acc[ai][bj][m][0], b = acc[ai][bj][m][1];
                    const float x0 = bflo(o.x) + a.x, x1 = bfhi(o.x) + a.y, x2 = bflo(o.y) + a.z, x3 = bfhi(o.y) + a.w, x4 = bflo(o.z) + b.x, x5 = bfhi(o.z) + b.y, x6 = bflo(o.w) + b.z, x7 = bfhi(o.w) + b.w;
                    ss += ((x0 * x0 + x1 * x1) + (x2 * x2 + x3 * x3)) + ((x4 * x4 + x5 * x5) + (x6 * x6 + x7 * x7));
                    u32x4 n4; n4.x = pk2(x0, x1); n4.y = pk2(x2, x3); n4.z = pk2(x4, x5); n4.w = pk2(x6, x7); *(u32x4*)(xp + bj * HALF) = n4; }
                const int lane = fq * 16 + fr; ss += shx(ss, 16, lane); ss += shx(ss, 32, lane);
                if (fq == 0) atomicAdd(rsq_next + row, ss); }
        }
    }
};
struct OneUnit {
    int pm, pn, have;
    DI bool next(int i, Unit& u) const { if (i != 0 || !have) return false; u.pm = pm; u.pn = pn; return true; }
    DI void a_ready(const Unit&) const {}
    DI void done(const Unit&) const {}
};
template <class Epi, class Sched>
DI void gemm_phase(LAS unsigned char* lds, const Gemm g, const Sched& S, const Epi& E, int wv) {
    const int tid = get_tid(wv), wid = wv, lane = tid & 63, wr = wid >> 2, wc = wid & 3, fr = lane & 15, fq = lane >> 4;
    const int K = g.K, nt = K / BK;
    unsigned voffA[2], voffB[2];
#pragma unroll
    for (int i = 0; i < 2; ++i) { int R, C; stage_rc(tid * 16 + i * 8192, R, C); const int Rb = Epi::PERM ? ((R & ~31) + perm32(R & 31)) : R;
        voffA[i] = (unsigned)(R * g.lda + C) * 2u; voffB[i] = (unsigned)(Rb * g.ldb + C) * 2u; }
    const size_t kstep = (size_t)(BK * 2);
    const size_t hstepA = (size_t)HALF * g.lda * 2, hstepB = (size_t)HALF * g.ldb * 2;
    const size_t tstepA = 2 * hstepA, tstepB = 2 * hstepB;
    const unsigned ldsw = (unsigned)wid * 1024u;
    const int aoff = lds_byte(wr * 64 + fr, fq * 8), boff = lds_byte(wc * 32 + fr, fq * 8);
#define PG8_SA(b, h) (((b) * 2 + (h)) * HTB)
#define PG8_SB(b, h) ((4 + (b) * 2 + (h)) * HTB)
#define PG8_STAGE(bufoff, gbase, voff) do { _Pragma("unroll") for (int _i = 0; _i < 2; ++_i) \
        __builtin_amdgcn_global_load_lds((const unsigned*)((const char*)(gbase) + (voff)[_i]), (LAS unsigned*)(lds + (bufoff) + ldsw + _i * 8192), 16, 0, 0); } while (0)
#define PG8_LDA(dst, b, h) do { _Pragma("unroll") for (int m = 0; m < 4; ++m) _Pragma("unroll") for (int k = 0; k < 2; ++k) dst[m][k] = *(const LAS bf16x8*)(lds + PG8_SA(b, h) + aoff + m * 2048 + k * 1024); } while (0)
#define PG8_LDB(dst, b, h) do { _Pragma("unroll") for (int n = 0; n < 2; ++n) _Pragma("unroll") for (int k = 0; k < 2; ++k) dst[n][k] = *(const LAS bf16x8*)(lds + PG8_SB(b, h) + boff + n * 2048 + k * 1024); } while (0)
#define PG8_MMA(ai, bj, At, Bt) do { __builtin_amdgcn_s_setprio(1); _Pragma("unroll") for (int m = 0; m < 4; ++m) _Pragma("unroll") for (int n = 0; n < 2; ++n) _Pragma("unroll") for (int k = 0; k < 2; ++k) \
        acc[ai][bj][m][n] = __builtin_amdgcn_mfma_f32_16x16x32_bf16(Bt[n][k], At[m][k], acc[ai][bj][m][n], 0, 0, 0); __builtin_amdgcn_s_setprio(0); } while (0)
#define PG8_WAIT_V(n) asm volatile("s_waitcnt vmcnt(" #n ")" ::: "memory")
#define PG8_WAIT_L(n) asm volatile("s_waitcnt lgkmcnt(" #n ")" ::: "memory")
#define PG8_BAR __builtin_amdgcn_s_barrier()
#define PG8_SCHED __builtin_amdgcn_sched_barrier(0)
    Unit cur, nxt; int ui = 0;
    if (!S.next(0, cur)) return;
    f32x4 acc[2][2][4][2];
#pragma unroll
    for (int a = 0; a < 2; ++a)
#pragma unroll
        for (int b = 0; b < 2; ++b)
#pragma unroll
            for (int m = 0; m < 4; ++m)
#pragma unroll
                for (int n = 0; n < 2; ++n) acc[a][b][m][n] = (f32x4){0.f, 0.f, 0.f, 0.f};
    bf16x8 At[4][2], B0[2][2], B1[2][2];
    const char* cA = (const char*)g.A + (size_t)cur.pm * tstepA; const char* cB = (const char*)g.Bt + (size_t)cur.pn * tstepB;
    S.a_ready(cur);
    PG8_STAGE(PG8_SB(0, 0), cB, voffB); PG8_STAGE(PG8_SA(0, 0), cA, voffA); PG8_STAGE(PG8_SB(0, 1), cB + hstepB, voffB); PG8_STAGE(PG8_SA(0, 1), cA + hstepA, voffA);
    if (wr == 1) PG8_BAR;
    PG8_WAIT_V(4); PG8_BAR;
    PG8_STAGE(PG8_SB(1, 0), cB + kstep, voffB); PG8_STAGE(PG8_SA(1, 0), cA + kstep, voffA); PG8_STAGE(PG8_SB(1, 1), cB + hstepB + kstep, voffB);
    PG8_WAIT_V(6); PG8_BAR;
    for (;;) {
        const bool has_next = S.next(ui + 1, nxt);
        const char* nA = has_next ? (const char*)g.A + (size_t)nxt.pm * tstepA : cA; const char* nB = has_next ? (const char*)g.Bt + (size_t)nxt.pn * tstepB : cB;
        for (int t = 0; t < nt; t += 2) {
            const bool last = (t == nt - 2);
            const char* a1 = cA + (size_t)(t + 1) * kstep;
            const char* a2 = last ? nA : cA + (size_t)(t + 2) * kstep; const char* b2 = last ? nB : cB + (size_t)(t + 2) * kstep;
            const char* a3 = a2 + kstep; const char* b3 = b2 + kstep;
            if (last && has_next) S.a_ready(nxt);
            if constexpr (Epi::KSCALE) { if (t >= 32 && (t & 3) == 0 && (t < 48 || (t & 7) == 0)) E.rescale(acc, t < 48 ? (t - 32) >> 2 : 4 + ((t - 48) >> 3), wr, fr); }
            PG8_LDB(B0, 0, 0); PG8_SCHED; PG8_LDA(At, 0, 0); PG8_STAGE(PG8_SA(1, 1), a1 + hstepA, voffA);
            PG8_WAIT_L(8); PG8_BAR; PG8_WAIT_L(0); PG8_MMA(0, 0, At, B0); PG8_BAR; PG8_SCHED;
            PG8_LDB(B1, 0, 1); PG8_STAGE(PG8_SB(0, 0), b2, voffB);
            PG8_BAR; PG8_WAIT_L(0); PG8_MMA(0, 1, At, B1); PG8_BAR;
            PG8_LDA(At, 0, 1); PG8_STAGE(PG8_SA(0, 0), a2, voffA);
            PG8_BAR; PG8_WAIT_L(0); PG8_MMA(1, 0, At, B0); PG8_BAR; PG8_SCHED;
            PG8_STAGE(PG8_SB(0, 1), b2 + hstepB, voffB);
            PG8_WAIT_V(6); PG8_BAR; PG8_MMA(1, 1, At, B1); PG8_BAR;
            PG8_LDB(B0, 1, 0); PG8_SCHED; PG8_LDA(At, 1, 0); PG8_STAGE(PG8_SA(0, 1), a2 + hstepA, voffA);
            PG8_WAIT_L(8); PG8_BAR; PG8_WAIT_L(0); PG8_MMA(0, 0, At, B0); PG8_BAR; PG8_SCHED;
            PG8_LDB(B1, 1, 1); PG8_STAGE(PG8_SB(1, 0), b3, voffB);
            PG8_BAR; PG8_WAIT_L(0); PG8_MMA(0, 1, At, B1); PG8_BAR;
            PG8_LDA(At, 1, 1); PG8_STAGE(PG8_SA(1, 0), a3, voffA);
            PG8_BAR; PG8_WAIT_L(0); PG8_MMA(1, 0, At, B0); PG8_BAR; PG8_SCHED;
            PG8_STAGE(PG8_SB(1, 1), b3 + hstepB, voffB);
            PG8_WAIT_V(6); PG8_BAR; PG8_MMA(1, 1, At, B1); PG8_BAR;
        }
        E(acc, cur, wr, wc, fr, fq);
        if constexpr (Epi::TWICE) {
#pragma unroll
            for (int a = 0; a < 2; ++a)
#pragma unroll
                for (int b = 0; b < 2; ++b) asm volatile("" : "+v"(acc[a][b][0][0]), "+v"(acc[a][b][0][1]), "+v"(acc[a][b][1][0]), "+v"(acc[a][b][1][1]), "+v"(acc[a][b][2][0]), "+v"(acc[a][b][2][1]), "+v"(acc[a][b][3][0]), "+v"(acc[a][b][3][1]) :: "memory");
            E(acc, cur, wr, wc, fr, fq); }
        S.done(cur);
        if (!has_next) break;
#pragma unroll
        for (int a = 0; a < 2; ++a)
#pragma unroll
            for (int b = 0; b < 2; ++b)
#pragma unroll
                for (int m = 0; m < 4; ++m)
#pragma unroll
                    for (int n = 0; n < 2; ++n) acc[a][b][m][n] = (f32x4){0.f, 0.f, 0.f, 0.f};
        cur = nxt; cA = nA; cB = nB; ++ui;
    }
    PG8_WAIT_V(0);
    if (wr == 0) PG8_BAR;
    PG8_BAR;
#undef PG8_SA
#undef PG8_SB
#undef PG8_STAGE
#undef PG8_LDA
#undef PG8_LDB
#undef PG8_MMA
#undef PG8_WAIT_V
#undef PG8_WAIT_L
#undef PG8_BAR
#undef PG8_SCHED
}
}

struct Ctx {
    KP kp; const float* const __attribute__((address_space(4)))* in; float* out; unsigned char* ws;
    LAS unsigned char* lds;
    int tid, lane, wave, G, wg;
    float* lb; bf16_t* win; bf16_t* wout; bf16_t* xb; bf16_t* proj; float* projs; float* dtb; bf16_t* mix; bf16_t* xbcs; float* rowsq; unsigned* ctl;
};
DI Ctx make_ctx(int wv) {
    extern __shared__ __attribute__((aligned(16))) unsigned char lds_raw[];
    Ctx c; c.kp = get_params(); c.in = c.kp->in; c.out = c.kp->out; c.ws = c.kp->ws;
    c.lds = (LAS unsigned char*)lds_raw;
    asm volatile("" : "+s"(wv));
    int wg = blockIdx.x; asm volatile("" : "+s"(wg));
    c.tid = get_tid(wv); c.lane = c.tid & 63; c.wave = wv; c.G = gridDim.x; c.wg = wg;
    unsigned char* ws = c.ws;
    c.ctl = (unsigned*)(ws + WS_CTL); c.lb = (float*)(ws + WS_LB); c.win = (bf16_t*)(ws + WS_WIN); c.wout = (bf16_t*)(ws + WS_WOUT); c.xb = (bf16_t*)(ws + WS_XB);
    c.proj = (bf16_t*)(ws + WS_PROJ); c.projs = (float*)(ws + WS_PROJS); c.dtb = (float*)(ws + WS_DTB); c.mix = (bf16_t*)(ws + WS_MIX); c.xbcs = (bf16_t*)(ws + WS_XBCS); c.rowsq = (float*)(c.ctl + CW_ROWSQ);
    return c;
}

DI void p0_transpose_item(const float* W, int ldw, int k0, int n0, bf16_t* WT, int K, int drow0, LAS float* scr, int lane, const float* ksc) {
    float t[32];
#pragma unroll
    for (int i = 0; i < 32; ++i) t[i] = W[(size_t)(k0 + 2 * i + (lane >> 5)) * ldw + n0 + (lane & 31)];
#pragma unroll
    for (int i = 0; i < 32; ++i) scr[(2 * i + (lane >> 5)) * 33 + (lane & 31)] = t[i];
    const int c = lane & 7;
    f32x4 s0 = (f32x4){1.f, 1.f, 1.f, 1.f}, s1 = s0;
    if (ksc) { s0 = *(const f32x4*)(ksc + k0 + 8 * c); s1 = *(const f32x4*)(ksc + k0 + 8 * c + 4); }
    asm volatile("s_waitcnt lgkmcnt(0)" ::: "memory");
#pragma unroll
    for (int j = 0; j < 4; ++j) { const int n = (lane >> 3) + 8 * j; const LAS float* s = scr + (8 * c) * 33 + n;
        u32x4 o; o.x = pk2(s[0 * 33] * s0.x, s[1 * 33] * s0.y); o.y = pk2(s[2 * 33] * s0.z, s[3 * 33] * s0.w); o.z = pk2(s[4 * 33] * s1.x, s[5 * 33] * s1.y); o.w = pk2(s[6 * 33] * s1.z, s[7 * 33] * s1.w);
        *(u32x4*)(WT + (size_t)(drow0 + n) * K + k0 + 8 * c) = o; }
    asm volatile("s_waitcnt lgkmcnt(0)" ::: "memory");
}
DI void phase_prologue(int wv) {
    const Ctx c = make_ctx(wv);
    LAS float* scr = (LAS float*)(c.lds + c.wave * 16384);
    const int gw = c.wg * 8 + c.wave, NGW = c.G * 8;
    constexpr int NB1 = SRC_GLA / 32, NB2 = (SRC_DT - SRC_SSZ) / 32;
    constexpr int I_A = (D_MODEL / 64) * NB1, I_B = (D_MODEL / 64) * NB2, I_O = (D_MIX / 64) * (D_MODEL / 32), I_L = I_A + I_B + I_O;
    for (int it = gw; it < DEPTH * I_L; it += NGW) {
        const int l = it / I_L; int r = it % I_L;
        const float* win = c.in[I_WIN] + (size_t)l * D_MODEL * N_IN; bf16_t* wt = c.win + (size_t)l * LDP * D_MODEL; const float* rmsw = c.in[I_RMS] + (size_t)l * D_MODEL;
        if (r < I_A) { const int kb = r / NB1, nb = r % NB1; p0_transpose_item(win, N_IN, 64 * kb, 32 * nb, wt, D_MODEL, 32 * nb, scr, c.lane, rmsw); }
        else if (r < I_A + I_B) { r -= I_A; const int kb = r / NB2, nb = r % NB2; p0_transpose_item(win, N_IN, 64 * kb, SRC_SSZ + 32 * nb, wt, D_MODEL, C_SSZ + 32 * nb, scr, c.lane, rmsw); }
        else { r -= I_A + I_B; const int kb = r / (D_MODEL / 32), nb = r % (D_MODEL / 32);
            p0_transpose_item(c.in[I_WOUT] + (size_t)l * D_MIX * D_MODEL, D_MODEL, 64 * kb, 32 * nb, c.wout + (size_t)l * D_MODEL * D_MIX, D_MIX, 32 * nb, scr, c.lane, kb >= 48 ? c.in[I_SSN] + (size_t)l * 1024 - 3072 : nullptr); }
    }
    const int gt = c.wg * 512 + c.tid, NGT = c.G * 512;
    for (int it = gw; it < DEPTH * 32 * 8; it += NGW) {
        const int l = it >> 8, kb = (it >> 3) & 31, nb = it & 7, k = kb * 64 + c.lane;
        const float* wr = c.in[I_WIN] + ((size_t)l * D_MODEL + k) * N_IN + SRC_GLA; const float* up = c.in[I_GWU] + (size_t)l * 16 * 512 + nb * 64;
        const f32x4 a0 = *(const f32x4*)wr, a1 = *(const f32x4*)(wr + 4), a2 = *(const f32x4*)(wr + 8), a3 = *(const f32x4*)(wr + 12);
        const float rk = c.in[I_RMS][(size_t)l * D_MODEL + k];
        bf16_t* dst = c.win + ((size_t)l * LDP + C_GLF + nb * 64) * D_MODEL + k;
#pragma unroll 4
        for (int n = 0; n < 64; ++n) {
            const float s = a0.x * up[n] + a0.y * up[512 + n] + a0.z * up[1024 + n] + a0.w * up[1536 + n] + a1.x * up[2048 + n] + a1.y * up[2560 + n] + a1.z * up[3072 + n] + a1.w * up[3584 + n]
                          + a2.x * up[4096 + n] + a2.y * up[4608 + n] + a2.z * up[5120 + n] + a2.w * up[5632 + n] + a3.x * up[6144 + n] + a3.y * up[6656 + n] + a3.z * up[7168 + n] + a3.w * up[7680 + n];
            dst[(size_t)n * D_MODEL] = (bf16_t)f2bf(s * rk); }
    }
    for (int i = gt; i < DEPTH * 16 * D_MODEL; i += NGT) {
        const int l = i / (16 * D_MODEL), e = i % (16 * D_MODEL), n = e / D_MODEL, k = e % D_MODEL;
        c.win[((size_t)l * LDP + C_DT + n) * D_MODEL + k] = (bf16_t)f2bf(c.in[I_WIN][((size_t)l * D_MODEL + k) * N_IN + SRC_DT + n] * c.in[I_RMS][(size_t)l * D_MODEL + k]);
    }
    constexpr int PADW = (LDP - C_DT - 16) * D_MODEL * 2 / 16;
    for (int i = gt; i < DEPTH * PADW; i += NGT) { const int l = i / PADW, r = i % PADW;
        ((u32x4*)(c.win + ((size_t)l * LDP + C_DT + 16) * D_MODEL))[r] = (u32x4){0u, 0u, 0u, 0u}; }
    constexpr int PADX = (M_PAD - TT) * D_MODEL * 2 / 16;
    for (int i = gt; i < PADX; i += NGT) ((u32x4*)(c.xb + (size_t)TT * D_MODEL))[i] = (u32x4){0u, 0u, 0u, 0u};
    for (int r = gw; r < TT; r += NGW) {
        const f32x4* x4 = (const f32x4*)(r < TP ? c.in[I_XP] + (size_t)r * D_MODEL : c.in[I_XS] + (size_t)(r - TP) * D_MODEL);
        u32x2* o = (u32x2*)(c.xb + (size_t)r * D_MODEL); float s = 0.f;
#pragma unroll
        for (int j = 0; j < 8; ++j) { const f32x4 v = x4[c.lane + 64 * j]; s += (v.x * v.x + v.y * v.y) + (v.z * v.z + v.w * v.w); u32x2 p; p.x = pk2(v.x, v.y); p.y = pk2(v.z, v.w); o[c.lane + 64 * j] = p; }
        s = wave_sum(s, c.lane);
        if (c.lane == 0) c.rowsq[r] = s;
    }
    for (int i = gt; i < 1024; i += NGT) {
        const float* p = c.in[I_LB];
        const float a0 = p[i], a1 = p[1024 + i], a2 = p[2048 + i], a3 = p[3072 + i];
        const float mx = fmaxf(fmaxf(a0, a1), fmaxf(a2, a3));
        const float e0 = expf(a0 - mx), e1 = expf(a1 - mx), e2 = expf(a2 - mx), e3 = expf(a3 - mx);
        const float inv = 1.0f / (e0 + e1 + e2 + e3);
        c.lb[i] = 0.f; c.lb[1024 + i] = e1 * inv; c.lb[2048 + i] = (e1 + e2) * inv; c.lb[3072 + i] = (e1 + e2 + e3) * inv;
    }
}

DI void phase_final_norm(int wv) {
    const Ctx c = make_ctx(wv);
    const int gw = c.wg * 8 + c.wave, NGW = c.G * 8;
    const f32x4* w4 = (const f32x4*)c.in[I_RMSF];
    for (int r = gw; r < TT; r += NGW) {
        const u32x2* x2 = (const u32x2*)(c.xb + (size_t)r * D_MODEL);
        const float rstd = row_rstd(c.rowsq + DEPTH * M_PAD, r);
        f32x4* o = (f32x4*)(c.out + O_YP + (size_t)r * D_MODEL);
#pragma unroll
        for (int j = 0; j < 8; ++j) { const u32x2 p = x2[c.lane + 64 * j]; const f32x4 w = w4[c.lane + 64 * j];
            o[c.lane + 64 * j] = (f32x4){bflo(p.x) * rstd * w.x, bfhi(p.x) * rstd * w.y, bflo(p.y) * rstd * w.z, bfhi(p.y) * rstd * w.w}; }
    }
}

DI float ps4(const float* p) { return (p[0] + p[PST]) + (p[2 * PST] + p[3 * PST]); }
DI float conv1(const float* prow, float rs, int col, int ch, int nch, const float* cw, const float* cb, const float* buf, float* nbuf) {
    const float b0 = buf[ch], b1 = buf[nch + ch], b2 = buf[2 * nch + ch], xn = ps4(prow + col + ch) * rs, w0 = cw[ch], w1 = cw[nch + ch], w2 = cw[2 * nch + ch], w3 = cw[3 * nch + ch], bb = cb[ch];
    nbuf[ch] = b1; nbuf[nch + ch] = b2; nbuf[2 * nch + ch] = xn;
    return bb + w0 * b0 + w1 * b1 + w2 * b2 + w3 * xn;
}
constexpr int SM_Q = 0, SM_K = 1024, SM_F = 2048, SM_V = 3072, SM_O = 4096, SM_WS = 5120, SM_PART = 5376;
DI void sample_item(const Ctx& c, int l, int s, int type) {
    LAS float* sm = (LAS float*)c.lds;
    LAS float* QS = sm + SM_Q; LAS float* KS = sm + SM_K; LAS float* FS = sm + SM_F; LAS float* VS = sm + SM_V; LAS float* OS_ = sm + SM_O; LAS float* WSUM = sm + SM_WS;
    const int tid = get_tid(c.wave), lane = tid & 63, w = c.wave;
    const float* pr = c.projs + (size_t)s * LDP; const float rs = row_rstd(c.rowsq + (size_t)l * M_PAD, TP + s);
    __syncthreads();
    if (type == 0) {
#pragma unroll
        for (int e = 0; e < 2; ++e) { const int ch = 2 * tid + e; const float qraw = (ps4(pr + C_HGQ + ch) * rs), fraw = (ps4(pr + C_HGF + ch) * rs), lbv = c.lb[(size_t)l * 1024 + ch];
            QS[ch] = silu(qraw); FS[ch] = fmaxf(lbv + (1.0f - lbv) * sigm(fraw), TINY); KS[ch] = (1.0f - lbv) * sigm(-fraw); VS[ch] = (ps4(pr + C_HGI + ch) * rs); }
    } else if (type == 1) {
#pragma unroll
        for (int e = 0; e < 2; ++e) { const int ch = 2 * tid + e; VS[ch] = (ps4(pr + C_GLV + ch) * rs);
            if (tid < 256) { QS[ch] = (ps4(pr + C_GLQ + ch) * rs) * 0.08838834764831845f; KS[ch] = (ps4(pr + C_GLK + ch) * rs);
                const float z = (ps4(pr + C_GLF + ch) * rs) + c.in[I_GBU][(size_t)l * 512 + ch]; FS[ch] = fexp(-softplus(-z) * (1.0f / 16.0f)); } }
    } else {
        const float* scw = c.in[I_SCW] + (size_t)l * 4 * 1536; const float* scb = c.in[I_SCB] + (size_t)l * 1536;
        const float* sbuf = c.in[I_SSSDC] + ((size_t)l * DEC + s) * 3 * 1536; float* nbuf = c.out + O_SSDC_S + ((size_t)l * DEC + s) * 4608;
        float cv0, cv1, cv2 = 0.f, cv3 = 0.f;
        cv0 = conv1(pr, rs, C_XBC, 2 * tid, 1536, scw, scb, sbuf, nbuf); cv1 = conv1(pr, rs, C_XBC, 2 * tid + 1, 1536, scw, scb, sbuf, nbuf);
        if (tid < 256) { cv2 = conv1(pr, rs, C_XBC, 1024 + tid, 1536, scw, scb, sbuf, nbuf); cv3 = conv1(pr, rs, C_XBC, 1280 + tid, 1536, scw, scb, sbuf, nbuf); }
        VS[2 * tid] = silu(cv0); VS[2 * tid + 1] = silu(cv1);
        if (tid < 256) { KS[tid] = silu(cv2); QS[tid] = silu(cv3); }
        if (tid < 16) { const float dt = softplus((ps4(pr + C_DT + tid) * rs) + c.in[I_DTB][l * 16 + tid]); FS[tid] = dt; FS[16 + tid] = fexp(-dt * expf(c.in[I_ALOG][l * 16 + tid])); }
    }
    __syncthreads();
    if (type < 2) {
        const int h = type == 0 ? w : (w >> 1), RS = type == 0 ? 128 : 256, voff = type == 0 ? 0 : 128 * (w & 1);
        const size_t sb = type == 0 ? (((size_t)l * DEC + s) * 8 + h) * 16384 : (((size_t)l * DEC + s) * 4 + h) * 32768;
        const float* s0 = (type == 0 ? c.in[I_SHG] : c.in[I_SGLA]) + sb; float* so = c.out + (type == 0 ? O_HG_S : O_GLA_S) + sb;
        const int vq = lane & 31, kh = lane >> 5, vb = (type == 0 ? h * 128 : h * 256 + voff) + 4 * vq, qb = h * 128;
        const f32x4 vv = *(const LAS f32x4*)(VS + vb); f32x4 o4 = (f32x4){0.f, 0.f, 0.f, 0.f};
        const int eo = kh * RS + voff + 4 * vq;
        f32x4 st[3][8];
#define SI_LOAD(bf, kb) do { _Pragma("unroll") for (int u = 0; u < 8; ++u) st[bf][u] = *(const f32x4*)(s0 + (size_t)(2 * (8 * (kb) + u)) * RS + eo); } while (0)
        SI_LOAD(0, 0); SI_LOAD(1, 1);
#pragma unroll
        for (int kb = 0; kb < 8; ++kb) {
            if (kb + 2 < 8) SI_LOAD((kb + 2) % 3, kb + 2);
#pragma unroll
            for (int u = 0; u < 8; ++u) { const int k = 2 * (8 * kb + u) + kh; const float fk = FS[qb + k], kk = KS[qb + k], qk = QS[qb + k];
                f32x4 t = st[kb % 3][u] * fk + vv * kk; o4 += t * qk; *(f32x4*)(so + (size_t)(2 * (8 * kb + u)) * RS + eo) = t; }
        }
#undef SI_LOAD
        o4.x += shx(o4.x, 32, lane); o4.y += shx(o4.y, 32, lane); o4.z += shx(o4.z, 32, lane); o4.w += shx(o4.w, 32, lane);
        if (kh == 0) *(LAS f32x4*)(OS_ + vb) = o4;
    } else {
        LAS float* PART = sm + SM_PART + w * 2304;
        const int nq = lane & 31, ph = lane >> 5, g = w >> 2;
        const f32x4 B4 = *(const LAS f32x4*)(KS + g * 128 + 4 * nq), C4 = *(const LAS f32x4*)(QS + g * 128 + 4 * nq);
        const float* s0 = c.in[I_SSSD] + (((size_t)l * DEC + s) * 16 + 2 * w) * 8192; float* so = c.out + O_SSD_S + (((size_t)l * DEC + s) * 16 + 2 * w) * 8192;
        const int eo = ph * 128 + 4 * nq;
        f32x4 st[3][8];
#define SI_LOAD(bf, kb) do { _Pragma("unroll") for (int u = 0; u < 8; ++u) st[bf][u] = *(const f32x4*)(s0 + (size_t)((kb) >> 2) * 8192 + (size_t)(2 * (8 * ((kb) & 3) + u)) * 128 + eo); } while (0)
        SI_LOAD(0, 0); SI_LOAD(1, 1);
#pragma unroll
        for (int kb = 0; kb < 8; ++kb) { const int h = 2 * w + (kb >> 2);
            if (kb + 2 < 8) SI_LOAD((kb + 2) % 3, kb + 2);
            const float dt = FS[h], dA = FS[16 + h];
#pragma unroll
            for (int u = 0; u < 8; ++u) { const int p = 2 * (8 * (kb & 3) + u) + ph; const float xv = VS[h * 64 + p] * dt;
                const f32x4 t = st[kb % 3][u] * dA + B4 * xv; *(f32x4*)(so + (size_t)(kb >> 2) * 8192 + (size_t)(2 * (8 * (kb & 3) + u)) * 128 + eo) = t;
                PART[p * 36 + nq] = (t.x * C4.x + t.y * C4.y) + (t.z * C4.z + t.w * C4.w); }
            if ((kb & 3) == 3) {
                asm volatile("s_waitcnt lgkmcnt(0)" ::: "memory");
                float o = 0.f;
#pragma unroll
                for (int q = 0; q < 8; ++q) { const f32x4 tt = *(const LAS f32x4*)(PART + lane * 36 + 4 * q); o += (tt.x + tt.y) + (tt.z + tt.w); }
                const float x = VS[h * 64 + lane], z = (ps4(pr + C_SSZ + h * 64 + lane) * rs);
                OS_[h * 64 + lane] = (o + c.in[I_SD][l * 16 + h] * x) * silu(z);
                asm volatile("s_waitcnt lgkmcnt(0)" ::: "memory"); }
        }
#undef SI_LOAD
    }
    __syncthreads();
    { const f32x2 o2 = *(const LAS f32x2*)(OS_ + 2 * tid);
      const float ssw = wave_sum(o2.x * o2.x + o2.y * o2.y, lane);
      if (lane == 0) WSUM[w] = ssw;
      __syncthreads();
      float ss, gsz; const float* nw; int mcol, gcol = 0;
      if (type == 0) { ss = WSUM[w]; gsz = 128.f; nw = c.in[I_HGN] + (size_t)l * 1024; mcol = 0; gcol = C_HGG; }
      else if (type == 1) { ss = WSUM[w & ~1] + WSUM[w | 1]; gsz = 256.f; nw = c.in[I_GLN] + (size_t)l * 1024; mcol = 2048; gcol = C_GLG; }
      else { const int b4 = w & ~3; ss = (WSUM[b4] + WSUM[b4 + 1]) + (WSUM[b4 + 2] + WSUM[b4 + 3]); gsz = 512.f; nw = c.in[I_SSN] + (size_t)l * 1024; mcol = 3072; }
      const float rstd = rsqrtf(ss / gsz + EPS);
      float y0 = o2.x * rstd, y1 = o2.y * rstd;
      if (type < 2) { y0 *= nw[2 * tid]; y1 *= nw[2 * tid + 1]; }
      if (type < 2) { y0 *= silu((ps4(pr + gcol + 2 * tid) * rs)); y1 *= silu((ps4(pr + gcol + 2 * tid + 1) * rs)); }
      *(unsigned*)(c.mix + (size_t)(TP + s) * D_MIX + mcol + 2 * tid) = pk2(y0, y1); }
}

DI void lds_barrier() { asm volatile("s_waitcnt lgkmcnt(0)\n\ts_barrier" ::: "memory"); }
DI f32x16 mfma32(bf16x8 a, bf16x8 b, f32x16 c) { return __builtin_amdgcn_mfma_f32_32x32x16_bf16(a, b, c, 0, 0, 0); }
DI bf16x8 ldfrag(const LAS unsigned char* p) { return *(const LAS bf16x8*)p; }
DI int crow(int i, int hh) { return (i & 3) + 8 * (i >> 2) + 4 * hh; }
constexpr int L_QP = 0, L_KP = 17408, L_KPT = 34816, L_VT = 53248, L_VT2 = 71680, L_AM = 90112, L_TOT = 108544, L_E1 = 112640, L_E2 = 113152, L_CUM = 113664;
constexpr int SQ = 272, SV = 144;
#define ZERO16(x) do { _Pragma("unroll") for (int _i = 0; _i < 16; ++_i) (x)[_i] = 0.f; } while (0)

template <int TYPE>
DI void la_head_unit(const Ctx& c, int l, int b, int hu) {
    constexpr int DV = 128, NSW = DV / 32, OS = DV * 2 + 16, NC = DV / 8;
    LAS unsigned char* L = c.lds;
    const int tid = get_tid(c.wave), lane = tid & 63, w = c.wave;
    const int r = lane & 31, hh = lane >> 5;
    const int row0 = b * SEQ;
    const bf16_t* P = TYPE == 2 ? c.xbcs : c.proj;
    constexpr int LDR = TYPE == 2 ? 1536 : LDP;
    LAS float* TOT = (LAS float*)(L + L_TOT); LAS float* E1 = (LAS float*)(L + L_E1); LAS float* E2 = (LAS float*)(L + L_E2);
    int colQ, colK, colG, colV, colGate, colOut, sidx; const int grp = hu >> 2;
    if constexpr (TYPE == 0) { colQ = C_HGQ + hu * 128; colK = 0; colG = C_HGF + hu * 128; colV = C_HGI + hu * 128; colGate = C_HGG + hu * 128; colOut = hu * 128; sidx = 0; }
    else if constexpr (TYPE == 1) { const int hd = hu >> 1; colQ = C_GLQ + hd * 128; colK = C_GLK + hd * 128; colG = C_GLF + hd * 128; colV = C_GLV + hu * 128; colGate = C_GLG + hu * 128; colOut = 2048 + hu * 128; sidx = 2 + hd; }
    else { colK = 1024 + grp * 128; colQ = 1280 + grp * 128; colG = 0; colV = hu * 128; colGate = C_SSZ + hu * 128; colOut = 3072 + hu * 128; sidx = grp; }
    float Ah[2], Dh[2];
    if constexpr (TYPE == 2) {
#pragma unroll
        for (int e = 0; e < 2; ++e) { Ah[e] = -expf(c.in[I_ALOG][l * 16 + 2 * hu + e]); Dh[e] = c.in[I_SD][l * 16 + 2 * hu + e]; }
    }
    unsigned r0[8], r1[8], r2[8], r3[8]; float dtn = 0.f;
#define LOAD_CHUNK(tn) do { const bf16_t* pq_ = P + (size_t)(row0 + (tn) + 8 * w) * LDR + 2 * lane; \
        if constexpr (TYPE == 0) { _Pragma("unroll") for (int i = 0; i < 8; ++i) { r0[i] = *(const unsigned*)(pq_ + (size_t)i * LDR + colQ); r1[i] = *(const unsigned*)(pq_ + (size_t)i * LDR + colG); r2[i] = *(const unsigned*)(pq_ + (size_t)i * LDR + colV); } } \
        else if constexpr (TYPE == 1) { _Pragma("unroll") for (int i = 0; i < 8; ++i) { r0[i] = *(const unsigned*)(pq_ + (size_t)i * LDR + colQ); r1[i] = *(const unsigned*)(pq_ + (size_t)i * LDR + colK); \
                                                                                       r2[i] = *(const unsigned*)(pq_ + (size_t)i * LDR + colG); r3[i] = *(const unsigned*)(pq_ + (size_t)i * LDR + colV); } } \
        else { _Pragma("unroll") for (int i = 0; i < 8; ++i) { r0[i] = *(const unsigned*)(pq_ + (size_t)i * LDR + colQ); r1[i] = *(const unsigned*)(pq_ + (size_t)i * LDR + colK); r2[i] = *(const unsigned*)(pq_ + (size_t)i * LDR + colV); } \
            if (w < 2) dtn = c.dtb[(size_t)(row0 + (tn) + lane) * 16 + 2 * hu + w]; } } while (0)
    f32x16 S[4];
#pragma unroll
    for (int kt = 0; kt < 4; ++kt) ZERO16(S[kt]);
    float e2pa = 1.f, e2pb = 1.f;
    constexpr bool PF = true;
    if constexpr (PF) LOAD_CHUNK(0);
    for (int ck = -(SEQ / 64) * (PROBE_LONG_REP - 1); ck < SEQ / 64; ++ck) {
        if (PROBE_LONG_REP > 1 && ck == 0) { e2pa = 1.f; e2pb = 1.f;
#pragma unroll
            for (int kt = 0; kt < 4; ++kt) ZERO16(S[kt]); }
        const int t0 = (ck & (SEQ / 64 - 1)) * 64;
        if constexpr (TYPE == 2) { if ((ck & (SEQ / 64 - 1)) == 15) {
            if (tid == 0) { unsigned* xp1 = c.ctl + CW_XPRE + 128 * l + 64; unsigned sp = 0;
                while (__hip_atomic_load(xp1, __ATOMIC_RELAXED, __HIP_MEMORY_SCOPE_AGENT) < 128u) { __builtin_amdgcn_s_sleep(8); if (++sp > (1u << 22)) break; }
                __builtin_amdgcn_fence(__ATOMIC_ACQUIRE, "agent"); asm volatile("s_waitcnt vmcnt(0)" ::: "memory"); }
            __syncthreads(); } }
        LAS float* CUM = (LAS float*)(L + L_CUM + (ck & 1) * 1536);
        if constexpr (!PF) LOAD_CHUNK(t0);
        float qa[8], qb[8], ka[8], kb[8], ga[8], gb[8], xa[8], xb[8]; unsigned uv[8];
        if constexpr (TYPE == 0) {
            float ta = 0.f, tb = 0.f;
#pragma unroll
            for (int i = 0; i < 8; ++i) { qa[i] = bflo(r0[i]); qb[i] = bfhi(r0[i]); const float g0 = bflo(r1[i]), g1 = bfhi(r1[i]); uv[i] = r2[i];
                ka[i] = 1.0f - fexp(g0); kb[i] = 1.0f - fexp(g1); ta += g0; tb += g1; ga[i] = ta; gb[i] = tb; }
            *(LAS f32x2*)(TOT + w * 128 + 2 * lane) = (f32x2){ta, tb};
        } else if constexpr (TYPE == 1) {
            float ta = 0.f, tb = 0.f;
#pragma unroll
            for (int i = 0; i < 8; ++i) { qa[i] = bflo(r0[i]); qb[i] = bfhi(r0[i]); ka[i] = bflo(r1[i]); kb[i] = bfhi(r1[i]); ta += bflo(r2[i]); tb += bfhi(r2[i]); ga[i] = ta; gb[i] = tb; uv[i] = r3[i]; }
            *(LAS f32x2*)(TOT + w * 128 + 2 * lane) = (f32x2){ta, tb};
        } else {
#pragma unroll
            for (int i = 0; i < 8; ++i) { qa[i] = bflo(r0[i]); qb[i] = bfhi(r0[i]); ka[i] = bflo(r1[i]); kb[i] = bfhi(r1[i]); xa[i] = bflo(r2[i]); xb[i] = bfhi(r2[i]); }
            if (w < 2) {
                const float dt = dtn; float x = dt * (w == 0 ? Ah[0] : Ah[1]);
#pragma unroll
                for (int o = 1; o < 64; o <<= 1) { const float y = shup(x, o, lane); if (lane >= o) x += y; }
                CUM[w * 192 + lane] = x; CUM[w * 192 + 64 + lane] = fmaxf(dt, 1e-30f); CUM[w * 192 + 128 + lane] = fexp(x);
            }
        }
        lds_barrier();
        if constexpr (TYPE < 2) {
            float offa = 0.f, offb = 0.f, brefa = 0.f, brefb = 0.f, bla = 0.f, blb = 0.f;
#pragma unroll
            for (int g = 0; g < 8; ++g) { const f32x2 t = *(const LAS f32x2*)(TOT + g * 128 + 2 * lane);
                if (g < w) { offa += t.x; offb += t.y; }
                if (g < 4) { brefa += t.x; brefb += t.y; }
                bla += t.x; blb += t.y; }
#pragma unroll
            for (int i = 0; i < 8; ++i) { const float da = clampf(ga[i] + offa - brefa, -80.f, 80.f), db = clampf(gb[i] + offb - brefb, -80.f, 80.f);
                qa[i] *= fexp(da); ka[i] *= fexp(-da); qb[i] *= fexp(db); kb[i] *= fexp(-db); }
            if (w == 0) {
                const float e2a = fexp(bla - brefa), e2b = fexp(blb - brefb);
                *(LAS f32x2*)(E1 + 2 * lane) = (f32x2){fexp(brefa) * e2pa, fexp(brefb) * e2pb}; *(LAS f32x2*)(E2 + 2 * lane) = (f32x2){e2a, e2b}; e2pa = e2a; e2pb = e2b; }
        }
#pragma unroll
        for (int i = 0; i < 8; ++i) { *(LAS unsigned*)(L + L_QP + (8 * w + i) * SQ + 4 * lane) = pk2(qa[i], qb[i]); *(LAS unsigned*)(L + L_KP + (8 * w + i) * SQ + 4 * lane) = pk2(ka[i], kb[i]); }
        { u32x4 a, bq; a.x = pk2(ka[0], ka[1]); a.y = pk2(ka[2], ka[3]); a.z = pk2(ka[4], ka[5]); a.w = pk2(ka[6], ka[7]);
          bq.x = pk2(kb[0], kb[1]); bq.y = pk2(kb[2], kb[3]); bq.z = pk2(kb[4], kb[5]); bq.w = pk2(kb[6], kb[7]);
          *(LAS u32x4*)(L + L_KPT + (2 * lane) * SV + 16 * w) = a; *(LAS u32x4*)(L + L_KPT + (2 * lane + 1) * SV + 16 * w) = bq; }
        if constexpr (TYPE < 2) {
            u32x4 a, bq;
            a.x = (uv[0] & 0xffffu) | (uv[1] << 16); a.y = (uv[2] & 0xffffu) | (uv[3] << 16); a.z = (uv[4] & 0xffffu) | (uv[5] << 16); a.w = (uv[6] & 0xffffu) | (uv[7] << 16);
            bq.x = (uv[0] >> 16) | (uv[1] & 0xffff0000u); bq.y = (uv[2] >> 16) | (uv[3] & 0xffff0000u); bq.z = (uv[4] >> 16) | (uv[5] & 0xffff0000u); bq.w = (uv[6] >> 16) | (uv[7] & 0xffff0000u);
            *(LAS u32x4*)(L + L_VT + (2 * lane) * SV + 16 * w) = a; *(LAS u32x4*)(L + L_VT + (2 * lane + 1) * SV + 16 * w) = bq;
        } else {
            const int hs = lane >> 5;
            const LAS float* cm = CUM + hs * 192; const float cl = cm[63];
            float v1a[8], v1b[8], v2a[8], v2b[8];
#pragma unroll
            for (int j = 0; j < 8; ++j) { const int s = 8 * w + j; const float dt = cm[64 + s], wgt = fexp(fminf(cl - cm[s], 0.f));
                v1a[j] = dt * xa[j]; v1b[j] = dt * xb[j]; v2a[j] = v1a[j] * wgt; v2b[j] = v1b[j] * wgt; }
            u32x4 a, bq;
            a.x = pk2(v1a[0], v1a[1]); a.y = pk2(v1a[2], v1a[3]); a.z = pk2(v1a[4], v1a[5]); a.w = pk2(v1a[6], v1a[7]);
            bq.x = pk2(v1b[0], v1b[1]); bq.y = pk2(v1b[2], v1b[3]); bq.z = pk2(v1b[4], v1b[5]); bq.w = pk2(v1b[6], v1b[7]);
            *(LAS u32x4*)(L + L_VT + (2 * lane) * SV + 16 * w) = a; *(LAS u32x4*)(L + L_VT + (2 * lane + 1) * SV + 16 * w) = bq;
            a.x = pk2(v2a[0], v2a[1]); a.y = pk2(v2a[2], v2a[3]); a.z = pk2(v2a[4], v2a[5]); a.w = pk2(v2a[6], v2a[7]);
            bq.x = pk2(v2b[0], v2b[1]); bq.y = pk2(v2b[2], v2b[3]); bq.z = pk2(v2b[4], v2b[5]); bq.w = pk2(v2b[6], v2b[7]);
            *(LAS u32x4*)(L + L_VT2 + (2 * lane) * SV + 16 * w) = a; *(LAS u32x4*)(L + L_VT2 + (2 * lane + 1) * SV + 16 * w) = bq;
        }
        lds_barrier();
        if constexpr (PF) { if (ck + 1 < SEQ / 64) LOAD_CHUNK(((ck + 1) & (SEQ / 64 - 1)) * 64); }
        if (w >= 5) {
            const int sb = (w == 7) ? 1 : 0, tb = (w == 5) ? 0 : 1;
            f32x16 X; ZERO16(X);
#pragma unroll
            for (int k4 = 0; k4 < 8; k4 += 4) { bf16x8 fk[4], fq[4];
#pragma unroll
                for (int u = 0; u < 4; ++u) { fk[u] = ldfrag(L + L_KP + (32 * sb + r) * SQ + (16 * (k4 + u) + 8 * hh) * 2); fq[u] = ldfrag(L + L_QP + (32 * tb + r) * SQ + (16 * (k4 + u) + 8 * hh) * 2); }
#pragma unroll
                for (int u = 0; u < 4; ++u) X = mfma32(fk[u], fq[u], X); }
            const int t = 32 * tb + r;
#pragma unroll
            for (int hs = 0; hs < (TYPE == 2 ? 2 : 1); ++hs) {
                float ct = 0.f, ddt = 0.f;
                if constexpr (TYPE == 2) { ct = CUM[hs * 192 + t]; ddt = (hs == 0 ? Dh[0] : Dh[1]) / CUM[hs * 192 + 64 + t]; }
#pragma unroll
                for (int g = 0; g < 4; ++g) { const int s0 = 32 * sb + 8 * g + 4 * hh;
                    float x0 = X[4 * g], x1 = X[4 * g + 1], x2 = X[4 * g + 2], x3 = X[4 * g + 3];
                    if constexpr (TYPE == 2) { const f32x4 cs = *(const LAS f32x4*)(CUM + hs * 192 + s0);
                        x0 *= fexp(fminf(ct - cs.x, 0.f)); x1 *= fexp(fminf(ct - cs.y, 0.f)); x2 *= fexp(fminf(ct - cs.z, 0.f)); x3 *= fexp(fminf(ct - cs.w, 0.f));
                        x0 += (s0 == t) ? ddt : 0.f; x1 += (s0 + 1 == t) ? ddt : 0.f; x2 += (s0 + 2 == t) ? ddt : 0.f; x3 += (s0 + 3 == t) ? ddt : 0.f; }
                    x0 = (s0 <= t) ? x0 : 0.f; x1 = (s0 + 1 <= t) ? x1 : 0.f; x2 = (s0 + 2 <= t) ? x2 : 0.f; x3 = (s0 + 3 <= t) ? x3 : 0.f;
                    u32x2 p; p.x = pk2(x0, x1); p.y = pk2(x2, x3);
                    *(LAS u32x2*)(L + L_AM + hs * 9216 + t * SV + s0 * 2) = p; }
            }
        }
        f32x16 O[2]; bf16x8 Bv[4];
        const int hsw = w >> 1;
        if (w < NSW) {
            if constexpr (TYPE < 2) {
#pragma unroll
                for (int kt = 0; kt < 4; ++kt)
#pragma unroll
                    for (int g = 0; g < 4; ++g) { const f32x4 e = *(const LAS f32x4*)(E1 + 32 * kt + 8 * g + 4 * hh);
                        S[kt][4 * g] *= e.x; S[kt][4 * g + 1] *= e.y; S[kt][4 * g + 2] *= e.z; S[kt][4 * g + 3] *= e.w; }
            }
            ZERO16(O[0]); ZERO16(O[1]);
#pragma unroll
            for (int kt = 0; kt < 4; ++kt) {
                u32x2 ql[2][2], qh[2][2];
#pragma unroll
                for (int s = 0; s < 2; ++s)
#pragma unroll
                    for (int tt = 0; tt < 2; ++tt) { const LAS unsigned char* qp = L + L_QP + (32 * tt + r) * SQ + (32 * kt + 16 * s + 4 * hh) * 2;
                        ql[s][tt] = *(const LAS u32x2*)qp; qh[s][tt] = *(const LAS u32x2*)(qp + 16); }
#pragma unroll
                for (int s = 0; s < 2; ++s) {
                    u32x4 pa; pa.x = pk2(S[kt][8 * s], S[kt][8 * s + 1]); pa.y = pk2(S[kt][8 * s + 2], S[kt][8 * s + 3]); pa.z = pk2(S[kt][8 * s + 4], S[kt][8 * s + 5]); pa.w = pk2(S[kt][8 * s + 6], S[kt][8 * s + 7]);
                    const bf16x8 A = __builtin_bit_cast(bf16x8, pa);
#pragma unroll
                    for (int tt = 0; tt < 2; ++tt) O[tt] = mfma32(A, __builtin_bit_cast(bf16x8, (u32x4){ql[s][tt].x, ql[s][tt].y, qh[s][tt].x, qh[s][tt].y}), O[tt]);
                }
            }
            if constexpr (TYPE == 2) {
                const LAS float* cm = CUM + hsw * 192; const float e0 = cm[128 + r], e1 = cm[128 + 32 + r], sc = cm[128 + 63];
#pragma unroll
                for (int i = 0; i < 16; ++i) { O[0][i] *= e0; O[1][i] *= e1; }
#pragma unroll
                for (int kt = 0; kt < 4; ++kt)
#pragma unroll
                    for (int i = 0; i < 16; ++i) S[kt][i] *= sc;
            }
#pragma unroll
            for (int st = 0; st < 4; ++st) { bf16x8 kf[4];
                Bv[st] = ldfrag(L + (TYPE == 2 ? L_VT2 : L_VT) + (32 * w + r) * SV + (16 * st + 8 * hh) * 2);
#pragma unroll
                for (int kt = 0; kt < 4; ++kt) kf[kt] = ldfrag(L + L_KPT + (32 * kt + r) * SV + (16 * st + 8 * hh) * 2);
#pragma unroll
                for (int kt = 0; kt < 4; ++kt) S[kt] = mfma32(kf[kt], Bv[st], S[kt]); }
        }
        const int nt_ = tid >> 3, nseg = tid & 7;
        u32x4 gq[NC / 8];
        { const bf16_t* pg = c.proj + (size_t)(row0 + t0 + nt_) * LDP + colGate + nseg * NC;
#pragma unroll
          for (int q = 0; q < NC / 8; ++q) gq[q] = *(const u32x4*)(pg + 8 * q); }
        lds_barrier();
        if (w < NSW) {
#pragma unroll
            for (int st = 0; st < 4; ++st) { bf16x8 Av = Bv[st];
                if constexpr (TYPE == 2) Av = ldfrag(L + L_VT + (32 * w + r) * SV + (16 * st + 8 * hh) * 2);
#pragma unroll
                for (int tt = 0; tt < 2; ++tt) if (st < 2 || tt == 1)
                    O[tt] = mfma32(Av, ldfrag(L + L_AM + (TYPE == 2 ? hsw * 9216 : 0) + (32 * tt + r) * SV + (16 * st + 8 * hh) * 2), O[tt]); }
#pragma unroll
            for (int tt = 0; tt < 2; ++tt)
#pragma unroll
                for (int g = 0; g < 4; ++g) { u32x2 p; p.x = pk2(O[tt][4 * g], O[tt][4 * g + 1]); p.y = pk2(O[tt][4 * g + 2], O[tt][4 * g + 3]);
                    *(LAS u32x2*)(L + (32 * tt + r) * OS + (32 * w + 8 * g + 4 * hh) * 2) = p; }
        }
        lds_barrier();
        {
            float o[NC], gv[NC]; float ss = 0.f;
#pragma unroll
            for (int q = 0; q < NC / 8; ++q) { const u32x4 ov = *(const LAS u32x4*)(L + nt_ * OS + (nseg * NC + 8 * q) * 2);
                o[8 * q] = bflo(ov.x); o[8 * q + 1] = bfhi(ov.x); o[8 * q + 2] = bflo(ov.y); o[8 * q + 3] = bfhi(ov.y); o[8 * q + 4] = bflo(ov.z); o[8 * q + 5] = bfhi(ov.z); o[8 * q + 6] = bflo(ov.w); o[8 * q + 7] = bfhi(ov.w);
                gv[8 * q] = bflo(gq[q].x); gv[8 * q + 1] = bfhi(gq[q].x); gv[8 * q + 2] = bflo(gq[q].y); gv[8 * q + 3] = bfhi(gq[q].y); gv[8 * q + 4] = bflo(gq[q].z); gv[8 * q + 5] = bfhi(gq[q].z); gv[8 * q + 6] = bflo(gq[q].w); gv[8 * q + 7] = bfhi(gq[q].w); }
            if constexpr (TYPE == 2) {
#pragma unroll
                for (int e = 0; e < NC; ++e) o[e] *= gv[e];
            }
#pragma unroll
            for (int e = 0; e < NC; ++e) ss += o[e] * o[e];
            ss += shx(ss, 1, lane); ss += shx(ss, 2, lane); ss += shx(ss, 4, lane);
            float mul = 1.0f;
            if constexpr (TYPE == 0) mul = rsqrtf(ss * (1.0f / DV) + EPS);
            else { if (nseg == 0 && ck >= 0) atomicAdd((float*)(c.ctl + CW_STATS) + ((size_t)l * TP + row0 + t0 + nt_) * 6 + sidx, ss); }
            if constexpr (TYPE < 2) {
#pragma unroll
                for (int e = 0; e < NC; ++e) o[e] *= mul * gv[e];
            }
            bf16_t* pm = c.mix + (size_t)(row0 + t0 + nt_) * D_MIX + colOut + nseg * NC;
#pragma unroll
            for (int q = 0; q < NC / 8; ++q) { u32x4 ov; ov.x = pk2(o[8 * q], o[8 * q + 1]); ov.y = pk2(o[8 * q + 2], o[8 * q + 3]); ov.z = pk2(o[8 * q + 4], o[8 * q + 5]); ov.w = pk2(o[8 * q + 6], o[8 * q + 7]);
                *(u32x4*)(pm + 8 * q) = ov; }
        }
    }
#undef LOAD_CHUNK
    if (w < NSW) {
        const int lane2 = get_tid(c.wave) & 63, r = lane2 & 31, hh = lane2 >> 5;
        if constexpr (TYPE < 2) {
#pragma unroll
            for (int kt = 0; kt < 4; ++kt)
#pragma unroll
                for (int g = 0; g < 4; ++g) { const f32x4 e = *(const LAS f32x4*)(E2 + 32 * kt + 8 * g + 4 * hh);
                    S[kt][4 * g] *= e.x; S[kt][4 * g + 1] *= e.y; S[kt][4 * g + 2] *= e.z; S[kt][4 * g + 3] *= e.w; }
        }
        float* sout; int sk, sv, vb;
        if constexpr (TYPE == 0) { sout = c.out + O_HG_P + (((size_t)l * NB + b) * 8 + hu) * 16384; sk = 128; sv = 1; vb = 32 * w; }
        else if constexpr (TYPE == 1) { sout = c.out + O_GLA_P + (((size_t)l * NB + b) * 4 + (hu >> 1)) * 32768; sk = 256; sv = 1; vb = 128 * (hu & 1) + 32 * w; }
        else { sout = c.out + O_SSD_P + (((size_t)l * NB + b) * 16 + 2 * hu + (w >> 1)) * 8192; sk = 1; sv = 128; vb = 32 * (w & 1); }
#pragma unroll
        for (int kt = 0; kt < 4; ++kt)
#pragma unroll
            for (int i = 0; i < 16; ++i) sout[(32 * kt + crow(i, hh)) * sk + (vb + r) * sv] = S[kt][i];
    }
}

constexpr int R_WT = 74752;
DI void rg_load_gates(const Ctx& c, int l, int n, int tid, int j, int hh, bf16x8 (&Br)[8], bf16x8 (&Bi)[8]) {
    LAS unsigned char* L = c.lds;
    const float* wr = c.in[I_WR] + (size_t)(l * 8 + n) * 128 * 128; const float* wi = c.in[I_WI] + (size_t)(l * 8 + n) * 128 * 128;
    __syncthreads();
    f32x4 v[16];
#pragma unroll
    for (int q = 0; q < 16; ++q) { const int e = tid + 512 * q, mat = e >> 12, rem = e & 4095; v[q] = *(const f32x4*)((mat ? wi : wr) + rem * 4); }
#pragma unroll
    for (int q = 0; q < 16; ++q) { const int e = tid + 512 * q, mat = e >> 12, rem = e & 4095, i = rem >> 5, j4 = (rem & 31) * 4;
        LAS unsigned char* p = L + R_WT + mat * 34816 + j4 * SQ + i * 2;
        *(LAS bf16_t*)(p) = (bf16_t)f2bf(v[q].x); *(LAS bf16_t*)(p + SQ) = (bf16_t)f2bf(v[q].y); *(LAS bf16_t*)(p + 2 * SQ) = (bf16_t)f2bf(v[q].z); *(LAS bf16_t*)(p + 3 * SQ) = (bf16_t)f2bf(v[q].w); }
    __syncthreads();
#pragma unroll
    for (int ks = 0; ks < 8; ++ks) { Br[ks] = ldfrag(L + R_WT + j * SQ + (16 * ks + 8 * hh) * 2); Bi[ks] = ldfrag(L + R_WT + 34816 + j * SQ + (16 * ks + 8 * hh) * 2); }
}
constexpr int R_XCB = 0, R_XCF = 17408, R_SUMA = 50176, R_SUMU = 58368, R_HIN = 66560;
DI void rg_chunk_unit(const Ctx& c, int l, int b, int n) {
    LAS unsigned char* L = c.lds;
    const int tid = get_tid(c.wave), lane = tid & 63, w = c.wave, r = lane & 31, hh = lane >> 5;
    const int tb = w >> 2, jb = w & 3;
    const int j = 32 * jb + r, ch = n * 128 + j;
    const int row0 = b * SEQ;
    const bf16_t* P = c.proj;
    LAS float* XCF = (LAS float*)(L + R_XCF); LAS float* SUMA = (LAS float*)(L + R_SUMA); LAS float* SUMU = (LAS float*)(L + R_SUMU); LAS float* HIN = (LAS float*)(L + R_HIN);
    bf16x8 Br[8], Bi[8];
    rg_load_gates(c, l, n, tid, j, hh, Br, Bi);
    const float sp = softplus(-c.in[I_LAM][l * 1024 + ch]), brv = c.in[I_BR][(l * 8 + n) * 128 + j], biv = c.in[I_BI][(l * 8 + n) * 128 + j];
    float cw[4][2], cb[2];
#pragma unroll
    for (int e = 0; e < 2; ++e) {
#pragma unroll
        for (int m = 0; m < 4; ++m) cw[m][e] = c.in[I_RCW][l * 4 * 1024 + m * 1024 + n * 128 + 2 * lane + e];
        cb[e] = c.in[I_RCB][l * 1024 + n * 128 + 2 * lane + e]; }
    float hcarry = 0.f;
    unsigned ux[11]; bf16_t gtr[16];
#define RG_LOAD(tn) do { const bf16_t* pq_ = P + (size_t)(row0 + (tn) + 8 * w) * LDP + C_RGX + n * 128 + 2 * lane; const bool first_ = ((tn) == 0 && w == 0); \
        _Pragma("unroll") for (int jx = 0; jx < 11; ++jx) ux[jx] = (first_ && jx < 3) ? 0u : *(const unsigned*)(pq_ + (ptrdiff_t)(jx - 3) * LDP); \
        const bf16_t* pg_ = P + (size_t)(row0 + (tn) + 32 * tb) * LDP; const int goff_ = 4 * hh * LDP + C_RGG + ch; \
        _Pragma("unroll") for (int i = 0; i < 16; ++i) gtr[i] = (pg_ + (size_t)((i & 3) + 8 * (i >> 2)) * LDP)[goff_]; } while (0)
    RG_LOAD(0);
    for (int ck = -(SEQ / 64) * (PROBE_RG_REP - 1); ck < SEQ / 64; ++ck) {
        if (PROBE_RG_REP > 1 && ck == 0) hcarry = 0.f;
        const int t0 = (ck & (SEQ / 64 - 1)) * 64;
#pragma unroll
        for (int i = 0; i < 8; ++i) { const int t = 8 * w + i;
            const float x0 = cb[0] + cw[0][0] * bflo(ux[i]) + cw[1][0] * bflo(ux[i + 1]) + cw[2][0] * bflo(ux[i + 2]) + cw[3][0] * bflo(ux[i + 3]);
            const float x1 = cb[1] + cw[0][1] * bfhi(ux[i]) + cw[1][1] * bfhi(ux[i + 1]) + cw[2][1] * bfhi(ux[i + 2]) + cw[3][1] * bfhi(ux[i + 3]);
            *(LAS f32x2*)(XCF + t * 128 + 2 * lane) = (f32x2){x0, x1}; *(LAS unsigned*)(L + R_XCB + t * SQ + 4 * lane) = pk2(x0, x1); }
        float gt[16];
#pragma unroll
        for (int i = 0; i < 16; ++i) gt[i] = bf1(gtr[i]);
        lds_barrier();
        if (ck + 1 < SEQ / 64) RG_LOAD(((ck + 1) & (SEQ / 64 - 1)) * 64);
        f32x16 R, I; ZERO16(R); ZERO16(I);
#pragma unroll
        for (int ks = 0; ks < 8; ++ks) { const bf16x8 a = ldfrag(L + R_XCB + (32 * tb + r) * SQ + (16 * ks + 8 * hh) * 2); R = mfma32(a, Br[ks], R); I = mfma32(a, Bi[ks], I); }
        float av[16], uv[16];
#pragma unroll
        for (int i = 0; i < 16; ++i) { const int t = 32 * tb + crow(i, hh); const float xc = XCF[t * 128 + j];
            const float e1 = fexp(fminf(-(R[i] + brv), 40.f)), e2 = fexp(fminf(-(I[i] + biv), 40.f)), p1 = 1.0f + e1, p2 = 1.0f + e2, inv = rcp(p1 * p2);
            const float rr = p2 * inv, ii = p1 * inv;
            const float la = -8.0f * rr * sp, a = fexp(la), x2 = 2.0f * la;
            const float ser = -x2 * (1.0f + 0.5f * x2 * (1.0f + 0.33333334f * x2 * (1.0f + 0.25f * x2 * (1.0f + 0.2f * x2))));
            const float om = fabsf(x2) < 0.25f ? ser : 1.0f - a * a;
            av[i] = a; uv[i] = __builtin_amdgcn_sqrtf(fmaxf(om, 0.f)) * (ii * xc); }
#pragma unroll
        for (int g = 0; g < 4; ++g) { float A = 1.f, U = 0.f;
#pragma unroll
            for (int m = 0; m < 4; ++m) { U = av[4 * g + m] * U + uv[4 * g + m]; A *= av[4 * g + m]; }
            const int gi = 8 * tb + 2 * g + hh; SUMA[gi * 128 + j] = A; SUMU[gi * 128 + j] = U; }
        lds_barrier();
        if (tid < 128) { float hc = hcarry, sa[16], su[16];
#pragma unroll
            for (int gi = 0; gi < 16; ++gi) { sa[gi] = SUMA[gi * 128 + tid]; su[gi] = SUMU[gi * 128 + tid]; }
#pragma unroll
            for (int gi = 0; gi < 16; ++gi) { HIN[gi * 128 + tid] = hc; hc = sa[gi] * hc + su[gi]; }
            hcarry = hc; }
        lds_barrier();
        { bf16_t* pm = c.mix + (size_t)(row0 + t0 + 32 * tb) * D_MIX; const int moff = 4 * hh * D_MIX + 1024 + ch;
#pragma unroll
          for (int g = 0; g < 4; ++g) { float hc = HIN[(8 * tb + 2 * g + hh) * 128 + j];
#pragma unroll
            for (int m = 0; m < 4; ++m) { const int i = 4 * g + m; hc = av[i] * hc + uv[i];
                (pm + (size_t)((i & 3) + 8 * (i >> 2)) * D_MIX)[moff] = (bf16_t)f2bf(hc * gt[i]); } } }
    }
#undef RG_LOAD
    if (tid < 128) c.out[O_RG_P + ((size_t)l * NB + b) * 1024 + n * 128 + tid] = hcarry;
    if (w == 7) {
#pragma unroll
        for (int jx = 0; jx < 3; ++jx) *(f32x2*)(c.out + O_RGC_P + ((size_t)l * NB + b) * 3072 + jx * 1024 + n * 128 + 2 * lane) = (f32x2){bflo(ux[8 + jx]), bfhi(ux[8 + jx])}; }
}

DI void rg_sample_unit(const Ctx& c, int l, int n) {
    LAS unsigned char* L = c.lds;
    const int tid = get_tid(c.wave), lane = tid & 63, w = c.wave, r = lane & 31, hh = lane >> 5;
    const int tb = w >> 2, jb = w & 3;
    const int j = 32 * jb + r, ch = n * 128 + j;
    LAS float* XCF = (LAS float*)(L + R_XCF);
    bf16x8 Br[8], Bi[8];
    rg_load_gates(c, l, n, tid, j, hh, Br, Bi);
    const float sp = softplus(-c.in[I_LAM][l * 1024 + ch]), brv = c.in[I_BR][(l * 8 + n) * 128 + j], biv = c.in[I_BI][(l * 8 + n) * 128 + j];
    float cw[4][2], cb[2];
#pragma unroll
    for (int e = 0; e < 2; ++e) {
#pragma unroll
        for (int m = 0; m < 4; ++m) cw[m][e] = c.in[I_RCW][l * 4 * 1024 + m * 1024 + n * 128 + 2 * lane + e];
        cb[e] = c.in[I_RCB][l * 1024 + n * 128 + 2 * lane + e]; }
    for (int chunk = 0; chunk < 2; ++chunk) {
        __syncthreads();
        f32x2 cb0[8], cb1[8], cb2[8], cxn[8];
#pragma unroll
        for (int i = 0; i < 8; ++i) { const int s = 64 * chunk + 8 * w + i;
            const float* buf = c.in[I_SRGC] + ((size_t)l * DEC + s) * 3 * 1024 + n * 128 + 2 * lane;
            cb0[i] = *(const f32x2*)buf; cb1[i] = *(const f32x2*)(buf + 1024); cb2[i] = *(const f32x2*)(buf + 2048);
            cxn[i] = (f32x2){ps4(c.projs + (size_t)s * LDP + C_RGX + n * 128 + 2 * lane), ps4(c.projs + (size_t)s * LDP + C_RGX + n * 128 + 2 * lane + 1)} * row_rstd(c.rowsq + (size_t)l * M_PAD, TP + s); }
#pragma unroll
        for (int i = 0; i < 8; ++i) { const int t = 8 * w + i, s = 64 * chunk + t;
            const f32x2 b0 = cb0[i], b1 = cb1[i], b2 = cb2[i], xn = cxn[i];
            const float x0 = cb[0] + cw[0][0] * b0.x + cw[1][0] * b1.x + cw[2][0] * b2.x + cw[3][0] * xn.x;
            const float x1 = cb[1] + cw[0][1] * b0.y + cw[1][1] * b1.y + cw[2][1] * b2.y + cw[3][1] * xn.y;
            *(LAS f32x2*)(XCF + t * 128 + 2 * lane) = (f32x2){x0, x1}; *(LAS unsigned*)(L + R_XCB + t * SQ + 4 * lane) = pk2(x0, x1);
            float* nb = c.out + O_RGC_S + ((size_t)l * DEC + s) * 3072 + n * 128 + 2 * lane;
            *(f32x2*)nb = b1; *(f32x2*)(nb + 1024) = b2; *(f32x2*)(nb + 2048) = xn; }
        __syncthreads();
        f32x16 R, I; ZERO16(R); ZERO16(I);
#pragma unroll
        for (int ks = 0; ks < 8; ++ks) { const bf16x8 a = ldfrag(L + R_XCB + (32 * tb + r) * SQ + (16 * ks + 8 * hh) * 2); R = mfma32(a, Br[ks], R); I = mfma32(a, Bi[ks], I); }
#pragma unroll
        for (int i = 0; i < 16; ++i) { const int t = 32 * tb + crow(i, hh), s = 64 * chunk + t;
            const float rr = sigm(R[i] + brv), ii = sigm(I[i] + biv), xc = XCF[t * 128 + j];
            const float la = -8.0f * rr * sp, a = fexp(la);
            const float hn = a * c.in[I_SRG][((size_t)l * DEC + s) * 1024 + ch] + sqrtf(fmaxf(neg_expm1(2.0f * la), 0.f)) * (ii * xc);
            c.mix[(size_t)(TP + s) * D_MIX + 1024 + ch] = (bf16_t)f2bf(hn * silu(ps4(c.projs + (size_t)s * LDP + C_RGG + ch) * row_rstd(c.rowsq + (size_t)l * M_PAD, TP + s)));
            c.out[O_RG_S + ((size_t)l * DEC + s) * 1024 + ch] = hn; }
    }
}

#ifndef PROBE_REP_LONG
#define PROBE_REP_LONG 1
#endif
#ifndef PROBE_G1_REP
#define PROBE_G1_REP 1
#endif
#ifndef PROBE_REP_SHORT
#define PROBE_REP_SHORT 1
#endif
DI void xbc_prepass_item(const Ctx& c, int l, int it) {
    const int tid = get_tid(c.wave);
    const float* scw = c.in[I_SCW] + (size_t)l * 4 * 1536; const float* scb = c.in[I_SCB] + (size_t)l * 1536;
    const int r0 = ((it & 7) >> 1) * SEQ + (it >> 3) * 64 + (it & 1) * 32;
    const bool head = (r0 & (SEQ - 1)) == 0;
    for (int p = tid; p < 768; p += 512) {
        float cw[4][2], cb[2];
#pragma unroll
        for (int e = 0; e < 2; ++e) { cb[e] = scb[2 * p + e];
#pragma unroll
            for (int m = 0; m < 4; ++m) cw[m][e] = scw[m * 1536 + 2 * p + e]; }
        const bf16_t* src = c.proj + (size_t)r0 * LDP + C_XBC + 2 * p; bf16_t* dst = c.xbcs + (size_t)r0 * 1536 + 2 * p;
        unsigned u[35];
#pragma unroll
        for (int i = 0; i < 35; ++i) u[i] = (head && i < 3) ? 0u : *(const unsigned*)(src + (ptrdiff_t)(i - 3) * LDP);
#pragma unroll
        for (int i = 0; i < 32; ++i) {
            const float a = silu(cb[0] + cw[0][0] * bflo(u[i]) + cw[1][0] * bflo(u[i + 1]) + cw[2][0] * bflo(u[i + 2]) + cw[3][0] * bflo(u[i + 3]));
            const float b = silu(cb[1] + cw[0][1] * bfhi(u[i]) + cw[1][1] * bfhi(u[i + 1]) + cw[2][1] * bfhi(u[i + 2]) + cw[3][1] * bfhi(u[i + 3]));
            *(unsigned*)(dst + (size_t)i * 1536) = pk2(a, b); }
        if (((r0 + 32) & (SEQ - 1)) == 0) {
#pragma unroll
            for (int jx = 0; jx < 3; ++jx) *(f32x2*)(c.out + O_SSDC_P + ((size_t)l * NB + r0 / SEQ) * 4608 + jx * 1536 + 2 * p) = (f32x2){bflo(u[32 + jx]), bfhi(u[32 + jx])}; }
    }
}
DI void phase_mixer(int l, int wv) {
    const Ctx c = make_ctx(wv);
    constexpr int PER_B = 8 + 8 + 8 + 8;
    constexpr int N_LONG = NB * PER_B, N_SHORT = 8 + DEC * 3;
    constexpr int NREP = 1;
    volatile LAS int* slot = (volatile LAS int*)(c.lds + MISC_OFF + 64);
    unsigned* xpre = c.ctl + CW_XPRE + 128 * l;
    if (c.wg >= N_LONG || c.G <= N_LONG) {
        const int nfree = c.G > N_LONG ? c.G - N_LONG : c.G, first = c.G > N_LONG ? c.wg - N_LONG : c.wg;
        for (int it = first; it < TP / 32; it += nfree) {
            xbc_prepass_item(c, l, it);
            asm volatile("s_waitcnt vmcnt(0)" ::: "memory"); __syncthreads();
            if (c.tid == 0) { __builtin_amdgcn_fence(__ATOMIC_RELEASE, "agent"); asm volatile("s_waitcnt vmcnt(0)" ::: "memory");
                __hip_atomic_fetch_add(xpre + (it < 128 ? 0 : 64), 1u, __ATOMIC_RELAXED, __HIP_MEMORY_SCOPE_AGENT); }
        }
    }
    for (int rep = 0; rep < NREP; ++rep) {
    unsigned* ctr = c.ctl + CW_QCTR + 64 * (l * 4 + rep);
    int cur = c.wg; bool dyn = false;
    for (;;) {
        int item;
        if (!dyn) { if (cur < N_LONG) { item = cur; cur += c.G; } else { dyn = true; continue; } }
        else {
            __syncthreads();
            if (c.tid == 0) *slot = (int)atomicAdd(ctr, 1u);
            __syncthreads();
            item = N_LONG + *slot;
            if (item >= N_LONG + N_SHORT) break;
        }
        if (item < N_LONG) {
            const int b = item & 3, u = item >> 2;
            if (u < 8) la_head_unit<1>(c, l, b, u); else if (u < 16) la_head_unit<0>(c, l, b, u - 8); else if (u < 24) {
                if (c.tid == 0) { unsigned sp = 0; while (__hip_atomic_load(xpre, __ATOMIC_RELAXED, __HIP_MEMORY_SCOPE_AGENT) < 128u) { __builtin_amdgcn_s_sleep(8); if (++sp > (1u << 22)) break; }
                    __builtin_amdgcn_fence(__ATOMIC_ACQUIRE, "agent"); asm volatile("s_waitcnt vmcnt(0)" ::: "memory"); }
                __syncthreads();
                la_head_unit<2>(c, l, b, u - 16); } else rg_chunk_unit(c, l, b, u - 24);
            __syncthreads();
        } else { const int it = item - N_LONG;
            for (int rp = 0; rp < PROBE_REP_SHORT; ++rp) { if (it < 8) rg_sample_unit(c, l, it); else sample_item(c, l, (it - 8) / 3, (it - 8) % 3); } }
    }
    __syncthreads();
    }
}

DI void phase_dt(const Ctx& c, int l) {
    LAS float* PT = (LAS float*)c.lds;
    const int tid = get_tid(c.wave), lane = tid & 63, w = c.wave, r = lane & 31, hh = lane >> 5;
    for (int rt = c.wg; rt < TP / 32; rt += c.G) {
        const bf16_t* pa = c.xb + (size_t)(rt * 32 + r) * D_MODEL + w * 256 + 8 * hh;
        const bf16_t* pb = c.win + ((size_t)l * LDP + C_DT + r) * D_MODEL + w * 256 + 8 * hh;
        f32x16 acc; ZERO16(acc);
#pragma unroll
        for (int k4 = 0; k4 < 16; k4 += 8) { bf16x8 fa[8], fb[8];
#pragma unroll
            for (int u = 0; u < 8; ++u) { fa[u] = *(const bf16x8*)(pa + 16 * (k4 + u)); fb[u] = *(const bf16x8*)(pb + 16 * (k4 + u)); }
#pragma unroll
            for (int u = 0; u < 8; ++u) acc = mfma32(fa[u], fb[u], acc); }
        __syncthreads();
#pragma unroll
        for (int i = 0; i < 16; ++i) PT[w * 1024 + crow(i, hh) * 32 + r] = acc[i];
        __syncthreads();
        { const int row = tid >> 4, col = tid & 15; float s = 0.f;
#pragma unroll
          for (int q = 0; q < 8; ++q) s += PT[q * 1024 + row * 32 + col];
          c.dtb[(size_t)(rt * 32 + row) * 16 + col] = softplus(s * row_rstd(c.rowsq + (size_t)l * M_PAD, rt * 32 + row) + c.in[I_DTB][l * 16 + col]); }
    }
}

DI void g2_sample(const Ctx& c, int l) {
    LAS float* PT = (LAS float*)c.lds;
    const int tid = get_tid(c.wave), lane = tid & 63, w = c.wave, rr = lane & 15, quad = lane >> 4;
    float* rsq_next = c.rowsq + (size_t)(l + 1) * M_PAD;
    for (int it = c.wg; it < 4 * (D_MODEL / 32); it += c.G) {
        const int rb = it & 3, ct = it >> 2;
        const bf16_t* pa = c.mix + (size_t)(TP + 32 * rb + rr) * D_MIX + 512 * w + 8 * quad;
        const bf16_t* pb = c.wout + (size_t)l * D_MODEL * D_MIX + (size_t)(32 * ct + rr) * D_MIX + 512 * w + 8 * quad;
        f32x4 acc[2][2];
#pragma unroll
        for (int rt = 0; rt < 2; ++rt) { acc[rt][0] = (f32x4){0.f, 0.f, 0.f, 0.f}; acc[rt][1] = acc[rt][0]; }
        bf16x8 fa0[4][2], fb0[4][2], fa1[4][2], fb1[4][2];
#define G2S_LOAD(FA, FB, k4) do { _Pragma("unroll") for (int u = 0; u < 4; ++u) _Pragma("unroll") for (int t = 0; t < 2; ++t) { \
            FA[u][t] = *(const bf16x8*)(pa + (size_t)16 * t * D_MIX + 32 * ((k4) + u)); FB[u][t] = *(const bf16x8*)(pb + (size_t)16 * t * D_MIX + 32 * ((k4) + u)); } } while (0)
#define G2S_MMA(FA, FB) do { _Pragma("unroll") for (int u = 0; u < 4; ++u) _Pragma("unroll") for (int rt = 0; rt < 2; ++rt) _Pragma("unroll") for (int nt = 0; nt < 2; ++nt) \
            acc[rt][nt] = __builtin_amdgcn_mfma_f32_16x16x32_bf16(FA[u][rt], FB[u][nt], acc[rt][nt], 0, 0, 0); } while (0)
        G2S_LOAD(fa0, fb0, 0);
        G2S_LOAD(fa1, fb1, 4);
        G2S_MMA(fa0, fb0);
        G2S_LOAD(fa0, fb0, 8);
        G2S_MMA(fa1, fb1);
        G2S_LOAD(fa1, fb1, 12);
        G2S_MMA(fa0, fb0);
        G2S_MMA(fa1, fb1);
#undef G2S_LOAD
#undef G2S_MMA
        __syncthreads();
#pragma unroll
        for (int rt = 0; rt < 2; ++rt)
#pragma unroll
            for (int nt = 0; nt < 2; ++nt)
#pragma unroll
                for (int j = 0; j < 4; ++j) PT[(w * 32 + 16 * rt + 4 * quad + j) * 32 + 16 * nt + rr] = acc[rt][nt][j];
        __syncthreads();
        { const int row = tid >> 4, c2 = 2 * (tid & 15); float x0 = 0.f, x1 = 0.f;
#pragma unroll
          for (int q = 0; q < 8; ++q) { const f32x2 t = *(const LAS f32x2*)(PT + (q * 32 + row) * 32 + c2); x0 += t.x; x1 += t.y; }
          unsigned* xp = (unsigned*)(c.xb + (size_t)(TP + 32 * rb + row) * D_MODEL + 32 * ct + c2); const unsigned o = *xp;
          x0 += bflo(o); x1 += bfhi(o); *xp = pk2(x0, x1);
          float ss = x0 * x0 + x1 * x1; ss += shx(ss, 1, lane); ss += shx(ss, 2, lane); ss += shx(ss, 4, lane); ss += shx(ss, 8, lane);
          if ((tid & 15) == 0) atomicAdd(rsq_next + TP + 32 * rb + row, ss); }
    }
}

__global__ void __launch_bounds__(512, 2) mk_fwd(Params p) {
    extern __shared__ __attribute__((aligned(16))) unsigned char lds_raw[];
    LAS unsigned char* lds = (LAS unsigned char*)lds_raw;
    volatile LAS unsigned* misc = (volatile LAS unsigned*)(lds + MISC_OFF);
    const int wv = __builtin_amdgcn_readfirstlane(threadIdx.x >> 6);
    if (threadIdx.x < 32) misc[threadIdx.x] = 0u;
    __syncthreads();
    const int lo = p.ph_lo, hi = p.ph_hi;
    unsigned* barw = (unsigned*)(p.ws + WS_CTL) + CW_BAR;
    XcdBarrier bar; bar.bar = barw; bar.x = 0; bar.st = misc;
    if (hi - lo > 1) bar = xcd_barrier_post(barw, misc, get_tid(wv));
#define PH_IN(k) (lo <= (k) && (k) < hi)
#define SEAM(k) do { if (PH_IN(k) && PH_IN((k) + 1)) xcd_barrier(bar, wv); } while (0)
    if (PH_IN(0)) { phase_prologue(wv); }
    SEAM(0);
    for (int l = 0; l < DEPTH; ++l) {
        const int pb = 1 + 3 * l;
        if (PH_IN(pb)) {
            __syncthreads();
            const Ctx c = make_ctx(wv);
            {
                pg8::Gemm g{c.xb, c.win + (size_t)l * LDP * D_MODEL, TP, N_MAIN, D_MODEL, D_MODEL, D_MODEL}; pg8::StaticOrder S; S.init(TP, N_MAIN, c.G, c.wg); S.rep = PROBE_G1; S.balance = 1;
                pg8::EpiProj E{c.proj, c.lb + (size_t)l * 1024, c.in[I_HGN] + (size_t)l * 1024, c.in[I_GLN] + (size_t)l * 1024, c.in[I_GBU] + (size_t)l * 512, c.rowsq + (size_t)l * M_PAD};
                pg8::gemm_phase<pg8::EpiProj, pg8::StaticOrder>(c.lds, g, S, E, wv); }
            __syncthreads();
            {
                const int pn = c.wg % 49, ks = c.wg / 49;
                pg8::Gemm g{c.xb + (size_t)TP * D_MODEL + ks * 512, c.win + (size_t)l * LDP * D_MODEL + ks * 512, 256, LDP, 512, D_MODEL, D_MODEL};
                pg8::OneUnit S{0, pn, c.wg < 196 ? 1 : 0};
                pg8::EpiSample E{c.projs + (size_t)ks * PST};
                pg8::gemm_phase<pg8::EpiSample, pg8::OneUnit>(c.lds, g, S, E, wv); }
            __syncthreads();
            phase_dt(c, l);
            __syncthreads();
        }
        SEAM(pb);
        if (PH_IN(pb + 1)) phase_mixer(l, wv);
        SEAM(pb + 1);
        if (PH_IN(pb + 2)) {
            __syncthreads();
            const Ctx c = make_ctx(wv);
            {
                pg8::Gemm g{c.mix, c.wout + (size_t)l * D_MODEL * D_MIX, TP, D_MODEL, D_MIX, D_MIX, D_MIX}; pg8::StaticOrder S; S.init(TP, D_MODEL, c.G, c.wg);
                LAS float* tab = (LAS float*)(c.lds + pg8::STAGE_BYTES);
                pg8::EpiResid E{c.xb, c.rowsq + (size_t)(l + 1) * M_PAD, tab};
                const float* stats = (const float*)(c.ctl + CW_STATS) + (size_t)l * TP * 6;
                for (int i = 0; ; ++i) { pg8::Unit u; if (!S.next(i, u)) break;
                    __syncthreads();
                    { const int tid = get_tid(wv);
                      if (tid < 256) { const float* st = stats + (size_t)(u.pm * 256 + tid) * 6;
                        const f32x2 sa = *(const f32x2*)st, sb = *(const f32x2*)(st + 2), sc = *(const f32x2*)(st + 4);
                        const float d0 = __builtin_amdgcn_rsqf(sa.x * (1.0f / 512.0f) + EPS), d1 = __builtin_amdgcn_rsqf(sa.y * (1.0f / 512.0f) + EPS);
                        const float g0 = __builtin_amdgcn_rsqf(sb.x * (1.0f / 256.0f) + EPS), g1 = __builtin_amdgcn_rsqf(sb.y * (1.0f / 256.0f) + EPS), g2 = __builtin_amdgcn_rsqf(sc.x * (1.0f / 256.0f) + EPS), g3 = __builtin_amdgcn_rsqf(sc.y * (1.0f / 256.0f) + EPS);
                        tab[tid] = rcp(g0); tab[256 + tid] = g0 * rcp(g1); tab[512 + tid] = g1 * rcp(g2); tab[768 + tid] = g2 * rcp(g3); tab[1024 + tid] = g3 * rcp(d0); tab[1280 + tid] = d0 * rcp(d1); tab[1536 + tid] = d1; } }
                    __syncthreads();
                    pg8::OneUnit O{u.pm, u.pn, 1};
                    pg8::gemm_phase<pg8::EpiResid, pg8::OneUnit>(c.lds, g, O, E, wv); }
            }
            __syncthreads();
            g2_sample(c, l);
        }
        SEAM(pb + 2);
    }
    if (PH_IN(NPHASE - 1)) phase_final_norm(wv);
#undef PH_IN
#undef SEAM
}

extern "C" void kernel_launch(void* const* d_in, const int* in_sizes, int n_in, void* d_out, int out_size, void* d_ws, size_t ws_size, hipStream_t stream) {
    static int grid = 0;
    if (grid == 0) {
        if (n_in != N_INPUTS || (size_t)out_size != O_END || ws_size < WS_END) { fprintf(stderr, "kernel_launch: unexpected shapes (n_in %d out %d ws %zu)\n", n_in, out_size, ws_size); grid = -1; return; }
        int dev = 0, cus = 0;
        if (hipGetDevice(&dev) != hipSuccess || hipDeviceGetAttribute(&cus, hipDeviceAttributeMultiprocessorCount, dev) != hipSuccess) { grid = -1; return; }
        if (hipFuncSetAttribute((const void*)mk_fwd, hipFuncAttributeMaxDynamicSharedMemorySize, LDS_BYTES) != hipSuccess) { fprintf(stderr, "kernel_launch: hipFuncSetAttribute failed\n"); grid = -1; return; }
        int per_cu = 0;
        if (hipOccupancyMaxActiveBlocksPerMultiprocessor(&per_cu, (const void*)mk_fwd, 512, LDS_BYTES) != hipSuccess || per_cu < 1) fprintf(stderr, "kernel_launch: occupancy query says %d\n", per_cu);
        (void)hipGetLastError();
        grid = cus;
    }
    if (grid < 0) return;
    (void)hipMemsetAsync((char*)d_ws + WS_CTL, 0, CTL_ZERO_BYTES, stream);
    Params p{};
    for (int i = 0; i < N_INPUTS; ++i) p.in[i] = (const float*)d_in[i];
    p.out = (float*)d_out; p.ws = (unsigned char*)d_ws;
#if MK_ONE_LAUNCH
    p.ph_lo = 0; p.ph_hi = NPHASE;
    hipLaunchKernelGGL(mk_fwd, dim3(grid), dim3(512), LDS_BYTES, stream, p);
#else
    for (int ph = 0; ph < NPHASE; ++ph) { p.ph_lo = ph; p.ph_hi = ph + 1; hipLaunchKernelGGL(mk_fwd, dim3(grid), dim3(512), LDS_BYTES, stream, p); }
#endif
}
```

```cpp
#include <hip/hip_runtime.h>
#include <cstdio>
#include <cstdint>

#ifndef MK_ONE_LAUNCH
#define MK_ONE_LAUNCH 1
#endif

#ifndef PROBE_LONG_REP
#define PROBE_LONG_REP 1
#endif
#ifndef PROBE_RG_REP
#define PROBE_RG_REP PROBE_LONG_REP
#endif
#ifndef PROBE_G1_NOEPI
#define PROBE_G1_NOEPI 0
#endif
#ifndef PROBE_G2
#define PROBE_G2 0
#endif
#ifndef PROBE_G1
#define PROBE_G1 1
#endif
#define LAS __attribute__((address_space(3)))
#define DI __device__ __forceinline__

constexpr int D_MODEL = 2048, NB = 4, SEQ = 2048, DEPTH = 4, DEC = 128;
constexpr int BRANCH = 1024, D_MIX = 4096;
constexpr int TP = NB * SEQ;
constexpr int TT = TP + DEC;
constexpr int M_PAD = 8448;
constexpr int N_IN = 11808;
constexpr int LDP = 12544;
constexpr int N_MAIN = 12288;
constexpr int PST = 128 * LDP;
constexpr float EPS = 1e-6f, TINY = 1e-30f;
constexpr int C_HGQ = 0, C_HGF = 1024, C_HGI = 2048, C_HGG = 3072, C_RGX = 4096, C_RGG = 5120, C_GLQ = 6144, C_GLK = 6656, C_GLV = 7168, C_GLG = 8192,
              C_GLF = 9216, C_SSZ = 9728, C_XBC = 10752, C_DT = 12288;
constexpr int SRC_GLA = 9216, SRC_SSZ = 9232, SRC_DT = 11792;
enum { I_XP = 0, I_XS, I_SHG, I_SRG, I_SRGC, I_SGLA, I_SSSD, I_SSSDC, I_RMS, I_WIN, I_LB, I_HGN, I_RCW, I_RCB, I_WR, I_BR, I_WI, I_BI, I_LAM,
       I_GWU, I_GBU, I_GLN, I_SCW, I_SCB, I_DTB, I_ALOG, I_SD, I_SSN, I_WOUT, I_RMSF, N_INPUTS };
constexpr size_t O_YP = 0, O_YS = (size_t)TP * D_MODEL, O_HG_P = O_YS + (size_t)DEC * D_MODEL,
    O_RG_P = O_HG_P + (size_t)DEPTH * NB * 131072, O_RGC_P = O_RG_P + (size_t)DEPTH * NB * 1024, O_GLA_P = O_RGC_P + (size_t)DEPTH * NB * 3072,
    O_SSD_P = O_GLA_P + (size_t)DEPTH * NB * 131072, O_SSDC_P = O_SSD_P + (size_t)DEPTH * NB * 131072, O_HG_S = O_SSDC_P + (size_t)DEPTH * NB * 4608,
    O_RG_S = O_HG_S + (size_t)DEPTH * DEC * 131072, O_RGC_S = O_RG_S + (size_t)DEPTH * DEC * 1024, O_GLA_S = O_RGC_S + (size_t)DEPTH * DEC * 3072,
    O_SSD_S = O_GLA_S + (size_t)DEPTH * DEC * 131072, O_SSDC_S = O_SSD_S + (size_t)DEPTH * DEC * 131072, O_END = O_SSDC_S + (size_t)DEPTH * DEC * 4608;
constexpr size_t MiB = 1u << 20;
constexpr size_t WS_CTL = 0, CTL_ZERO_BYTES = 2 * MiB, WS_LB = 2 * MiB, WS_WIN = 3 * MiB, WS_WOUT = 199 * MiB, WS_XB = 263 * MiB, WS_PROJ = 296 * MiB,
    WS_DTB = 492 * MiB, WS_MIX = 493 * MiB, WS_PROJS = 559 * MiB, WS_XBCS = 584 * MiB, WS_END = 608 * MiB;
static_assert(WS_WIN + (size_t)DEPTH * LDP * D_MODEL * 2 <= WS_WOUT && WS_WOUT + (size_t)DEPTH * D_MODEL * D_MIX * 2 <= WS_XB && WS_XB + (size_t)M_PAD * D_MODEL * 2 <= WS_PROJ &&
              WS_PROJ + (size_t)TP * LDP * 2 <= WS_DTB && WS_DTB + (size_t)TP * 16 * 4 <= WS_MIX &&
              WS_MIX + (size_t)M_PAD * D_MIX * 2 <= WS_PROJS && WS_PROJS + (size_t)4 * DEC * LDP * 4 <= WS_XBCS && WS_XBCS + (size_t)TP * 1536 * 2 <= WS_END, "ws map");
constexpr int CW_BAR = 4096, CW_QCTR = 16384, CW_XPRE = 24576  , CW_STATS = 32768, CW_ROWSQ = 262144;
static_assert(CW_STATS + DEPTH * TP * 6 <= CW_ROWSQ && (size_t)(CW_ROWSQ + (DEPTH + 1) * M_PAD) * 4 <= CTL_ZERO_BYTES, "ctl map");
constexpr int LDS_BYTES = 147456, MISC_OFF = LDS_BYTES - 256;
constexpr int NPHASE = 2 + 3 * DEPTH;

typedef unsigned short bf16_t;
typedef short bf16x8 __attribute__((ext_vector_type(8)));
typedef float f32x4 __attribute__((ext_vector_type(4)));
typedef float f32x2 __attribute__((ext_vector_type(2)));
typedef float f32x16 __attribute__((ext_vector_type(16)));
typedef unsigned u32x4 __attribute__((ext_vector_type(4)));
typedef unsigned u32x2 __attribute__((ext_vector_type(2)));
typedef __bf16 bf16v2 __attribute__((ext_vector_type(2)));

DI unsigned pk2(float lo, float hi) { const f32x2 v = {lo, hi}; return __builtin_bit_cast(unsigned, __builtin_convertvector(v, bf16v2)); }
DI unsigned f2bf(float f) { return pk2(f, 0.f) & 0xffffu; }
DI float bflo(unsigned u) { return __builtin_bit_cast(float, u << 16); }
DI float bfhi(unsigned u) { return __builtin_bit_cast(float, u & 0xffff0000u); }
DI float bf1(bf16_t u) { return __builtin_bit_cast(float, (unsigned)u << 16); }
DI float ex2(float x) { return __builtin_amdgcn_exp2f(x); }
DI float lg2(float x) { return __builtin_amdgcn_logf(x); }
DI float rcp(float x) { return __builtin_amdgcn_rcpf(x); }
constexpr float LOG2E = 1.4426950408889634f, LN2 = 0.6931471805599453f;
DI float fexp(float x) { return ex2(x * LOG2E); }
DI float flog(float x) { return lg2(x) * LN2; }
DI float sigm(float x) { return rcp(1.0f + fexp(-x)); }
DI float silu(float x) { return x * sigm(x); }
DI float sigm_fast(float x) { return sigm(x); }
DI float silu_fast(float x) { return silu(x); }
DI float log1p_pos(float e) { const float a = e * (1.0f - e * (0.5f - e * (0.33333334f - 0.25f * e))), b = flog(1.0f + e); return e < 0.03f ? a : b; }
DI float softplus(float x) { return fmaxf(x, 0.f) + log1p_pos(fexp(-fabsf(x))); }
DI float neg_expm1(float x) { const float a = -x * (1.0f + 0.5f * x * (1.0f + 0.33333334f * x * (1.0f + 0.25f * x * (1.0f + 0.2f * x)))), b = 1.0f - fexp(x); return fabsf(x) < 0.25f ? a : b; }
DI float row_rstd(const float* rowsq, int row) { return __builtin_amdgcn_rsqf(rowsq[row] * (1.0f / D_MODEL) + EPS); }
DI float clampf(float x, float lo, float hi) { return fminf(fmaxf(x, lo), hi); }
DI float shx(float v, int mask, int lane) { return __builtin_bit_cast(float, __builtin_amdgcn_ds_bpermute((lane ^ mask) << 2, __builtin_bit_cast(int, v))); }
DI float shup(float v, int o, int lane) { return __builtin_bit_cast(float, __builtin_amdgcn_ds_bpermute((lane >= o ? lane - o : lane) << 2, __builtin_bit_cast(int, v))); }
DI float wave_sum(float v, int lane) {
#pragma unroll
    for (int o = 1; o < 64; o <<= 1) v += shx(v, o, lane);
    return v;
}

struct Params { const float* in[N_INPUTS]; float* out; unsigned char* ws; int ph_lo, ph_hi; };
static_assert(sizeof(Params) == N_INPUTS * 8 + 8 + 8 + 8, "no padding holes in Params");
typedef const __attribute__((address_space(4))) Params* KP;
DI KP get_params() { auto kp = __builtin_amdgcn_kernarg_segment_ptr(); asm volatile("" : "+s"(kp)); return (KP)kp; }
DI int get_tid(int wv) { int ln; asm volatile("v_mbcnt_lo_u32_b32 %0, -1, 0\n\tv_mbcnt_hi_u32_b32 %0, -1, %0" : "=v"(ln)); return (wv << 6) | ln; }

#define XB_TMO      128
#define XB_XCNT(j)  (256  + 64 * (j))
#define XB_XSUB(j)  (1280 + 64 * (j))
#define XB_XGEN(j)  (2304 + 64 * (j))
#define XB_TOP      3328
#define XB_TOPGEN   3392
#define XCD_BAR_WORDS 3456
#define XB_SPIN_CAP (1u << 20)
DI unsigned xb_ld(unsigned* p)              { return __hip_atomic_load(p, __ATOMIC_RELAXED, __HIP_MEMORY_SCOPE_AGENT); }
DI unsigned xb_add(unsigned* p, unsigned v) { return __hip_atomic_fetch_add(p, v, __ATOMIC_RELAXED, __HIP_MEMORY_SCOPE_AGENT); }
DI unsigned xb_xcc_id() { return (unsigned)__builtin_amdgcn_s_getreg((3 << 11) | 20) & 0xFu; }
#define XB_SPIN(cond, bar) do { unsigned _sp = 0; while (cond) { __builtin_amdgcn_s_sleep(1); \
    if ((++_sp & 255u) == 0u) { if (xb_ld(&(bar)[XB_TMO])) break; if (_sp > XB_SPIN_CAP) { atomicAdd(&(bar)[XB_TMO], 1u); break; } } } } while (0)
struct XcdBarrier { unsigned* bar; unsigned x; volatile LAS unsigned* st; };
DI XcdBarrier xcd_barrier_post(unsigned* bar, volatile LAS unsigned* st, int tid) {
    XcdBarrier b; b.bar = bar; b.x = xb_xcc_id(); b.st = st;
    if (tid == 0) (void)xb_add(&bar[XB_XCNT(b.x)], 1u);
    return b;
}
DI void xcd_barrier_complete(unsigned* bar, unsigned x, unsigned& nloc, unsigned& nx) {
    const unsigned G = gridDim.x * gridDim.y * gridDim.z;
    unsigned sum, cnt, mine, sp = 0u;
    for (;;) {
        sum = 0u; cnt = 0u; mine = 0u;
#pragma unroll
        for (unsigned j = 0; j < 16; ++j) { const unsigned c = xb_ld(&bar[XB_XCNT(j)]); sum += c; cnt += (c > 0u) ? 1u : 0u; mine = (j == x) ? c : mine; }
        if (sum == G) break;
        __builtin_amdgcn_s_sleep(1);
        if ((++sp & 255u) == 0u) { if (xb_ld(&bar[XB_TMO])) break; if (sp > XB_SPIN_CAP) { atomicAdd(&bar[XB_TMO], 1u); break; } }
    }
    nloc = mine > 0u ? mine : 1u; nx = cnt > 0u ? cnt : 1u;
}
DI void xcd_barrier(const XcdBarrier& b, int wv) {
    asm volatile("s_waitcnt vmcnt(0)" ::: "memory");
    __syncthreads();
    if (get_tid(wv) == 0) {
        unsigned* bar = b.bar;
        __builtin_amdgcn_s_waitcnt(0);
        unsigned nloc = b.st[0], nx = b.st[1];
        if (nloc == 0u) { xcd_barrier_complete(bar, b.x, nloc, nx); b.st[0] = nloc; b.st[1] = nx; }
        const unsigned old = xb_add(&bar[XB_XSUB(b.x)], 1u);
        const unsigned gen = old / nloc;
        if (old + 1u == (gen + 1u) * nloc) {
            __builtin_amdgcn_fence(__ATOMIC_RELEASE, "agent");
            asm volatile("s_waitcnt vmcnt(0)" ::: "memory");
            const unsigned og = xb_add(&bar[XB_TOP], 1u);
            const unsigned tg = og / nx;
            if (og + 1u == (tg + 1u) * nx) xb_add(&bar[XB_TOPGEN], 1u);
            else XB_SPIN(xb_ld(&bar[XB_TOPGEN]) == tg, bar);
            __builtin_amdgcn_fence(__ATOMIC_ACQUIRE, "agent");
            xb_add(&bar[XB_XGEN(b.x)], 1u);
            asm volatile("s_waitcnt vmcnt(0)" ::: "memory");
        } else {
            XB_SPIN(xb_ld(&bar[XB_XGEN(b.x)]) == gen, bar);
            __builtin_amdgcn_fence(__ATOMIC_ACQUIRE, "agent");
            asm volatile("s_waitcnt vmcnt(0)" ::: "memory");
        }
    }
    __syncthreads();
}

namespace pg8 {
constexpr int BM = 256, BK = 64, HALF = 128, HTB = HALF * BK * 2, STAGE_BYTES = 8 * HTB, NXCD = 8, WGM = 8;
DI int lds_byte(int r, int c) { const int st = (r >> 4) * 2 + (c >> 5), rr = r & 15, cc = c & 31, ob = rr * 64 + cc * 2; return st * 1024 + (ob ^ (((ob >> 9) & 1) << 5)); }
DI void stage_rc(int b, int& R, int& C) { const int st = b / 1024, sb = b % 1024, swz = sb ^ (((sb >> 9) & 1) << 5); R = (st >> 1) * 16 + swz / 64; C = (st & 1) * 32 + (swz % 64) / 2; }
DI int perm32(int rho) { const int n = rho >> 4, i = rho & 15; return 8 * (i >> 2) + 4 * n + (i & 3); }
struct Unit { int pm, pn; };
struct Gemm { const bf16_t* A; const bf16_t* Bt; int M, N, K, lda, ldb; };
struct StaticOrder {
    int nM, nN, nwg, G, c, rep = 1, balance = 0;
    DI void init(int M, int N, int G_, int c_) { nM = M / BM; nN = N / BM; nwg = nM * nN; G = G_; c = c_; }
    DI bool next(int i, Unit& u) const {
        const long L = (long)(i / rep) * G + c; if (L >= nwg) return false;
        int wgid = (int)L; { const int q = nwg / NXCD, r = nwg % NXCD, xcd = wgid % NXCD, off = wgid / NXCD; wgid = (xcd < r ? xcd * (q + 1) : r * (q + 1) + (xcd - r) * q) + off; }
        const int nig = WGM * nN, gid = wgid / nig, fm = gid * WGM, gsz = (nM - fm) < WGM ? (nM - fm) : WGM;
        u.pm = fm + ((wgid % nig) % gsz); u.pn = (wgid % nig) / gsz;
        if (balance) {
            const int p = u.pn / 24, r = u.pn % 24, i = r >> 2, j = r & 3;
            const unsigned long long T0 = 0x1810080c0004ull  , T1 = 0x2a1e1c161424ull  , T2 = 0x2e2c28262220ull  ;
            u.pn = p == 0 ? (int)((T0 >> (8 * i)) & 0xff) + j : j < 2 ? (int)((T1 >> (8 * i)) & 0xff) + j : (int)((T2 >> (8 * i)) & 0xff) + (j - 2);
        }
        return true;
    }
    DI void a_ready(const Unit&) const {}
    DI void done(const Unit&) const {}
};
struct EpiProj {
    static constexpr bool PERM = true, TWICE = PROBE_G1_NOEPI != 0, KSCALE = false;
    bf16_t* P; const float* lb; const float* hgn; const float* gln; const float* bup; const float* rsq;
    template <int MODE>
    DI void body(const f32x4 (&acc)[2][2][4][2], bf16_t* prow, const float* vec, float scale, const float (&rs)[2][4]) const {
        f32x4 cv[2][2];
#pragma unroll
        for (int bj = 0; bj < 2; ++bj) { cv[bj][0] = (f32x4){1.f, 1.f, 1.f, 1.f}; cv[bj][1] = cv[bj][0];
            if constexpr (MODE >= 2) { cv[bj][0] = *(const f32x4*)(vec + bj * HALF); cv[bj][1] = *(const f32x4*)(vec + bj * HALF + 4); } }
#pragma unroll
        for (int bj = 0; bj < 2; ++bj) {
            const f32x4 c0 = cv[bj][0], c1 = cv[bj][1];
#pragma unroll
            for (int ai = 0; ai < 2; ++ai)
#pragma unroll
                for (int m = 0; m < 4; ++m) {
                    f32x4 a = acc[ai][bj][m][0] * rs[ai][m], b = acc[ai][bj][m][1] * rs[ai][m];
                    if constexpr (MODE == 0) { a = a * scale; b = b * scale; }
                    else if constexpr (MODE == 1) { a = (f32x4){silu(a.x), silu(a.y), silu(a.z), silu(a.w)}; b = (f32x4){silu(b.x), silu(b.y), silu(b.z), silu(b.w)}; }
                    else if constexpr (MODE == 2) { a = (f32x4){silu(a.x), silu(a.y), silu(a.z), silu(a.w)} * c0; b = (f32x4){silu(b.x), silu(b.y), silu(b.z), silu(b.w)} * c1; }
                    else if constexpr (MODE == 3) {
#define LOGF(x, l) flog(fmaxf((l) + (1.0f - (l)) * sigm(x), TINY))
                        a = (f32x4){LOGF(a.x, c0.x), LOGF(a.y, c0.y), LOGF(a.z, c0.z), LOGF(a.w, c0.w)}; b = (f32x4){LOGF(b.x, c1.x), LOGF(b.y, c1.y), LOGF(b.z, c1.z), LOGF(b.w, c1.w)};
#undef LOGF
                    } else {
#define LSIG(x, bb) (-0.0625f * (fmaxf(-((x) + (bb)), 0.f) + flog(1.0f + fexp(-fabsf((x) + (bb))))))
                        a = (f32x4){LSIG(a.x, c0.x), LSIG(a.y, c0.y), LSIG(a.z, c0.z), LSIG(a.w, c0.w)}; b = (f32x4){LSIG(b.x, c1.x), LSIG(b.y, c1.y), LSIG(b.z, c1.z), LSIG(b.w, c1.w)};
#undef LSIG
                    }
                    u32x4 w4; w4.x = pk2(a.x, a.y); w4.y = pk2(a.z, a.w); w4.z = pk2(b.x, b.y); w4.w = pk2(b.z, b.w);
                    *(u32x4*)(prow + (size_t)(ai * HALF + m * 16) * LDP + bj * HALF) = w4;
                }
        }
    }
    DI void operator()(const f32x4 (&acc)[2][2][4][2], const Unit& u, int wr, int wc, int fr, int fq) const {
        const int col = u.pn * BM + wc * 32 + 8 * fq;
        bf16_t* prow = P + (size_t)(u.pm * BM + wr * 64 + fr) * LDP + col;
        float rs[2][4];
#pragma unroll
        for (int ai = 0; ai < 2; ++ai)
#pragma unroll
            for (int m = 0; m < 4; ++m) rs[ai][m] = rsq[u.pm * BM + wr * 64 + fr + ai * HALF + m * 16];
#pragma unroll
        for (int ai = 0; ai < 2; ++ai)
#pragma unroll
            for (int m = 0; m < 4; ++m) rs[ai][m] = __builtin_amdgcn_rsqf(rs[ai][m] * (1.0f / D_MODEL) + EPS);
        const int pn = u.pn;
        if (pn < 4) body<1>(acc, prow, nullptr, 1.f, rs);
        else if (pn < 8) body<3>(acc, prow, lb + (col - C_HGF), 1.f, rs);
        else if (pn < 12) body<0>(acc, prow, nullptr, 1.f, rs);
        else if (pn < 16) body<2>(acc, prow, hgn + (col - C_HGG), 1.f, rs);
        else if (pn < 20) body<0>(acc, prow, nullptr, 1.f, rs);
        else if (pn < 24) body<1>(acc, prow, nullptr, 1.f, rs);
        else if (pn < 26) body<0>(acc, prow, nullptr, 0.08838834764831845f, rs);
        else if (pn < 32) body<0>(acc, prow, nullptr, 1.f, rs);
        else if (pn < 36) body<2>(acc, prow, gln + (col - C_GLG), 1.f, rs);
        else if (pn < 38) body<4>(acc, prow, bup + (col - C_GLF), 1.f, rs);
        else if (pn < 42) body<1>(acc, prow, nullptr, 1.f, rs);
        else body<0>(acc, prow, nullptr, 1.f, rs);
    }
};
struct EpiSample {
    static constexpr bool PERM = false, TWICE = false, KSCALE = false;
    float* PS;
    DI void operator()(const f32x4 (&acc)[2][2][4][2], const Unit& u, int wr, int wc, int fr, int fq) const {
        const int row0 = wr * 64 + fr, col0 = u.pn * BM + wc * 32 + 4 * fq;
#pragma unroll
        for (int m = 0; m < 4; ++m) { float* op = PS + (size_t)(row0 + m * 16) * LDP + col0;
#pragma unroll
            for (int bj = 0; bj < 2; ++bj)
#pragma unroll
                for (int n = 0; n < 2; ++n) *(f32x4*)(op + bj * HALF + n * 16) = acc[0][bj][m][n]; }
    }
};
struct EpiResid {
    static constexpr bool PERM = true, TWICE = false, KSCALE = true;
    bf16_t* xb; float* rsq_next; const LAS float* tab;
    DI void rescale(f32x4 (&acc)[2][2][4][2], int seg, int wr, int fr) const {
#pragma unroll
        for (int ai = 0; ai < 2; ++ai)
#pragma unroll
            for (int m = 0; m < 4; ++m) { const float r = tab[seg * 256 + ai * HALF + wr * 64 + m * 16 + fr];
#pragma unroll
                for (int bj = 0; bj < 2; ++bj) { acc[ai][bj][m][0] = acc[ai][bj][m][0] * r; acc[ai][bj][m][1] = acc[ai][bj][m][1] * r; } }
    }
    DI void operator()(f32x4 (&acc)[2][2][4][2], const Unit& u, int wr, int wc, int fr, int fq) const {
        rescale(acc, 6, wr, fr);
        const int row0 = u.pm * BM + wr * 64 + fr, col0 = u.pn * BM + wc * 32 + 8 * fq;
#pragma unroll
        for (int ai = 0; ai < 2; ++ai) {
            u32x4 ob[4][2];
#pragma unroll
            for (int m = 0; m < 4; ++m)
#pragma unroll
                for (int bj = 0; bj < 2; ++bj) ob[m][bj] = *(const u32x4*)(xb + (size_t)(row0 + ai * HALF + m * 16) * D_MODEL + col0 + bj * HALF);
#pragma unroll
            for (int m = 0; m < 4; ++m) { const int row = row0 + ai * HALF + m * 16; bf16_t* xp = xb + (size_t)row * D_MODEL + col0; float ss = 0.f;
#pragma unroll
                for (int bj = 0; bj < 2; ++bj) { const u32x4 o = ob[m][bj]; const f32x4 a = acc[ai][bj][m][0], b = acc[ai][bj][m][1];
                    const float x0 = bflo(o.x) + a.x, x1 = bfhi(o.x) + a.y, x2 = bflo(o.y) + a.z, x3 = bfhi(o.y) + a.w, x4 = bflo(o.z) + b.x, x5 = bfhi(o.z) + b.y, x6 = bflo(o.w) + b.z, x7 = bfhi(o.w) + b.w;
                    ss += ((x0 * x0 + x1 * x1) + (x2 * x2 + x3 * x3)) + ((x4 * x4 + x5 * x5) + (x6 * x6 + x7 * x7));
                    u32x4 n4; n4.x = pk2(x0, x1); n4.y = pk2(x2, x3); n4.z = pk2(x4, x5); n4.w = pk2(x6, x7); *(u32x4*)(xp + bj * HALF) = n4; }
                const int lane = fq * 16 + fr; ss += shx(ss, 16, lane); ss += shx(ss, 32, lane);
                if (fq == 0) atomicAdd(rsq_next + row, ss); }
        }
    }
};
struct OneUnit {
    int pm, pn, have;
    DI bool next(int i, Unit& u) const { if (i != 0 || !have) return false; u.pm = pm; u.pn = pn; return true; }
    DI void a_ready(const Unit&) const {}
    DI void done(const Unit&) const {}
};
template <class Epi, class Sched>
DI void gemm_phase(LAS unsigned char* lds, const Gemm g, const Sched& S, const Epi& E, int wv) {
    const int tid = get_tid(wv), wid = wv, lane = tid & 63, wr = wid >> 2, wc = wid & 3, fr = lane & 15, fq = lane >> 4;
    const int K = g.K, nt = K / BK;
    unsigned voffA[2], voffB[2];
#pragma unroll
    for (int i = 0; i < 2; ++i) { int R, C; stage_rc(tid * 16 + i * 8192, R, C); const int Rb = Epi::PERM ? ((R & ~31) + perm32(R & 31)) : R;
        voffA[i] = (unsigned)(R * g.lda + C) * 2u; voffB[i] = (unsigned)(Rb * g.ldb + C) * 2u; }
    const size_t kstep = (size_t)(BK * 2);
    const size_t hstepA = (size_t)HALF * g.lda * 2, hstepB = (size_t)HALF * g.ldb * 2;
    const size_t tstepA = 2 * hstepA, tstepB = 2 * hstepB;
    const unsigned ldsw = (unsigned)wid * 1024u;
    const int aoff = lds_byte(wr * 64 + fr, fq * 8), boff = lds_byte(wc * 32 + fr, fq * 8);
#define PG8_SA(b, h) (((b) * 2 + (h)) * HTB)
#define PG8_SB(b, h) ((4 + (b) * 2 + (h)) * HTB)
#define PG8_STAGE(bufoff, gbase, voff) do { _Pragma("unroll") for (int _i = 0; _i < 2; ++_i) \
        __builtin_amdgcn_global_load_lds((const unsigned*)((const char*)(gbase) + (voff)[_i]), (LAS unsigned*)(lds + (bufoff) + ldsw + _i * 8192), 16, 0, 0); } while (0)
#define PG8_LDA(dst, b, h) do { _Pragma("unroll") for (int m = 0; m < 4; ++m) _Pragma("unroll") for (int k = 0; k < 2; ++k) dst[m][k] = *(const LAS bf16x8*)(lds + PG8_SA(b, h) + aoff + m * 2048 + k * 1024); } while (0)
#define PG8_LDB(dst, b, h) do { _Pragma("unroll") for (int n = 0; n < 2; ++n) _Pragma("unroll") for (int k = 0; k < 2; ++k) dst[n][k] = *(const LAS bf16x8*)(lds + PG8_SB(b, h) + boff + n * 2048 + k * 1024); } while (0)
#define PG8_MMA(ai, bj, At, Bt) do { __builtin_amdgcn_s_setprio(1); _Pragma("unroll") for (int m = 0; m < 4; ++m) _Pragma("unroll") for (int n = 0; n < 2; ++n) _Pragma("unroll") for (int k = 0; k < 2; ++k) \
        acc[ai][bj][m][n] = __builtin_amdgcn_mfma_f32_16x16x32_bf16(Bt[n][k], At[m][k], acc[ai][bj][m][n], 0, 0, 0); __builtin_amdgcn_s_setprio(0); } while (0)
#define PG8_WAIT_V(n) asm volatile("s_waitcnt vmcnt(" #n ")" ::: "memory")
#define PG8_WAIT_L(n) asm volatile("s_waitcnt lgkmcnt(" #n ")" ::: "memory")
#define PG8_BAR __builtin_amdgcn_s_barrier()
#define PG8_SCHED __builtin_amdgcn_sched_barrier(0)
    Unit cur, nxt; int ui = 0;
    if (!S.next(0, cur)) return;
    f32x4 acc[2][2][4][2];
#pragma unroll
    for (int a = 0; a < 2; ++a)
#pragma unroll
        for (int b = 0; b < 2; ++b)
#pragma unroll
            for (int m = 0; m < 4; ++m)
#pragma unroll
                for (int n = 0; n < 2; ++n) acc[a][b][m][n] = (f32x4){0.f, 0.f, 0.f, 0.f};
    bf16x8 At[4][2], B0[2][2], B1[2][2];
    const char* cA = (const char*)g.A + (size_t)cur.pm * tstepA; const char* cB = (const char*)g.Bt + (size_t)cur.pn * tstepB;
    S.a_ready(cur);
    PG8_STAGE(PG8_SB(0, 0), cB, voffB); PG8_STAGE(PG8_SA(0, 0), cA, voffA); PG8_STAGE(PG8_SB(0, 1), cB + hstepB, voffB); PG8_STAGE(PG8_SA(0, 1), cA + hstepA, voffA);
    if (wr == 1) PG8_BAR;
    PG8_WAIT_V(4); PG8_BAR;
    PG8_STAGE(PG8_SB(1, 0), cB + kstep, voffB); PG8_STAGE(PG8_SA(1, 0), cA + kstep, voffA); PG8_STAGE(PG8_SB(1, 1), cB + hstepB + kstep, voffB);
    PG8_WAIT_V(6); PG8_BAR;
    for (;;) {
        const bool has_next = S.next(ui + 1, nxt);
        const char* nA = has_next ? (const char*)g.A + (size_t)nxt.pm * tstepA : cA; const char* nB = has_next ? (const char*)g.Bt + (size_t)nxt.pn * tstepB : cB;
        for (int t = 0; t < nt; t += 2) {
            const bool last = (t == nt - 2);
            const char* a1 = cA + (size_t)(t + 1) * kstep;
            const char* a2 = last ? nA : cA + (size_t)(t + 2) * kstep; const char* b2 = last ? nB : cB + (size_t)(t + 2) * kstep;
            const char* a3 = a2 + kstep; const char* b3 = b2 + kstep;
            if (last && has_next) S.a_ready(nxt);
            if constexpr (Epi::KSCALE) { if (t >= 32 && (t & 3) == 0 && (t < 48 || (t & 7) == 0)) E.rescale(acc, t < 48 ? (t - 32) >> 2 : 4 + ((t - 48) >> 3), wr, fr); }
            PG8_LDB(B0, 0, 0); PG8_SCHED; PG8_LDA(At, 0, 0); PG8_STAGE(PG8_SA(1, 1), a1 + hstepA, voffA);
            PG8_WAIT_L(8); PG8_BAR; PG8_WAIT_L(0); PG8_MMA(0, 0, At, B0); PG8_BAR; PG8_SCHED;
            PG8_LDB(B1, 0, 1); PG8_STAGE(PG8_SB(0, 0), b2, voffB);
            PG8_BAR; PG8_WAIT_L(0); PG8_MMA(0, 1, At, B1); PG8_BAR;
            PG8_LDA(At, 0, 1); PG8_STAGE(PG8_SA(0, 0), a2, voffA);
            PG8_BAR; PG8_WAIT_L(0); PG8_MMA(1, 0, At, B0); PG8_BAR; PG8_SCHED;
            PG8_STAGE(PG8_SB(0, 1), b2 + hstepB, voffB);
            PG8_WAIT_V(6); PG8_BAR; PG8_MMA(1, 1, At, B1); PG8_BAR;
            PG8_LDB(B0, 1, 0); PG8_SCHED; PG8_LDA(At, 1, 0); PG8_STAGE(PG8_SA(0, 1), a2 + hstepA, voffA);
            PG8_WAIT_L(8); PG8_BAR; PG8_WAIT_L(0); PG8_MMA(0, 0, At, B0); PG8_BAR; PG8_SCHED;
            PG8_LDB(B1, 1, 1); PG8_STAGE(PG8_SB(1, 0), b3, voffB);
            PG8_BAR; PG8_WAIT_L(0); PG8_MMA(0, 1, At, B1); PG8_BAR;
            PG8_LDA(At, 1, 1); PG8_STAGE(PG8_SA(1, 0), a3, voffA);
            PG8_BAR; PG8_WAIT_L(0); PG8_MMA(1, 0, At, B0); PG8_BAR; PG8_SCHED;
            PG8_STAGE(PG8_SB(1, 1), b3 + hstepB, voffB);
            PG8_WAIT_V(6); PG8_BAR; PG8_MMA(1, 1, At, B1); PG8_BAR;
        }
        E(acc, cur, wr, wc, fr, fq);
        if constexpr (Epi::TWICE) {
#pragma unroll
            for (int a = 0; a < 2; ++a)
#pragma unroll
                for (int b = 0; b < 2; ++b) asm volatile("" : "+v"(acc[a][b][0][0]), "+v"(acc[a][b][0][1]), "+v"(acc[a][b][1][0]), "+v"(acc[a][b][1][1]), "+v"(acc[a][b][2][0]), "+v"(acc[a][b][2][1]), "+v"(acc[a][b][3][0]), "+v"(acc[a][b][3][1]) :: "memory");
            E(acc, cur, wr, wc, fr, fq); }
        S.done(cur);
        if (!has_next) break;
#pragma unroll
        for (int a = 0; a < 2; ++a)
#pragma unroll
            for (int b = 0; b < 2; ++b)
#pragma unroll
                for (int m = 0; m < 4; ++m)
#pragma unroll
                    for (int n = 0; n < 2; ++n) acc[a][b][m][n] = (f32x4){0.f, 0.f, 0.f, 0.f};
        cur = nxt; cA = nA; cB = nB; ++ui;
    }
    PG8_WAIT_V(0);
    if (wr == 0) PG8_BAR;
    PG8_BAR;
#undef PG8_SA
#undef PG8_SB
#undef PG8_STAGE
#undef PG8_LDA
#undef PG8_LDB
#undef PG8_MMA
#undef PG8_WAIT_V
#undef PG8_WAIT_L
#undef PG8_BAR
#undef PG8_SCHED
}
}

struct Ctx {
    KP kp; const float* const __attribute__((address_space(4)))* in; float* out; unsigned char* ws;
    LAS unsigned char* lds;
    int tid, lane, wave, G, wg;
    float* lb; bf16_t* win; bf16_t* wout; bf16_t* xb; bf16_t* proj; float* projs; float* dtb; bf16_t* mix; bf16_t* xbcs; float* rowsq; unsigned* ctl;
};
DI Ctx make_ctx(int wv) {
    extern __shared__ __attribute__((aligned(16))) unsigned char lds_raw[];
    Ctx c; c.kp = get_params(); c.in = c.kp->in; c.out = c.kp->out; c.ws = c.kp->ws;
    c.lds = (LAS unsigned char*)lds_raw;
    asm volatile("" : "+s"(wv));
    int wg = blockIdx.x; asm volatile("" : "+s"(wg));
    c.tid = get_tid(wv); c.lane = c.tid & 63; c.wave = wv; c.G = gridDim.x; c.wg = wg;
    unsigned char* ws = c.ws;
    c.ctl = (unsigned*)(ws + WS_CTL); c.lb = (float*)(ws + WS_LB); c.win = (bf16_t*)(ws + WS_WIN); c.wout = (bf16_t*)(ws + WS_WOUT); c.xb = (bf16_t*)(ws + WS_XB);
    c.proj = (bf16_t*)(ws + WS_PROJ); c.projs = (float*)(ws + WS_PROJS); c.dtb = (float*)(ws + WS_DTB); c.mix = (bf16_t*)(ws + WS_MIX); c.xbcs = (bf16_t*)(ws + WS_XBCS); c.rowsq = (float*)(c.ctl + CW_ROWSQ);
    return c;
}

DI void p0_transpose_item(const float* W, int ldw, int k0, int n0, bf16_t* WT, int K, int drow0, LAS float* scr, int lane, const float* ksc) {
    float t[32];
#pragma unroll
    for (int i = 0; i < 32; ++i) t[i] = W[(size_t)(k0 + 2 * i + (lane >> 5)) * ldw + n0 + (lane & 31)];
#pragma unroll
    for (int i = 0; i < 32; ++i) scr[(2 * i + (lane >> 5)) * 33 + (lane & 31)] = t[i];
    const int c = lane & 7;
    f32x4 s0 = (f32x4){1.f, 1.f, 1.f, 1.f}, s1 = s0;
    if (ksc) { s0 = *(const f32x4*)(ksc + k0 + 8 * c); s1 = *(const f32x4*)(ksc + k0 + 8 * c + 4); }
    asm volatile("s_waitcnt lgkmcnt(0)" ::: "memory");
#pragma unroll
    for (int j = 0; j < 4; ++j) { const int n = (lane >> 3) + 8 * j; const LAS float* s = scr + (8 * c) * 33 + n;
        u32x4 o; o.x = pk2(s[0 * 33] * s0.x, s[1 * 33] * s0.y); o.y = pk2(s[2 * 33] * s0.z, s[3 * 33] * s0.w); o.z = pk2(s[4 * 33] * s1.x, s[5 * 33] * s1.y); o.w = pk2(s[6 * 33] * s1.z, s[7 * 33] * s1.w);
        *(u32x4*)(WT + (size_t)(drow0 + n) * K + k0 + 8 * c) = o; }
    asm volatile("s_waitcnt lgkmcnt(0)" ::: "memory");
}
DI void phase_prologue(int wv) {
    const Ctx c = make_ctx(wv);
    LAS float* scr = (LAS float*)(c.lds + c.wave * 16384);
    const int gw = c.wg * 8 + c.wave, NGW = c.G * 8;
    constexpr int NB1 = SRC_GLA / 32, NB2 = (SRC_DT - SRC_SSZ) / 32;
    constexpr int I_A = (D_MODEL / 64) * NB1, I_B = (D_MODEL / 64) * NB2, I_O = (D_MIX / 64) * (D_MODEL / 32), I_L = I_A + I_B + I_O;
    for (int it = gw; it < DEPTH * I_L; it += NGW) {
        const int l = it / I_L; int r = it % I_L;
        const float* win = c.in[I_WIN] + (size_t)l * D_MODEL * N_IN; bf16_t* wt = c.win + (size_t)l * LDP * D_MODEL; const float* rmsw = c.in[I_RMS] + (size_t)l * D_MODEL;
        if (r < I_A) { const int kb = r / NB1, nb = r % NB1; p0_transpose_item(win, N_IN, 64 * kb, 32 * nb, wt, D_MODEL, 32 * nb, scr, c.lane, rmsw); }
        else if (r < I_A + I_B) { r -= I_A; const int kb = r / NB2, nb = r % NB2; p0_transpose_item(win, N_IN, 64 * kb, SRC_SSZ + 32 * nb, wt, D_MODEL, C_SSZ + 32 * nb, scr, c.lane, rmsw); }
        else { r -= I_A + I_B; const int kb = r / (D_MODEL / 32), nb = r % (D_MODEL / 32);
            p0_transpose_item(c.in[I_WOUT] + (size_t)l * D_MIX * D_MODEL, D_MODEL, 64 * kb, 32 * nb, c.wout + (size_t)l * D_MODEL * D_MIX, D_MIX, 32 * nb, scr, c.lane, kb >= 48 ? c.in[I_SSN] + (size_t)l * 1024 - 3072 : nullptr); }
    }
    const int gt = c.wg * 512 + c.tid, NGT = c.G * 512;
    for (int it = gw; it < DEPTH * 32 * 8; it += NGW) {
        const int l = it >> 8, kb = (it >> 3) & 31, nb = it & 7, k = kb * 64 + c.lane;
        const float* wr = c.in[I_WIN] + ((size_t)l * D_MODEL + k) * N_IN + SRC_GLA; const float* up = c.in[I_GWU] + (size_t)l * 16 * 512 + nb * 64;
        const f32x4 a0 = *(const f32x4*)wr, a1 = *(const f32x4*)(wr + 4), a2 = *(const f32x4*)(wr + 8), a3 = *(const f32x4*)(wr + 12);
        const float rk = c.in[I_RMS][(size_t)l * D_MODEL + k];
        bf16_t* dst = c.win + ((size_t)l * LDP + C_GLF + nb * 64) * D_MODEL + k;
#pragma unroll 4
        for (int n = 0; n < 64; ++n) {
            const float s = a0.x * up[n] + a0.y * up[512 + n] + a0.z * up[1024 + n] + a0.w * up[1536 + n] + a1.x * up[2048 + n] + a1.y * up[2560 + n] + a1.z * up[3072 + n] + a1.w * up[3584 + n]
                          + a2.x * up[4096 + n] + a2.y * up[4608 + n] + a2.z * up[5120 + n] + a2.w * up[5632 + n] + a3.x * up[6144 + n] + a3.y * up[6656 + n] + a3.z * up[7168 + n] + a3.w * up[7680 + n];
            dst[(size_t)n * D_MODEL] = (bf16_t)f2bf(s * rk); }
    }
    for (int i = gt; i < DEPTH * 16 * D_MODEL; i += NGT) {
        const int l = i / (16 * D_MODEL), e = i % (16 * D_MODEL), n = e / D_MODEL, k = e % D_MODEL;
        c.win[((size_t)l * LDP + C_DT + n) * D_MODEL + k] = (bf16_t)f2bf(c.in[I_WIN][((size_t)l * D_MODEL + k) * N_IN + SRC_DT + n] * c.in[I_RMS][(size_t)l * D_MODEL + k]);
    }
    constexpr int PADW = (LDP - C_DT - 16) * D_MODEL * 2 / 16;
    for (int i = gt; i < DEPTH * PADW; i += NGT) { const int l = i / PADW, r = i % PADW;
        ((u32x4*)(c.win + ((size_t)l * LDP + C_DT + 16) * D_MODEL))[r] = (u32x4){0u, 0u, 0u, 0u}; }
    constexpr int PADX = (M_PAD - TT) * D_MODEL * 2 / 16;
    for (int i = gt; i < PADX; i += NGT) ((u32x4*)(c.xb + (size_t)TT * D_MODEL))[i] = (u32x4){0u, 0u, 0u, 0u};
    for (int r = gw; r < TT; r += NGW) {
        const f32x4* x4 = (const f32x4*)(r < TP ? c.in[I_XP] + (size_t)r * D_MODEL : c.in[I_XS] + (size_t)(r - TP) * D_MODEL);
        u32x2* o = (u32x2*)(c.xb + (size_t)r * D_MODEL); float s = 0.f;
#pragma unroll
        for (int j = 0; j < 8; ++j) { const f32x4 v = x4[c.lane + 64 * j]; s += (v.x * v.x + v.y * v.y) + (v.z * v.z + v.w * v.w); u32x2 p; p.x = pk2(v.x, v.y); p.y = pk2(v.z, v.w); o[c.lane + 64 * j] = p; }
        s = wave_sum(s, c.lane);
        if (c.lane == 0) c.rowsq[r] = s;
    }
    for (int i = gt; i < 1024; i += NGT) {
        const float* p = c.in[I_LB];
        const float a0 = p[i], a1 = p[1024 + i], a2 = p[2048 + i], a3 = p[3072 + i];
        const float mx = fmaxf(fmaxf(a0, a1), fmaxf(a2, a3));
        const float e0 = expf(a0 - mx), e1 = expf(a1 - mx), e2 = expf(a2 - mx), e3 = expf(a3 - mx);
        const float inv = 1.0f / (e0 + e1 + e2 + e3);
        c.lb[i] = 0.f; c.lb[1024 + i] = e1 * inv; c.lb[2048 + i] = (e1 + e2) * inv; c.lb[3072 + i] = (e1 + e2 + e3) * inv;
    }
}

DI void phase_final_norm(int wv) {
    const Ctx c = make_ctx(wv);
    const int gw = c.wg * 8 + c.wave, NGW = c.G * 8;
    const f32x4* w4 = (const f32x4*)c.in[I_RMSF];
    for (int r = gw; r < TT; r += NGW) {
        const u32x2* x2 = (const u32x2*)(c.xb + (size_t)r * D_MODEL);
        const float rstd = row_rstd(c.rowsq + DEPTH * M_PAD, r);
        f32x4* o = (f32x4*)(c.out + O_YP + (size_t)r * D_MODEL);
#pragma unroll
        for (int j = 0; j < 8; ++j) { const u32x2 p = x2[c.lane + 64 * j]; const f32x4 w = w4[c.lane + 64 * j];
            o[c.lane + 64 * j] = (f32x4){bflo(p.x) * rstd * w.x, bfhi(p.x) * rstd * w.y, bflo(p.y) * rstd * w.z, bfhi(p.y) * rstd * w.w}; }
    }
}

DI float ps4(const float* p) { return (p[0] + p[PST]) + (p[2 * PST] + p[3 * PST]); }
DI float conv1(const float* prow, float rs, int col, int ch, int nch, const float* cw, const float* cb, const float* buf, float* nbuf) {
    const float b0 = buf[ch], b1 = buf[nch + ch], b2 = buf[2 * nch + ch], xn = ps4(prow + col + ch) * rs, w0 = cw[ch], w1 = cw[nch + ch], w2 = cw[2 * nch + ch], w3 = cw[3 * nch + ch], bb = cb[ch];
    nbuf[ch] = b1; nbuf[nch + ch] = b2; nbuf[2 * nch + ch] = xn;
    return bb + w0 * b0 + w1 * b1 + w2 * b2 + w3 * xn;
}
constexpr int SM_Q = 0, SM_K = 1024, SM_F = 2048, SM_V = 3072, SM_O = 4096, SM_WS = 5120, SM_PART = 5376;
DI void sample_item(const Ctx& c, int l, int s, int type) {
    LAS float* sm = (LAS float*)c.lds;
    LAS float* QS = sm + SM_Q; LAS float* KS = sm + SM_K; LAS float* FS = sm + SM_F; LAS float* VS = sm + SM_V; LAS float* OS_ = sm + SM_O; LAS float* WSUM = sm + SM_WS;
    const int tid = get_tid(c.wave), lane = tid & 63, w = c.wave;
    const float* pr = c.projs + (size_t)s * LDP; const float rs = row_rstd(c.rowsq + (size_t)l * M_PAD, TP + s);
    __syncthreads();
    if (type == 0) {
#pragma unroll
        for (int e = 0; e < 2; ++e) { const int ch = 2 * tid + e; const float qraw = (ps4(pr + C_HGQ + ch) * rs), fraw = (ps4(pr + C_HGF + ch) * rs), lbv = c.lb[(size_t)l * 1024 + ch];
            QS[ch] = silu(qraw); FS[ch] = fmaxf(lbv + (1.0f - lbv) * sigm(fraw), TINY); KS[ch] = (1.0f - lbv) * sigm(-fraw); VS[ch] = (ps4(pr + C_HGI + ch) * rs); }
    } else if (type == 1) {
#pragma unroll
        for (int e = 0; e < 2; ++e) { const int ch = 2 * tid + e; VS[ch] = (ps4(pr + C_GLV + ch) * rs);
            if (tid < 256) { QS[ch] = (ps4(pr + C_GLQ + ch) * rs) * 0.08838834764831845f; KS[ch] = (ps4(pr + C_GLK + ch) * rs);
                const float z = (ps4(pr + C_GLF + ch) * rs) + c.in[I_GBU][(size_t)l * 512 + ch]; FS[ch] = fexp(-softplus(-z) * (1.0f / 16.0f)); } }
    } else {
        const float* scw = c.in[I_SCW] + (size_t)l * 4 * 1536; const float* scb = c.in[I_SCB] + (size_t)l * 1536;
        const float* sbuf = c.in[I_SSSDC] + ((size_t)l * DEC + s) * 3 * 1536; float* nbuf = c.out + O_SSDC_S + ((size_t)l * DEC + s) * 4608;
        float cv0, cv1, cv2 = 0.f, cv3 = 0.f;
        cv0 = conv1(pr, rs, C_XBC, 2 * tid, 1536, scw, scb, sbuf, nbuf); cv1 = conv1(pr, rs, C_XBC, 2 * tid + 1, 1536, scw, scb, sbuf, nbuf);
        if (tid < 256) { cv2 = conv1(pr, rs, C_XBC, 1024 + tid, 1536, scw, scb, sbuf, nbuf); cv3 = conv1(pr, rs, C_XBC, 1280 + tid, 1536, scw, scb, sbuf, nbuf); }
        VS[2 * tid] = silu(cv0); VS[2 * tid + 1] = silu(cv1);
        if (tid < 256) { KS[tid] = silu(cv2); QS[tid] = silu(cv3); }
        if (tid < 16) { const float dt = softplus((ps4(pr + C_DT + tid) * rs) + c.in[I_DTB][l * 16 + tid]); FS[tid] = dt; FS[16 + tid] = fexp(-dt * expf(c.in[I_ALOG][l * 16 + tid])); }
    }
    __syncthreads();
    if (type < 2) {
        const int h = type == 0 ? w : (w >> 1), RS = type == 0 ? 128 : 256, voff = type == 0 ? 0 : 128 * (w & 1);
        const size_t sb = type == 0 ? (((size_t)l * DEC + s) * 8 + h) * 16384 : (((size_t)l * DEC + s) * 4 + h) * 32768;
        const float* s0 = (type == 0 ? c.in[I_SHG] : c.in[I_SGLA]) + sb; float* so = c.out + (type == 0 ? O_HG_S : O_GLA_S) + sb;
        const int vq = lane & 31, kh = lane >> 5, vb = (type == 0 ? h * 128 : h * 256 + voff) + 4 * vq, qb = h * 128;
        const f32x4 vv = *(const LAS f32x4*)(VS + vb); f32x4 o4 = (f32x4){0.f, 0.f, 0.f, 0.f};
        const int eo = kh * RS + voff + 4 * vq;
        f32x4 st[3][8];
#define SI_LOAD(bf, kb) do { _Pragma("unroll") for (int u = 0; u < 8; ++u) st[bf][u] = *(const f32x4*)(s0 + (size_t)(2 * (8 * (kb) + u)) * RS + eo); } while (0)
        SI_LOAD(0, 0); SI_LOAD(1, 1);
#pragma unroll
        for (int kb = 0; kb < 8; ++kb) {
            if (kb + 2 < 8) SI_LOAD((kb + 2) % 3, kb + 2);
#pragma unroll
            for (int u = 0; u < 8; ++u) { const int k = 2 * (8 * kb + u) + kh; const float fk = FS[qb + k], kk = KS[qb + k], qk = QS[qb + k];
                f32x4 t = st[kb % 3][u] * fk + vv * kk; o4 += t * qk; *(f32x4*)(so + (size_t)(2 * (8 * kb + u)) * RS + eo) = t; }
        }
#undef SI_LOAD
        o4.x += shx(o4.x, 32, lane); o4.y += shx(o4.y, 32, lane); o4.z += shx(o4.z, 32, lane); o4.w += shx(o4.w, 32, lane);
        if (kh == 0) *(LAS f32x4*)(OS_ + vb) = o4;
    } else {
        LAS float* PART = sm + SM_PART + w * 2304;
        const int nq = lane & 31, ph = lane >> 5, g = w >> 2;
        const f32x4 B4 = *(const LAS f32x4*)(KS + g * 128 + 4 * nq), C4 = *(const LAS f32x4*)(QS + g * 128 + 4 * nq);
        const float* s0 = c.in[I_SSSD] + (((size_t)l * DEC + s) * 16 + 2 * w) * 8192; float* so = c.out + O_SSD_S + (((size_t)l * DEC + s) * 16 + 2 * w) * 8192;
        const int eo = ph * 128 + 4 * nq;
        f32x4 st[3][8];
#define SI_LOAD(bf, kb) do { _Pragma("unroll") for (int u = 0; u < 8; ++u) st[bf][u] = *(const f32x4*)(s0 + (size_t)((kb) >> 2) * 8192 + (size_t)(2 * (8 * ((kb) & 3) + u)) * 128 + eo); } while (0)
        SI_LOAD(0, 0); SI_LOAD(1, 1);
#pragma unroll
        for (int kb = 0; kb < 8; ++kb) { const int h = 2 * w + (kb >> 2);
            if (kb + 2 < 8) SI_LOAD((kb + 2) % 3, kb + 2);
            const float dt = FS[h], dA = FS[16 + h];
#pragma unroll
            for (int u = 0; u < 8; ++u) { const int p = 2 * (8 * (kb & 3) + u) + ph; const float xv = VS[h * 64 + p] * dt;
                const f32x4 t = st[kb % 3][u] * dA + B4 * xv; *(f32x4*)(so + (size_t)(kb >> 2) * 8192 + (size_t)(2 * (8 * (kb & 3) + u)) * 128 + eo) = t;
                PART[p * 36 + nq] = (t.x * C4.x + t.y * C4.y) + (t.z * C4.z + t.w * C4.w); }
            if ((kb & 3) == 3) {
                asm volatile("s_waitcnt lgkmcnt(0)" ::: "memory");
                float o = 0.f;
#pragma unroll
                for (int q = 0; q < 8; ++q) { const f32x4 tt = *(const LAS f32x4*)(PART + lane * 36 + 4 * q); o += (tt.x + tt.y) + (tt.z + tt.w); }
                const float x = VS[h * 64 + lane], z = (ps4(pr + C_SSZ + h * 64 + lane) * rs);
                OS_[h * 64 + lane] = (o + c.in[I_SD][l * 16 + h] * x) * silu(z);
                asm volatile("s_waitcnt lgkmcnt(0)" ::: "memory"); }
        }
#undef SI_LOAD
    }
    __syncthreads();
    { const f32x2 o2 = *(const LAS f32x2*)(OS_ + 2 * tid);
      const float ssw = wave_sum(o2.x * o2.x + o2.y * o2.y, lane);
      if (lane == 0) WSUM[w] = ssw;
      __syncthreads();
      float ss, gsz; const float* nw; int mcol, gcol = 0;
      if (type == 0) { ss = WSUM[w]; gsz = 128.f; nw = c.in[I_HGN] + (size_t)l * 1024; mcol = 0; gcol = C_HGG; }
      else if (type == 1) { ss = WSUM[w & ~1] + WSUM[w | 1]; gsz = 256.f; nw = c.in[I_GLN] + (size_t)l * 1024; mcol = 2048; gcol = C_GLG; }
      else { const int b4 = w & ~3; ss = (WSUM[b4] + WSUM[b4 + 1]) + (WSUM[b4 + 2] + WSUM[b4 + 3]); gsz = 512.f; nw = c.in[I_SSN] + (size_t)l * 1024; mcol = 3072; }
      const float rstd = rsqrtf(ss / gsz + EPS);
      float y0 = o2.x * rstd, y1 = o2.y * rstd;
      if (type < 2) { y0 *= nw[2 * tid]; y1 *= nw[2 * tid + 1]; }
      if (type < 2) { y0 *= silu((ps4(pr + gcol + 2 * tid) * rs)); y1 *= silu((ps4(pr + gcol + 2 * tid + 1) * rs)); }
      *(unsigned*)(c.mix + (size_t)(TP + s) * D_MIX + mcol + 2 * tid) = pk2(y0, y1); }
}

DI void lds_barrier() { asm volatile("s_waitcnt lgkmcnt(0)\n\ts_barrier" ::: "memory"); }
DI f32x16 mfma32(bf16x8 a, bf16x8 b, f32x16 c) { return __builtin_amdgcn_mfma_f32_32x32x16_bf16(a, b, c, 0, 0, 0); }
DI bf16x8 ldfrag(const LAS unsigned char* p) { return *(const LAS bf16x8*)p; }
DI int crow(int i, int hh) { return (i & 3) + 8 * (i >> 2) + 4 * hh; }
constexpr int L_QP = 0, L_KP = 17408, L_KPT = 34816, L_VT = 53248, L_VT2 = 71680, L_AM = 90112, L_TOT = 108544, L_E1 = 112640, L_E2 = 113152, L_CUM = 113664;
constexpr int SQ = 272, SV = 144;
#define ZERO16(x) do { _Pragma("unroll") for (int _i = 0; _i < 16; ++_i) (x)[_i] = 0.f; } while (0)

template <int TYPE>
DI void la_head_unit(const Ctx& c, int l, int b, int hu) {
    constexpr int DV = 128, NSW = DV / 32, OS = DV * 2 + 16, NC = DV / 8;
    LAS unsigned char* L = c.lds;
    const int tid = get_tid(c.wave), lane = tid & 63, w = c.wave;
    const int r = lane & 31, hh = lane >> 5;
    const int row0 = b * SEQ;
    const bf16_t* P = TYPE == 2 ? c.xbcs : c.proj;
    constexpr int LDR = TYPE == 2 ? 1536 : LDP;
    LAS float* TOT = (LAS float*)(L + L_TOT); LAS float* E1 = (LAS float*)(L + L_E1); LAS float* E2 = (LAS float*)(L + L_E2);
    int colQ, colK, colG, colV, colGate, colOut, sidx; const int grp = hu >> 2;
    if constexpr (TYPE == 0) { colQ = C_HGQ + hu * 128; colK = 0; colG = C_HGF + hu * 128; colV = C_HGI + hu * 128; colGate = C_HGG + hu * 128; colOut = hu * 128; sidx = 0; }
    else if constexpr (TYPE == 1) { const int hd = hu >> 1; colQ = C_GLQ + hd * 128; colK = C_GLK + hd * 128; colG = C_GLF + hd * 128; colV = C_GLV + hu * 128; colGate = C_GLG + hu * 128; colOut = 2048 + hu * 128; sidx = 2 + hd; }
    else { colK = 1024 + grp * 128; colQ = 1280 + grp * 128; colG = 0; colV = hu * 128; colGate = C_SSZ + hu * 128; colOut = 3072 + hu * 128; sidx = grp; }
    float Ah[2], Dh[2];
    if constexpr (TYPE == 2) {
#pragma unroll
        for (int e = 0; e < 2; ++e) { Ah[e] = -expf(c.in[I_ALOG][l * 16 + 2 * hu + e]); Dh[e] = c.in[I_SD][l * 16 + 2 * hu + e]; }
    }
    unsigned r0[8], r1[8], r2[8], r3[8]; float dtn = 0.f;
#define LOAD_CHUNK(tn) do { const bf16_t* pq_ = P + (size_t)(row0 + (tn) + 8 * w) * LDR + 2 * lane; \
        if constexpr (TYPE == 0) { _Pragma("unroll") for (int i = 0; i < 8; ++i) { r0[i] = *(const unsigned*)(pq_ + (size_t)i * LDR + colQ); r1[i] = *(const unsigned*)(pq_ + (size_t)i * LDR + colG); r2[i] = *(const unsigned*)(pq_ + (size_t)i * LDR + colV); } } \
        else if constexpr (TYPE == 1) { _Pragma("unroll") for (int i = 0; i < 8; ++i) { r0[i] = *(const unsigned*)(pq_ + (size_t)i * LDR + colQ); r1[i] = *(const unsigned*)(pq_ + (size_t)i * LDR + colK); \
                                                                                       r2[i] = *(const unsigned*)(pq_ + (size_t)i * LDR + colG); r3[i] = *(const unsigned*)(pq_ + (size_t)i * LDR + colV); } } \
        else { _Pragma("unroll") for (int i = 0; i < 8; ++i) { r0[i] = *(const unsigned*)(pq_ + (size_t)i * LDR + colQ); r1[i] = *(const unsigned*)(pq_ + (size_t)i * LDR + colK); r2[i] = *(const unsigned*)(pq_ + (size_t)i * LDR + colV); } \
            if (w < 2) dtn = c.dtb[(size_t)(row0 + (tn) + lane) * 16 + 2 * hu + w]; } } while (0)
    f32x16 S[4];
#pragma unroll
    for (int kt = 0; kt < 4; ++kt) ZERO16(S[kt]);
    float e2pa = 1.f, e2pb = 1.f;
    constexpr bool PF = true;
    if constexpr (PF) LOAD_CHUNK(0);
    for (int ck = -(SEQ / 64) * (PROBE_LONG_REP - 1); ck < SEQ / 64; ++ck) {
        if (PROBE_LONG_REP > 1 && ck == 0) { e2pa = 1.f; e2pb = 1.f;
#pragma unroll
            for (int kt = 0; kt < 4; ++kt) ZERO16(S[kt]); }
        const int t0 = (ck & (SEQ / 64 - 1)) * 64;
        if constexpr (TYPE == 2) { if ((ck & (SEQ / 64 - 1)) == 15) {
            if (tid == 0) { unsigned* xp1 = c.ctl + CW_XPRE + 128 * l + 64; unsigned sp = 0;
                while (__hip_atomic_load(xp1, __ATOMIC_RELAXED, __HIP_MEMORY_SCOPE_AGENT) < 128u) { __builtin_amdgcn_s_sleep(8); if (++sp > (1u << 22)) break; }
                __builtin_amdgcn_fence(__ATOMIC_ACQUIRE, "agent"); asm volatile("s_waitcnt vmcnt(0)" ::: "memory"); }
            __syncthreads(); } }
        LAS float* CUM = (LAS float*)(L + L_CUM + (ck & 1) * 1536);
        if constexpr (!PF) LOAD_CHUNK(t0);
        float qa[8], qb[8], ka[8], kb[8], ga[8], gb[8], xa[8], xb[8]; unsigned uv[8];
        if constexpr (TYPE == 0) {
            float ta = 0.f, tb = 0.f;
#pragma unroll
            for (int i = 0; i < 8; ++i) { qa[i] = bflo(r0[i]); qb[i] = bfhi(r0[i]); const float g0 = bflo(r1[i]), g1 = bfhi(r1[i]); uv[i] = r2[i];
                ka[i] = 1.0f - fexp(g0); kb[i] = 1.0f - fexp(g1); ta += g0; tb += g1; ga[i] = ta; gb[i] = tb; }
            *(LAS f32x2*)(TOT + w * 128 + 2 * lane) = (f32x2){ta, tb};
        } else if constexpr (TYPE == 1) {
            float ta = 0.f, tb = 0.f;
#pragma unroll
            for (int i = 0; i < 8; ++i) { qa[i] = bflo(r0[i]); qb[i] = bfhi(r0[i]); ka[i] = bflo(r1[i]); kb[i] = bfhi(r1[i]); ta += bflo(r2[i]); tb += bfhi(r2[i]); ga[i] = ta; gb[i] = tb; uv[i] = r3[i]; }
            *(LAS f32x2*)(TOT + w * 128 + 2 * lane) = (f32x2){ta, tb};
        } else {
#pragma unroll
            for (int i = 0; i < 8; ++i) { qa[i] = bflo(r0[i]); qb[i] = bfhi(r0[i]); ka[i] = bflo(r1[i]); kb[i] = bfhi(r1[i]); xa[i] = bflo(r2[i]); xb[i] = bfhi(r2[i]); }
            if (w < 2) {
                const float dt = dtn; float x = dt * (w == 0 ? Ah[0] : Ah[1]);
#pragma unroll
                for (int o = 1; o < 64; o <<= 1) { const float y = shup(x, o, lane); if (lane >= o) x += y; }
                CUM[w * 192 + lane] = x; CUM[w * 192 + 64 + lane] = fmaxf(dt, 1e-30f); CUM[w * 192 + 128 + lane] = fexp(x);
            }
        }
        lds_barrier();
        if constexpr (TYPE < 2) {
            float offa = 0.f, offb = 0.f, brefa = 0.f, brefb = 0.f, bla = 0.f, blb = 0.f;
#pragma unroll
            for (int g = 0; g < 8; ++g) { const f32x2 t = *(const LAS f32x2*)(TOT + g * 128 + 2 * lane);
                if (g < w) { offa += t.x; offb += t.y; }
                if (g < 4) { brefa += t.x; brefb += t.y; }
                bla += t.x; blb += t.y; }
#pragma unroll
            for (int i = 0; i < 8; ++i) { const float da = clampf(ga[i] + offa - brefa, -80.f, 80.f), db = clampf(gb[i] + offb - brefb, -80.f, 80.f);
                qa[i] *= fexp(da); ka[i] *= fexp(-da); qb[i] *= fexp(db); kb[i] *= fexp(-db); }
            if (w == 0) {
                const float e2a = fexp(bla - brefa), e2b = fexp(blb - brefb);
                *(LAS f32x2*)(E1 + 2 * lane) = (f32x2){fexp(brefa) * e2pa, fexp(brefb) * e2pb}; *(LAS f32x2*)(E2 + 2 * lane) = (f32x2){e2a, e2b}; e2pa = e2a; e2pb = e2b; }
        }
#pragma unroll
        for (int i = 0; i < 8; ++i) { *(LAS unsigned*)(L + L_QP + (8 * w + i) * SQ + 4 * lane) = pk2(qa[i], qb[i]); *(LAS unsigned*)(L + L_KP + (8 * w + i) * SQ + 4 * lane) = pk2(ka[i], kb[i]); }
        { u32x4 a, bq; a.x = pk2(ka[0], ka[1]); a.y = pk2(ka[2], ka[3]); a.z = pk2(ka[4], ka[5]); a.w = pk2(ka[6], ka[7]);
          bq.x = pk2(kb[0], kb[1]); bq.y = pk2(kb[2], kb[3]); bq.z = pk2(kb[4], kb[5]); bq.w = pk2(kb[6], kb[7]);
          *(LAS u32x4*)(L + L_KPT + (2 * lane) * SV + 16 * w) = a; *(LAS u32x4*)(L + L_KPT + (2 * lane + 1) * SV + 16 * w) = bq; }
        if constexpr (TYPE < 2) {
            u32x4 a, bq;
            a.x = (uv[0] & 0xffffu) | (uv[1] << 16); a.y = (uv[2] & 0xffffu) | (uv[3] << 16); a.z = (uv[4] & 0xffffu) | (uv[5] << 16); a.w = (uv[6] & 0xffffu) | (uv[7] << 16);
            bq.x = (uv[0] >> 16) | (uv[1] & 0xffff0000u); bq.y = (uv[2] >> 16) | (uv[3] & 0xffff0000u); bq.z = (uv[4] >> 16) | (uv[5] & 0xffff0000u); bq.w = (uv[6] >> 16) | (uv[7] & 0xffff0000u);
            *(LAS u32x4*)(L + L_VT + (2 * lane) * SV + 16 * w) = a; *(LAS u32x4*)(L + L_VT + (2 * lane + 1) * SV + 16 * w) = bq;
        } else {
            const int hs = lane >> 5;
            const LAS float* cm = CUM + hs * 192; const float cl = cm[63];
            float v1a[8], v1b[8], v2a[8], v2b[8];
#pragma unroll
            for (int j = 0; j < 8; ++j) { const int s = 8 * w + j; const float dt = cm[64 + s], wgt = fexp(fminf(cl - cm[s], 0.f));
                v1a[j] = dt * xa[j]; v1b[j] = dt * xb[j]; v2a[j] = v1a[j] * wgt; v2b[j] = v1b[j] * wgt; }
            u32x4 a, bq;
            a.x = pk2(v1a[0], v1a[1]); a.y = pk2(v1a[2], v1a[3]); a.z = pk2(v1a[4], v1a[5]); a.w = pk2(v1a[6], v1a[7]);
            bq.x = pk2(v1b[0], v1b[1]); bq.y = pk2(v1b[2], v1b[3]); bq.z = pk2(v1b[4], v1b[5]); bq.w = pk2(v1b[6], v1b[7]);
            *(LAS u32x4*)(L + L_VT + (2 * lane) * SV + 16 * w) = a; *(LAS u32x4*)(L + L_VT + (2 * lane + 1) * SV + 16 * w) = bq;
            a.x = pk2(v2a[0], v2a[1]); a.y = pk2(v2a[2], v2a[3]); a.z = pk2(v2a[4], v2a[5]); a.w = pk2(v2a[6], v2a[7]);
            bq.x = pk2(v2b[0], v2b[1]); bq.y = pk2(v2b[2], v2b[3]); bq.z = pk2(v2b[4], v2b[5]); bq.w = pk2(v2b[6], v2b[7]);
            *(LAS u32x4*)(L + L_VT2 + (2 * lane) * SV + 16 * w) = a; *(LAS u32x4*)(L + L_VT2 + (2 * lane + 1) * SV + 16 * w) = bq;
        }
        lds_barrier();
        if constexpr (PF) { if (ck + 1 < SEQ / 64) LOAD_CHUNK(((ck + 1) & (SEQ / 64 - 1)) * 64); }
        if (w >= 5) {
            const int sb = (w == 7) ? 1 : 0, tb = (w == 5) ? 0 : 1;
            f32x16 X; ZERO16(X);
#pragma unroll
            for (int k4 = 0; k4 < 8; k4 += 4) { bf16x8 fk[4], fq[4];
#pragma unroll
                for (int u = 0; u < 4; ++u) { fk[u] = ldfrag(L + L_KP + (32 * sb + r) * SQ + (16 * (k4 + u) + 8 * hh) * 2); fq[u] = ldfrag(L + L_QP + (32 * tb + r) * SQ + (16 * (k4 + u) + 8 * hh) * 2); }
#pragma unroll
                for (int u = 0; u < 4; ++u) X = mfma32(fk[u], fq[u], X); }
            const int t = 32 * tb + r;
#pragma unroll
            for (int hs = 0; hs < (TYPE == 2 ? 2 : 1); ++hs) {
                float ct = 0.f, ddt = 0.f;
                if constexpr (TYPE == 2) { ct = CUM[hs * 192 + t]; ddt = (hs == 0 ? Dh[0] : Dh[1]) / CUM[hs * 192 + 64 + t]; }
#pragma unroll
                for (int g = 0; g < 4; ++g) { const int s0 = 32 * sb + 8 * g + 4 * hh;
                    float x0 = X[4 * g], x1 = X[4 * g + 1], x2 = X[4 * g + 2], x3 = X[4 * g + 3];
                    if constexpr (TYPE == 2) { const f32x4 cs = *(const LAS f32x4*)(CUM + hs * 192 + s0);
                        x0 *= fexp(fminf(ct - cs.x, 0.f)); x1 *= fexp(fminf(ct - cs.y, 0.f)); x2 *= fexp(fminf(ct - cs.z, 0.f)); x3 *= fexp(fminf(ct - cs.w, 0.f));
                        x0 += (s0 == t) ? ddt : 0.f; x1 += (s0 + 1 == t) ? ddt : 0.f; x2 += (s0 + 2 == t) ? ddt : 0.f; x3 += (s0 + 3 == t) ? ddt : 0.f; }
                    x0 = (s0 <= t) ? x0 : 0.f; x1 = (s0 + 1 <= t) ? x1 : 0.f; x2 = (s0 + 2 <= t) ? x2 : 0.f; x3 = (s0 + 3 <= t) ? x3 : 0.f;
                    u32x2 p; p.x = pk2(x0, x1); p.y = pk2(x2, x3);
                    *(LAS u32x2*)(L + L_AM + hs * 9216 + t * SV + s0 * 2) = p; }
            }
        }
        f32x16 O[2]; bf16x8 Bv[4];
        const int hsw = w >> 1;
        if (w < NSW) {
            if constexpr (TYPE < 2) {
#pragma unroll
                for (int kt = 0; kt < 4; ++kt)
#pragma unroll
                    for (int g = 0; g < 4; ++g) { const f32x4 e = *(const LAS f32x4*)(E1 + 32 * kt + 8 * g + 4 * hh);
                        S[kt][4 * g] *= e.x; S[kt][4 * g + 1] *= e.y; S[kt][4 * g + 2] *= e.z; S[kt][4 * g + 3] *= e.w; }
            }
            ZERO16(O[0]); ZERO16(O[1]);
#pragma unroll
            for (int kt = 0; kt < 4; ++kt) {
                u32x2 ql[2][2], qh[2][2];
#pragma unroll
                for (int s = 0; s < 2; ++s)
#pragma unroll
                    for (int tt = 0; tt < 2; ++tt) { const LAS unsigned char* qp = L + L_QP + (32 * tt + r) * SQ + (32 * kt + 16 * s + 4 * hh) * 2;
                        ql[s][tt] = *(const LAS u32x2*)qp; qh[s][tt] = *(const LAS u32x2*)(qp + 16); }
#pragma unroll
                for (int s = 0; s < 2; ++s) {
                    u32x4 pa; pa.x = pk2(S[kt][8 * s], S[kt][8 * s + 1]); pa.y = pk2(S[kt][8 * s + 2], S[kt][8 * s + 3]); pa.z = pk2(S[kt][8 * s + 4], S[kt][8 * s + 5]); pa.w = pk2(S[kt][8 * s + 6], S[kt][8 * s + 7]);
                    const bf16x8 A = __builtin_bit_cast(bf16x8, pa);
#pragma unroll
                    for (int tt = 0; tt < 2; ++tt) O[tt] = mfma32(A, __builtin_bit_cast(bf16x8, (u32x4){ql[s][tt].x, ql[s][tt].y, qh[s][tt].x, qh[s][tt].y}), O[tt]);
                }
            }
            if constexpr (TYPE == 2) {
                const LAS float* cm = CUM + hsw * 192; const float e0 = cm[128 + r], e1 = cm[128 + 32 + r], sc = cm[128 + 63];
#pragma unroll
                for (int i = 0; i < 16; ++i) { O[0][i] *= e0; O[1][i] *= e1; }
#pragma unroll
                for (int kt = 0; kt < 4; ++kt)
#pragma unroll
                    for (int i = 0; i < 16; ++i) S[kt][i] *= sc;
            }
#pragma unroll
            for (int st = 0; st < 4; ++st) { bf16x8 kf[4];
                Bv[st] = ldfrag(L + (TYPE == 2 ? L_VT2 : L_VT) + (32 * w + r) * SV + (16 * st + 8 * hh) * 2);
#pragma unroll
                for (int kt = 0; kt < 4; ++kt) kf[kt] = ldfrag(L + L_KPT + (32 * kt + r) * SV + (16 * st + 8 * hh) * 2);
#pragma unroll
                for (int kt = 0; kt < 4; ++kt) S[kt] = mfma32(kf[kt], Bv[st], S[kt]); }
        }
        const int nt_ = tid >> 3, nseg = tid & 7;
        u32x4 gq[NC / 8];
        { const bf16_t* pg = c.proj + (size_t)(row0 + t0 + nt_) * LDP + colGate + nseg * NC;
#pragma unroll
          for (int q = 0; q < NC / 8; ++q) gq[q] = *(const u32x4*)(pg + 8 * q); }
        lds_barrier();
        if (w < NSW) {
#pragma unroll
            for (int st = 0; st < 4; ++st) { bf16x8 Av = Bv[st];
                if constexpr (TYPE == 2) Av = ldfrag(L + L_VT + (32 * w + r) * SV + (16 * st + 8 * hh) * 2);
#pragma unroll
                for (int tt = 0; tt < 2; ++tt) if (st < 2 || tt == 1)
                    O[tt] = mfma32(Av, ldfrag(L + L_AM + (TYPE == 2 ? hsw * 9216 : 0) + (32 * tt + r) * SV + (16 * st + 8 * hh) * 2), O[tt]); }
#pragma unroll
            for (int tt = 0; tt < 2; ++tt)
#pragma unroll
                for (int g = 0; g < 4; ++g) { u32x2 p; p.x = pk2(O[tt][4 * g], O[tt][4 * g + 1]); p.y = pk2(O[tt][4 * g + 2], O[tt][4 * g + 3]);
                    *(LAS u32x2*)(L + (32 * tt + r) * OS + (32 * w + 8 * g + 4 * hh) * 2) = p; }
        }
        lds_barrier();
        {
            float o[NC], gv[NC]; float ss = 0.f;
#pragma unroll
            for (int q = 0; q < NC / 8; ++q) { const u32x4 ov = *(const LAS u32x4*)(L + nt_ * OS + (nseg * NC + 8 * q) * 2);
                o[8 * q] = bflo(ov.x); o[8 * q + 1] = bfhi(ov.x); o[8 * q + 2] = bflo(ov.y); o[8 * q + 3] = bfhi(ov.y); o[8 * q + 4] = bflo(ov.z); o[8 * q + 5] = bfhi(ov.z); o[8 * q + 6] = bflo(ov.w); o[8 * q + 7] = bfhi(ov.w);
                gv[8 * q] = bflo(gq[q].x); gv[8 * q + 1] = bfhi(gq[q].x); gv[8 * q + 2] = bflo(gq[q].y); gv[8 * q + 3] = bfhi(gq[q].y); gv[8 * q + 4] = bflo(gq[q].z); gv[8 * q + 5] = bfhi(gq[q].z); gv[8 * q + 6] = bflo(gq[q].w); gv[8 * q + 7] = bfhi(gq[q].w); }
            if constexpr (TYPE == 2) {
#pragma unroll
                for (int e = 0; e < NC; ++e) o[e] *= gv[e];
            }
#pragma unroll
            for (int e = 0; e < NC; ++e) ss += o[e] * o[e];
            ss += shx(ss, 1, lane); ss += shx(ss, 2, lane); ss += shx(ss, 4, lane);
            float mul = 1.0f;
            if constexpr (TYPE == 0) mul = rsqrtf(ss * (1.0f / DV) + EPS);
            else { if (nseg == 0 && ck >= 0) atomicAdd((float*)(c.ctl + CW_STATS) + ((size_t)l * TP + row0 + t0 + nt_) * 6 + sidx, ss); }
            if constexpr (TYPE < 2) {
#pragma unroll
                for (int e = 0; e < NC; ++e) o[e] *= mul * gv[e];
            }
            bf16_t* pm = c.mix + (size_t)(row0 + t0 + nt_) * D_MIX + colOut + nseg * NC;
#pragma unroll
            for (int q = 0; q < NC / 8; ++q) { u32x4 ov; ov.x = pk2(o[8 * q], o[8 * q + 1]); ov.y = pk2(o[8 * q + 2], o[8 * q + 3]); ov.z = pk2(o[8 * q + 4], o[8 * q + 5]); ov.w = pk2(o[8 * q + 6], o[8 * q + 7]);
                *(u32x4*)(pm + 8 * q) = ov; }
        }
    }
#undef LOAD_CHUNK
    if (w < NSW) {
        const int lane2 = get_tid(c.wave) & 63, r = lane2 & 31, hh = lane2 >> 5;
        if constexpr (TYPE < 2) {
#pragma unroll
            for (int kt = 0; kt < 4; ++kt)
#pragma unroll
                for (int g = 0; g < 4; ++g) { const f32x4 e = *(const LAS f32x4*)(E2 + 32 * kt + 8 * g + 4 * hh);
                    S[kt][4 * g] *= e.x; S[kt][4 * g + 1] *= e.y; S[kt][4 * g + 2] *= e.z; S[kt][4 * g + 3] *= e.w; }
        }
        float* sout; int sk, sv, vb;
        if constexpr (TYPE == 0) { sout = c.out + O_HG_P + (((size_t)l * NB + b) * 8 + hu) * 16384; sk = 128; sv = 1; vb = 32 * w; }
        else if constexpr (TYPE == 1) { sout = c.out + O_GLA_P + (((size_t)l * NB + b) * 4 + (hu >> 1)) * 32768; sk = 256; sv = 1; vb = 128 * (hu & 1) + 32 * w; }
        else { sout = c.out + O_SSD_P + (((size_t)l * NB + b) * 16 + 2 * hu + (w >> 1)) * 8192; sk = 1; sv = 128; vb = 32 * (w & 1); }
#pragma unroll
        for (int kt = 0; kt < 4; ++kt)
#pragma unroll
            for (int i = 0; i < 16; ++i) sout[(32 * kt + crow(i, hh)) * sk + (vb + r) * sv] = S[kt][i];
    }
}

constexpr int R_WT = 74752;
DI void rg_load_gates(const Ctx& c, int l, int n, int tid, int j, int hh, bf16x8 (&Br)[8], bf16x8 (&Bi)[8]) {
    LAS unsigned char* L = c.lds;
    const float* wr = c.in[I_WR] + (size_t)(l * 8 + n) * 128 * 128; const float* wi = c.in[I_WI] + (size_t)(l * 8 + n) * 128 * 128;
    __syncthreads();
    f32x4 v[16];
#pragma unroll
    for (int q = 0; q < 16; ++q) { const int e = tid + 512 * q, mat = e >> 12, rem = e & 4095; v[q] = *(const f32x4*)((mat ? wi : wr) + rem * 4); }
#pragma unroll
    for (int q = 0; q < 16; ++q) { const int e = tid + 512 * q, mat = e >> 12, rem = e & 4095, i = rem >> 5, j4 = (rem & 31) * 4;
        LAS unsigned char* p = L + R_WT + mat * 34816 + j4 * SQ + i * 2;
        *(LAS bf16_t*)(p) = (bf16_t)f2bf(v[q].x); *(LAS bf16_t*)(p + SQ) = (bf16_t)f2bf(v[q].y); *(LAS bf16_t*)(p + 2 * SQ) = (bf16_t)f2bf(v[q].z); *(LAS bf16_t*)(p + 3 * SQ) = (bf16_t)f2bf(v[q].w); }
    __syncthreads();
#pragma unroll
    for (int ks = 0; ks < 8; ++ks) { Br[ks] = ldfrag(L + R_WT + j * SQ + (16 * ks + 8 * hh) * 2); Bi[ks] = ldfrag(L + R_WT + 34816 + j * SQ + (16 * ks + 8 * hh) * 2); }
}
constexpr int R_XCB = 0, R_XCF = 17408, R_SUMA = 50176, R_SUMU = 58368, R_HIN = 66560;
DI void rg_chunk_unit(const Ctx& c, int l, int b, int n) {
    LAS unsigned char* L = c.lds;
    const int tid = get_tid(c.wave), lane = tid & 63, w = c.wave, r = lane & 31, hh = lane >> 5;
    const int tb = w >> 2, jb = w & 3;
    const int j = 32 * jb + r, ch = n * 128 + j;
    const int row0 = b * SEQ;
    const bf16_t* P = c.proj;
    LAS float* XCF = (LAS float*)(L + R_XCF); LAS float* SUMA = (LAS float*)(L + R_SUMA); LAS float* SUMU = (LAS float*)(L + R_SUMU); LAS float* HIN = (LAS float*)(L + R_HIN);
    bf16x8 Br[8], Bi[8];
    rg_load_gates(c, l, n, tid, j, hh, Br, Bi);
    const float sp = softplus(-c.in[I_LAM][l * 1024 + ch]), brv = c.in[I_BR][(l * 8 + n) * 128 + j], biv = c.in[I_BI][(l * 8 + n) * 128 + j];
    float cw[4][2], cb[2];
#pragma unroll
    for (int e = 0; e < 2; ++e) {
#pragma unroll
        for (int m = 0; m < 4; ++m) cw[m][e] = c.in[I_RCW][l * 4 * 1024 + m * 1024 + n * 128 + 2 * lane + e];
        cb[e] = c.in[I_RCB][l * 1024 + n * 128 + 2 * lane + e]; }
    float hcarry = 0.f;
    unsigned ux[11]; bf16_t gtr[16];
#define RG_LOAD(tn) do { const bf16_t* pq_ = P + (size_t)(row0 + (tn) + 8 * w) * LDP + C_RGX + n * 128 + 2 * lane; const bool first_ = ((tn) == 0 && w == 0); \
        _Pragma("unroll") for (int jx = 0; jx < 11; ++jx) ux[jx] = (first_ && jx < 3) ? 0u : *(const unsigned*)(pq_ + (ptrdiff_t)(jx - 3) * LDP); \
        const bf16_t* pg_ = P + (size_t)(row0 + (tn) + 32 * tb) * LDP; const int goff_ = 4 * hh * LDP + C_RGG + ch; \
        _Pragma("unroll") for (int i = 0; i < 16; ++i) gtr[i] = (pg_ + (size_t)((i & 3) + 8 * (i >> 2)) * LDP)[goff_]; } while (0)
    RG_LOAD(0);
    for (int ck = -(SEQ / 64) * (PROBE_RG_REP - 1); ck < SEQ / 64; ++ck) {
        if (PROBE_RG_REP > 1 && ck == 0) hcarry = 0.f;
        const int t0 = (ck & (SEQ / 64 - 1)) * 64;
#pragma unroll
        for (int i = 0; i < 8; ++i) { const int t = 8 * w + i;
            const float x0 = cb[0] + cw[0][0] * bflo(ux[i]) + cw[1][0] * bflo(ux[i + 1]) + cw[2][0] * bflo(ux[i + 2]) + cw[3][0] * bflo(ux[i + 3]);
            const float x1 = cb[1] + cw[0][1] * bfhi(ux[i]) + cw[1][1] * bfhi(ux[i + 1]) + cw[2][1] * bfhi(ux[i + 2]) + cw[3][1] * bfhi(ux[i + 3]);
            *(LAS f32x2*)(XCF + t * 128 + 2 * lane) = (f32x2){x0, x1}; *(LAS unsigned*)(L + R_XCB + t * SQ + 4 * lane) = pk2(x0, x1); }
        float gt[16];
#pragma unroll
        for (int i = 0; i < 16; ++i) gt[i] = bf1(gtr[i]);
        lds_barrier();
        if (ck + 1 < SEQ / 64) RG_LOAD(((ck + 1) & (SEQ / 64 - 1)) * 64);
        f32x16 R, I; ZERO16(R); ZERO16(I);
#pragma unroll
        for (int ks = 0; ks < 8; ++ks) { const bf16x8 a = ldfrag(L + R_XCB + (32 * tb + r) * SQ + (16 * ks + 8 * hh) * 2); R = mfma32(a, Br[ks], R); I = mfma32(a, Bi[ks], I); }
        float av[16], uv[16];
#pragma unroll
        for (int i = 0; i < 16; ++i) { const int t = 32 * tb + crow(i, hh); const float xc = XCF[t * 128 + j];
            const float e1 = fexp(fminf(-(R[i] + brv), 40.f)), e2 = fexp(fminf(-(I[i] + biv), 40.f)), p1 = 1.0f + e1, p2 = 1.0f + e2, inv = rcp(p1 * p2);
            const float rr = p2 * inv, ii = p1 * inv;
            const float la = -8.0f * rr * sp, a = fexp(la), x2 = 2.0f * la;
            const float ser = -x2 * (1.0f + 0.5f * x2 * (1.0f + 0.33333334f * x2 * (1.0f + 0.25f * x2 * (1.0f + 0.2f * x2))));
            const float om = fabsf(x2) < 0.25f ? ser : 1.0f - a * a;
            av[i] = a; uv[i] = __builtin_amdgcn_sqrtf(fmaxf(om, 0.f)) * (ii * xc); }
#pragma unroll
        for (int g = 0; g < 4; ++g) { float A = 1.f, U = 0.f;
#pragma unroll
            for (int m = 0; m < 4; ++m) { U = av[4 * g + m] * U + uv[4 * g + m]; A *= av[4 * g + m]; }
            const int gi = 8 * tb + 2 * g + hh; SUMA[gi * 128 + j] = A; SUMU[gi * 128 + j] = U; }
        lds_barrier();
        if (tid < 128) { float hc = hcarry, sa[16], su[16];
#pragma unroll
            for (int gi = 0; gi < 16; ++gi) { sa[gi] = SUMA[gi * 128 + tid]; su[gi] = SUMU[gi * 128 + tid]; }
#pragma unroll
            for (int gi = 0; gi < 16; ++gi) { HIN[gi * 128 + tid] = hc; hc = sa[gi] * hc + su[gi]; }
            hcarry = hc; }
        lds_barrier();
        { bf16_t* pm = c.mix + (size_t)(row0 + t0 + 32 * tb) * D_MIX; const int moff = 4 * hh * D_MIX + 1024 + ch;
#pragma unroll
          for (int g = 0; g < 4; ++g) { float hc = HIN[(8 * tb + 2 * g + hh) * 128 + j];
#pragma unroll
            for (int m = 0; m < 4; ++m) { const int i = 4 * g + m; hc = av[i] * hc + uv[i];
                (pm + (size_t)((i & 3) + 8 * (i >> 2)) * D_MIX)[moff] = (bf16_t)f2bf(hc * gt[i]); } } }
    }
#undef RG_LOAD
    if (tid < 128) c.out[O_RG_P + ((size_t)l * NB + b) * 1024 + n * 128 + tid] = hcarry;
    if (w == 7) {
#pragma unroll
        for (int jx = 0; jx < 3; ++jx) *(f32x2*)(c.out + O_RGC_P + ((size_t)l * NB + b) * 3072 + jx * 1024 + n * 128 + 2 * lane) = (f32x2){bflo(ux[8 + jx]), bfhi(ux[8 + jx])}; }
}

DI void rg_sample_unit(const Ctx& c, int l, int n) {
    LAS unsigned char* L = c.lds;
    const int tid = get_tid(c.wave), lane = tid & 63, w = c.wave, r = lane & 31, hh = lane >> 5;
    const int tb = w >> 2, jb = w & 3;
    const int j = 32 * jb + r, ch = n * 128 + j;
    LAS float* XCF = (LAS float*)(L + R_XCF);
    bf16x8 Br[8], Bi[8];
    rg_load_gates(c, l, n, tid, j, hh, Br, Bi);
    const float sp = softplus(-c.in[I_LAM][l * 1024 + ch]), brv = c.in[I_BR][(l * 8 + n) * 128 + j], biv = c.in[I_BI][(l * 8 + n) * 128 + j];
    float cw[4][2], cb[2];
#pragma unroll
    for (int e = 0; e < 2; ++e) {
#pragma unroll
        for (int m = 0; m < 4; ++m) cw[m][e] = c.in[I_RCW][l * 4 * 1024 + m * 1024 + n * 128 + 2 * lane + e];
        cb[e] = c.in[I_RCB][l * 1024 + n * 128 + 2 * lane + e]; }
    for (int chunk = 0; chunk < 2; ++chunk) {
        __syncthreads();
        f32x2 cb0[8], cb1[8], cb2[8], cxn[8];
#pragma unroll
        for (int i = 0; i < 8; ++i) { const int s = 64 * chunk + 8 * w + i;
            const float* buf = c.in[I_SRGC] + ((size_t)l * DEC + s) * 3 * 1024 + n * 128 + 2 * lane;
            cb0[i] = *(const f32x2*)buf; cb1[i] = *(const f32x2*)(buf + 1024); cb2[i] = *(const f32x2*)(buf + 2048);
            cxn[i] = (f32x2){ps4(c.projs + (size_t)s * LDP + C_RGX + n * 128 + 2 * lane), ps4(c.projs + (size_t)s * LDP + C_RGX + n * 128 + 2 * lane + 1)} * row_rstd(c.rowsq + (size_t)l * M_PAD, TP + s); }
#pragma unroll
        for (int i = 0; i < 8; ++i) { const int t = 8 * w + i, s = 64 * chunk + t;
            const f32x2 b0 = cb0[i], b1 = cb1[i], b2 = cb2[i], xn = cxn[i];
            const float x0 = cb[0] + cw[0][0] * b0.x + cw[1][0] * b1.x + cw[2][0] * b2.x + cw[3][0] * xn.x;
            const float x1 = cb[1] + cw[0][1] * b0.y + cw[1][1] * b1.y + cw[2][1] * b2.y + cw[3][1] * xn.y;
            *(LAS f32x2*)(XCF + t * 128 + 2 * lane) = (f32x2){x0, x1}; *(LAS unsigned*)(L + R_XCB + t * SQ + 4 * lane) = pk2(x0, x1);
            float* nb = c.out + O_RGC_S + ((size_t)l * DEC + s) * 3072 + n * 128 + 2 * lane;
            *(f32x2*)nb = b1; *(f32x2*)(nb + 1024) = b2; *(f32x2*)(nb + 2048) = xn; }
        __syncthreads();
        f32x16 R, I; ZERO16(R); ZERO16(I);
#pragma unroll
        for (int ks = 0; ks < 8; ++ks) { const bf16x8 a = ldfrag(L + R_XCB + (32 * tb + r) * SQ + (16 * ks + 8 * hh) * 2); R = mfma32(a, Br[ks], R); I = mfma32(a, Bi[ks], I); }
#pragma unroll
        for (int i = 0; i < 16; ++i) { const int t = 32 * tb + crow(i, hh), s = 64 * chunk + t;
            const float rr = sigm(R[i] + brv), ii = sigm(I[i] + biv), xc = XCF[t * 128 + j];
            const float la = -8.0f * rr * sp, a = fexp(la);
            const float hn = a * c.in[I_SRG][((size_t)l * DEC + s) * 1024 + ch] + sqrtf(fmaxf(neg_expm1(2.0f * la), 0.f)) * (ii * xc);
            c.mix[(size_t)(TP + s) * D_MIX + 1024 + ch] = (bf16_t)f2bf(hn * silu(ps4(c.projs + (size_t)s * LDP + C_RGG + ch) * row_rstd(c.rowsq + (size_t)l * M_PAD, TP + s)));
            c.out[O_RG_S + ((size_t)l * DEC + s) * 1024 + ch] = hn; }
    }
}

#ifndef PROBE_REP_LONG
#define PROBE_REP_LONG 1
#endif
#ifndef PROBE_G1_REP
#define PROBE_G1_REP 1
#endif
#ifndef PROBE_REP_SHORT
#define PROBE_REP_SHORT 1
#endif
DI void xbc_prepass_item(const Ctx& c, int l, int it) {
    const int tid = get_tid(c.wave);
    const float* scw = c.in[I_SCW] + (size_t)l * 4 * 1536; const float* scb = c.in[I_SCB] + (size_t)l * 1536;
    const int r0 = ((it & 7) >> 1) * SEQ + (it >> 3) * 64 + (it & 1) * 32;
    const bool head = (r0 & (SEQ - 1)) == 0;
    for (int p = tid; p < 768; p += 512) {
        float cw[4][2], cb[2];
#pragma unroll
        for (int e = 0; e < 2; ++e) { cb[e] = scb[2 * p + e];
#pragma unroll
            for (int m = 0; m < 4; ++m) cw[m][e] = scw[m * 1536 + 2 * p + e]; }
        const bf16_t* src = c.proj + (size_t)r0 * LDP + C_XBC + 2 * p; bf16_t* dst = c.xbcs + (size_t)r0 * 1536 + 2 * p;
        unsigned u[35];
#pragma unroll
        for (int i = 0; i < 35; ++i) u[i] = (head && i < 3) ? 0u : *(const unsigned*)(src + (ptrdiff_t)(i - 3) * LDP);
#pragma unroll
        for (int i = 0; i < 32; ++i) {
            const float a = silu(cb[0] + cw[0][0] * bflo(u[i]) + cw[1][0] * bflo(u[i + 1]) + cw[2][0] * bflo(u[i + 2]) + cw[3][0] * bflo(u[i + 3]));
            const float b = silu(cb[1] + cw[0][1] * bfhi(u[i]) + cw[1][1] * bfhi(u[i + 1]) + cw[2][1] * bfhi(u[i + 2]) + cw[3][1] * bfhi(u[i + 3]));
            __hip_atomic_store((unsigned*)(dst + (size_t)i * 1536), pk2(a, b), __ATOMIC_RELAXED, __HIP_MEMORY_SCOPE_AGENT); }
        if (((r0 + 32) & (SEQ - 1)) == 0) {
#pragma unroll
            for (int jx = 0; jx < 3; ++jx) *(f32x2*)(c.out + O_SSDC_P + ((size_t)l * NB + r0 / SEQ) * 4608 + jx * 1536 + 2 * p) = (f32x2){bflo(u[32 + jx]), bfhi(u[32 + jx])}; }
    }
}
DI void phase_mixer(int l, int wv) {
    const Ctx c = make_ctx(wv);
    constexpr int PER_B = 8 + 8 + 8 + 8;
    constexpr int N_LONG = NB * PER_B, N_SHORT = 8 + DEC * 3;
    constexpr int NREP = 1;
    volatile LAS int* slot = (volatile LAS int*)(c.lds + MISC_OFF + 64);
    unsigned* xpre = c.ctl + CW_XPRE + 128 * l;
    if (c.wg >= N_LONG || c.G <= N_LONG) {
        const int nfree = c.G > N_LONG ? c.G - N_LONG : c.G, first = c.G > N_LONG ? c.wg - N_LONG : c.wg;
        for (int it = first; it < TP / 32; it += nfree) {
            xbc_prepass_item(c, l, it);
            asm volatile("s_waitcnt vmcnt(0)" ::: "memory"); __syncthreads();
            if (c.tid == 0) __hip_atomic_fetch_add(xpre + (it < 128 ? 0 : 64), 1u, __ATOMIC_RELAXED, __HIP_MEMORY_SCOPE_AGENT);
        }
    }
    for (int rep = 0; rep < NREP; ++rep) {
    unsigned* ctr = c.ctl + CW_QCTR + 64 * (l * 4 + rep);
    int cur = c.wg; bool dyn = false;
    for (;;) {
        int item;
        if (!dyn) { if (cur < N_LONG) { item = cur; cur += c.G; } else { dyn = true; continue; } }
        else {
            __syncthreads();
            if (c.tid == 0) *slot = (int)atomicAdd(ctr, 1u);
            __syncthreads();
            item = N_LONG + *slot;
            if (item >= N_LONG + N_SHORT) break;
        }
        if (item < N_LONG) {
            const int b = item & 3, u = item >> 2;
            if (u < 8) la_head_unit<1>(c, l, b, u); else if (u < 16) la_head_unit<0>(c, l, b, u - 8); else if (u < 24) {
                if (c.tid == 0) { unsigned sp = 0; while (__hip_atomic_load(xpre, __ATOMIC_RELAXED, __HIP_MEMORY_SCOPE_AGENT) < 128u) { __builtin_amdgcn_s_sleep(8); if (++sp > (1u << 22)) break; }
                    __builtin_amdgcn_fence(__ATOMIC_ACQUIRE, "agent"); asm volatile("s_waitcnt vmcnt(0)" ::: "memory"); }
                __syncthreads();
                la_head_unit<2>(c, l, b, u - 16); } else rg_chunk_unit(c, l, b, u - 24);
            __syncthreads();
        } else { const int it = item - N_LONG;
            for (int rp = 0; rp < PROBE_REP_SHORT; ++rp) { if (it < 8) rg_sample_unit(c, l, it); else sample_item(c, l, (it - 8) / 3, (it - 8) % 3); } }
    }
    __syncthreads();
    }
}

DI void phase_dt(const Ctx& c, int l) {
    LAS float* PT = (LAS float*)c.lds;
    const int tid = get_tid(c.wave), lane = tid & 63, w = c.wave, r = lane & 31, hh = lane >> 5;
    for (int rt = c.wg; rt < TP / 32; rt += c.G) {
        const bf16_t* pa = c.xb + (size_t)(rt * 32 + r) * D_MODEL + w * 256 + 8 * hh;
        const bf16_t* pb = c.win + ((size_t)l * LDP + C_DT + r) * D_MODEL + w * 256 + 8 * hh;
        f32x16 acc; ZERO16(acc);
#pragma unroll
        for (int k4 = 0; k4 < 16; k4 += 8) { bf16x8 fa[8], fb[8];
#pragma unroll
            for (int u = 0; u < 8; ++u) { fa[u] = *(const bf16x8*)(pa + 16 * (k4 + u)); fb[u] = *(const bf16x8*)(pb + 16 * (k4 + u)); }
#pragma unroll
            for (int u = 0; u < 8; ++u) acc = mfma32(fa[u], fb[u], acc); }
        __syncthreads();
#pragma unroll
        for (int i = 0; i < 16; ++i) PT[w * 1024 + crow(i, hh) * 32 + r] = acc[i];
        __syncthreads();
        { const int row = tid >> 4, col = tid & 15; float s = 0.f;
#pragma unroll
          for (int q = 0; q < 8; ++q) s += PT[q * 1024 + row * 32 + col];
          c.dtb[(size_t)(rt * 32 + row) * 16 + col] = softplus(s * row_rstd(c.rowsq + (size_t)l * M_PAD, rt * 32 + row) + c.in[I_DTB][l * 16 + col]); }
    }
}

DI void g2_sample(const Ctx& c, int l) {
    LAS float* PT = (LAS float*)c.lds;
    const int tid = get_tid(c.wave), lane = tid & 63, w = c.wave, rr = lane & 15, quad = lane >> 4;
    float* rsq_next = c.rowsq + (size_t)(l + 1) * M_PAD;
    for (int it = c.wg; it < 4 * (D_MODEL / 32); it += c.G) {
        const int rb = it & 3, ct = it >> 2;
        const bf16_t* pa = c.mix + (size_t)(TP + 32 * rb + rr) * D_MIX + 512 * w + 8 * quad;
        const bf16_t* pb = c.wout + (size_t)l * D_MODEL * D_MIX + (size_t)(32 * ct + rr) * D_MIX + 512 * w + 8 * quad;
        f32x4 acc[2][2];
#pragma unroll
        for (int rt = 0; rt < 2; ++rt) { acc[rt][0] = (f32x4){0.f, 0.f, 0.f, 0.f}; acc[rt][1] = acc[rt][0]; }
        bf16x8 fa0[4][2], fb0[4][2], fa1[4][2], fb1[4][2];
#define G2S_LOAD(FA, FB, k4) do { _Pragma("unroll") for (int u = 0; u < 4; ++u) _Pragma("unroll") for (int t = 0; t < 2; ++t) { \
            FA[u][t] = *(const bf16x8*)(pa + (size_t)16 * t * D_MIX + 32 * ((k4) + u)); FB[u][t] = *(const bf16x8*)(pb + (size_t)16 * t * D_MIX + 32 * ((k4) + u)); } } while (0)
#define G2S_MMA(FA, FB) do { _Pragma("unroll") for (int u = 0; u < 4; ++u) _Pragma("unroll") for (int rt = 0; rt < 2; ++rt) _Pragma("unroll") for (int nt = 0; nt < 2; ++nt) \
            acc[rt][nt] = __builtin_amdgcn_mfma_f32_16x16x32_bf16(FA[u][rt], FB[u][nt], acc[rt][nt], 0, 0, 0); } while (0)
        G2S_LOAD(fa0, fb0, 0);
        G2S_LOAD(fa1, fb1, 4);
        G2S_MMA(fa0, fb0);
        G2S_LOAD(fa0, fb0, 8);
        G2S_MMA(fa1, fb1);
        G2S_LOAD(fa1, fb1, 12);
        G2S_MMA(fa0, fb0);
        G2S_MMA(fa1, fb1);
#undef G2S_LOAD
#undef G2S_MMA
        __syncthreads();
#pragma unroll
        for (int rt = 0; rt < 2; ++rt)
#pragma unroll
            for (int nt = 0; nt < 2; ++nt)
#pragma unroll
                for (int j = 0; j < 4; ++j) PT[(w * 32 + 16 * rt + 4 * quad + j) * 32 + 16 * nt + rr] = acc[rt][nt][j];
        __syncthreads();
        { const int row = tid >> 4, c2 = 2 * (tid & 15); float x0 = 0.f, x1 = 0.f;
#pragma unroll
          for (int q = 0; q < 8; ++q) { const f32x2 t = *(const LAS f32x2*)(PT + (q * 32 + row) * 32 + c2); x0 += t.x; x1 += t.y; }
          unsigned* xp = (unsigned*)(c.xb + (size_t)(TP + 32 * rb + row) * D_MODEL + 32 * ct + c2); const unsigned o = *xp;
          x0 += bflo(o); x1 += bfhi(o); *xp = pk2(x0, x1);
          float ss = x0 * x0 + x1 * x1; ss += shx(ss, 1, lane); ss += shx(ss, 2, lane); ss += shx(ss, 4, lane); ss += shx(ss, 8, lane);
          if ((tid & 15) == 0) atomicAdd(rsq_next + TP + 32 * rb + row, ss); }
    }
}

__global__ void __launch_bounds__(512, 2) mk_fwd(Params p) {
    extern __shared__ __attribute__((aligned(16))) unsigned char lds_raw[];
    LAS unsigned char* lds = (LAS unsigned char*)lds_raw;
    volatile LAS unsigned* misc = (volatile LAS unsigned*)(lds + MISC_OFF);
    const int wv = __builtin_amdgcn_readfirstlane(threadIdx.x >> 6);
    if (threadIdx.x < 32) misc[threadIdx.x] = 0u;
    __syncthreads();
    const int lo = p.ph_lo, hi = p.ph_hi;
    unsigned* barw = (unsigned*)(p.ws + WS_CTL) + CW_BAR;
    XcdBarrier bar; bar.bar = barw; bar.x = 0; bar.st = misc;
    if (hi - lo > 1) bar = xcd_barrier_post(barw, misc, get_tid(wv));
#define PH_IN(k) (lo <= (k) && (k) < hi)
#define SEAM(k) do { if (PH_IN(k) && PH_IN((k) + 1)) xcd_barrier(bar, wv); } while (0)
    if (PH_IN(0)) { phase_prologue(wv); }
    SEAM(0);
    for (int l = 0; l < DEPTH; ++l) {
        const int pb = 1 + 3 * l;
        if (PH_IN(pb)) {
            __syncthreads();
            const Ctx c = make_ctx(wv);
            {
                pg8::Gemm g{c.xb, c.win + (size_t)l * LDP * D_MODEL, TP, N_MAIN, D_MODEL, D_MODEL, D_MODEL}; pg8::StaticOrder S; S.init(TP, N_MAIN, c.G, c.wg); S.rep = PROBE_G1; S.balance = 1;
                pg8::EpiProj E{c.proj, c.lb + (size_t)l * 1024, c.in[I_HGN] + (size_t)l * 1024, c.in[I_GLN] + (size_t)l * 1024, c.in[I_GBU] + (size_t)l * 512, c.rowsq + (size_t)l * M_PAD};
                pg8::gemm_phase<pg8::EpiProj, pg8::StaticOrder>(c.lds, g, S, E, wv); }
            __syncthreads();
            {
                const int pn = c.wg % 49, ks = c.wg / 49;
                pg8::Gemm g{c.xb + (size_t)TP * D_MODEL + ks * 512, c.win + (size_t)l * LDP * D_MODEL + ks * 512, 256, LDP, 512, D_MODEL, D_MODEL};
                pg8::OneUnit S{0, pn, c.wg < 196 ? 1 : 0};
                pg8::EpiSample E{c.projs + (size_t)ks * PST};
                pg8::gemm_phase<pg8::EpiSample, pg8::OneUnit>(c.lds, g, S, E, wv); }
            __syncthreads();
            phase_dt(c, l);
            __syncthreads();
        }
        SEAM(pb);
        if (PH_IN(pb + 1)) phase_mixer(l, wv);
        SEAM(pb + 1);
        if (PH_IN(pb + 2)) {
            __syncthreads();
            const Ctx c = make_ctx(wv);
            {
                pg8::Gemm g{c.mix, c.wout + (size_t)l * D_MODEL * D_MIX, TP, D_MODEL, D_MIX, D_MIX, D_MIX}; pg8::StaticOrder S; S.init(TP, D_MODEL, c.G, c.wg);
                LAS float* tab = (LAS float*)(c.lds + pg8::STAGE_BYTES);
                pg8::EpiResid E{c.xb, c.rowsq + (size_t)(l + 1) * M_PAD, tab};
                const float* stats = (const float*)(c.ctl + CW_STATS) + (size_t)l * TP * 6;
                for (int i = 0; ; ++i) { pg8::Unit u; if (!S.next(i, u)) break;
                    __syncthreads();
                    { const int tid = get_tid(wv);
                      if (tid < 256) { const float* st = stats + (size_t)(u.pm * 256 + tid) * 6;
                        const f32x2 sa = *(const f32x2*)st, sb = *(const f32x2*)(st + 2), sc = *(const f32x2*)(st + 4);
                        const float d0 = __builtin_amdgcn_rsqf(sa.x * (1.0f / 512.0f) + EPS), d1 = __builtin_amdgcn_rsqf(sa.y * (1.0f / 512.0f) + EPS);
                        const float g0 = __builtin_amdgcn_rsqf(sb.x * (1.0f / 256.0f) + EPS), g1 = __builtin_amdgcn_rsqf(sb.y * (1.0f / 256.0f) + EPS), g2 = __builtin_amdgcn_rsqf(sc.x * (1.0f / 256.0f) + EPS), g3 = __builtin_amdgcn_rsqf(sc.y * (1.0f / 256.0f) + EPS);
                        tab[tid] = rcp(g0); tab[256 + tid] = g0 * rcp(g1); tab[512 + tid] = g1 * rcp(g2); tab[768 + tid] = g2 * rcp(g3); tab[1024 + tid] = g3 * rcp(d0); tab[1280 + tid] = d0 * rcp(d1); tab[1536 + tid] = d1; } }
                    __syncthreads();
                    pg8::OneUnit O{u.pm, u.pn, 1};
                    pg8::gemm_phase<pg8::EpiResid, pg8::OneUnit>(c.lds, g, O, E, wv); }
            }
            __syncthreads();
            g2_sample(c, l);
        }
        SEAM(pb + 2);
    }
    if (PH_IN(NPHASE - 1)) phase_final_norm(wv);
#undef PH_IN
#undef SEAM
}

extern "C" void kernel_launch(void* const* d_in, const int* in_sizes, int n_in, void* d_out, int out_size, void* d_ws, size_t ws_size, hipStream_t stream) {
    static int grid = 0;
    if (grid == 0) {
        if (n_in != N_INPUTS || (size_t)out_size != O_END || ws_size < WS_END) { fprintf(stderr, "kernel_launch: unexpected shapes (n_in %d out %d ws %zu)\n", n_in, out_size, ws_size); grid = -1; return; }
        int dev = 0, cus = 0;
        if (hipGetDevice(&dev) != hipSuccess || hipDeviceGetAttribute(&cus, hipDeviceAttributeMultiprocessorCount, dev) != hipSuccess) { grid = -1; return; }
        if (hipFuncSetAttribute((const void*)mk_fwd, hipFuncAttributeMaxDynamicSharedMemorySize, LDS_BYTES) != hipSuccess) { fprintf(stderr, "kernel_launch: hipFuncSetAttribute failed\n"); grid = -1; return; }
        int per_cu = 0;
        if (hipOccupancyMaxActiveBlocksPerMultiprocessor(&per_cu, (const void*)mk_fwd, 512, LDS_BYTES) != hipSuccess || per_cu < 1) fprintf(stderr, "kernel_launch: occupancy query says %d\n", per_cu);
        (void)hipGetLastError();
        grid = cus;
    }
    if (grid < 0) return;
    (void)hipMemsetAsync((char*)d_ws + WS_CTL, 0, CTL_ZERO_BYTES, stream);
    Params p{};
    for (int i = 0; i < N_INPUTS; ++i) p.in[i] = (const float*)d_in[i];
    p.out = (float*)d_out; p.ws = (unsigned char*)d_ws;
#if MK_ONE_LAUNCH
    p.ph_lo = 0; p.ph_hi = NPHASE;
    hipLaunchKernelGGL(mk_fwd, dim3(grid), dim3(512), LDS_BYTES, stream, p);
#else
    for (int ph = 0; ph < NPHASE; ++ph) { p.ph_lo = ph; p.ph_hi = ph + 1; hipLaunchKernelGGL(mk_fwd, dim3(grid), dim3(512), LDS_BYTES, stream, p); }
#endif
}
```

```cpp
#include <hip/hip_runtime.h>
#include <cstdio>
#include <cstdint>

#ifndef MK_ONE_LAUNCH
#define MK_ONE_LAUNCH 1
#endif

#ifndef PROBE_LONG_REP
#define PROBE_LONG_REP 1
#endif
#ifndef PROBE_RG_REP
#define PROBE_RG_REP PROBE_LONG_REP
#endif
#ifndef PROBE_G1_NOEPI
#define PROBE_G1_NOEPI 0
#endif
#ifndef PROBE_G2
#define PROBE_G2 0
#endif
#ifndef PROBE_G1
#define PROBE_G1 1
#endif
#define LAS __attribute__((address_space(3)))
#define DI __device__ __forceinline__

constexpr int D_MODEL = 2048, NB = 4, SEQ = 2048, DEPTH = 4, DEC = 128;
constexpr int BRANCH = 1024, D_MIX = 4096;
constexpr int TP = NB * SEQ;
constexpr int TT = TP + DEC;
constexpr int M_PAD = 8448;
constexpr int N_IN = 11808;
constexpr int LDP = 12544;
constexpr int N_MAIN = 12288;
constexpr int PST = 128 * LDP;
constexpr float EPS = 1e-6f, TINY = 1e-30f;
constexpr int C_HGQ = 0, C_HGF = 1024, C_HGI = 2048, C_HGG = 3072, C_RGX = 4096, C_RGG = 5120, C_GLQ = 6144, C_GLK = 6656, C_GLV = 7168, C_GLG = 8192,
              C_GLF = 9216, C_SSZ = 9728, C_XBC = 10752, C_DT = 12288;
constexpr int SRC_GLA = 9216, SRC_SSZ = 9232, SRC_DT = 11792;
enum { I_XP = 0, I_XS, I_SHG, I_SRG, I_SRGC, I_SGLA, I_SSSD, I_SSSDC, I_RMS, I_WIN, I_LB, I_HGN, I_RCW, I_RCB, I_WR, I_BR, I_WI, I_BI, I_LAM,
       I_GWU, I_GBU, I_GLN, I_SCW, I_SCB, I_DTB, I_ALOG, I_SD, I_SSN, I_WOUT, I_RMSF, N_INPUTS };
constexpr size_t O_YP = 0, O_YS = (size_t)TP * D_MODEL, O_HG_P = O_YS + (size_t)DEC * D_MODEL,
    O_RG_P = O_HG_P + (size_t)DEPTH * NB * 131072, O_RGC_P = O_RG_P + (size_t)DEPTH * NB * 1024, O_GLA_P = O_RGC_P + (size_t)DEPTH * NB * 3072,
    O_SSD_P = O_GLA_P + (size_t)DEPTH * NB * 131072, O_SSDC_P = O_SSD_P + (size_t)DEPTH * NB * 131072, O_HG_S = O_SSDC_P + (size_t)DEPTH * NB * 4608,
    O_RG_S = O_HG_S + (size_t)DEPTH * DEC * 131072, O_RGC_S = O_RG_S + (size_t)DEPTH * DEC * 1024, O_GLA_S = O_RGC_S + (size_t)DEPTH * DEC * 3072,
    O_SSD_S = O_GLA_S + (size_t)DEPTH * DEC * 131072, O_SSDC_S = O_SSD_S + (size_t)DEPTH * DEC * 131072, O_END = O_SSDC_S + (size_t)DEPTH * DEC * 4608;
constexpr size_t MiB = 1u << 20;
constexpr size_t WS_CTL = 0, CTL_ZERO_BYTES = 2 * MiB, WS_LB = 2 * MiB, WS_WIN = 3 * MiB, WS_WOUT = 199 * MiB, WS_XB = 263 * MiB, WS_PROJ = 296 * MiB,
    WS_DTB = 492 * MiB, WS_MIX = 493 * MiB, WS_PROJS = 559 * MiB, WS_XBCS = 584 * MiB, WS_END = 608 * MiB;
static_assert(WS_WIN + (size_t)DEPTH * LDP * D_MODEL * 2 <= WS_WOUT && WS_WOUT + (size_t)DEPTH * D_MODEL * D_MIX * 2 <= WS_XB && WS_XB + (size_t)M_PAD * D_MODEL * 2 <= WS_PROJ &&
              WS_PROJ + (size_t)TP * LDP * 2 <= WS_DTB && WS_DTB + (size_t)TP * 16 * 4 <= WS_MIX &&
              WS_MIX + (size_t)M_PAD * D_MIX * 2 <= WS_PROJS && WS_PROJS + (size_t)4 * DEC * LDP * 4 <= WS_XBCS && WS_XBCS + (size_t)TP * 1536 * 2 <= WS_END, "ws map");
constexpr int CW_BAR = 4096, CW_QCTR = 16384, CW_XPRE = 24576  , CW_STATS = 32768, CW_ROWSQ = 262144;
static_assert(CW_STATS + DEPTH * TP * 6 <= CW_ROWSQ && (size_t)(CW_ROWSQ + (DEPTH + 1) * M_PAD) * 4 <= CTL_ZERO_BYTES, "ctl map");
constexpr int LDS_BYTES = 147456, MISC_OFF = LDS_BYTES - 256;
constexpr int NPHASE = 2 + 3 * DEPTH;

typedef unsigned short bf16_t;
typedef short bf16x8 __attribute__((ext_vector_type(8)));
typedef float f32x4 __attribute__((ext_vector_type(4)));
typedef float f32x2 __attribute__((ext_vector_type(2)));
typedef float f32x16 __attribute__((ext_vector_type(16)));
typedef unsigned u32x4 __attribute__((ext_vector_type(4)));
typedef unsigned u32x2 __attribute__((ext_vector_type(2)));
typedef __bf16 bf16v2 __attribute__((ext_vector_type(2)));

DI unsigned pk2(float lo, float hi) { const f32x2 v = {lo, hi}; return __builtin_bit_cast(unsigned, __builtin_convertvector(v, bf16v2)); }
DI unsigned f2bf(float f) { return pk2(f, 0.f) & 0xffffu; }
DI float bflo(unsigned u) { return __builtin_bit_cast(float, u << 16); }
DI float bfhi(unsigned u) { return __builtin_bit_cast(float, u & 0xffff0000u); }
DI float bf1(bf16_t u) { return __builtin_bit_cast(float, (unsigned)u << 16); }
DI float ex2(float x) { return __builtin_amdgcn_exp2f(x); }
DI float lg2(float x) { return __builtin_amdgcn_logf(x); }
DI float rcp(float x) { return __builtin_amdgcn_rcpf(x); }
constexpr float LOG2E = 1.4426950408889634f, LN2 = 0.6931471805599453f;
DI float fexp(float x) { return ex2(x * LOG2E); }
DI float flog(float x) { return lg2(x) * LN2; }
DI float sigm(float x) { return rcp(1.0f + fexp(-x)); }
DI float silu(float x) { return x * sigm(x); }
DI float sigm_fast(float x) { return sigm(x); }
DI float silu_fast(float x) { return silu(x); }
DI float log1p_pos(float e) { const float a = e * (1.0f - e * (0.5f - e * (0.33333334f - 0.25f * e))), b = flog(1.0f + e); return e < 0.03f ? a : b; }
DI float softplus(float x) { return fmaxf(x, 0.f) + log1p_pos(fexp(-fabsf(x))); }
DI float neg_expm1(float x) { const float a = -x * (1.0f + 0.5f * x * (1.0f + 0.33333334f * x * (1.0f + 0.25f * x * (1.0f + 0.2f * x)))), b = 1.0f - fexp(x); return fabsf(x) < 0.25f ? a : b; }
DI float row_rstd(const float* rowsq, int row) { return __builtin_amdgcn_rsqf(rowsq[row] * (1.0f / D_MODEL) + EPS); }
DI float clampf(float x, float lo, float hi) { return fminf(fmaxf(x, lo), hi); }
DI float shx(float v, int mask, int lane) { return __builtin_bit_cast(float, __builtin_amdgcn_ds_bpermute((lane ^ mask) << 2, __builtin_bit_cast(int, v))); }
DI float shup(float v, int o, int lane) { return __builtin_bit_cast(float, __builtin_amdgcn_ds_bpermute((lane >= o ? lane - o : lane) << 2, __builtin_bit_cast(int, v))); }
DI float wave_sum(float v, int lane) {
#pragma unroll
    for (int o = 1; o < 64; o <<= 1) v += shx(v, o, lane);
    return v;
}

struct Params { const float* in[N_INPUTS]; float* out; unsigned char* ws; int ph_lo, ph_hi; };
static_assert(sizeof(Params) == N_INPUTS * 8 + 8 + 8 + 8, "no padding holes in Params");
typedef const __attribute__((address_space(4))) Params* KP;
DI KP get_params() { auto kp = __builtin_amdgcn_kernarg_segment_ptr(); asm volatile("" : "+s"(kp)); return (KP)kp; }
DI int get_tid(int wv) { int ln; asm volatile("v_mbcnt_lo_u32_b32 %0, -1, 0\n\tv_mbcnt_hi_u32_b32 %0, -1, %0" : "=v"(ln)); return (wv << 6) | ln; }

#define XB_TMO      128
#define XB_XCNT(j)  (256  + 64 * (j))
#define XB_XSUB(j)  (1280 + 64 * (j))
#define XB_XGEN(j)  (2304 + 64 * (j))
#define XB_TOP      3328
#define XB_TOPGEN   3392
#define XCD_BAR_WORDS 3456
#define XB_SPIN_CAP (1u << 20)
DI unsigned xb_ld(unsigned* p)              { return __hip_atomic_load(p, __ATOMIC_RELAXED, __HIP_MEMORY_SCOPE_AGENT); }
DI unsigned xb_add(unsigned* p, unsigned v) { return __hip_atomic_fetch_add(p, v, __ATOMIC_RELAXED, __HIP_MEMORY_SCOPE_AGENT); }
DI unsigned xb_xcc_id() { return (unsigned)__builtin_amdgcn_s_getreg((3 << 11) | 20) & 0xFu; }
#define XB_SPIN(cond, bar) do { unsigned _sp = 0; while (cond) { __builtin_amdgcn_s_sleep(1); \
    if ((++_sp & 255u) == 0u) { if (xb_ld(&(bar)[XB_TMO])) break; if (_sp > XB_SPIN_CAP) { atomicAdd(&(bar)[XB_TMO], 1u); break; } } } } while (0)
struct XcdBarrier { unsigned* bar; unsigned x; volatile LAS unsigned* st; };
DI XcdBarrier xcd_barrier_post(unsigned* bar, volatile LAS unsigned* st, int tid) {
    XcdBarrier b; b.bar = bar; b.x = xb_xcc_id(); b.st = st;
    if (tid == 0) (void)xb_add(&bar[XB_XCNT(b.x)], 1u);
    return b;
}
DI void xcd_barrier_complete(unsigned* bar, unsigned x, unsigned& nloc, unsigned& nx) {
    const unsigned G = gridDim.x * gridDim.y * gridDim.z;
    unsigned sum, cnt, mine, sp = 0u;
    for (;;) {
        sum = 0u; cnt = 0u; mine = 0u;
#pragma unroll
        for (unsigned j = 0; j < 16; ++j) { const unsigned c = xb_ld(&bar[XB_XCNT(j)]); sum += c; cnt += (c > 0u) ? 1u : 0u; mine = (j == x) ? c : mine; }
        if (sum == G) break;
        __builtin_amdgcn_s_sleep(1);
        if ((++sp & 255u) == 0u) { if (xb_ld(&bar[XB_TMO])) break; if (sp > XB_SPIN_CAP) { atomicAdd(&bar[XB_TMO], 1u); break; } }
    }
    nloc = mine > 0u ? mine : 1u; nx = cnt > 0u ? cnt : 1u;
}
DI void xcd_barrier(const XcdBarrier& b, int wv) {
    asm volatile("s_waitcnt vmcnt(0)" ::: "memory");
    __syncthreads();
    if (get_tid(wv) == 0) {
        unsigned* bar = b.bar;
        __builtin_amdgcn_s_waitcnt(0);
        unsigned nloc = b.st[0], nx = b.st[1];
        if (nloc == 0u) { xcd_barrier_complete(bar, b.x, nloc, nx); b.st[0] = nloc; b.st[1] = nx; }
        const unsigned old = xb_add(&bar[XB_XSUB(b.x)], 1u);
        const unsigned gen = old / nloc;
        if (old + 1u == (gen + 1u) * nloc) {
            __builtin_amdgcn_fence(__ATOMIC_RELEASE, "agent");
            asm volatile("s_waitcnt vmcnt(0)" ::: "memory");
            const unsigned og = xb_add(&bar[XB_TOP], 1u);
            const unsigned tg = og / nx;
            if (og + 1u == (tg + 1u) * nx) xb_add(&bar[XB_TOPGEN], 1u);
            else XB_SPIN(xb_ld(&bar[XB_TOPGEN]) == tg, bar);
            __builtin_amdgcn_fence(__ATOMIC_ACQUIRE, "agent");
            xb_add(&bar[XB_XGEN(b.x)], 1u);
            asm volatile("s_waitcnt vmcnt(0)" ::: "memory");
        } else {
            XB_SPIN(xb_ld(&bar[XB_XGEN(b.x)]) == gen, bar);
            __builtin_amdgcn_fence(__ATOMIC_ACQUIRE, "agent");
            asm volatile("s_waitcnt vmcnt(0)" ::: "memory");
        }
    }
    __syncthreads();
}

namespace pg8 {
constexpr int BM = 256, BK = 64, HALF = 128, HTB = HALF * BK * 2, STAGE_BYTES = 8 * HTB, NXCD = 8, WGM = 8;
DI int lds_byte(int r, int c) { const int st = (r >> 4) * 2 + (c >> 5), rr = r & 15, cc = c & 31, ob = rr * 64 + cc * 2; return st * 1024 + (ob ^ (((ob >> 9) & 1) << 5)); }
DI void stage_rc(int b, int& R, int& C) { const int st = b / 1024, sb = b % 1024, swz = sb ^ (((sb >> 9) & 1) << 5); R = (st >> 1) * 16 + swz / 64; C = (st & 1) * 32 + (swz % 64) / 2; }
DI int perm32(int rho) { const int n = rho >> 4, i = rho & 15; return 8 * (i >> 2) + 4 * n + (i & 3); }
struct Unit { int pm, pn; };
struct Gemm { const bf16_t* A; const bf16_t* Bt; int M, N, K, lda, ldb; };
struct StaticOrder {
    int nM, nN, nwg, G, c, rep = 1, balance = 0;
    DI void init(int M, int N, int G_, int c_) { nM = M / BM; nN = N / BM; nwg = nM * nN; G = G_; c = c_; }
    DI bool next(int i, Unit& u) const {
        const long L = (long)(i / rep) * G + c; if (L >= nwg) return false;
        int wgid = (int)L; { const int q = nwg / NXCD, r = nwg % NXCD, xcd = wgid % NXCD, off = wgid / NXCD; wgid = (xcd < r ? xcd * (q + 1) : r * (q + 1) + (xcd - r) * q) + off; }
        const int nig = WGM * nN, gid = wgid / nig, fm = gid * WGM, gsz = (nM - fm) < WGM ? (nM - fm) : WGM;
        u.pm = fm + ((wgid % nig) % gsz); u.pn = (wgid % nig) / gsz;
        if (balance) {
            const int p = u.pn / 24, r = u.pn % 24, i = r >> 2, j = r & 3;
            const unsigned long long T0 = 0x1810080c0004ull  , T1 = 0x2a1e1c161424ull  , T2 = 0x2e2c28262220ull  ;
            u.pn = p == 0 ? (int)((T0 >> (8 * i)) & 0xff) + j : j < 2 ? (int)((T1 >> (8 * i)) & 0xff) + j : (int)((T2 >> (8 * i)) & 0xff) + (j - 2);
        }
        return true;
    }
    DI void a_ready(const Unit&) const {}
    DI void done(const Unit&) const {}
};
struct EpiProj {
    static constexpr bool PERM = true, TWICE = PROBE_G1_NOEPI != 0, KSCALE = false;
    bf16_t* P; const float* lb; const float* hgn; const float* gln; const float* bup; const float* rsq;
    template <int MODE>
    DI void body(const f32x4 (&acc)[2][2][4][2], bf16_t* prow, const float* vec, float scale, const float (&rs)[2][4]) const {
        f32x4 cv[2][2];
#pragma unroll
        for (int bj = 0; bj < 2; ++bj) { cv[bj][0] = (f32x4){1.f, 1.f, 1.f, 1.f}; cv[bj][1] = cv[bj][0];
            if constexpr (MODE >= 2) { cv[bj][0] = *(const f32x4*)(vec + bj * HALF); cv[bj][1] = *(const f32x4*)(vec + bj * HALF + 4); } }
#pragma unroll
        for (int bj = 0; bj < 2; ++bj) {
            const f32x4 c0 = cv[bj][0], c1 = cv[bj][1];
#pragma unroll
            for (int ai = 0; ai < 2; ++ai)
#pragma unroll
                for (int m = 0; m < 4; ++m) {
                    f32x4 a = acc[ai][bj][m][0] * rs[ai][m], b = acc[ai][bj][m][1] * rs[ai][m];
                    if constexpr (MODE == 0) { a = a * scale; b = b * scale; }
                    else if constexpr (MODE == 1) { a = (f32x4){silu(a.x), silu(a.y), silu(a.z), silu(a.w)}; b = (f32x4){silu(b.x), silu(b.y), silu(b.z), silu(b.w)}; }
                    else if constexpr (MODE == 2) { a = (f32x4){silu(a.x), silu(a.y), silu(a.z), silu(a.w)} * c0; b = (f32x4){silu(b.x), silu(b.y), silu(b.z), silu(b.w)} * c1; }
                    else if constexpr (MODE == 3) {
#define LOGF(x, l) flog(fmaxf((l) + (1.0f - (l)) * sigm(x), TINY))
                        a = (f32x4){LOGF(a.x, c0.x), LOGF(a.y, c0.y), LOGF(a.z, c0.z), LOGF(a.w, c0.w)}; b = (f32x4){LOGF(b.x, c1.x), LOGF(b.y, c1.y), LOGF(b.z, c1.z), LOGF(b.w, c1.w)};
#undef LOGF
                    } else {
#define LSIG(x, bb) (-0.0625f * (fmaxf(-((x) + (bb)), 0.f) + flog(1.0f + fexp(-fabsf((x) + (bb))))))
                        a = (f32x4){LSIG(a.x, c0.x), LSIG(a.y, c0.y), LSIG(a.z, c0.z), LSIG(a.w, c0.w)}; b = (f32x4){LSIG(b.x, c1.x), LSIG(b.y, c1.y), LSIG(b.z, c1.z), LSIG(b.w, c1.w)};
#undef LSIG
                    }
                    u32x4 w4; w4.x = pk2(a.x, a.y); w4.y = pk2(a.z, a.w); w4.z = pk2(b.x, b.y); w4.w = pk2(b.z, b.w);
                    *(u32x4*)(prow + (size_t)(ai * HALF + m * 16) * LDP + bj * HALF) = w4;
                }
        }
    }
    DI void operator()(const f32x4 (&acc)[2][2][4][2], const Unit& u, int wr, int wc, int fr, int fq) const {
        const int col = u.pn * BM + wc * 32 + 8 * fq;
        bf16_t* prow = P + (size_t)(u.pm * BM + wr * 64 + fr) * LDP + col;
        float rs[2][4];
#pragma unroll
        for (int ai = 0; ai < 2; ++ai)
#pragma unroll
            for (int m = 0; m < 4; ++m) rs[ai][m] = rsq[u.pm * BM + wr * 64 + fr + ai * HALF + m * 16];
#pragma unroll
        for (int ai = 0; ai < 2; ++ai)
#pragma unroll
            for (int m = 0; m < 4; ++m) rs[ai][m] = __builtin_amdgcn_rsqf(rs[ai][m] * (1.0f / D_MODEL) + EPS);
        const int pn = u.pn;
        if (pn < 4) body<1>(acc, prow, nullptr, 1.f, rs);
        else if (pn < 8) body<3>(acc, prow, lb + (col - C_HGF), 1.f, rs);
        else if (pn < 12) body<0>(acc, prow, nullptr, 1.f, rs);
        else if (pn < 16) body<2>(acc, prow, hgn + (col - C_HGG), 1.f, rs);
        else if (pn < 20) body<0>(acc, prow, nullptr, 1.f, rs);
        else if (pn < 24) body<1>(acc, prow, nullptr, 1.f, rs);
        else if (pn < 26) body<0>(acc, prow, nullptr, 0.08838834764831845f, rs);
        else if (pn < 32) body<0>(acc, prow, nullptr, 1.f, rs);
        else if (pn < 36) body<2>(acc, prow, gln + (col - C_GLG), 1.f, rs);
        else if (pn < 38) body<4>(acc, prow, bup + (col - C_GLF), 1.f, rs);
        else if (pn < 42) body<1>(acc, prow, nullptr, 1.f, rs);
        else body<0>(acc, prow, nullptr, 1.f, rs);
    }
};
struct EpiSample {
    static constexpr bool PERM = false, TWICE = false, KSCALE = false;
    float* PS;
    DI void operator()(const f32x4 (&acc)[2][2][4][2], const Unit& u, int wr, int wc, int fr, int fq) const {
        const int row0 = wr * 64 + fr, col0 = u.pn * BM + wc * 32 + 4 * fq;
#pragma unroll
        for (int m = 0; m < 4; ++m) { float* op = PS + (size_t)(row0 + m * 16) * LDP + col0;
#pragma unroll
            for (int bj = 0; bj < 2; ++bj)
#pragma unroll
                for (int n = 0; n < 2; ++n) *(f32x4*)(op + bj * HALF + n * 16) = acc[0][bj][m][n]; }
    }
};
struct EpiResid {
    static constexpr bool PERM = true, TWICE = false, KSCALE = true;
    bf16_t* xb; float* rsq_next; const LAS float* tab;
    DI void rescale(f32x4 (&acc)[2][2][4][2], int seg, int wr, int fr) const {
#pragma unroll
        for (int ai = 0; ai < 2; ++ai)
#pragma unroll
            for (int m = 0; m < 4; ++m) { const float r = tab[seg * 256 + ai * HALF + wr * 64 + m * 16 + fr];
#pragma unroll
                for (int bj = 0; bj < 2; ++bj) { acc[ai][bj][m][0] = acc[ai][bj][m][0] * r; acc[ai][bj][m][1] = acc[ai][bj][m][1] * r; } }
    }
    DI void operator()(f32x4 (&acc)[2][2][4][2], const Unit& u, int wr, int wc, int fr, int fq) const {
        rescale(acc, 6, wr, fr);
        const int row0 = u.pm * BM + wr * 64 + fr, col0 = u.pn * BM + wc * 32 + 8 * fq;
#pragma unroll
        for (int ai = 0; ai < 2; ++ai) {
            u32x4 ob[4][2];
#pragma unroll
            for (int m = 0; m < 4; ++m)
#pragma unroll
                for (int bj = 0; bj < 2; ++bj) ob[m][bj] = *(const u32x4*)(xb + (size_t)(row0 + ai * HALF + m * 16) * D_MODEL + col0 + bj * HALF);
#pragma unroll
            for (int m = 0; m < 4; ++m) { const int row = row0 + ai * HALF + m * 16; bf16_t* xp = xb + (size_t)row * D_MODEL + col0; float ss = 0.f;
#pragma unroll
                for (int bj = 0; bj < 2; ++bj) { const u32x4 o = ob[m][bj]; const f32x4 a = acc[ai][bj][m][0], b = acc[ai][bj][m][1];
                    const float x0 = bflo(o.x) + a.x, x1 = bfhi(o.x) + a.y, x2 = bflo(o.y) + a.z, x3 = bfhi(o.y) + a.w, x4 = bflo(o.z) + b.x, x5 = bfhi(o.z) + b.y, x6 = bflo(o.w) + b.z, x7 = bfhi(o.w) + b.w;
                    ss += ((x0 * x0 + x1 * x1) + (x2 * x2 + x3 * x3)) + ((x4 * x4 + x5 * x5) + (x6 * x6 + x7 * x7));
                    u32x4 n4; n4.x = pk2(x0, x1); n4.y = pk2(x2, x3); n4.z = pk2(x4, x5); n4.w = pk2(x6, x7); *(u32x4*)(xp + bj * HALF) = n4; }
                const int lane = fq * 16 + fr; ss += shx(ss, 16, lane); ss += shx(ss, 32, lane);
                if (fq == 0) atomicAdd(rsq_next + row, ss); }
        }
    }
};
struct OneUnit {
    int pm, pn, have;
    DI bool next(int i, Unit& u) const { if (i != 0 || !have) return false; u.pm = pm; u.pn = pn; return true; }
    DI void a_ready(const Unit&) const {}
    DI void done(const Unit&) const {}
};
template <class Epi, class Sched>
DI void gemm_phase(LAS unsigned char* lds, const Gemm g, const Sched& S, const Epi& E, int wv) {
    const int tid = get_tid(wv), wid = wv, lane = tid & 63, wr = wid >> 2, wc = wid & 3, fr = lane & 15, fq = lane >> 4;
    const int K = g.K, nt = K / BK;
    unsigned voffA[2], voffB[2];
#pragma unroll
    for (int i = 0; i < 2; ++i) { int R, C; stage_rc(tid * 16 + i * 8192, R, C); const int Rb = Epi::PERM ? ((R & ~31) + perm32(R & 31)) : R;
        voffA[i] = (unsigned)(R * g.lda + C) * 2u; voffB[i] = (unsigned)(Rb * g.ldb + C) * 2u; }
    const size_t kstep = (size_t)(BK * 2);
    const size_t hstepA = (size_t)HALF * g.lda * 2, hstepB = (size_t)HALF * g.ldb * 2;
    const size_t tstepA = 2 * hstepA, tstepB = 2 * hstepB;
    const unsigned ldsw = (unsigned)wid * 1024u;
    const int aoff = lds_byte(wr * 64 + fr, fq * 8), boff = lds_byte(wc * 32 + fr, fq * 8);
#define PG8_SA(b, h) (((b) * 2 + (h)) * HTB)
#define PG8_SB(b, h) ((4 + (b) * 2 + (h)) * HTB)
#define PG8_STAGE(bufoff, gbase, voff) do { _Pragma("unroll") for (int _i = 0; _i < 2; ++_i) \
        __builtin_amdgcn_global_load_lds((const unsigned*)((const char*)(gbase) + (voff)[_i]), (LAS unsigned*)(lds + (bufoff) + ldsw + _i * 8192), 16, 0, 0); } while (0)
#define PG8_LDA(dst, b, h) do { _Pragma("unroll") for (int m = 0; m < 4; ++m) _Pragma("unroll") for (int k = 0; k < 2; ++k) dst[m][k] = *(const LAS bf16x8*)(lds + PG8_SA(b, h) + aoff + m * 2048 + k * 1024); } while (0)
#define PG8_LDB(dst, b, h) do { _Pragma("unroll") for (int n = 0; n < 2; ++n) _Pragma("unroll") for (int k = 0; k < 2; ++k) dst[n][k] = *(const LAS bf16x8*)(lds + PG8_SB(b, h) + boff + n * 2048 + k * 1024); } while (0)
#define PG8_MMA(ai, bj, At, Bt) do { __builtin_amdgcn_s_setprio(1); _Pragma("unroll") for (int m = 0; m < 4; ++m) _Pragma("unroll") for (int n = 0; n < 2; ++n) _Pragma("unroll") for (int k = 0; k < 2; ++k) \
        acc[ai][bj][m][n] = __builtin_amdgcn_mfma_f32_16x16x32_bf16(Bt[n][k], At[m][k], acc[ai][bj][m][n], 0, 0, 0); __builtin_amdgcn_s_setprio(0); } while (0)
#define PG8_WAIT_V(n) asm volatile("s_waitcnt vmcnt(" #n ")" ::: "memory")
#define PG8_WAIT_L(n) asm volatile("s_waitcnt lgkmcnt(" #n ")" ::: "memory")
#define PG8_BAR __builtin_amdgcn_s_barrier()
#define PG8_SCHED __builtin_amdgcn_sched_barrier(0)
    Unit cur, nxt; int ui = 0;
    if (!S.next(0, cur)) return;
    f32x4 acc[2][2][4][2];
#pragma unroll
    for (int a = 0; a < 2; ++a)
#pragma unroll
        for (int b = 0; b < 2; ++b)
#pragma unroll
            for (int m = 0; m < 4; ++m)
#pragma unroll
                for (int n = 0; n < 2; ++n) acc[a][b][m][n] = (f32x4){0.f, 0.f, 0.f, 0.f};
    bf16x8 At[4][2], B0[2][2], B1[2][2];
    const char* cA = (const char*)g.A + (size_t)cur.pm * tstepA; const char* cB = (const char*)g.Bt + (size_t)cur.pn * tstepB;
    S.a_ready(cur);
    PG8_STAGE(PG8_SB(0, 0), cB, voffB); PG8_STAGE(PG8_SA(0, 0), cA, voffA); PG8_STAGE(PG8_SB(0, 1), cB + hstepB, voffB); PG8_STAGE(PG8_SA(0, 1), cA + hstepA, voffA);
    if (wr == 1) PG8_BAR;
    PG8_WAIT_V(4); PG8_BAR;
    PG8_STAGE(PG8_SB(1, 0), cB + kstep, voffB); PG8_STAGE(PG8_SA(1, 0), cA + kstep, voffA); PG8_STAGE(PG8_SB(1, 1), cB + hstepB + kstep, voffB);
    PG8_WAIT_V(6); PG8_BAR;
    for (;;) {
        const bool has_next = S.next(ui + 1, nxt);
        const char* nA = has_next ? (const char*)g.A + (size_t)nxt.pm * tstepA : cA; const char* nB = has_next ? (const char*)g.Bt + (size_t)nxt.pn * tstepB : cB;
        for (int t = 0; t < nt; t += 2) {
            const bool last = (t == nt - 2);
            const char* a1 = cA + (size_t)(t + 1) * kstep;
            const char* a2 = last ? nA : cA + (size_t)(t + 2) * kstep; const char* b2 = last ? nB : cB + (size_t)(t + 2) * kstep;
            const char* a3 = a2 + kstep; const char* b3 = b2 + kstep;
            if (last && has_next) S.a_ready(nxt);
            if constexpr (Epi::KSCALE) { if (t >= 32 && (t & 3) == 0 && (t < 48 || (t & 7) == 0)) E.rescale(acc, t < 48 ? (t - 32) >> 2 : 4 + ((t - 48) >> 3), wr, fr); }
            PG8_LDB(B0, 0, 0); PG8_SCHED; PG8_LDA(At, 0, 0); PG8_STAGE(PG8_SA(1, 1), a1 + hstepA, voffA);
            PG8_WAIT_L(8); PG8_BAR; PG8_WAIT_L(0); PG8_MMA(0, 0, At, B0); PG8_BAR; PG8_SCHED;
            PG8_LDB(B1, 0, 1); PG8_STAGE(PG8_SB(0, 0), b2, voffB);
            PG8_BAR; PG8_WAIT_L(0); PG8_MMA(0, 1, At, B1); PG8_BAR;
            PG8_LDA(At, 0, 1); PG8_STAGE(PG8_SA(0, 0), a2, voffA);
            PG8_BAR; PG8_WAIT_L(0); PG8_MMA(1, 0, At, B0); PG8_BAR; PG8_SCHED;
            PG8_STAGE(PG8_SB(0, 1), b2 + hstepB, voffB);
            PG8_WAIT_V(6); PG8_BAR; PG8_MMA(1, 1, At, B1); PG8_BAR;
            PG8_LDB(B0, 1, 0); PG8_SCHED; PG8_LDA(At, 1, 0); PG8_STAGE(PG8_SA(0, 1), a2 + hstepA, voffA);
            PG8_WAIT_L(8); PG8_BAR; PG8_WAIT_L(0); PG8_MMA(0, 0, At, B0); PG8_BAR; PG8_SCHED;
            PG8_LDB(B1, 1, 1); PG8_STAGE(PG8_SB(1, 0), b3, voffB);
            PG8_BAR; PG8_WAIT_L(0); PG8_MMA(0, 1, At, B1); PG8_BAR;
            PG8_LDA(At, 1, 1); PG8_STAGE(PG8_SA(1, 0), a3, voffA);
            PG8_BAR; PG8_WAIT_L(0); PG8_MMA(1, 0, At, B0); PG8_BAR; PG8_SCHED;
            PG8_STAGE(PG8_SB(1, 1), b3 + hstepB, voffB);
            PG8_WAIT_V(6); PG8_BAR; PG8_MMA(1, 1, At, B1); PG8_BAR;
        }
        E(acc, cur, wr, wc, fr, fq);
        if constexpr (Epi::TWICE) {
#pragma unroll
            for (int a = 0; a < 2; ++a)
#pragma unroll
                for (int b = 0; b < 2; ++b) asm volatile("" : "+v"(acc[a][b][0][0]), "+v"(acc[a][b][0][1]), "+v"(acc[a][b][1][0]), "+v"(acc[a][b][1][1]), "+v"(acc[a][b][2][0]), "+v"(acc[a][b][2][1]), "+v"(acc[a][b][3][0]), "+v"(acc[a][b][3][1]) :: "memory");
            E(acc, cur, wr, wc, fr, fq); }
        S.done(cur);
        if (!has_next) break;
#pragma unroll
        for (int a = 0; a < 2; ++a)
#pragma unroll
            for (int b = 0; b < 2; ++b)
#pragma unroll
                for (int m = 0; m < 4; ++m)
#pragma unroll
                    for (int n = 0; n < 2; ++n) acc[a][b][m][n] = (f32x4){0.f, 0.f, 0.f, 0.f};
        cur = nxt; cA = nA; cB = nB; ++ui;
    }
    PG8_WAIT_V(0);
    if (wr == 0) PG8_BAR;
    PG8_BAR;
#undef PG8_SA
#undef PG8_SB
#undef PG8_STAGE
#undef PG8_LDA
#undef PG8_LDB
#undef PG8_MMA
#undef PG8_WAIT_V
#undef PG8_WAIT_L
#undef PG8_BAR
#undef PG8_SCHED
}
}

struct Ctx {
    KP kp; const float* const __attribute__((address_space(4)))* in; float* out; unsigned char* ws;
    LAS unsigned char* lds;
    int tid, lane, wave, G, wg;
    float* lb; bf16_t* win; bf16_t* wout; bf16_t* xb; bf16_t* proj; float* projs; float* dtb; bf16_t* mix; bf16_t* xbcs; float* rowsq; unsigned* ctl;
};
DI Ctx make_ctx(int wv) {
    extern __shared__ __attribute__((aligned(16))) unsigned char lds_raw[];
    Ctx c; c.kp = get_params(); c.in = c.kp->in; c.out = c.kp->out; c.ws = c.kp->ws;
    c.lds = (LAS unsigned char*)lds_raw;
    asm volatile("" : "+s"(wv));
    int wg = blockIdx.x; asm volatile("" : "+s"(wg));
    c.tid = get_tid(wv); c.lane = c.tid & 63; c.wave = wv; c.G = gridDim.x; c.wg = wg;
    unsigned char* ws = c.ws;
    c.ctl = (unsigned*)(ws + WS_CTL); c.lb = (float*)(ws + WS_LB); c.win = (bf16_t*)(ws + WS_WIN); c.wout = (bf16_t*)(ws + WS_WOUT); c.xb = (bf16_t*)(ws + WS_XB);
    c.proj = (bf16_t*)(ws + WS_PROJ); c.projs = (float*)(ws + WS_PROJS); c.dtb = (float*)(ws + WS_DTB); c.mix = (bf16_t*)(ws + WS_MIX); c.xbcs = (bf16_t*)(ws + WS_XBCS); c.rowsq = (float*)(c.ctl + CW_ROWSQ);
    return c;
}

DI void p0_transpose_item(const float* W, int ldw, int k0, int n0, bf16_t* WT, int K, int drow0, LAS float* scr, int lane, const float* ksc) {
    float t[32];
#pragma unroll
    for (int i = 0; i < 32; ++i) t[i] = W[(size_t)(k0 + 2 * i + (lane >> 5)) * ldw + n0 + (lane & 31)];
#pragma unroll
    for (int i = 0; i < 32; ++i) scr[(2 * i + (lane >> 5)) * 33 + (lane & 31)] = t[i];
    const int c = lane & 7;
    f32x4 s0 = (f32x4){1.f, 1.f, 1.f, 1.f}, s1 = s0;
    if (ksc) { s0 = *(const f32x4*)(ksc + k0 + 8 * c); s1 = *(const f32x4*)(ksc + k0 + 8 * c + 4); }
    asm volatile("s_waitcnt lgkmcnt(0)" ::: "memory");
#pragma unroll
    for (int j = 0; j < 4; ++j) { const int n = (lane >> 3) + 8 * j; const LAS float* s = scr + (8 * c) * 33 + n;
        u32x4 o; o.x = pk2(s[0 * 33] * s0.x, s[1 * 33] * s0.y); o.y = pk2(s[2 * 33] * s0.z, s[3 * 33] * s0.w); o.z = pk2(s[4 * 33] * s1.x, s[5 * 33] * s1.y); o.w = pk2(s[6 * 33] * s1.z, s[7 * 33] * s1.w);
        *(u32x4*)(WT + (size_t)(drow0 + n) * K + k0 + 8 * c) = o; }
    asm volatile("s_waitcnt lgkmcnt(0)" ::: "memory");
}
DI void phase_prologue(int wv) {
    const Ctx c = make_ctx(wv);
    LAS float* scr = (LAS float*)(c.lds + c.wave * 16384);
    const int gw = c.wg * 8 + c.wave, NGW = c.G * 8;
    constexpr int NB1 = SRC_GLA / 32, NB2 = (SRC_DT - SRC_SSZ) / 32;
    constexpr int I_A = (D_MODEL / 64) * NB1, I_B = (D_MODEL / 64) * NB2, I_O = (D_MIX / 64) * (D_MODEL / 32), I_L = I_A + I_B + I_O;
    for (int it = gw; it < DEPTH * I_L; it += NGW) {
        const int l = it / I_L; int r = it % I_L;
        const float* win = c.in[I_WIN] + (size_t)l * D_MODEL * N_IN; bf16_t* wt = c.win + (size_t)l * LDP * D_MODEL; const float* rmsw = c.in[I_RMS] + (size_t)l * D_MODEL;
        if (r < I_A) { const int kb = r / NB1, nb = r % NB1; p0_transpose_item(win, N_IN, 64 * kb, 32 * nb, wt, D_MODEL, 32 * nb, scr, c.lane, rmsw); }
        else if (r < I_A + I_B) { r -= I_A; const int kb = r / NB2, nb = r % NB2; p0_transpose_item(win, N_IN, 64 * kb, SRC_SSZ + 32 * nb, wt, D_MODEL, C_SSZ + 32 * nb, scr, c.lane, rmsw); }
        else { r -= I_A + I_B; const int kb = r / (D_MODEL / 32), nb = r % (D_MODEL / 32);
            p0_transpose_item(c.in[I_WOUT] + (size_t)l * D_MIX * D_MODEL, D_MODEL, 64 * kb, 32 * nb, c.wout + (size_t)l * D_MODEL * D_MIX, D_MIX, 32 * nb, scr, c.lane, kb >= 48 ? c.in[I_SSN] + (size_t)l * 1024 - 3072 : nullptr); }
    }
    const int gt = c.wg * 512 + c.tid, NGT = c.G * 512;
    for (int it = gw; it < DEPTH * 32 * 8; it += NGW) {
        const int l = it >> 8, kb = (it >> 3) & 31, nb = it & 7, k = kb * 64 + c.lane;
        const float* wr = c.in[I_WIN] + ((size_t)l * D_MODEL + k) * N_IN + SRC_GLA; const float* up = c.in[I_GWU] + (size_t)l * 16 * 512 + nb * 64;
        const f32x4 a0 = *(const f32x4*)wr, a1 = *(const f32x4*)(wr + 4), a2 = *(const f32x4*)(wr + 8), a3 = *(const f32x4*)(wr + 12);
        const float rk = c.in[I_RMS][(size_t)l * D_MODEL + k];
        bf16_t* dst = c.win + ((size_t)l * LDP + C_GLF + nb * 64) * D_MODEL + k;
#pragma unroll 4
        for (int n = 0; n < 64; ++n) {
            const float s = a0.x * up[n] + a0.y * up[512 + n] + a0.z * up[1024 + n] + a0.w * up[1536 + n] + a1.x * up[2048 + n] + a1.y * up[2560 + n] + a1.z * up[3072 + n] + a1.w * up[3584 + n]
                          + a2.x * up[4096 + n] + a2.y * up[4608 + n] + a2.z * up[5120 + n] + a2.w * up[5632 + n] + a3.x * up[6144 + n] + a3.y * up[6656 + n] + a3.z * up[7168 + n] + a3.w * up[7680 + n];
            dst[(size_t)n * D_MODEL] = (bf16_t)f2bf(s * rk); }
    }
    for (int i = gt; i < DEPTH * 16 * D_MODEL; i += NGT) {
        const int l = i / (16 * D_MODEL), e = i % (16 * D_MODEL), n = e / D_MODEL, k = e % D_MODEL;
        c.win[((size_t)l * LDP + C_DT + n) * D_MODEL + k] = (bf16_t)f2bf(c.in[I_WIN][((size_t)l * D_MODEL + k) * N_IN + SRC_DT + n] * c.in[I_RMS][(size_t)l * D_MODEL + k]);
    }
    constexpr int PADW = (LDP - C_DT - 16) * D_MODEL * 2 / 16;
    for (int i = gt; i < DEPTH * PADW; i += NGT) { const int l = i / PADW, r = i % PADW;
        ((u32x4*)(c.win + ((size_t)l * LDP + C_DT + 16) * D_MODEL))[r] = (u32x4){0u, 0u, 0u, 0u}; }
    constexpr int PADX = (M_PAD - TT) * D_MODEL * 2 / 16;
    for (int i = gt; i < PADX; i += NGT) ((u32x4*)(c.xb + (size_t)TT * D_MODEL))[i] = (u32x4){0u, 0u, 0u, 0u};
    for (int r = gw; r < TT; r += 2 * NGW) {
        const int r1 = r + NGW; const bool two = r1 < TT; const int rb = two ? r1 : r;
        const f32x4* xa = (const f32x4*)(r < TP ? c.in[I_XP] + (size_t)r * D_MODEL : c.in[I_XS] + (size_t)(r - TP) * D_MODEL);
        const f32x4* xb4 = (const f32x4*)(rb < TP ? c.in[I_XP] + (size_t)rb * D_MODEL : c.in[I_XS] + (size_t)(rb - TP) * D_MODEL);
        f32x4 va[8], vb[8];
#pragma unroll
        for (int j = 0; j < 8; ++j) { va[j] = xa[c.lane + 64 * j]; vb[j] = xb4[c.lane + 64 * j]; }
        u32x2* oa = (u32x2*)(c.xb + (size_t)r * D_MODEL); u32x2* ob = (u32x2*)(c.xb + (size_t)rb * D_MODEL); float sa = 0.f, sb = 0.f;
#pragma unroll
        for (int j = 0; j < 8; ++j) { const f32x4 v = va[j]; sa += (v.x * v.x + v.y * v.y) + (v.z * v.z + v.w * v.w); u32x2 p; p.x = pk2(v.x, v.y); p.y = pk2(v.z, v.w); oa[c.lane + 64 * j] = p; }
#pragma unroll
        for (int j = 0; j < 8; ++j) { const f32x4 v = vb[j]; sb += (v.x * v.x + v.y * v.y) + (v.z * v.z + v.w * v.w); u32x2 p; p.x = pk2(v.x, v.y); p.y = pk2(v.z, v.w); if (two) ob[c.lane + 64 * j] = p; }
        sa = wave_sum(sa, c.lane); sb = wave_sum(sb, c.lane);
        if (c.lane == 0) { c.rowsq[r] = sa; if (two) c.rowsq[r1] = sb; }
    }
    for (int i = gt; i < 1024; i += NGT) {
        const float* p = c.in[I_LB];
        const float a0 = p[i], a1 = p[1024 + i], a2 = p[2048 + i], a3 = p[3072 + i];
        const float mx = fmaxf(fmaxf(a0, a1), fmaxf(a2, a3));
        const float e0 = expf(a0 - mx), e1 = expf(a1 - mx), e2 = expf(a2 - mx), e3 = expf(a3 - mx);
        const float inv = 1.0f / (e0 + e1 + e2 + e3);
        c.lb[i] = 0.f; c.lb[1024 + i] = e1 * inv; c.lb[2048 + i] = (e1 + e2) * inv; c.lb[3072 + i] = (e1 + e2 + e3) * inv;
    }
}

DI void phase_final_norm(int wv) {
    const Ctx c = make_ctx(wv);
    const int gw = c.wg * 8 + c.wave, NGW = c.G * 8;
    const f32x4* w4 = (const f32x4*)c.in[I_RMSF];
    f32x4 wn[8];
#pragma unroll
    for (int j = 0; j < 8; ++j) wn[j] = w4[c.lane + 64 * j];
    for (int r = gw; r < TT; r += 2 * NGW) {
        const int r1 = r + NGW; const bool two = r1 < TT;
        const u32x2* xa = (const u32x2*)(c.xb + (size_t)r * D_MODEL); const u32x2* xb2 = (const u32x2*)(c.xb + (size_t)(two ? r1 : r) * D_MODEL);
        const float ra = row_rstd(c.rowsq + DEPTH * M_PAD, r), rb = row_rstd(c.rowsq + DEPTH * M_PAD, two ? r1 : r);
        u32x2 pa[8], pb[8];
#pragma unroll
        for (int j = 0; j < 8; ++j) { pa[j] = xa[c.lane + 64 * j]; pb[j] = xb2[c.lane + 64 * j]; }
        f32x4* oa = (f32x4*)(c.out + O_YP + (size_t)r * D_MODEL); f32x4* ob = (f32x4*)(c.out + O_YP + (size_t)r1 * D_MODEL);
#pragma unroll
        for (int j = 0; j < 8; ++j) { const u32x2 p = pa[j]; const f32x4 w = wn[j];
            oa[c.lane + 64 * j] = (f32x4){bflo(p.x) * ra * w.x, bfhi(p.x) * ra * w.y, bflo(p.y) * ra * w.z, bfhi(p.y) * ra * w.w}; }
        if (two) {
#pragma unroll
            for (int j = 0; j < 8; ++j) { const u32x2 p = pb[j]; const f32x4 w = wn[j];
                ob[c.lane + 64 * j] = (f32x4){bflo(p.x) * rb * w.x, bfhi(p.x) * rb * w.y, bflo(p.y) * rb * w.z, bfhi(p.y) * rb * w.w}; } }
    }
}

DI float ps4(const float* p) { return (p[0] + p[PST]) + (p[2 * PST] + p[3 * PST]); }
DI float conv1(const float* prow, float rs, int col, int ch, int nch, const float* cw, const float* cb, const float* buf, float* nbuf) {
    const float b0 = buf[ch], b1 = buf[nch + ch], b2 = buf[2 * nch + ch], xn = ps4(prow + col + ch) * rs, w0 = cw[ch], w1 = cw[nch + ch], w2 = cw[2 * nch + ch], w3 = cw[3 * nch + ch], bb = cb[ch];
    nbuf[ch] = b1; nbuf[nch + ch] = b2; nbuf[2 * nch + ch] = xn;
    return bb + w0 * b0 + w1 * b1 + w2 * b2 + w3 * xn;
}
constexpr int SM_Q = 0, SM_K = 1024, SM_F = 2048, SM_V = 3072, SM_O = 4096, SM_WS = 5120, SM_PART = 5376;
DI void sample_item(const Ctx& c, int l, int s, int type) {
    LAS float* sm = (LAS float*)c.lds;
    LAS float* QS = sm + SM_Q; LAS float* KS = sm + SM_K; LAS float* FS = sm + SM_F; LAS float* VS = sm + SM_V; LAS float* OS_ = sm + SM_O; LAS float* WSUM = sm + SM_WS;
    const int tid = get_tid(c.wave), lane = tid & 63, w = c.wave;
    const float* pr = c.projs + (size_t)s * LDP; const float rs = row_rstd(c.rowsq + (size_t)l * M_PAD, TP + s);
    __syncthreads();
    if (type == 0) {
#pragma unroll
        for (int e = 0; e < 2; ++e) { const int ch = 2 * tid + e; const float qraw = (ps4(pr + C_HGQ + ch) * rs), fraw = (ps4(pr + C_HGF + ch) * rs), lbv = c.lb[(size_t)l * 1024 + ch];
            QS[ch] = silu(qraw); FS[ch] = fmaxf(lbv + (1.0f - lbv) * sigm(fraw), TINY); KS[ch] = (1.0f - lbv) * sigm(-fraw); VS[ch] = (ps4(pr + C_HGI + ch) * rs); }
    } else if (type == 1) {
#pragma unroll
        for (int e = 0; e < 2; ++e) { const int ch = 2 * tid + e; VS[ch] = (ps4(pr + C_GLV + ch) * rs);
            if (tid < 256) { QS[ch] = (ps4(pr + C_GLQ + ch) * rs) * 0.08838834764831845f; KS[ch] = (ps4(pr + C_GLK + ch) * rs);
                const float z = (ps4(pr + C_GLF + ch) * rs) + c.in[I_GBU][(size_t)l * 512 + ch]; FS[ch] = fexp(-softplus(-z) * (1.0f / 16.0f)); } }
    } else {
        const float* scw = c.in[I_SCW] + (size_t)l * 4 * 1536; const float* scb = c.in[I_SCB] + (size_t)l * 1536;
        const float* sbuf = c.in[I_SSSDC] + ((size_t)l * DEC + s) * 3 * 1536; float* nbuf = c.out + O_SSDC_S + ((size_t)l * DEC + s) * 4608;
        float cv0, cv1, cv2 = 0.f, cv3 = 0.f;
        cv0 = conv1(pr, rs, C_XBC, 2 * tid, 1536, scw, scb, sbuf, nbuf); cv1 = conv1(pr, rs, C_XBC, 2 * tid + 1, 1536, scw, scb, sbuf, nbuf);
        if (tid < 256) { cv2 = conv1(pr, rs, C_XBC, 1024 + tid, 1536, scw, scb, sbuf, nbuf); cv3 = conv1(pr, rs, C_XBC, 1280 + tid, 1536, scw, scb, sbuf, nbuf); }
        VS[2 * tid] = silu(cv0); VS[2 * tid + 1] = silu(cv1);
        if (tid < 256) { KS[tid] = silu(cv2); QS[tid] = silu(cv3); }
        if (tid < 16) { const float dt = softplus((ps4(pr + C_DT + tid) * rs) + c.in[I_DTB][l * 16 + tid]); FS[tid] = dt; FS[16 + tid] = fexp(-dt * expf(c.in[I_ALOG][l * 16 + tid])); }
    }
    __syncthreads();
    if (type < 2) {
        const int h = type == 0 ? w : (w >> 1), RS = type == 0 ? 128 : 256, voff = type == 0 ? 0 : 128 * (w & 1);
        const size_t sb = type == 0 ? (((size_t)l * DEC + s) * 8 + h) * 16384 : (((size_t)l * DEC + s) * 4 + h) * 32768;
        const float* s0 = (type == 0 ? c.in[I_SHG] : c.in[I_SGLA]) + sb; float* so = c.out + (type == 0 ? O_HG_S : O_GLA_S) + sb;
        const int vq = lane & 31, kh = lane >> 5, vb = (type == 0 ? h * 128 : h * 256 + voff) + 4 * vq, qb = h * 128;
        const f32x4 vv = *(const LAS f32x4*)(VS + vb); f32x4 o4 = (f32x4){0.f, 0.f, 0.f, 0.f};
        const int eo = kh * RS + voff + 4 * vq;
        f32x4 st[3][8];
#define SI_LOAD(bf, kb) do { _Pragma("unroll") for (int u = 0; u < 8; ++u) st[bf][u] = *(const f32x4*)(s0 + (size_t)(2 * (8 * (kb) + u)) * RS + eo); } while (0)
        SI_LOAD(0, 0); SI_LOAD(1, 1);
#pragma unroll
        for (int kb = 0; kb < 8; ++kb) {
            if (kb + 2 < 8) SI_LOAD((kb + 2) % 3, kb + 2);
#pragma unroll
            for (int u = 0; u < 8; ++u) { const int k = 2 * (8 * kb + u) + kh; const float fk = FS[qb + k], kk = KS[qb + k], qk = QS[qb + k];
                f32x4 t = st[kb % 3][u] * fk + vv * kk; o4 += t * qk; *(f32x4*)(so + (size_t)(2 * (8 * kb + u)) * RS + eo) = t; }
        }
#undef SI_LOAD
        o4.x += shx(o4.x, 32, lane); o4.y += shx(o4.y, 32, lane); o4.z += shx(o4.z, 32, lane); o4.w += shx(o4.w, 32, lane);
        if (kh == 0) *(LAS f32x4*)(OS_ + vb) = o4;
    } else {
        LAS float* PART = sm + SM_PART + w * 2304;
        const int nq = lane & 31, ph = lane >> 5, g = w >> 2;
        const f32x4 B4 = *(const LAS f32x4*)(KS + g * 128 + 4 * nq), C4 = *(const LAS f32x4*)(QS + g * 128 + 4 * nq);
        const float* s0 = c.in[I_SSSD] + (((size_t)l * DEC + s) * 16 + 2 * w) * 8192; float* so = c.out + O_SSD_S + (((size_t)l * DEC + s) * 16 + 2 * w) * 8192;
        const int eo = ph * 128 + 4 * nq;
        f32x4 st[3][8];
#define SI_LOAD(bf, kb) do { _Pragma("unroll") for (int u = 0; u < 8; ++u) st[bf][u] = *(const f32x4*)(s0 + (size_t)((kb) >> 2) * 8192 + (size_t)(2 * (8 * ((kb) & 3) + u)) * 128 + eo); } while (0)
        SI_LOAD(0, 0); SI_LOAD(1, 1);
#pragma unroll
        for (int kb = 0; kb < 8; ++kb) { const int h = 2 * w + (kb >> 2);
            if (kb + 2 < 8) SI_LOAD((kb + 2) % 3, kb + 2);
            const float dt = FS[h], dA = FS[16 + h];
#pragma unroll
            for (int u = 0; u < 8; ++u) { const int p = 2 * (8 * (kb & 3) + u) + ph; const float xv = VS[h * 64 + p] * dt;
                const f32x4 t = st[kb % 3][u] * dA + B4 * xv; *(f32x4*)(so + (size_t)(kb >> 2) * 8192 + (size_t)(2 * (8 * (kb & 3) + u)) * 128 + eo) = t;
                PART[p * 36 + nq] = (t.x * C4.x + t.y * C4.y) + (t.z * C4.z + t.w * C4.w); }
            if ((kb & 3) == 3) {
                asm volatile("s_waitcnt lgkmcnt(0)" ::: "memory");
                float o = 0.f;
#pragma unroll
                for (int q = 0; q < 8; ++q) { const f32x4 tt = *(const LAS f32x4*)(PART + lane * 36 + 4 * q); o += (tt.x + tt.y) + (tt.z + tt.w); }
                const float x = VS[h * 64 + lane], z = (ps4(pr + C_SSZ + h * 64 + lane) * rs);
                OS_[h * 64 + lane] = (o + c.in[I_SD][l * 16 + h] * x) * silu(z);
                asm volatile("s_waitcnt lgkmcnt(0)" ::: "memory"); }
        }
#undef SI_LOAD
    }
    __syncthreads();
    { const f32x2 o2 = *(const LAS f32x2*)(OS_ + 2 * tid);
      const float ssw = wave_sum(o2.x * o2.x + o2.y * o2.y, lane);
      if (lane == 0) WSUM[w] = ssw;
      __syncthreads();
      float ss, gsz; const float* nw; int mcol, gcol = 0;
      if (type == 0) { ss = WSUM[w]; gsz = 128.f; nw = c.in[I_HGN] + (size_t)l * 1024; mcol = 0; gcol = C_HGG; }
      else if (type == 1) { ss = WSUM[w & ~1] + WSUM[w | 1]; gsz = 256.f; nw = c.in[I_GLN] + (size_t)l * 1024; mcol = 2048; gcol = C_GLG; }
      else { const int b4 = w & ~3; ss = (WSUM[b4] + WSUM[b4 + 1]) + (WSUM[b4 + 2] + WSUM[b4 + 3]); gsz = 512.f; nw = c.in[I_SSN] + (size_t)l * 1024; mcol = 3072; }
      const float rstd = rsqrtf(ss / gsz + EPS);
      float y0 = o2.x * rstd, y1 = o2.y * rstd;
      if (type < 2) { y0 *= nw[2 * tid]; y1 *= nw[2 * tid + 1]; }
      if (type < 2) { y0 *= silu((ps4(pr + gcol + 2 * tid) * rs)); y1 *= silu((ps4(pr + gcol + 2 * tid + 1) * rs)); }
      *(unsigned*)(c.mix + (size_t)(TP + s) * D_MIX + mcol + 2 * tid) = pk2(y0, y1); }
}

DI void lds_barrier() { asm volatile("s_waitcnt lgkmcnt(0)\n\ts_barrier" ::: "memory"); }
DI f32x16 mfma32(bf16x8 a, bf16x8 b, f32x16 c) { return __builtin_amdgcn_mfma_f32_32x32x16_bf16(a, b, c, 0, 0, 0); }
DI bf16x8 ldfrag(const LAS unsigned char* p) { return *(const LAS bf16x8*)p; }
DI int crow(int i, int hh) { return (i & 3) + 8 * (i >> 2) + 4 * hh; }
constexpr int L_QP = 0, L_KP = 17408, L_KPT = 34816, L_VT = 53248, L_VT2 = 71680, L_AM = 90112, L_TOT = 108544, L_E1 = 112640, L_E2 = 113152, L_CUM = 113664;
constexpr int SQ = 272, SV = 144;
#define ZERO16(x) do { _Pragma("unroll") for (int _i = 0; _i < 16; ++_i) (x)[_i] = 0.f; } while (0)

template <int TYPE>
DI void la_head_unit(const Ctx& c, int l, int b, int hu) {
    constexpr int DV = 128, NSW = DV / 32, OS = DV * 2 + 16, NC = DV / 8;
    LAS unsigned char* L = c.lds;
    const int tid = get_tid(c.wave), lane = tid & 63, w = c.wave;
    const int r = lane & 31, hh = lane >> 5;
    const int row0 = b * SEQ;
    const bf16_t* P = TYPE == 2 ? c.xbcs : c.proj;
    constexpr int LDR = TYPE == 2 ? 1536 : LDP;
    LAS float* TOT = (LAS float*)(L + L_TOT); LAS float* E1 = (LAS float*)(L + L_E1); LAS float* E2 = (LAS float*)(L + L_E2);
    int colQ, colK, colG, colV, colGate, colOut, sidx; const int grp = hu >> 2;
    if constexpr (TYPE == 0) { colQ = C_HGQ + hu * 128; colK = 0; colG = C_HGF + hu * 128; colV = C_HGI + hu * 128; colGate = C_HGG + hu * 128; colOut = hu * 128; sidx = 0; }
    else if constexpr (TYPE == 1) { const int hd = hu >> 1; colQ = C_GLQ + hd * 128; colK = C_GLK + hd * 128; colG = C_GLF + hd * 128; colV = C_GLV + hu * 128; colGate = C_GLG + hu * 128; colOut = 2048 + hu * 128; sidx = 2 + hd; }
    else { colK = 1024 + grp * 128; colQ = 1280 + grp * 128; colG = 0; colV = hu * 128; colGate = C_SSZ + hu * 128; colOut = 3072 + hu * 128; sidx = grp; }
    float Ah[2], Dh[2];
    if constexpr (TYPE == 2) {
#pragma unroll
        for (int e = 0; e < 2; ++e) { Ah[e] = -expf(c.in[I_ALOG][l * 16 + 2 * hu + e]); Dh[e] = c.in[I_SD][l * 16 + 2 * hu + e]; }
    }
    unsigned r0[8], r1[8], r2[8], r3[8]; float dtn = 0.f;
#define LOAD_CHUNK(tn) do { const bf16_t* pq_ = P + (size_t)(row0 + (tn) + 8 * w) * LDR + 2 * lane; \
        if constexpr (TYPE == 0) { _Pragma("unroll") for (int i = 0; i < 8; ++i) { r0[i] = *(const unsigned*)(pq_ + (size_t)i * LDR + colQ); r1[i] = *(const unsigned*)(pq_ + (size_t)i * LDR + colG); r2[i] = *(const unsigned*)(pq_ + (size_t)i * LDR + colV); } } \
        else if constexpr (TYPE == 1) { _Pragma("unroll") for (int i = 0; i < 8; ++i) { r0[i] = *(const unsigned*)(pq_ + (size_t)i * LDR + colQ); r1[i] = *(const unsigned*)(pq_ + (size_t)i * LDR + colK); \
                                                                                       r2[i] = *(const unsigned*)(pq_ + (size_t)i * LDR + colG); r3[i] = *(const unsigned*)(pq_ + (size_t)i * LDR + colV); } } \
        else { _Pragma("unroll") for (int i = 0; i < 8; ++i) { r0[i] = *(const unsigned*)(pq_ + (size_t)i * LDR + colQ); r1[i] = *(const unsigned*)(pq_ + (size_t)i * LDR + colK); r2[i] = *(const unsigned*)(pq_ + (size_t)i * LDR + colV); } \
            if (w < 2) dtn = c.dtb[(size_t)(row0 + (tn) + lane) * 16 + 2 * hu + w]; } } while (0)
    f32x16 S[4];
#pragma unroll
    for (int kt = 0; kt < 4; ++kt) ZERO16(S[kt]);
    float e2pa = 1.f, e2pb = 1.f;
    constexpr bool PF = true;
    if constexpr (PF) LOAD_CHUNK(0);
    for (int ck = -(SEQ / 64) * (PROBE_LONG_REP - 1); ck < SEQ / 64; ++ck) {
        if (PROBE_LONG_REP > 1 && ck == 0) { e2pa = 1.f; e2pb = 1.f;
#pragma unroll
            for (int kt = 0; kt < 4; ++kt) ZERO16(S[kt]); }
        const int t0 = (ck & (SEQ / 64 - 1)) * 64;
        if constexpr (TYPE == 2) { if ((ck & (SEQ / 64 - 1)) == 15) {
            if (tid == 0) { unsigned* xp1 = c.ctl + CW_XPRE + 128 * l + 64; unsigned sp = 0;
                while (__hip_atomic_load(xp1, __ATOMIC_RELAXED, __HIP_MEMORY_SCOPE_AGENT) < 128u) { __builtin_amdgcn_s_sleep(8); if (++sp > (1u << 22)) break; }
                __builtin_amdgcn_fence(__ATOMIC_ACQUIRE, "agent"); asm volatile("s_waitcnt vmcnt(0)" ::: "memory"); }
            __syncthreads(); } }
        LAS float* CUM = (LAS float*)(L + L_CUM + (ck & 1) * 1536);
        if constexpr (!PF) LOAD_CHUNK(t0);
        float qa[8], qb[8], ka[8], kb[8], ga[8], gb[8], xa[8], xb[8]; unsigned uv[8];
        if constexpr (TYPE == 0) {
            float ta = 0.f, tb = 0.f;
#pragma unroll
            for (int i = 0; i < 8; ++i) { qa[i] = bflo(r0[i]); qb[i] = bfhi(r0[i]); const float g0 = bflo(r1[i]), g1 = bfhi(r1[i]); uv[i] = r2[i];
                ka[i] = 1.0f - fexp(g0); kb[i] = 1.0f - fexp(g1); ta += g0; tb += g1; ga[i] = ta; gb[i] = tb; }
            *(LAS f32x2*)(TOT + w * 128 + 2 * lane) = (f32x2){ta, tb};
        } else if constexpr (TYPE == 1) {
            float ta = 0.f, tb = 0.f;
#pragma unroll
            for (int i = 0; i < 8; ++i) { qa[i] = bflo(r0[i]); qb[i] = bfhi(r0[i]); ka[i] = bflo(r1[i]); kb[i] = bfhi(r1[i]); ta += bflo(r2[i]); tb += bfhi(r2[i]); ga[i] = ta; gb[i] = tb; uv[i] = r3[i]; }
            *(LAS f32x2*)(TOT + w * 128 + 2 * lane) = (f32x2){ta, tb};
        } else {
#pragma unroll
            for (int i = 0; i < 8; ++i) { qa[i] = bflo(r0[i]); qb[i] = bfhi(r0[i]); ka[i] = bflo(r1[i]); kb[i] = bfhi(r1[i]); xa[i] = bflo(r2[i]); xb[i] = bfhi(r2[i]); }
            if (w < 2) {
                const float dt = dtn; float x = dt * (w == 0 ? Ah[0] : Ah[1]);
#pragma unroll
                for (int o = 1; o < 64; o <<= 1) { const float y = shup(x, o, lane); if (lane >= o) x += y; }
                CUM[w * 192 + lane] = x; CUM[w * 192 + 64 + lane] = fmaxf(dt, 1e-30f); CUM[w * 192 + 128 + lane] = fexp(x);
            }
        }
        lds_barrier();
        if constexpr (TYPE < 2) {
            float offa = 0.f, offb = 0.f, brefa = 0.f, brefb = 0.f, bla = 0.f, blb = 0.f;
#pragma unroll
            for (int g = 0; g < 8; ++g) { const f32x2 t = *(const LAS f32x2*)(TOT + g * 128 + 2 * lane);
                if (g < w) { offa += t.x; offb += t.y; }
                if (g < 4) { brefa += t.x; brefb += t.y; }
                bla += t.x; blb += t.y; }
#pragma unroll
            for (int i = 0; i < 8; ++i) { const float da = clampf(ga[i] + offa - brefa, -80.f, 80.f), db = clampf(gb[i] + offb - brefb, -80.f, 80.f);
                qa[i] *= fexp(da); ka[i] *= fexp(-da); qb[i] *= fexp(db); kb[i] *= fexp(-db); }
            if (w == 0) {
                const float e2a = fexp(bla - brefa), e2b = fexp(blb - brefb);
                *(LAS f32x2*)(E1 + 2 * lane) = (f32x2){fexp(brefa) * e2pa, fexp(brefb) * e2pb}; *(LAS f32x2*)(E2 + 2 * lane) = (f32x2){e2a, e2b}; e2pa = e2a; e2pb = e2b; }
        }
#pragma unroll
        for (int i = 0; i < 8; ++i) { *(LAS unsigned*)(L + L_QP + (8 * w + i) * SQ + 4 * lane) = pk2(qa[i], qb[i]); *(LAS unsigned*)(L + L_KP + (8 * w + i) * SQ + 4 * lane) = pk2(ka[i], kb[i]); }
        { u32x4 a, bq; a.x = pk2(ka[0], ka[1]); a.y = pk2(ka[2], ka[3]); a.z = pk2(ka[4], ka[5]); a.w = pk2(ka[6], ka[7]);
          bq.x = pk2(kb[0], kb[1]); bq.y = pk2(kb[2], kb[3]); bq.z = pk2(kb[4], kb[5]); bq.w = pk2(kb[6], kb[7]);
          *(LAS u32x4*)(L + L_KPT + (2 * lane) * SV + 16 * w) = a; *(LAS u32x4*)(L + L_KPT + (2 * lane + 1) * SV + 16 * w) = bq; }
        if constexpr (TYPE < 2) {
            u32x4 a, bq;
            a.x = (uv[0] & 0xffffu) | (uv[1] << 16); a.y = (uv[2] & 0xffffu) | (uv[3] << 16); a.z = (uv[4] & 0xffffu) | (uv[5] << 16); a.w = (uv[6] & 0xffffu) | (uv[7] << 16);
            bq.x = (uv[0] >> 16) | (uv[1] & 0xffff0000u); bq.y = (uv[2] >> 16) | (uv[3] & 0xffff0000u); bq.z = (uv[4] >> 16) | (uv[5] & 0xffff0000u); bq.w = (uv[6] >> 16) | (uv[7] & 0xffff0000u);
            *(LAS u32x4*)(L + L_VT + (2 * lane) * SV + 16 * w) = a; *(LAS u32x4*)(L + L_VT + (2 * lane + 1) * SV + 16 * w) = bq;
        } else {
            const int hs = lane >> 5;
            const LAS float* cm = CUM + hs * 192; const float cl = cm[63];
            float v1a[8], v1b[8], v2a[8], v2b[8];
#pragma unroll
            for (int j = 0; j < 8; ++j) { const int s = 8 * w + j; const float dt = cm[64 + s], wgt = fexp(fminf(cl - cm[s], 0.f));
                v1a[j] = dt * xa[j]; v1b[j] = dt * xb[j]; v2a[j] = v1a[j] * wgt; v2b[j] = v1b[j] * wgt; }
            u32x4 a, bq;
            a.x = pk2(v1a[0], v1a[1]); a.y = pk2(v1a[2], v1a[3]); a.z = pk2(v1a[4], v1a[5]); a.w = pk2(v1a[6], v1a[7]);
            bq.x = pk2(v1b[0], v1b[1]); bq.y = pk2(v1b[2], v1b[3]); bq.z = pk2(v1b[4], v1b[5]); bq.w = pk2(v1b[6], v1b[7]);
            *(LAS u32x4*)(L + L_VT + (2 * lane) * SV + 16 * w) = a; *(LAS u32x4*)(L + L_VT + (2 * lane + 1) * SV + 16 * w) = bq;
            a.x = pk2(v2a[0], v2a[1]); a.y = pk2(v2a[2], v2a[3]); a.z = pk2(v2a[4], v2a[5]); a.w = pk2(v2a[6], v2a[7]);
            bq.x = pk2(v2b[0], v2b[1]); bq.y = pk2(v2b[2], v2b[3]); bq.z = pk2(v2b[4], v2b[5]); bq.w = pk2(v2b[6], v2b[7]);
            *(LAS u32x4*)(L + L_VT2 + (2 * lane) * SV + 16 * w) = a; *(LAS u32x4*)(L + L_VT2 + (2 * lane + 1) * SV + 16 * w) = bq;
        }
        lds_barrier();
        if constexpr (PF) { if (ck + 1 < SEQ / 64) LOAD_CHUNK(((ck + 1) & (SEQ / 64 - 1)) * 64); }
        if (w >= 5) {
            const int sb = (w == 7) ? 1 : 0, tb = (w == 5) ? 0 : 1;
            f32x16 X; ZERO16(X);
#pragma unroll
            for (int k4 = 0; k4 < 8; k4 += 4) { bf16x8 fk[4], fq[4];
#pragma unroll
                for (int u = 0; u < 4; ++u) { fk[u] = ldfrag(L + L_KP + (32 * sb + r) * SQ + (16 * (k4 + u) + 8 * hh) * 2); fq[u] = ldfrag(L + L_QP + (32 * tb + r) * SQ + (16 * (k4 + u) + 8 * hh) * 2); }
#pragma unroll
                for (int u = 0; u < 4; ++u) X = mfma32(fk[u], fq[u], X); }
            const int t = 32 * tb + r;
#pragma unroll
            for (int hs = 0; hs < (TYPE == 2 ? 2 : 1); ++hs) {
                float ct = 0.f, ddt = 0.f;
                if constexpr (TYPE == 2) { ct = CUM[hs * 192 + t]; ddt = (hs == 0 ? Dh[0] : Dh[1]) / CUM[hs * 192 + 64 + t]; }
#pragma unroll
                for (int g = 0; g < 4; ++g) { const int s0 = 32 * sb + 8 * g + 4 * hh;
                    float x0 = X[4 * g], x1 = X[4 * g + 1], x2 = X[4 * g + 2], x3 = X[4 * g + 3];
                    if constexpr (TYPE == 2) { const f32x4 cs = *(const LAS f32x4*)(CUM + hs * 192 + s0);
                        x0 *= fexp(fminf(ct - cs.x, 0.f)); x1 *= fexp(fminf(ct - cs.y, 0.f)); x2 *= fexp(fminf(ct - cs.z, 0.f)); x3 *= fexp(fminf(ct - cs.w, 0.f));
                        x0 += (s0 == t) ? ddt : 0.f; x1 += (s0 + 1 == t) ? ddt : 0.f; x2 += (s0 + 2 == t) ? ddt : 0.f; x3 += (s0 + 3 == t) ? ddt : 0.f; }
                    x0 = (s0 <= t) ? x0 : 0.f; x1 = (s0 + 1 <= t) ? x1 : 0.f; x2 = (s0 + 2 <= t) ? x2 : 0.f; x3 = (s0 + 3 <= t) ? x3 : 0.f;
                    u32x2 p; p.x = pk2(x0, x1); p.y = pk2(x2, x3);
                    *(LAS u32x2*)(L + L_AM + hs * 9216 + t * SV + s0 * 2) = p; }
            }
        }
        f32x16 O[2]; bf16x8 Bv[4];
        const int hsw = w >> 1;
        if (w < NSW) {
            if constexpr (TYPE < 2) {
#pragma unroll
                for (int kt = 0; kt < 4; ++kt)
#pragma unroll
                    for (int g = 0; g < 4; ++g) { const f32x4 e = *(const LAS f32x4*)(E1 + 32 * kt + 8 * g + 4 * hh);
                        S[kt][4 * g] *= e.x; S[kt][4 * g + 1] *= e.y; S[kt][4 * g + 2] *= e.z; S[kt][4 * g + 3] *= e.w; }
            }
            ZERO16(O[0]); ZERO16(O[1]);
#pragma unroll
            for (int kt = 0; kt < 4; ++kt) {
                u32x2 ql[2][2], qh[2][2];
#pragma unroll
                for (int s = 0; s < 2; ++s)
#pragma unroll
                    for (int tt = 0; tt < 2; ++tt) { const LAS unsigned char* qp = L + L_QP + (32 * tt + r) * SQ + (32 * kt + 16 * s + 4 * hh) * 2;
                        ql[s][tt] = *(const LAS u32x2*)qp; qh[s][tt] = *(const LAS u32x2*)(qp + 16); }
#pragma unroll
                for (int s = 0; s < 2; ++s) {
                    u32x4 pa; pa.x = pk2(S[kt][8 * s], S[kt][8 * s + 1]); pa.y = pk2(S[kt][8 * s + 2], S[kt][8 * s + 3]); pa.z = pk2(S[kt][8 * s + 4], S[kt][8 * s + 5]); pa.w = pk2(S[kt][8 * s + 6], S[kt][8 * s + 7]);
                    const bf16x8 A = __builtin_bit_cast(bf16x8, pa);
#pragma unroll
                    for (int tt = 0; tt < 2; ++tt) O[tt] = mfma32(A, __builtin_bit_cast(bf16x8, (u32x4){ql[s][tt].x, ql[s][tt].y, qh[s][tt].x, qh[s][tt].y}), O[tt]);
                }
            }
            if constexpr (TYPE == 2) {
                const LAS float* cm = CUM + hsw * 192; const float e0 = cm[128 + r], e1 = cm[128 + 32 + r], sc = cm[128 + 63];
#pragma unroll
                for (int i = 0; i < 16; ++i) { O[0][i] *= e0; O[1][i] *= e1; }
#pragma unroll
                for (int kt = 0; kt < 4; ++kt)
#pragma unroll
                    for (int i = 0; i < 16; ++i) S[kt][i] *= sc;
            }
#pragma unroll
            for (int st = 0; st < 4; ++st) { bf16x8 kf[4];
                Bv[st] = ldfrag(L + (TYPE == 2 ? L_VT2 : L_VT) + (32 * w + r) * SV + (16 * st + 8 * hh) * 2);
#pragma unroll
                for (int kt = 0; kt < 4; ++kt) kf[kt] = ldfrag(L + L_KPT + (32 * kt + r) * SV + (16 * st + 8 * hh) * 2);
#pragma unroll
                for (int kt = 0; kt < 4; ++kt) S[kt] = mfma32(kf[kt], Bv[st], S[kt]); }
        }
        const int nt_ = tid >> 3, nseg = tid & 7;
        u32x4 gq[NC / 8];
        { const bf16_t* pg = c.proj + (size_t)(row0 + t0 + nt_) * LDP + colGate + nseg * NC;
#pragma unroll
          for (int q = 0; q < NC / 8; ++q) gq[q] = *(const u32x4*)(pg + 8 * q); }
        lds_barrier();
        if (w < NSW) {
#pragma unroll
            for (int st = 0; st < 4; ++st) { bf16x8 Av = Bv[st];
                if constexpr (TYPE == 2) Av = ldfrag(L + L_VT + (32 * w + r) * SV + (16 * st + 8 * hh) * 2);
#pragma unroll
                for (int tt = 0; tt < 2; ++tt) if (st < 2 || tt == 1)
                    O[tt] = mfma32(Av, ldfrag(L + L_AM + (TYPE == 2 ? hsw * 9216 : 0) + (32 * tt + r) * SV + (16 * st + 8 * hh) * 2), O[tt]); }
#pragma unroll
            for (int tt = 0; tt < 2; ++tt)
#pragma unroll
                for (int g = 0; g < 4; ++g) { u32x2 p; p.x = pk2(O[tt][4 * g], O[tt][4 * g + 1]); p.y = pk2(O[tt][4 * g + 2], O[tt][4 * g + 3]);
                    *(LAS u32x2*)(L + (32 * tt + r) * OS + (32 * w + 8 * g + 4 * hh) * 2) = p; }
        }
        lds_barrier();
        {
            float o[NC], gv[NC]; float ss = 0.f;
#pragma unroll
            for (int q = 0; q < NC / 8; ++q) { const u32x4 ov = *(const LAS u32x4*)(L + nt_ * OS + (nseg * NC + 8 * q) * 2);
                o[8 * q] = bflo(ov.x); o[8 * q + 1] = bfhi(ov.x); o[8 * q + 2] = bflo(ov.y); o[8 * q + 3] = bfhi(ov.y); o[8 * q + 4] = bflo(ov.z); o[8 * q + 5] = bfhi(ov.z); o[8 * q + 6] = bflo(ov.w); o[8 * q + 7] = bfhi(ov.w);
                gv[8 * q] = bflo(gq[q].x); gv[8 * q + 1] = bfhi(gq[q].x); gv[8 * q + 2] = bflo(gq[q].y); gv[8 * q + 3] = bfhi(gq[q].y); gv[8 * q + 4] = bflo(gq[q].z); gv[8 * q + 5] = bfhi(gq[q].z); gv[8 * q + 6] = bflo(gq[q].w); gv[8 * q + 7] = bfhi(gq[q].w); }
            if constexpr (TYPE == 2) {
#pragma unroll
                for (int e = 0; e < NC; ++e) o[e] *= gv[e];
            }
#pragma unroll
            for (int e = 0; e < NC; ++e) ss += o[e] * o[e];
            ss += shx(ss, 1, lane); ss += shx(ss, 2, lane); ss += shx(ss, 4, lane);
            float mul = 1.0f;
            if constexpr (TYPE == 0) mul = rsqrtf(ss * (1.0f / DV) + EPS);
            else { if (nseg == 0 && ck >= 0) atomicAdd((float*)(c.ctl + CW_STATS) + ((size_t)l * TP + row0 + t0 + nt_) * 6 + sidx, ss); }
            if constexpr (TYPE < 2) {
#pragma unroll
                for (int e = 0; e < NC; ++e) o[e] *= mul * gv[e];
            }
            bf16_t* pm = c.mix + (size_t)(row0 + t0 + nt_) * D_MIX + colOut + nseg * NC;
#pragma unroll
            for (int q = 0; q < NC / 8; ++q) { u32x4 ov; ov.x = pk2(o[8 * q], o[8 * q + 1]); ov.y = pk2(o[8 * q + 2], o[8 * q + 3]); ov.z = pk2(o[8 * q + 4], o[8 * q + 5]); ov.w = pk2(o[8 * q + 6], o[8 * q + 7]);
                *(u32x4*)(pm + 8 * q) = ov; }
        }
    }
#undef LOAD_CHUNK
    if (w < NSW) {
        const int lane2 = get_tid(c.wave) & 63, r = lane2 & 31, hh = lane2 >> 5;
        if constexpr (TYPE < 2) {
#pragma unroll
            for (int kt = 0; kt < 4; ++kt)
#pragma unroll
                for (int g = 0; g < 4; ++g) { const f32x4 e = *(const LAS f32x4*)(E2 + 32 * kt + 8 * g + 4 * hh);
                    S[kt][4 * g] *= e.x; S[kt][4 * g + 1] *= e.y; S[kt][4 * g + 2] *= e.z; S[kt][4 * g + 3] *= e.w; }
        }
        float* sout; int sk, sv, vb;
        if constexpr (TYPE == 0) { sout = c.out + O_HG_P + (((size_t)l * NB + b) * 8 + hu) * 16384; sk = 128; sv = 1; vb = 32 * w; }
        else if constexpr (TYPE == 1) { sout = c.out + O_GLA_P + (((size_t)l * NB + b) * 4 + (hu >> 1)) * 32768; sk = 256; sv = 1; vb = 128 * (hu & 1) + 32 * w; }
        else { sout = c.out + O_SSD_P + (((size_t)l * NB + b) * 16 + 2 * hu + (w >> 1)) * 8192; sk = 1; sv = 128; vb = 32 * (w & 1); }
#pragma unroll
        for (int kt = 0; kt < 4; ++kt)
#pragma unroll
            for (int i = 0; i < 16; ++i) sout[(32 * kt + crow(i, hh)) * sk + (vb + r) * sv] = S[kt][i];
    }
}

constexpr int R_WT = 74752;
DI void rg_load_gates(const Ctx& c, int l, int n, int tid, int j, int hh, bf16x8 (&Br)[8], bf16x8 (&Bi)[8]) {
    LAS unsigned char* L = c.lds;
    const float* wr = c.in[I_WR] + (size_t)(l * 8 + n) * 128 * 128; const float* wi = c.in[I_WI] + (size_t)(l * 8 + n) * 128 * 128;
    __syncthreads();
    f32x4 v[16];
#pragma unroll
    for (int q = 0; q < 16; ++q) { const int e = tid + 512 * q, mat = e >> 12, rem = e & 4095; v[q] = *(const f32x4*)((mat ? wi : wr) + rem * 4); }
#pragma unroll
    for (int q = 0; q < 16; ++q) { const int e = tid + 512 * q, mat = e >> 12, rem = e & 4095, i = rem >> 5, j4 = (rem & 31) * 4;
        LAS unsigned char* p = L + R_WT + mat * 34816 + j4 * SQ + i * 2;
        *(LAS bf16_t*)(p) = (bf16_t)f2bf(v[q].x); *(LAS bf16_t*)(p + SQ) = (bf16_t)f2bf(v[q].y); *(LAS bf16_t*)(p + 2 * SQ) = (bf16_t)f2bf(v[q].z); *(LAS bf16_t*)(p + 3 * SQ) = (bf16_t)f2bf(v[q].w); }
    __syncthreads();
#pragma unroll
    for (int ks = 0; ks < 8; ++ks) { Br[ks] = ldfrag(L + R_WT + j * SQ + (16 * ks + 8 * hh) * 2); Bi[ks] = ldfrag(L + R_WT + 34816 + j * SQ + (16 * ks + 8 * hh) * 2); }
}
constexpr int R_XCB = 0, R_XCF = 17408, R_SUMA = 50176, R_SUMU = 58368, R_HIN = 66560;
DI void rg_chunk_unit(const Ctx& c, int l, int b, int n) {
    LAS unsigned char* L = c.lds;
    const int tid = get_tid(c.wave), lane = tid & 63, w = c.wave, r = lane & 31, hh = lane >> 5;
    const int tb = w >> 2, jb = w & 3;
    const int j = 32 * jb + r, ch = n * 128 + j;
    const int row0 = b * SEQ;
    const bf16_t* P = c.proj;
    LAS float* XCF = (LAS float*)(L + R_XCF); LAS float* SUMA = (LAS float*)(L + R_SUMA); LAS float* SUMU = (LAS float*)(L + R_SUMU); LAS float* HIN = (LAS float*)(L + R_HIN);
    bf16x8 Br[8], Bi[8];
    rg_load_gates(c, l, n, tid, j, hh, Br, Bi);
    const float sp = softplus(-c.in[I_LAM][l * 1024 + ch]), brv = c.in[I_BR][(l * 8 + n) * 128 + j], biv = c.in[I_BI][(l * 8 + n) * 128 + j];
    float cw[4][2], cb[2];
#pragma unroll
    for (int e = 0; e < 2; ++e) {
#pragma unroll
        for (int m = 0; m < 4; ++m) cw[m][e] = c.in[I_RCW][l * 4 * 1024 + m * 1024 + n * 128 + 2 * lane + e];
        cb[e] = c.in[I_RCB][l * 1024 + n * 128 + 2 * lane + e]; }
    float hcarry = 0.f;
    unsigned ux[11]; bf16_t gtr[16];
#define RG_LOAD(tn) do { const bf16_t* pq_ = P + (size_t)(row0 + (tn) + 8 * w) * LDP + C_RGX + n * 128 + 2 * lane; const bool first_ = ((tn) == 0 && w == 0); \
        _Pragma("unroll") for (int jx = 0; jx < 11; ++jx) ux[jx] = (first_ && jx < 3) ? 0u : *(const unsigned*)(pq_ + (ptrdiff_t)(jx - 3) * LDP); \
        const bf16_t* pg_ = P + (size_t)(row0 + (tn) + 32 * tb) * LDP; const int goff_ = 4 * hh * LDP + C_RGG + ch; \
        _Pragma("unroll") for (int i = 0; i < 16; ++i) gtr[i] = (pg_ + (size_t)((i & 3) + 8 * (i >> 2)) * LDP)[goff_]; } while (0)
    RG_LOAD(0);
    for (int ck = -(SEQ / 64) * (PROBE_RG_REP - 1); ck < SEQ / 64; ++ck) {
        if (PROBE_RG_REP > 1 && ck == 0) hcarry = 0.f;
        const int t0 = (ck & (SEQ / 64 - 1)) * 64;
#pragma unroll
        for (int i = 0; i < 8; ++i) { const int t = 8 * w + i;
            const float x0 = cb[0] + cw[0][0] * bflo(ux[i]) + cw[1][0] * bflo(ux[i + 1]) + cw[2][0] * bflo(ux[i + 2]) + cw[3][0] * bflo(ux[i + 3]);
            const float x1 = cb[1] + cw[0][1] * bfhi(ux[i]) + cw[1][1] * bfhi(ux[i + 1]) + cw[2][1] * bfhi(ux[i + 2]) + cw[3][1] * bfhi(ux[i + 3]);
            *(LAS f32x2*)(XCF + t * 128 + 2 * lane) = (f32x2){x0, x1}; *(LAS unsigned*)(L + R_XCB + t * SQ + 4 * lane) = pk2(x0, x1); }
        float gt[16];
#pragma unroll
        for (int i = 0; i < 16; ++i) gt[i] = bf1(gtr[i]);
        lds_barrier();
        if (ck + 1 < SEQ / 64) RG_LOAD(((ck + 1) & (SEQ / 64 - 1)) * 64);
        f32x16 R, I; ZERO16(R); ZERO16(I);
#pragma unroll
        for (int ks = 0; ks < 8; ++ks) { const bf16x8 a = ldfrag(L + R_XCB + (32 * tb + r) * SQ + (16 * ks + 8 * hh) * 2); R = mfma32(a, Br[ks], R); I = mfma32(a, Bi[ks], I); }
        float av[16], uv[16];
#pragma unroll
        for (int i = 0; i < 16; ++i) { const int t = 32 * tb + crow(i, hh); const float xc = XCF[t * 128 + j];
            const float e1 = fexp(fminf(-(R[i] + brv), 40.f)), e2 = fexp(fminf(-(I[i] + biv), 40.f)), p1 = 1.0f + e1, p2 = 1.0f + e2, inv = rcp(p1 * p2);
            const float rr = p2 * inv, ii = p1 * inv;
            const float la = -8.0f * rr * sp, a = fexp(la), x2 = 2.0f * la;
            const float ser = -x2 * (1.0f + 0.5f * x2 * (1.0f + 0.33333334f * x2 * (1.0f + 0.25f * x2 * (1.0f + 0.2f * x2))));
            const float om = fabsf(x2) < 0.25f ? ser : 1.0f - a * a;
            av[i] = a; uv[i] = __builtin_amdgcn_sqrtf(fmaxf(om, 0.f)) * (ii * xc); }
#pragma unroll
        for (int g = 0; g < 4; ++g) { float A = 1.f, U = 0.f;
#pragma unroll
            for (int m = 0; m < 4; ++m) { U = av[4 * g + m] * U + uv[4 * g + m]; A *= av[4 * g + m]; }
            const int gi = 8 * tb + 2 * g + hh; SUMA[gi * 128 + j] = A; SUMU[gi * 128 + j] = U; }
        lds_barrier();
        if (tid < 128) { float hc = hcarry, sa[16], su[16];
#pragma unroll
            for (int gi = 0; gi < 16; ++gi) { sa[gi] = SUMA[gi * 128 + tid]; su[gi] = SUMU[gi * 128 + tid]; }
#pragma unroll
            for (int gi = 0; gi < 16; ++gi) { HIN[gi * 128 + tid] = hc; hc = sa[gi] * hc + su[gi]; }
            hcarry = hc; }
        lds_barrier();
        { bf16_t* pm = c.mix + (size_t)(row0 + t0 + 32 * tb) * D_MIX; const int moff = 4 * hh * D_MIX + 1024 + ch;
#pragma unroll
          for (int g = 0; g < 4; ++g) { float hc = HIN[(8 * tb + 2 * g + hh) * 128 + j];
#pragma unroll
            for (int m = 0; m < 4; ++m) { const int i = 4 * g + m; hc = av[i] * hc + uv[i];
                (pm + (size_t)((i & 3) + 8 * (i >> 2)) * D_MIX)[moff] = (bf16_t)f2bf(hc * gt[i]); } } }
    }
#undef RG_LOAD
    if (tid < 128) c.out[O_RG_P + ((size_t)l * NB + b) * 1024 + n * 128 + tid] = hcarry;
    if (w == 7) {
#pragma unroll
        for (int jx = 0; jx < 3; ++jx) *(f32x2*)(c.out + O_RGC_P + ((size_t)l * NB + b) * 3072 + jx * 1024 + n * 128 + 2 * lane) = (f32x2){bflo(ux[8 + jx]), bfhi(ux[8 + jx])}; }
}

DI void rg_sample_unit(const Ctx& c, int l, int n) {
    LAS unsigned char* L = c.lds;
    const int tid = get_tid(c.wave), lane = tid & 63, w = c.wave, r = lane & 31, hh = lane >> 5;
    const int tb = w >> 2, jb = w & 3;
    const int j = 32 * jb + r, ch = n * 128 + j;
    LAS float* XCF = (LAS float*)(L + R_XCF);
    bf16x8 Br[8], Bi[8];
    rg_load_gates(c, l, n, tid, j, hh, Br, Bi);
    const float sp = softplus(-c.in[I_LAM][l * 1024 + ch]), brv = c.in[I_BR][(l * 8 + n) * 128 + j], biv = c.in[I_BI][(l * 8 + n) * 128 + j];
    float cw[4][2], cb[2];
#pragma unroll
    for (int e = 0; e < 2; ++e) {
#pragma unroll
        for (int m = 0; m < 4; ++m) cw[m][e] = c.in[I_RCW][l * 4 * 1024 + m * 1024 + n * 128 + 2 * lane + e];
        cb[e] = c.in[I_RCB][l * 1024 + n * 128 + 2 * lane + e]; }
    for (int chunk = 0; chunk < 2; ++chunk) {
        __syncthreads();
        f32x2 cb0[8], cb1[8], cb2[8], cxn[8];
#pragma unroll
        for (int i = 0; i < 8; ++i) { const int s = 64 * chunk + 8 * w + i;
            const float* buf = c.in[I_SRGC] + ((size_t)l * DEC + s) * 3 * 1024 + n * 128 + 2 * lane;
            cb0[i] = *(const f32x2*)buf; cb1[i] = *(const f32x2*)(buf + 1024); cb2[i] = *(const f32x2*)(buf + 2048);
            cxn[i] = (f32x2){ps4(c.projs + (size_t)s * LDP + C_RGX + n * 128 + 2 * lane), ps4(c.projs + (size_t)s * LDP + C_RGX + n * 128 + 2 * lane + 1)} * row_rstd(c.rowsq + (size_t)l * M_PAD, TP + s); }
#pragma unroll
        for (int i = 0; i < 8; ++i) { const int t = 8 * w + i, s = 64 * chunk + t;
            const f32x2 b0 = cb0[i], b1 = cb1[i], b2 = cb2[i], xn = cxn[i];
            const float x0 = cb[0] + cw[0][0] * b0.x + cw[1][0] * b1.x + cw[2][0] * b2.x + cw[3][0] * xn.x;
            const float x1 = cb[1] + cw[0][1] * b0.y + cw[1][1] * b1.y + cw[2][1] * b2.y + cw[3][1] * xn.y;
            *(LAS f32x2*)(XCF + t * 128 + 2 * lane) = (f32x2){x0, x1}; *(LAS unsigned*)(L + R_XCB + t * SQ + 4 * lane) = pk2(x0, x1);
            float* nb = c.out + O_RGC_S + ((size_t)l * DEC + s) * 3072 + n * 128 + 2 * lane;
            *(f32x2*)nb = b1; *(f32x2*)(nb + 1024) = b2; *(f32x2*)(nb + 2048) = xn; }
        __syncthreads();
        f32x16 R, I; ZERO16(R); ZERO16(I);
#pragma unroll
        for (int ks = 0; ks < 8; ++ks) { const bf16x8 a = ldfrag(L + R_XCB + (32 * tb + r) * SQ + (16 * ks + 8 * hh) * 2); R = mfma32(a, Br[ks], R); I = mfma32(a, Bi[ks], I); }
#pragma unroll
        for (int i = 0; i < 16; ++i) { const int t = 32 * tb + crow(i, hh), s = 64 * chunk + t;
            const float rr = sigm(R[i] + brv), ii = sigm(I[i] + biv), xc = XCF[t * 128 + j];
            const float la = -8.0f * rr * sp, a = fexp(la);
            const float hn = a * c.in[I_SRG][((size_t)l * DEC + s) * 1024 + ch] + sqrtf(fmaxf(neg_expm1(2.0f * la), 0.f)) * (ii * xc);
            c.mix[(size_t)(TP + s) * D_MIX + 1024 + ch] = (bf16_t)f2bf(hn * silu(ps4(c.projs + (size_t)s * LDP + C_RGG + ch) * row_rstd(c.rowsq + (size_t)l * M_PAD, TP + s)));
            c.out[O_RG_S + ((size_t)l * DEC + s) * 1024 + ch] = hn; }
    }
}

#ifndef PROBE_REP_LONG
#define PROBE_REP_LONG 1
#endif
#ifndef PROBE_G1_REP
#define PROBE_G1_REP 1
#endif
#ifndef PROBE_REP_SHORT
#define PROBE_REP_SHORT 1
#endif
DI void xbc_prepass_item(const Ctx& c, int l, int it) {
    const int tid = get_tid(c.wave);
    const float* scw = c.in[I_SCW] + (size_t)l * 4 * 1536; const float* scb = c.in[I_SCB] + (size_t)l * 1536;
    const int r0 = ((it & 7) >> 1) * SEQ + (it >> 3) * 64 + (it & 1) * 32;
    const bool head = (r0 & (SEQ - 1)) == 0;
    for (int p = tid; p < 768; p += 512) {
        float cw[4][2], cb[2];
#pragma unroll
        for (int e = 0; e < 2; ++e) { cb[e] = scb[2 * p + e];
#pragma unroll
            for (int m = 0; m < 4; ++m) cw[m][e] = scw[m * 1536 + 2 * p + e]; }
        const bf16_t* src = c.proj + (size_t)r0 * LDP + C_XBC + 2 * p; bf16_t* dst = c.xbcs + (size_t)r0 * 1536 + 2 * p;
        unsigned u[35];
#pragma unroll
        for (int i = 0; i < 35; ++i) u[i] = (head && i < 3) ? 0u : *(const unsigned*)(src + (ptrdiff_t)(i - 3) * LDP);
#pragma unroll
        for (int i = 0; i < 32; ++i) {
            const float a = silu(cb[0] + cw[0][0] * bflo(u[i]) + cw[1][0] * bflo(u[i + 1]) + cw[2][0] * bflo(u[i + 2]) + cw[3][0] * bflo(u[i + 3]));
            const float b = silu(cb[1] + cw[0][1] * bfhi(u[i]) + cw[1][1] * bfhi(u[i + 1]) + cw[2][1] * bfhi(u[i + 2]) + cw[3][1] * bfhi(u[i + 3]));
            __hip_atomic_store((unsigned*)(dst + (size_t)i * 1536), pk2(a, b), __ATOMIC_RELAXED, __HIP_MEMORY_SCOPE_AGENT); }
        if (((r0 + 32) & (SEQ - 1)) == 0) {
#pragma unroll
            for (int jx = 0; jx < 3; ++jx) *(f32x2*)(c.out + O_SSDC_P + ((size_t)l * NB + r0 / SEQ) * 4608 + jx * 1536 + 2 * p) = (f32x2){bflo(u[32 + jx]), bfhi(u[32 + jx])}; }
    }
}
DI void phase_mixer(int l, int wv) {
    const Ctx c = make_ctx(wv);
    constexpr int PER_B = 8 + 8 + 8 + 8;
    constexpr int N_LONG = NB * PER_B, N_SHORT = 8 + DEC * 3;
    constexpr int NREP = 1;
    volatile LAS int* slot = (volatile LAS int*)(c.lds + MISC_OFF + 64);
    unsigned* xpre = c.ctl + CW_XPRE + 128 * l;
    if (c.wg >= N_LONG || c.G <= N_LONG) {
        const int nfree = c.G > N_LONG ? c.G - N_LONG : c.G, first = c.G > N_LONG ? c.wg - N_LONG : c.wg;
        for (int it = first; it < TP / 32; it += nfree) {
            xbc_prepass_item(c, l, it);
            asm volatile("s_waitcnt vmcnt(0)" ::: "memory"); __syncthreads();
            if (c.tid == 0) __hip_atomic_fetch_add(xpre + (it < 128 ? 0 : 64), 1u, __ATOMIC_RELAXED, __HIP_MEMORY_SCOPE_AGENT);
        }
    }
    for (int rep = 0; rep < NREP; ++rep) {
    unsigned* ctr = c.ctl + CW_QCTR + 64 * (l * 4 + rep);
    int cur = c.wg; bool dyn = false;
    for (;;) {
        int item;
        if (!dyn) { if (cur < N_LONG) { item = cur; cur += c.G; } else { dyn = true; continue; } }
        else {
            __syncthreads();
            if (c.tid == 0) *slot = (int)atomicAdd(ctr, 1u);
            __syncthreads();
            item = N_LONG + *slot;
            if (item >= N_LONG + N_SHORT) break;
        }
        if (item < N_LONG) {
            const int b = item & 3, u = item >> 2;
            if (u < 8) la_head_unit<1>(c, l, b, u); else if (u < 16) la_head_unit<0>(c, l, b, u - 8); else if (u < 24) {
                if (c.tid == 0) { unsigned sp = 0; while (__hip_atomic_load(xpre, __ATOMIC_RELAXED, __HIP_MEMORY_SCOPE_AGENT) < 128u) { __builtin_amdgcn_s_sleep(8); if (++sp > (1u << 22)) break; }
                    __builtin_amdgcn_fence(__ATOMIC_ACQUIRE, "agent"); asm volatile("s_waitcnt vmcnt(0)" ::: "memory"); }
                __syncthreads();
                la_head_unit<2>(c, l, b, u - 16); } else rg_chunk_unit(c, l, b, u - 24);
            __syncthreads();
        } else { const int it = item - N_LONG;
            for (int rp = 0; rp < PROBE_REP_SHORT; ++rp) { if (it < 8) rg_sample_unit(c, l, it); else sample_item(c, l, (it - 8) / 3, (it - 8) % 3); } }
    }
    __syncthreads();
    }
}

DI void phase_dt(const Ctx& c, int l) {
    LAS float* PT = (LAS float*)c.lds;
    const int tid = get_tid(c.wave), lane = tid & 63, w = c.wave, r = lane & 31, hh = lane >> 5;
    for (int rt = c.wg; rt < TP / 32; rt += c.G) {
        const bf16_t* pa = c.xb + (size_t)(rt * 32 + r) * D_MODEL + w * 256 + 8 * hh;
        const bf16_t* pb = c.win + ((size_t)l * LDP + C_DT + r) * D_MODEL + w * 256 + 8 * hh;
        f32x16 acc; ZERO16(acc);
#pragma unroll
        for (int k4 = 0; k4 < 16; k4 += 8) { bf16x8 fa[8], fb[8];
#pragma unroll
            for (int u = 0; u < 8; ++u) { fa[u] = *(const bf16x8*)(pa + 16 * (k4 + u)); fb[u] = *(const bf16x8*)(pb + 16 * (k4 + u)); }
#pragma unroll
            for (int u = 0; u < 8; ++u) acc = mfma32(fa[u], fb[u], acc); }
        __syncthreads();
#pragma unroll
        for (int i = 0; i < 16; ++i) PT[w * 1024 + crow(i, hh) * 32 + r] = acc[i];
        __syncthreads();
        { const int row = tid >> 4, col = tid & 15; float s = 0.f;
#pragma unroll
          for (int q = 0; q < 8; ++q) s += PT[q * 1024 + row * 32 + col];
          c.dtb[(size_t)(rt * 32 + row) * 16 + col] = softplus(s * row_rstd(c.rowsq + (size_t)l * M_PAD, rt * 32 + row) + c.in[I_DTB][l * 16 + col]); }
    }
}

DI void g2_sample(const Ctx& c, int l) {
    LAS float* PT = (LAS float*)c.lds;
    const int tid = get_tid(c.wave), lane = tid & 63, w = c.wave, rr = lane & 15, quad = lane >> 4;
    float* rsq_next = c.rowsq + (size_t)(l + 1) * M_PAD;
    for (int it = c.wg; it < 4 * (D_MODEL / 32); it += c.G) {
        const int rb = it & 3, ct = it >> 2;
        const bf16_t* pa = c.mix + (size_t)(TP + 32 * rb + rr) * D_MIX + 512 * w + 8 * quad;
        const bf16_t* pb = c.wout + (size_t)l * D_MODEL * D_MIX + (size_t)(32 * ct + rr) * D_MIX + 512 * w + 8 * quad;
        f32x4 acc[2][2];
#pragma unroll
        for (int rt = 0; rt < 2; ++rt) { acc[rt][0] = (f32x4){0.f, 0.f, 0.f, 0.f}; acc[rt][1] = acc[rt][0]; }
        bf16x8 fa0[4][2], fb0[4][2], fa1[4][2], fb1[4][2];
#define G2S_LOAD(FA, FB, k4) do { _Pragma("unroll") for (int u = 0; u < 4; ++u) _Pragma("unroll") for (int t = 0; t < 2; ++t) { \
            FA[u][t] = *(const bf16x8*)(pa + (size_t)16 * t * D_MIX + 32 * ((k4) + u)); FB[u][t] = *(const bf16x8*)(pb + (size_t)16 * t * D_MIX + 32 * ((k4) + u)); } } while (0)
#define G2S_MMA(FA, FB) do { _Pragma("unroll") for (int u = 0; u < 4; ++u) _Pragma("unroll") for (int rt = 0; rt < 2; ++rt) _Pragma("unroll") for (int nt = 0; nt < 2; ++nt) \
            acc[rt][nt] = __builtin_amdgcn_mfma_f32_16x16x32_bf16(FA[u][rt], FB[u][nt], acc[rt][nt], 0, 0, 0); } while (0)
        G2S_LOAD(fa0, fb0, 0);
        G2S_LOAD(fa1, fb1, 4);
        G2S_MMA(fa0, fb0);
        G2S_LOAD(fa0, fb0, 8);
        G2S_MMA(fa1, fb1);
        G2S_LOAD(fa1, fb1, 12);
        G2S_MMA(fa0, fb0);
        G2S_MMA(fa1, fb1);
#undef G2S_LOAD
#undef G2S_MMA
        __syncthreads();
#pragma unroll
        for (int rt = 0; rt < 2; ++rt)
#pragma unroll
            for (int nt = 0; nt < 2; ++nt)
#pragma unroll
                for (int j = 0; j < 4; ++j) PT[(w * 32 + 16 * rt + 4 * quad + j) * 32 + 16 * nt + rr] = acc[rt][nt][j];
        __syncthreads();
        { const int row = tid >> 4, c2 = 2 * (tid & 15); float x0 = 0.f, x1 = 0.f;
#pragma unroll
          for (int q = 0; q < 8; ++q) { const f32x2 t = *(const LAS f32x2*)(PT + (q * 32 + row) * 32 + c2); x0 += t.x; x1 += t.y; }
          unsigned* xp = (unsigned*)(c.xb + (size_t)(TP + 32 * rb + row) * D_MODEL + 32 * ct + c2); const unsigned o = *xp;
          x0 += bflo(o); x1 += bfhi(o); *xp = pk2(x0, x1);
          float ss = x0 * x0 + x1 * x1; ss += shx(ss, 1, lane); ss += shx(ss, 2, lane); ss += shx(ss, 4, lane); ss += shx(ss, 8, lane);
          if ((tid & 15) == 0) atomicAdd(rsq_next + TP + 32 * rb + row, ss); }
    }
}

__global__ void __launch_bounds__(512, 2) mk_fwd(Params p) {
    extern __shared__ __attribute__((aligned(16))) unsigned char lds_raw[];
    LAS unsigned char* lds = (LAS unsigned char*)lds_raw;
    volatile LAS unsigned* misc = (volatile LAS unsigned*)(lds + MISC_OFF);
    const int wv = __builtin_amdgcn_readfirstlane(threadIdx.x >> 6);
    if (threadIdx.x < 32) misc[threadIdx.x] = 0u;
    __syncthreads();
    const int lo = p.ph_lo, hi = p.ph_hi;
    unsigned* barw = (unsigned*)(p.ws + WS_CTL) + CW_BAR;
    XcdBarrier bar; bar.bar = barw; bar.x = 0; bar.st = misc;
    if (hi - lo > 1) bar = xcd_barrier_post(barw, misc, get_tid(wv));
#define PH_IN(k) (lo <= (k) && (k) < hi)
#define SEAM(k) do { if (PH_IN(k) && PH_IN((k) + 1)) xcd_barrier(bar, wv); } while (0)
    if (PH_IN(0)) { phase_prologue(wv); }
    SEAM(0);
    for (int l = 0; l < DEPTH; ++l) {
        const int pb = 1 + 3 * l;
        if (PH_IN(pb)) {
            __syncthreads();
            const Ctx c = make_ctx(wv);
            {
                pg8::Gemm g{c.xb, c.win + (size_t)l * LDP * D_MODEL, TP, N_MAIN, D_MODEL, D_MODEL, D_MODEL}; pg8::StaticOrder S; S.init(TP, N_MAIN, c.G, c.wg); S.rep = PROBE_G1; S.balance = 1;
                pg8::EpiProj E{c.proj, c.lb + (size_t)l * 1024, c.in[I_HGN] + (size_t)l * 1024, c.in[I_GLN] + (size_t)l * 1024, c.in[I_GBU] + (size_t)l * 512, c.rowsq + (size_t)l * M_PAD};
                pg8::gemm_phase<pg8::EpiProj, pg8::StaticOrder>(c.lds, g, S, E, wv); }
            __syncthreads();
            {
                const int pn = c.wg % 49, ks = c.wg / 49;
                pg8::Gemm g{c.xb + (size_t)TP * D_MODEL + ks * 512, c.win + (size_t)l * LDP * D_MODEL + ks * 512, 256, LDP, 512, D_MODEL, D_MODEL};
                pg8::OneUnit S{0, pn, c.wg < 196 ? 1 : 0};
                pg8::EpiSample E{c.projs + (size_t)ks * PST};
                pg8::gemm_phase<pg8::EpiSample, pg8::OneUnit>(c.lds, g, S, E, wv); }
            __syncthreads();
            phase_dt(c, l);
            __syncthreads();
        }
        SEAM(pb);
        if (PH_IN(pb + 1)) phase_mixer(l, wv);
        SEAM(pb + 1);
        if (PH_IN(pb + 2)) {
            __syncthreads();
            const Ctx c = make_ctx(wv);
            {
                pg8::Gemm g{c.mix, c.wout + (size_t)l * D_MODEL * D_MIX, TP, D_MODEL, D_MIX, D_MIX, D_MIX}; pg8::StaticOrder S; S.init(TP, D_MODEL, c.G, c.wg);
                LAS float* tab = (LAS float*)(c.lds + pg8::STAGE_BYTES);
                pg8::EpiResid E{c.xb, c.rowsq + (size_t)(l + 1) * M_PAD, tab};
                const float* stats = (const float*)(c.ctl + CW_STATS) + (size_t)l * TP * 6;
                for (int i = 0; ; ++i) { pg8::Unit u; if (!S.next(i, u)) break;
                    __syncthreads();
                    { const int tid = get_tid(wv);
                      if (tid < 256) { const float* st = stats + (size_t)(u.pm * 256 + tid) * 6;
                        const f32x2 sa = *(const f32x2*)st, sb = *(const f32x2*)(st + 2), sc = *(const f32x2*)(st + 4);
                        const float d0 = __builtin_amdgcn_rsqf(sa.x * (1.0f / 512.0f) + EPS), d1 = __builtin_amdgcn_rsqf(sa.y * (1.0f / 512.0f) + EPS);
                        const float g0 = __builtin_amdgcn_rsqf(sb.x * (1.0f / 256.0f) + EPS), g1 = __builtin_amdgcn_rsqf(sb.y * (1.0f / 256.0f) + EPS), g2 = __builtin_amdgcn_rsqf(sc.x * (1.0f / 256.0f) + EPS), g3 = __builtin_amdgcn_rsqf(sc.y * (1.0f / 256.0f) + EPS);
                        tab[tid] = rcp(g0); tab[256 + tid] = g0 * rcp(g1); tab[512 + tid] = g1 * rcp(g2); tab[768 + tid] = g2 * rcp(g3); tab[1024 + tid] = g3 * rcp(d0); tab[1280 + tid] = d0 * rcp(d1); tab[1536 + tid] = d1; } }
                    __syncthreads();
                    pg8::OneUnit O{u.pm, u.pn, 1};
                    pg8::gemm_phase<pg8::EpiResid, pg8::OneUnit>(c.lds, g, O, E, wv); }
            }
            __syncthreads();
            g2_sample(c, l);
        }
        SEAM(pb + 2);
    }
    if (PH_IN(NPHASE - 1)) phase_final_norm(wv);
#undef PH_IN
#undef SEAM
}

extern "C" void kernel_launch(void* const* d_in, const int* in_sizes, int n_in, void* d_out, int out_size, void* d_ws, size_t ws_size, hipStream_t stream) {
    static int grid = 0;
    if (grid == 0) {
        if (n_in != N_INPUTS || (size_t)out_size != O_END || ws_size < WS_END) { fprintf(stderr, "kernel_launch: unexpected shapes (n_in %d out %d ws %zu)\n", n_in, out_size, ws_size); grid = -1; return; }
        int dev = 0, cus = 0;
        if (hipGetDevice(&dev) != hipSuccess || hipDeviceGetAttribute(&cus, hipDeviceAttributeMultiprocessorCount, dev) != hipSuccess) { grid = -1; return; }
        if (hipFuncSetAttribute((const void*)mk_fwd, hipFuncAttributeMaxDynamicSharedMemorySize, LDS_BYTES) != hipSuccess) { fprintf(stderr, "kernel_launch: hipFuncSetAttribute failed\n"); grid = -1; return; }
        int per_cu = 0;
        if (hipOccupancyMaxActiveBlocksPerMultiprocessor(&per_cu, (const void*)mk_fwd, 512, LDS_BYTES) != hipSuccess || per_cu < 1) fprintf(stderr, "kernel_launch: occupancy query says %d\n", per_cu);
        (void)hipGetLastError();
        grid = cus;
    }
    if (grid < 0) return;
    (void)hipMemsetAsync((char*)d_ws + WS_CTL, 0, CTL_ZERO_BYTES, stream);
    Params p{};
    for (int i = 0; i < N_INPUTS; ++i) p.in[i] = (const float*)d_in[i];
    p.out = (float*)d_out; p.ws = (unsigned char*)d_ws;
#if MK_ONE_LAUNCH
    p.ph_lo = 0; p.ph_hi = NPHASE;
    hipLaunchKernelGGL(mk_fwd, dim3(grid), dim3(512), LDS_BYTES, stream, p);
#else
    for (int ph = 0; ph < NPHASE; ++ph) { p.ph_lo = ph; p.ph_hi = ph + 1; hipLaunchKernelGGL(mk_fwd, dim3(grid), dim3(512), LDS_BYTES, stream, p); }
#endif
}
```

```cpp
#include <hip/hip_runtime.h>
#include <cstdio>
#include <cstdint>

#ifndef MK_ONE_LAUNCH
#define MK_ONE_LAUNCH 1
#endif

#ifndef PROBE_LONG_REP
#define PROBE_LONG_REP 1
#endif
#ifndef PROBE_RG_REP
#define PROBE_RG_REP PROBE_LONG_REP
#endif
#ifndef PROBE_G1_NOEPI
#define PROBE_G1_NOEPI 0
#endif
#ifndef PROBE_G2
#define PROBE_G2 0
#endif
#ifndef PROBE_G1
#define PROBE_G1 1
#endif
#define LAS __attribute__((address_space(3)))
#define DI __device__ __forceinline__

constexpr int D_MODEL = 2048, NB = 4, SEQ = 2048, DEPTH = 4, DEC = 128;
constexpr int BRANCH = 1024, D_MIX = 4096;
constexpr int TP = NB * SEQ;
constexpr int TT = TP + DEC;
constexpr int M_PAD = 8448;
constexpr int N_IN = 11808;
constexpr int LDP = 12544;
constexpr int N_MAIN = 12288;
constexpr int PST = 128 * LDP;
constexpr float EPS = 1e-6f, TINY = 1e-30f;
constexpr int C_HGQ = 0, C_HGF = 1024, C_HGI = 2048, C_HGG = 3072, C_RGX = 4096, C_RGG = 5120, C_GLQ = 6144, C_GLK = 6656, C_GLV = 7168, C_GLG = 8192,
              C_GLF = 9216, C_SSZ = 9728, C_XBC = 10752, C_DT = 12288;
constexpr int SRC_GLA = 9216, SRC_SSZ = 9232, SRC_DT = 11792;
enum { I_XP = 0, I_XS, I_SHG, I_SRG, I_SRGC, I_SGLA, I_SSSD, I_SSSDC, I_RMS, I_WIN, I_LB, I_HGN, I_RCW, I_RCB, I_WR, I_BR, I_WI, I_BI, I_LAM,
       I_GWU, I_GBU, I_GLN, I_SCW, I_SCB, I_DTB, I_ALOG, I_SD, I_SSN, I_WOUT, I_RMSF, N_INPUTS };
constexpr size_t O_YP = 0, O_YS = (size_t)TP * D_MODEL, O_HG_P = O_YS + (size_t)DEC * D_MODEL,
    O_RG_P = O_HG_P + (size_t)DEPTH * NB * 131072, O_RGC_P = O_RG_P + (size_t)DEPTH * NB * 1024, O_GLA_P = O_RGC_P + (size_t)DEPTH * NB * 3072,
    O_SSD_P = O_GLA_P + (size_t)DEPTH * NB * 131072, O_SSDC_P = O_SSD_P + (size_t)DEPTH * NB * 131072, O_HG_S = O_SSDC_P + (size_t)DEPTH * NB * 4608,
    O_RG_S = O_HG_S + (size_t)DEPTH * DEC * 131072, O_RGC_S = O_RG_S + (size_t)DEPTH * DEC * 1024, O_GLA_S = O_RGC_S + (size_t)DEPTH * DEC * 3072,
    O_SSD_S = O_GLA_S + (size_t)DEPTH * DEC * 131072, O_SSDC_S = O_SSD_S + (size_t)DEPTH * DEC * 131072, O_END = O_SSDC_S + (size_t)DEPTH * DEC * 4608;
constexpr size_t MiB = 1u << 20;
constexpr size_t WS_CTL = 0, CTL_ZERO_BYTES = 2 * MiB, WS_LB = 2 * MiB, WS_WIN = 3 * MiB, WS_WOUT = 199 * MiB, WS_XB = 263 * MiB, WS_PROJ = 296 * MiB,
    WS_DTB = 492 * MiB, WS_MIX = 493 * MiB, WS_PROJS = 559 * MiB, WS_XBCS = 584 * MiB, WS_END = 608 * MiB;
static_assert(WS_WIN + (size_t)DEPTH * LDP * D_MODEL * 2 <= WS_WOUT && WS_WOUT + (size_t)DEPTH * D_MODEL * D_MIX * 2 <= WS_XB && WS_XB + (size_t)M_PAD * D_MODEL * 2 <= WS_PROJ &&
              WS_PROJ + (size_t)TP * LDP * 2 <= WS_DTB && WS_DTB + (size_t)TP * 16 * 4 <= WS_MIX &&
              WS_MIX + (size_t)M_PAD * D_MIX * 2 <= WS_PROJS && WS_PROJS + (size_t)4 * DEC * LDP * 4 <= WS_XBCS && WS_XBCS + (size_t)TP * 1536 * 2 <= WS_END, "ws map");
constexpr int CW_BAR = 4096, CW_QCTR = 16384, CW_XPRE = 24576  , CW_STATS = 32768, CW_ROWSQ = 262144;
static_assert(CW_STATS + DEPTH * TP * 6 <= CW_ROWSQ && (size_t)(CW_ROWSQ + (DEPTH + 1) * M_PAD) * 4 <= CTL_ZERO_BYTES, "ctl map");
constexpr int LDS_BYTES = 147456, MISC_OFF = LDS_BYTES - 256;
constexpr int NPHASE = 2 + 3 * DEPTH;

typedef unsigned short bf16_t;
typedef short bf16x8 __attribute__((ext_vector_type(8)));
typedef float f32x4 __attribute__((ext_vector_type(4)));
typedef float f32x2 __attribute__((ext_vector_type(2)));
typedef float f32x16 __attribute__((ext_vector_type(16)));
typedef unsigned u32x4 __attribute__((ext_vector_type(4)));
typedef unsigned u32x2 __attribute__((ext_vector_type(2)));
typedef __bf16 bf16v2 __attribute__((ext_vector_type(2)));

DI unsigned pk2(float lo, float hi) { const f32x2 v = {lo, hi}; return __builtin_bit_cast(unsigned, __builtin_convertvector(v, bf16v2)); }
DI unsigned f2bf(float f) { return pk2(f, 0.f) & 0xffffu; }
DI float bflo(unsigned u) { return __builtin_bit_cast(float, u << 16); }
DI float bfhi(unsigned u) { return __builtin_bit_cast(float, u & 0xffff0000u); }
DI float bf1(bf16_t u) { return __builtin_bit_cast(float, (unsigned)u << 16); }
DI float ex2(float x) { return __builtin_amdgcn_exp2f(x); }
DI float lg2(float x) { return __builtin_amdgcn_logf(x); }
DI float rcp(float x) { return __builtin_amdgcn_rcpf(x); }
constexpr float LOG2E = 1.4426950408889634f, LN2 = 0.6931471805599453f;
DI float fexp(float x) { return ex2(x * LOG2E); }
DI float flog(float x) { return lg2(x) * LN2; }
DI float sigm(float x) { return rcp(1.0f + fexp(-x)); }
DI float silu(float x) { return x * sigm(x); }
DI float sigm_fast(float x) { return sigm(x); }
DI float silu_fast(float x) { return silu(x); }
DI float log1p_pos(float e) { const float a = e * (1.0f - e * (0.5f - e * (0.33333334f - 0.25f * e))), b = flog(1.0f + e); return e < 0.03f ? a : b; }
DI float softplus(float x) { return fmaxf(x, 0.f) + log1p_pos(fexp(-fabsf(x))); }
DI float neg_expm1(float x) { const float a = -x * (1.0f + 0.5f * x * (1.0f + 0.33333334f * x * (1.0f + 0.25f * x * (1.0f + 0.2f * x)))), b = 1.0f - fexp(x); return fabsf(x) < 0.25f ? a : b; }
DI float row_rstd(const float* rowsq, int row) { return __builtin_amdgcn_rsqf(rowsq[row] * (1.0f / D_MODEL) + EPS); }
DI float clampf(float x, float lo, float hi) { return fminf(fmaxf(x, lo), hi); }
DI float shx(float v, int mask, int lane) { return __builtin_bit_cast(float, __builtin_amdgcn_ds_bpermute((lane ^ mask) << 2, __builtin_bit_cast(int, v))); }
DI float shup(float v, int o, int lane) { return __builtin_bit_cast(float, __builtin_amdgcn_ds_bpermute((lane >= o ? lane - o : lane) << 2, __builtin_bit_cast(int, v))); }
DI float wave_sum(float v, int lane) {
#pragma unroll
    for (int o = 1; o < 64; o <<= 1) v += shx(v, o, lane);
    return v;
}

struct Params { const float* in[N_INPUTS]; float* out; unsigned char* ws; int ph_lo, ph_hi; };
static_assert(sizeof(Params) == N_INPUTS * 8 + 8 + 8 + 8, "no padding holes in Params");
typedef const __attribute__((address_space(4))) Params* KP;
DI KP get_params() { auto kp = __builtin_amdgcn_kernarg_segment_ptr(); asm volatile("" : "+s"(kp)); return (KP)kp; }
DI int get_tid(int wv) { int ln; asm volatile("v_mbcnt_lo_u32_b32 %0, -1, 0\n\tv_mbcnt_hi_u32_b32 %0, -1, %0" : "=v"(ln)); return (wv << 6) | ln; }

#define XB_TMO      128
#define XB_XCNT(j)  (256  + 64 * (j))
#define XB_XSUB(j)  (1280 + 64 * (j))
#define XB_XGEN(j)  (2304 + 64 * (j))
#define XB_TOP      3328
#define XB_TOPGEN   3392
#define XCD_BAR_WORDS 3456
#define XB_SPIN_CAP (1u << 20)
DI unsigned xb_ld(unsigned* p)              { return __hip_atomic_load(p, __ATOMIC_RELAXED, __HIP_MEMORY_SCOPE_AGENT); }
DI unsigned xb_add(unsigned* p, unsigned v) { return __hip_atomic_fetch_add(p, v, __ATOMIC_RELAXED, __HIP_MEMORY_SCOPE_AGENT); }
DI unsigned xb_xcc_id() { return (unsigned)__builtin_amdgcn_s_getreg((3 << 11) | 20) & 0xFu; }
#define XB_SPIN(cond, bar) do { unsigned _sp = 0; while (cond) { __builtin_amdgcn_s_sleep(1); \
    if ((++_sp & 255u) == 0u) { if (xb_ld(&(bar)[XB_TMO])) break; if (_sp > XB_SPIN_CAP) { atomicAdd(&(bar)[XB_TMO], 1u); break; } } } } while (0)
struct XcdBarrier { unsigned* bar; unsigned x; volatile LAS unsigned* st; };
DI XcdBarrier xcd_barrier_post(unsigned* bar, volatile LAS unsigned* st, int tid) {
    XcdBarrier b; b.bar = bar; b.x = xb_xcc_id(); b.st = st;
    if (tid == 0) (void)xb_add(&bar[XB_XCNT(b.x)], 1u);
    return b;
}
DI void xcd_barrier_complete(unsigned* bar, unsigned x, unsigned& nloc, unsigned& nx) {
    const unsigned G = gridDim.x * gridDim.y * gridDim.z;
    unsigned sum, cnt, mine, sp = 0u;
    for (;;) {
        sum = 0u; cnt = 0u; mine = 0u;
#pragma unroll
        for (unsigned j = 0; j < 16; ++j) { const unsigned c = xb_ld(&bar[XB_XCNT(j)]); sum += c; cnt += (c > 0u) ? 1u : 0u; mine = (j == x) ? c : mine; }
        if (sum == G) break;
        __builtin_amdgcn_s_sleep(1);
        if ((++sp & 255u) == 0u) { if (xb_ld(&bar[XB_TMO])) break; if (sp > XB_SPIN_CAP) { atomicAdd(&bar[XB_TMO], 1u); break; } }
    }
    nloc = mine > 0u ? mine : 1u; nx = cnt > 0u ? cnt : 1u;
}
DI void xcd_barrier(const XcdBarrier& b, int wv) {
    asm volatile("s_waitcnt vmcnt(0)" ::: "memory");
    __syncthreads();
    if (get_tid(wv) == 0) {
        unsigned* bar = b.bar;
        __builtin_amdgcn_s_waitcnt(0);
        unsigned nloc = b.st[0], nx = b.st[1];
        if (nloc == 0u) { xcd_barrier_complete(bar, b.x, nloc, nx); b.st[0] = nloc; b.st[1] = nx; }
        const unsigned old = xb_add(&bar[XB_XSUB(b.x)], 1u);
        const unsigned gen = old / nloc;
        if (old + 1u == (gen + 1u) * nloc) {
            __builtin_amdgcn_fence(__ATOMIC_RELEASE, "agent");
            asm volatile("s_waitcnt vmcnt(0)" ::: "memory");
            const unsigned og = xb_add(&bar[XB_TOP], 1u);
            const unsigned tg = og / nx;
            if (og + 1u == (tg + 1u) * nx) xb_add(&bar[XB_TOPGEN], 1u);
            else XB_SPIN(xb_ld(&bar[XB_TOPGEN]) == tg, bar);
            __builtin_amdgcn_fence(__ATOMIC_ACQUIRE, "agent");
            xb_add(&bar[XB_XGEN(b.x)], 1u);
            asm volatile("s_waitcnt vmcnt(0)" ::: "memory");
        } else {
            XB_SPIN(xb_ld(&bar[XB_XGEN(b.x)]) == gen, bar);
            __builtin_amdgcn_fence(__ATOMIC_ACQUIRE, "agent");
            asm volatile("s_waitcnt vmcnt(0)" ::: "memory");
        }
    }
    __syncthreads();
}

namespace pg8 {
constexpr int BM = 256, BK = 64, HALF = 128, HTB = HALF * BK * 2, STAGE_BYTES = 8 * HTB, NXCD = 8, WGM = 8;
DI int lds_byte(int r, int c) { const int st = (r >> 4) * 2 + (c >> 5), rr = r & 15, cc = c & 31, ob = rr * 64 + cc * 2; return st * 1024 + (ob ^ (((ob >> 9) & 1) << 5)); }
DI void stage_rc(int b, int& R, int& C) { const int st = b / 1024, sb = b % 1024, swz = sb ^ (((sb >> 9) & 1) << 5); R = (st >> 1) * 16 + swz / 64; C = (st & 1) * 32 + (swz % 64) / 2; }
DI int perm32(int rho) { const int n = rho >> 4, i = rho & 15; return 8 * (i >> 2) + 4 * n + (i & 3); }
struct Unit { int pm, pn; };
struct Gemm { const bf16_t* A; const bf16_t* Bt; int M, N, K, lda, ldb; };
struct StaticOrder {
    int nM, nN, nwg, G, c, rep = 1, balance = 0;
    DI void init(int M, int N, int G_, int c_) { nM = M / BM; nN = N / BM; nwg = nM * nN; G = G_; c = c_; }
    DI bool next(int i, Unit& u) const {
        const long L = (long)(i / rep) * G + c; if (L >= nwg) return false;
        int wgid = (int)L; { const int q = nwg / NXCD, r = nwg % NXCD, xcd = wgid % NXCD, off = wgid / NXCD; wgid = (xcd < r ? xcd * (q + 1) : r * (q + 1) + (xcd - r) * q) + off; }
        const int nig = WGM * nN, gid = wgid / nig, fm = gid * WGM, gsz = (nM - fm) < WGM ? (nM - fm) : WGM;
        u.pm = fm + ((wgid % nig) % gsz); u.pn = (wgid % nig) / gsz;
        if (balance) {
            const int p = u.pn / 24, r = u.pn % 24, i = r >> 2, j = r & 3;
            const unsigned long long T0 = 0x1810080c0004ull  , T1 = 0x2a1e1c161424ull  , T2 = 0x2e2c28262220ull  ;
            u.pn = p == 0 ? (int)((T0 >> (8 * i)) & 0xff) + j : j < 2 ? (int)((T1 >> (8 * i)) & 0xff) + j : (int)((T2 >> (8 * i)) & 0xff) + (j - 2);
        }
        return true;
    }
    DI void a_ready(const Unit&) const {}
    DI void done(const Unit&) const {}
};
struct EpiProj {
    static constexpr bool PERM = true, TWICE = PROBE_G1_NOEPI != 0, KSCALE = false;
    bf16_t* P; const float* lb; const float* hgn; const float* gln; const float* bup; const float* rsq;
    template <int MODE>
    DI void body(const f32x4 (&acc)[2][2][4][2], bf16_t* prow, const float* vec, float scale, const float (&rs)[2][4]) const {
        f32x4 cv[2][2];
#pragma unroll
        for (int bj = 0; bj < 2; ++bj) { cv[bj][0] = (f32x4){1.f, 1.f, 1.f, 1.f}; cv[bj][1] = cv[bj][0];
            if constexpr (MODE >= 2) { cv[bj][0] = *(const f32x4*)(vec + bj * HALF); cv[bj][1] = *(const f32x4*)(vec + bj * HALF + 4); } }
#pragma unroll
        for (int bj = 0; bj < 2; ++bj) {
            const f32x4 c0 = cv[bj][0], c1 = cv[bj][1];
#pragma unroll
            for (int ai = 0; ai < 2; ++ai)
#pragma unroll
                for (int m = 0; m < 4; ++m) {
                    f32x4 a = acc[ai][bj][m][0] * rs[ai][m], b = acc[ai][bj][m][1] * rs[ai][m];
                    if constexpr (MODE == 0) { a = a * scale; b = b * scale; }
                    else if constexpr (MODE == 1) { a = (f32x4){silu(a.x), silu(a.y), silu(a.z), silu(a.w)}; b = (f32x4){silu(b.x), silu(b.y), silu(b.z), silu(b.w)}; }
                    else if constexpr (MODE == 2) { a = (f32x4){silu(a.x), silu(a.y), silu(a.z), silu(a.w)} * c0; b = (f32x4){silu(b.x), silu(b.y), silu(b.z), silu(b.w)} * c1; }
                    else if constexpr (MODE == 3) {
#define LOGF(x, l) flog(fmaxf((l) + (1.0f - (l)) * sigm(x), TINY))
                        a = (f32x4){LOGF(a.x, c0.x), LOGF(a.y, c0.y), LOGF(a.z, c0.z), LOGF(a.w, c0.w)}; b = (f32x4){LOGF(b.x, c1.x), LOGF(b.y, c1.y), LOGF(b.z, c1.z), LOGF(b.w, c1.w)};
#undef LOGF
                    } else {
#define LSIG(x, bb) (-0.0625f * (fmaxf(-((x) + (bb)), 0.f) + flog(1.0f + fexp(-fabsf((x) + (bb))))))
                        a = (f32x4){LSIG(a.x, c0.x), LSIG(a.y, c0.y), LSIG(a.z, c0.z), LSIG(a.w, c0.w)}; b = (f32x4){LSIG(b.x, c1.x), LSIG(b.y, c1.y), LSIG(b.z, c1.z), LSIG(b.w, c1.w)};
#undef LSIG
                    }
                    u32x4 w4; w4.x = pk2(a.x, a.y); w4.y = pk2(a.z, a.w); w4.z = pk2(b.x, b.y); w4.w = pk2(b.z, b.w);
                    *(u32x4*)(prow + (size_t)(ai * HALF + m * 16) * LDP + bj * HALF) = w4;
                }
        }
    }
    DI void operator()(const f32x4 (&acc)[2][2][4][2], const Unit& u, int wr, int wc, int fr, int fq) const {
        const int col = u.pn * BM + wc * 32 + 8 * fq;
        bf16_t* prow = P + (size_t)(u.pm * BM + wr * 64 + fr) * LDP + col;
        float rs[2][4];
#pragma unroll
        for (int ai = 0; ai < 2; ++ai)
#pragma unroll
            for (int m = 0; m < 4; ++m) rs[ai][m] = rsq[u.pm * BM + wr * 64 + fr + ai * HALF + m * 16];
#pragma unroll
        for (int ai = 0; ai < 2; ++ai)
#pragma unroll
            for (int m = 0; m < 4; ++m) rs[ai][m] = __builtin_amdgcn_rsqf(rs[ai][m] * (1.0f / D_MODEL) + EPS);
        const int pn = u.pn;
        if (pn < 4) body<1>(acc, prow, nullptr, 1.f, rs);
        else if (pn < 8) body<3>(acc, prow, lb + (col - C_HGF), 1.f, rs);
        else if (pn < 12) body<0>(acc, prow, nullptr, 1.f, rs);
        else if (pn < 16) body<2>(acc, prow, hgn + (col - C_HGG), 1.f, rs);
        else if (pn < 20) body<0>(acc, prow, nullptr, 1.f, rs);
        else if (pn < 24) body<1>(acc, prow, nullptr, 1.f, rs);
        else if (pn < 26) body<0>(acc, prow, nullptr, 0.08838834764831845f, rs);
        else if (pn < 32) body<0>(acc, prow, nullptr, 1.f, rs);
        else if (pn < 36) body<2>(acc, prow, gln + (col - C_GLG), 1.f, rs);
        else if (pn < 38) body<4>(acc, prow, bup + (col - C_GLF), 1.f, rs);
        else if (pn < 42) body<1>(acc, prow, nullptr, 1.f, rs);
        else body<0>(acc, prow, nullptr, 1.f, rs);
    }
};
struct EpiSample {
    static constexpr bool PERM = false, TWICE = false, KSCALE = false;
    float* PS;
    DI void operator()(const f32x4 (&acc)[2][2][4][2], const Unit& u, int wr, int wc, int fr, int fq) const {
        const int row0 = wr * 64 + fr, col0 = u.pn * BM + wc * 32 + 4 * fq;
#pragma unroll
        for (int m = 0; m < 4; ++m) { float* op = PS + (size_t)(row0 + m * 16) * LDP + col0;
#pragma unroll
            for (int bj = 0; bj < 2; ++bj)
#pragma unroll
                for (int n = 0; n < 2; ++n) *(f32x4*)(op + bj * HALF + n * 16) = acc[0][bj][m][n]; }
    }
};
struct EpiResid {
    static constexpr bool PERM = true, TWICE = false, KSCALE = true;
    bf16_t* xb; float* rsq_next; const LAS float* tab;
    DI void rescale(f32x4 (&acc)[2][2][4][2], int seg, int wr, int fr) const {
#pragma unroll
        for (int ai = 0; ai < 2; ++ai)
#pragma unroll
            for (int m = 0; m < 4; ++m) { const float r = tab[seg * 256 + ai * HALF + wr * 64 + m * 16 + fr];
#pragma unroll
                for (int bj = 0; bj < 2; ++bj) { acc[ai][bj][m][0] = acc[ai][bj][m][0] * r; acc[ai][bj][m][1] = acc[ai][bj][m][1] * r; } }
    }
    DI void operator()(f32x4 (&acc)[2][2][4][2], const Unit& u, int wr, int wc, int fr, int fq) const {
        rescale(acc, 6, wr, fr);
        const int row0 = u.pm * BM + wr * 64 + fr, col0 = u.pn * BM + wc * 32 + 8 * fq;
#pragma unroll
        for (int ai = 0; ai < 2; ++ai) {
            u32x4 ob[4][2];
#pragma unroll
            for (int m = 0; m < 4; ++m)
#pragma unroll
                for (int bj = 0; bj < 2; ++bj) ob[m][bj] = *(const u32x4*)(xb + (size_t)(row0 + ai * HALF + m * 16) * D_MODEL + col0 + bj * HALF);
#pragma unroll
            for (int m = 0; m < 4; ++m) { const int row = row0 + ai * HALF + m * 16; bf16_t* xp = xb + (size_t)row * D_MODEL + col0; float ss = 0.f;
#pragma unroll
                for (int bj = 0; bj < 2; ++bj) { const u32x4 o = ob[m][bj]; const f32x4 a = acc[ai][bj][m][0], b = acc[ai][bj][m][1];
                    const float x0 = bflo(o.x) + a.x, x1 = bfhi(o.x) + a.y, x2 = bflo(o.y) + a.z, x3 = bfhi(o.y) + a.w, x4 = bflo(o.z) + b.x, x5 = bfhi(o.z) + b.y, x6 = bflo(o.w) + b.z, x7 = bfhi(o.w) + b.w;
                    ss += ((x0 * x0 + x1 * x1) + (x2 * x2 + x3 * x3)) + ((x4 * x4 + x5 * x5) + (x6 * x6 + x7 * x7));
                    u32x4 n4; n4.x = pk2(x0, x1); n4.y = pk2(x2, x3); n4.z = pk2(x4, x5); n4.w = pk2(x6, x7); *(u32x4*)(xp + bj * HALF) = n4; }
                const int lane = fq * 16 + fr; ss += shx(ss, 16, lane); ss += shx(ss, 32, lane);
                if (fq == 0) atomicAdd(rsq_next + row, ss); }
        }
    }
};
struct OneUnit {
    int pm, pn, have;
    DI bool next(int i, Unit& u) const { if (i != 0 || !have) return false; u.pm = pm; u.pn = pn; return true; }
    DI void a_ready(const Unit&) const {}
    DI void done(const Unit&) const {}
};
template <class Epi, class Sched>
DI void gemm_phase(LAS unsigned char* lds, const Gemm g, const Sched& S, const Epi& E, int wv) {
    const int tid = get_tid(wv), wid = wv, lane = tid & 63, wr = wid >> 2, wc = wid & 3, fr = lane & 15, fq = lane >> 4;
    const int K = g.K, nt = K / BK;
    unsigned voffA[2], voffB[2];
#pragma unroll
    for (int i = 0; i < 2; ++i) { int R, C; stage_rc(tid * 16 + i * 8192, R, C); const int Rb = Epi::PERM ? ((R & ~31) + perm32(R & 31)) : R;
        voffA[i] = (unsigned)(R * g.lda + C) * 2u; voffB[i] = (unsigned)(Rb * g.ldb + C) * 2u; }
    const size_t kstep = (size_t)(BK * 2);
    const size_t hstepA = (size_t)HALF * g.lda * 2, hstepB = (size_t)HALF * g.ldb * 2;
    const size_t tstepA = 2 * hstepA, tstepB = 2 * hstepB;
    const unsigned ldsw = (unsigned)wid * 1024u;
    const int aoff = lds_byte(wr * 64 + fr, fq * 8), boff = lds_byte(wc * 32 + fr, fq * 8);
#define PG8_SA(b, h) (((b) * 2 + (h)) * HTB)
#define PG8_SB(b, h) ((4 + (b) * 2 + (h)) * HTB)
#define PG8_STAGE(bufoff, gbase, voff) do { _Pragma("unroll") for (int _i = 0; _i < 2; ++_i) \
        __builtin_amdgcn_global_load_lds((const unsigned*)((const char*)(gbase) + (voff)[_i]), (LAS unsigned*)(lds + (bufoff) + ldsw + _i * 8192), 16, 0, 0); } while (0)
#define PG8_LDA(dst, b, h) do { _Pragma("unroll") for (int m = 0; m < 4; ++m) _Pragma("unroll") for (int k = 0; k < 2; ++k) dst[m][k] = *(const LAS bf16x8*)(lds + PG8_SA(b, h) + aoff + m * 2048 + k * 1024); } while (0)
#define PG8_LDB(dst, b, h) do { _Pragma("unroll") for (int n = 0; n < 2; ++n) _Pragma("unroll") for (int k = 0; k < 2; ++k) dst[n][k] = *(const LAS bf16x8*)(lds + PG8_SB(b, h) + boff + n * 2048 + k * 1024); } while (0)
#define PG8_MMA(ai, bj, At, Bt) do { __builtin_amdgcn_s_setprio(1); _Pragma("unroll") for (int m = 0; m < 4; ++m) _Pragma("unroll") for (int n = 0; n < 2; ++n) _Pragma("unroll") for (int k = 0; k < 2; ++k) \
        acc[ai][bj][m][n] = __builtin_amdgcn_mfma_f32_16x16x32_bf16(Bt[n][k], At[m][k], acc[ai][bj][m][n], 0, 0, 0); __builtin_amdgcn_s_setprio(0); } while (0)
#define PG8_WAIT_V(n) asm volatile("s_waitcnt vmcnt(" #n ")" ::: "memory")
#define PG8_WAIT_L(n) asm volatile("s_waitcnt lgkmcnt(" #n ")" ::: "memory")
#define PG8_BAR __builtin_amdgcn_s_barrier()
#define PG8_SCHED __builtin_amdgcn_sched_barrier(0)
    Unit cur, nxt; int ui = 0;
    if (!S.next(0, cur)) return;
    f32x4 acc[2][2][4][2];
#pragma unroll
    for (int a = 0; a < 2; ++a)
#pragma unroll
        for (int b = 0; b < 2; ++b)
#pragma unroll
            for (int m = 0; m < 4; ++m)
#pragma unroll
                for (int n = 0; n < 2; ++n) acc[a][b][m][n] = (f32x4){0.f, 0.f, 0.f, 0.f};
    bf16x8 At[4][2], B0[2][2], B1[2][2];
    const char* cA = (const char*)g.A + (size_t)cur.pm * tstepA; const char* cB = (const char*)g.Bt + (size_t)cur.pn * tstepB;
    S.a_ready(cur);
    PG8_STAGE(PG8_SB(0, 0), cB, voffB); PG8_STAGE(PG8_SA(0, 0), cA, voffA); PG8_STAGE(PG8_SB(0, 1), cB + hstepB, voffB); PG8_STAGE(PG8_SA(0, 1), cA + hstepA, voffA);
    if (wr == 1) PG8_BAR;
    PG8_WAIT_V(4); PG8_BAR;
    PG8_STAGE(PG8_SB(1, 0), cB + kstep, voffB); PG8_STAGE(PG8_SA(1, 0), cA + kstep, voffA); PG8_STAGE(PG8_SB(1, 1), cB + hstepB + kstep, voffB);
    PG8_WAIT_V(6); PG8_BAR;
    for (;;) {
        const bool has_next = S.next(ui + 1, nxt);
        const char* nA = has_next ? (const char*)g.A + (size_t)nxt.pm * tstepA : cA; const char* nB = has_next ? (const char*)g.Bt + (size_t)nxt.pn * tstepB : cB;
        for (int t = 0; t < nt; t += 2) {
            const bool last = (t == nt - 2);
            const char* a1 = cA + (size_t)(t + 1) * kstep;
            const char* a2 = last ? nA : cA + (size_t)(t + 2) * kstep; const char* b2 = last ? nB : cB + (size_t)(t + 2) * kstep;
            const char* a3 = a2 + kstep; const char* b3 = b2 + kstep;
            if (last && has_next) S.a_ready(nxt);
            if constexpr (Epi::KSCALE) { if (t >= 32 && (t & 3) == 0 && (t < 48 || (t & 7) == 0)) E.rescale(acc, t < 48 ? (t - 32) >> 2 : 4 + ((t - 48) >> 3), wr, fr); }
            PG8_LDB(B0, 0, 0); PG8_SCHED; PG8_LDA(At, 0, 0); PG8_STAGE(PG8_SA(1, 1), a1 + hstepA, voffA);
            PG8_WAIT_L(8); PG8_BAR; PG8_WAIT_L(0); PG8_MMA(0, 0, At, B0); PG8_BAR; PG8_SCHED;
            PG8_LDB(B1, 0, 1); PG8_STAGE(PG8_SB(0, 0), b2, voffB);
            PG8_BAR; PG8_WAIT_L(0); PG8_MMA(0, 1, At, B1); PG8_BAR;
            PG8_LDA(At, 0, 1); PG8_STAGE(PG8_SA(0, 0), a2, voffA);
            PG8_BAR; PG8_WAIT_L(0); PG8_MMA(1, 0, At, B0); PG8_BAR; PG8_SCHED;
            PG8_STAGE(PG8_SB(0, 1), b2 + hstepB, voffB);
            PG8_WAIT_V(6); PG8_BAR; PG8_MMA(1, 1, At, B1); PG8_BAR;
            PG8_LDB(B0, 1, 0); PG8_SCHED; PG8_LDA(At, 1, 0); PG8_STAGE(PG8_SA(0, 1), a2 + hstepA, voffA);
            PG8_WAIT_L(8); PG8_BAR; PG8_WAIT_L(0); PG8_MMA(0, 0, At, B0); PG8_BAR; PG8_SCHED;
            PG8_LDB(B1, 1, 1); PG8_STAGE(PG8_SB(1, 0), b3, voffB);
            PG8_BAR; PG8_WAIT_L(0); PG8_MMA(0, 1, At, B1); PG8_BAR;
            PG8_LDA(At, 1, 1); PG8_STAGE(PG8_SA(1, 0), a3, voffA);
            PG8_BAR; PG8_WAIT_L(0); PG8_MMA(1, 0, At, B0); PG8_BAR; PG8_SCHED;
            PG8_STAGE(PG8_SB(1, 1), b3 + hstepB, voffB);
            PG8_WAIT_V(6); PG8_BAR; PG8_MMA(1, 1, At, B1); PG8_BAR;
        }
        E(acc, cur, wr, wc, fr, fq);
        if constexpr (Epi::TWICE) {
#pragma unroll
            for (int a = 0; a < 2; ++a)
#pragma unroll
                for (int b = 0; b < 2; ++b) asm volatile("" : "+v"(acc[a][b][0][0]), "+v"(acc[a][b][0][1]), "+v"(acc[a][b][1][0]), "+v"(acc[a][b][1][1]), "+v"(acc[a][b][2][0]), "+v"(acc[a][b][2][1]), "+v"(acc[a][b][3][0]), "+v"(acc[a][b][3][1]) :: "memory");
            E(acc, cur, wr, wc, fr, fq); }
        S.done(cur);
        if (!has_next) break;
#pragma unroll
        for (int a = 0; a < 2; ++a)
#pragma unroll
            for (int b = 0; b < 2; ++b)
#pragma unroll
                for (int m = 0; m < 4; ++m)
#pragma unroll
                    for (int n = 0; n < 2; ++n) acc[a][b][m][n] = (f32x4){0.f, 0.f, 0.f, 0.f};
        cur = nxt; cA = nA; cB = nB; ++ui;
    }
    PG8_WAIT_V(0);
    if (wr == 0) PG8_BAR;
    PG8_BAR;
#undef PG8_SA
#undef PG8_SB
#undef PG8_STAGE
#undef PG8_LDA
#undef PG8_LDB
#undef PG8_MMA
#undef PG8_WAIT_V
#undef PG8_WAIT_L
#undef PG8_BAR
#undef PG8_SCHED
}
}

struct Ctx {
    KP kp; const float* const __attribute__((address_space(4)))* in; float* out; unsigned char* ws;
    LAS unsigned char* lds;
    int tid, lane, wave, G, wg;
    float* lb; bf16_t* win; bf16_t* wout; bf16_t* xb; bf16_t* proj; float* projs; float* dtb; bf16_t* mix; bf16_t* xbcs; float* rowsq; unsigned* ctl;
};
DI Ctx make_ctx(int wv) {
    extern __shared__ __attribute__((aligned(16))) unsigned char lds_raw[];
    Ctx c; c.kp = get_params(); c.in = c.kp->in; c.out = c.kp->out; c.ws = c.kp->ws;
    c.lds = (LAS unsigned char*)lds_raw;
    asm volatile("" : "+s"(wv));
    int wg = blockIdx.x; asm volatile("" : "+s"(wg));
    c.tid = get_tid(wv); c.lane = c.tid & 63; c.wave = wv; c.G = gridDim.x; c.wg = wg;
    unsigned char* ws = c.ws;
    c.ctl = (unsigned*)(ws + WS_CTL); c.lb = (float*)(ws + WS_LB); c.win = (bf16_t*)(ws + WS_WIN); c.wout = (bf16_t*)(ws + WS_WOUT); c.xb = (bf16_t*)(ws + WS_XB);
    c.proj = (bf16_t*)(ws + WS_PROJ); c.projs = (float*)(ws + WS_PROJS); c.dtb = (float*)(ws + WS_DTB); c.mix = (bf16_t*)(ws + WS_MIX); c.xbcs = (bf16_t*)(ws + WS_XBCS); c.rowsq = (float*)(c.ctl + CW_ROWSQ);
    return c;
}

DI void p0_transpose_item(const float* W, int ldw, int k0, int n0, bf16_t* WT, int K, int drow0, LAS float* scr, int lane, const float* ksc) {
    float t[32];
#pragma unroll
    for (int i = 0; i < 32; ++i) t[i] = W[(size_t)(k0 + 2 * i + (lane >> 5)) * ldw + n0 + (lane & 31)];
#pragma unroll
    for (int i = 0; i < 32; ++i) scr[(2 * i + (lane >> 5)) * 33 + (lane & 31)] = t[i];
    const int c = lane & 7;
    f32x4 s0 = (f32x4){1.f, 1.f, 1.f, 1.f}, s1 = s0;
    if (ksc) { s0 = *(const f32x4*)(ksc + k0 + 8 * c); s1 = *(const f32x4*)(ksc + k0 + 8 * c + 4); }
    asm volatile("s_waitcnt lgkmcnt(0)" ::: "memory");
#pragma unroll
    for (int j = 0; j < 4; ++j) { const int n = (lane >> 3) + 8 * j; const LAS float* s = scr + (8 * c) * 33 + n;
        u32x4 o; o.x = pk2(s[0 * 33] * s0.x, s[1 * 33] * s0.y); o.y = pk2(s[2 * 33] * s0.z, s[3 * 33] * s0.w); o.z = pk2(s[4 * 33] * s1.x, s[5 * 33] * s1.y); o.w = pk2(s[6 * 33] * s1.z, s[7 * 33] * s1.w);
        *(u32x4*)(WT + (size_t)(drow0 + n) * K + k0 + 8 * c) = o; }
    asm volatile("s_waitcnt lgkmcnt(0)" ::: "memory");
}
DI void phase_prologue(int wv) {
    const Ctx c = make_ctx(wv);
    LAS float* scr = (LAS float*)(c.lds + c.wave * 16384);
    const int gw = c.wg * 8 + c.wave, NGW = c.G * 8;
    constexpr int NB1 = SRC_GLA / 32, NB2 = (SRC_DT - SRC_SSZ) / 32;
    constexpr int I_A = (D_MODEL / 64) * NB1, I_B = (D_MODEL / 64) * NB2, I_O = (D_MIX / 64) * (D_MODEL / 32), I_L = I_A + I_B + I_O;
    for (int it = gw; it < DEPTH * I_L; it += NGW) {
        const int l = it / I_L; int r = it % I_L;
        const float* win = c.in[I_WIN] + (size_t)l * D_MODEL * N_IN; bf16_t* wt = c.win + (size_t)l * LDP * D_MODEL; const float* rmsw = c.in[I_RMS] + (size_t)l * D_MODEL;
        if (r < I_A) { const int kb = r / NB1, nb = r % NB1; p0_transpose_item(win, N_IN, 64 * kb, 32 * nb, wt, D_MODEL, 32 * nb, scr, c.lane, rmsw); }
        else if (r < I_A + I_B) { r -= I_A; const int kb = r / NB2, nb = r % NB2; p0_transpose_item(win, N_IN, 64 * kb, SRC_SSZ + 32 * nb, wt, D_MODEL, C_SSZ + 32 * nb, scr, c.lane, rmsw); }
        else { r -= I_A + I_B; const int kb = r / (D_MODEL / 32), nb = r % (D_MODEL / 32);
            p0_transpose_item(c.in[I_WOUT] + (size_t)l * D_MIX * D_MODEL, D_MODEL, 64 * kb, 32 * nb, c.wout + (size_t)l * D_MODEL * D_MIX, D_MIX, 32 * nb, scr, c.lane, kb >= 48 ? c.in[I_SSN] + (size_t)l * 1024 - 3072 : nullptr); }
    }
    const int gt = c.wg * 512 + c.tid, NGT = c.G * 512;
    for (int it = gw; it < DEPTH * 32 * 8; it += NGW) {
        const int l = it >> 8, kb = (it >> 3) & 31, nb = it & 7, k = kb * 64 + c.lane;
        const float* wr = c.in[I_WIN] + ((size_t)l * D_MODEL + k) * N_IN + SRC_GLA; const float* up = c.in[I_GWU] + (size_t)l * 16 * 512 + nb * 64;
        const f32x4 a0 = *(const f32x4*)wr, a1 = *(const f32x4*)(wr + 4), a2 = *(const f32x4*)(wr + 8), a3 = *(const f32x4*)(wr + 12);
        const float rk = c.in[I_RMS][(size_t)l * D_MODEL + k];
        bf16_t* dst = c.win + ((size_t)l * LDP + C_GLF + nb * 64) * D_MODEL + k;
#pragma unroll 4
        for (int n = 0; n < 64; ++n) {
            const float s = a0.x * up[n] + a0.y * up[512 + n] + a0.z * up[1024 + n] + a0.w * up[1536 + n] + a1.x * up[2048 + n] + a1.y * up[2560 + n] + a1.z * up[3072 + n] + a1.w * up[3584 + n]
                          + a2.x * up[4096 + n] + a2.y * up[4608 + n] + a2.z * up[5120 + n] + a2.w * up[5632 + n] + a3.x * up[6144 + n] + a3.y * up[6656 + n] + a3.z * up[7168 + n] + a3.w * up[7680 + n];
            dst[(size_t)n * D_MODEL] = (bf16_t)f2bf(s * rk); }
    }
    for (int i = gt; i < DEPTH * 16 * D_MODEL; i += NGT) {
        const int l = i / (16 * D_MODEL), e = i % (16 * D_MODEL), n = e / D_MODEL, k = e % D_MODEL;
        c.win[((size_t)l * LDP + C_DT + n) * D_MODEL + k] = (bf16_t)f2bf(c.in[I_WIN][((size_t)l * D_MODEL + k) * N_IN + SRC_DT + n] * c.in[I_RMS][(size_t)l * D_MODEL + k]);
    }
    constexpr int PADW = (LDP - C_DT - 16) * D_MODEL * 2 / 16;
    for (int i = gt; i < DEPTH * PADW; i += NGT) { const int l = i / PADW, r = i % PADW;
        ((u32x4*)(c.win + ((size_t)l * LDP + C_DT + 16) * D_MODEL))[r] = (u32x4){0u, 0u, 0u, 0u}; }
    constexpr int PADX = (M_PAD - TT) * D_MODEL * 2 / 16;
    for (int i = gt; i < PADX; i += NGT) ((u32x4*)(c.xb + (size_t)TT * D_MODEL))[i] = (u32x4){0u, 0u, 0u, 0u};
    constexpr int NRX = 4;
    for (int r = gw; r < TT; r += NRX * NGW) {
        f32x4 vx[NRX][8];
#pragma unroll
        for (int q = 0; q < NRX; ++q) { const int rq = (r + q * NGW < TT) ? r + q * NGW : r;
            const f32x4* xq = (const f32x4*)(rq < TP ? c.in[I_XP] + (size_t)rq * D_MODEL : c.in[I_XS] + (size_t)(rq - TP) * D_MODEL);
#pragma unroll
            for (int j = 0; j < 8; ++j) vx[q][j] = xq[c.lane + 64 * j]; }
#pragma unroll
        for (int q = 0; q < NRX; ++q) { const int rq = r + q * NGW;
            if (rq < TT) { u32x2* o = (u32x2*)(c.xb + (size_t)rq * D_MODEL); float s = 0.f;
#pragma unroll
                for (int j = 0; j < 8; ++j) { const f32x4 v = vx[q][j]; s += (v.x * v.x + v.y * v.y) + (v.z * v.z + v.w * v.w); u32x2 p; p.x = pk2(v.x, v.y); p.y = pk2(v.z, v.w); o[c.lane + 64 * j] = p; }
                s = wave_sum(s, c.lane);
                if (c.lane == 0) c.rowsq[rq] = s; } }
    }
    for (int i = gt; i < 1024; i += NGT) {
        const float* p = c.in[I_LB];
        const float a0 = p[i], a1 = p[1024 + i], a2 = p[2048 + i], a3 = p[3072 + i];
        const float mx = fmaxf(fmaxf(a0, a1), fmaxf(a2, a3));
        const float e0 = expf(a0 - mx), e1 = expf(a1 - mx), e2 = expf(a2 - mx), e3 = expf(a3 - mx);
        const float inv = 1.0f / (e0 + e1 + e2 + e3);
        c.lb[i] = 0.f; c.lb[1024 + i] = e1 * inv; c.lb[2048 + i] = (e1 + e2) * inv; c.lb[3072 + i] = (e1 + e2 + e3) * inv;
    }
}

DI void phase_final_norm(int wv) {
    const Ctx c = make_ctx(wv);
    const int gw = c.wg * 8 + c.wave, NGW = c.G * 8;
    const f32x4* w4 = (const f32x4*)c.in[I_RMSF];
    f32x4 wn[8];
#pragma unroll
    for (int j = 0; j < 8; ++j) wn[j] = w4[c.lane + 64 * j];
    constexpr int NR = 4;
    for (int r = gw; r < TT; r += NR * NGW) {
        u32x2 pv[NR][8]; float rr[NR];
#pragma unroll
        for (int q = 0; q < NR; ++q) { const int rq = (r + q * NGW < TT) ? r + q * NGW : r; const u32x2* xq = (const u32x2*)(c.xb + (size_t)rq * D_MODEL); rr[q] = row_rstd(c.rowsq + DEPTH * M_PAD, rq);
#pragma unroll
            for (int j = 0; j < 8; ++j) pv[q][j] = xq[c.lane + 64 * j]; }
#pragma unroll
        for (int q = 0; q < NR; ++q) { const int rq = r + q * NGW;
            if (rq < TT) { f32x4* o = (f32x4*)(c.out + O_YP + (size_t)rq * D_MODEL); const float rs_ = rr[q];
#pragma unroll
                for (int j = 0; j < 8; ++j) { const u32x2 p = pv[q][j]; const f32x4 w = wn[j];
                    o[c.lane + 64 * j] = (f32x4){bflo(p.x) * rs_ * w.x, bfhi(p.x) * rs_ * w.y, bflo(p.y) * rs_ * w.z, bfhi(p.y) * rs_ * w.w}; } } }
    }
}

DI float ps4(const float* p) { return (p[0] + p[PST]) + (p[2 * PST] + p[3 * PST]); }
DI float conv1(const float* prow, float rs, int col, int ch, int nch, const float* cw, const float* cb, const float* buf, float* nbuf) {
    const float b0 = buf[ch], b1 = buf[nch + ch], b2 = buf[2 * nch + ch], xn = ps4(prow + col + ch) * rs, w0 = cw[ch], w1 = cw[nch + ch], w2 = cw[2 * nch + ch], w3 = cw[3 * nch + ch], bb = cb[ch];
    nbuf[ch] = b1; nbuf[nch + ch] = b2; nbuf[2 * nch + ch] = xn;
    return bb + w0 * b0 + w1 * b1 + w2 * b2 + w3 * xn;
}
constexpr int SM_Q = 0, SM_K = 1024, SM_F = 2048, SM_V = 3072, SM_O = 4096, SM_WS = 5120, SM_PART = 5376;
DI void sample_item(const Ctx& c, int l, int s, int type) {
    LAS float* sm = (LAS float*)c.lds;
    LAS float* QS = sm + SM_Q; LAS float* KS = sm + SM_K; LAS float* FS = sm + SM_F; LAS float* VS = sm + SM_V; LAS float* OS_ = sm + SM_O; LAS float* WSUM = sm + SM_WS;
    const int tid = get_tid(c.wave), lane = tid & 63, w = c.wave;
    const float* pr = c.projs + (size_t)s * LDP; const float rs = row_rstd(c.rowsq + (size_t)l * M_PAD, TP + s);
    __syncthreads();
    if (type == 0) {
#pragma unroll
        for (int e = 0; e < 2; ++e) { const int ch = 2 * tid + e; const float qraw = (ps4(pr + C_HGQ + ch) * rs), fraw = (ps4(pr + C_HGF + ch) * rs), lbv = c.lb[(size_t)l * 1024 + ch];
            QS[ch] = silu(qraw); FS[ch] = fmaxf(lbv + (1.0f - lbv) * sigm(fraw), TINY); KS[ch] = (1.0f - lbv) * sigm(-fraw); VS[ch] = (ps4(pr + C_HGI + ch) * rs); }
    } else if (type == 1) {
#pragma unroll
        for (int e = 0; e < 2; ++e) { const int ch = 2 * tid + e; VS[ch] = (ps4(pr + C_GLV + ch) * rs);
            if (tid < 256) { QS[ch] = (ps4(pr + C_GLQ + ch) * rs) * 0.08838834764831845f; KS[ch] = (ps4(pr + C_GLK + ch) * rs);
                const float z = (ps4(pr + C_GLF + ch) * rs) + c.in[I_GBU][(size_t)l * 512 + ch]; FS[ch] = fexp(-softplus(-z) * (1.0f / 16.0f)); } }
    } else {
        const float* scw = c.in[I_SCW] + (size_t)l * 4 * 1536; const float* scb = c.in[I_SCB] + (size_t)l * 1536;
        const float* sbuf = c.in[I_SSSDC] + ((size_t)l * DEC + s) * 3 * 1536; float* nbuf = c.out + O_SSDC_S + ((size_t)l * DEC + s) * 4608;
        float cv0, cv1, cv2 = 0.f, cv3 = 0.f;
        cv0 = conv1(pr, rs, C_XBC, 2 * tid, 1536, scw, scb, sbuf, nbuf); cv1 = conv1(pr, rs, C_XBC, 2 * tid + 1, 1536, scw, scb, sbuf, nbuf);
        if (tid < 256) { cv2 = conv1(pr, rs, C_XBC, 1024 + tid, 1536, scw, scb, sbuf, nbuf); cv3 = conv1(pr, rs, C_XBC, 1280 + tid, 1536, scw, scb, sbuf, nbuf); }
        VS[2 * tid] = silu(cv0); VS[2 * tid + 1] = silu(cv1);
        if (tid < 256) { KS[tid] = silu(cv2); QS[tid] = silu(cv3); }
        if (tid < 16) { const float dt = softplus((ps4(pr + C_DT + tid) * rs) + c.in[I_DTB][l * 16 + tid]); FS[tid] = dt; FS[16 + tid] = fexp(-dt * expf(c.in[I_ALOG][l * 16 + tid])); }
    }
    __syncthreads();
    if (type < 2) {
        const int h = type == 0 ? w : (w >> 1), RS = type == 0 ? 128 : 256, voff = type == 0 ? 0 : 128 * (w & 1);
        const size_t sb = type == 0 ? (((size_t)l * DEC + s) * 8 + h) * 16384 : (((size_t)l * DEC + s) * 4 + h) * 32768;
        const float* s0 = (type == 0 ? c.in[I_SHG] : c.in[I_SGLA]) + sb; float* so = c.out + (type == 0 ? O_HG_S : O_GLA_S) + sb;
        const int vq = lane & 31, kh = lane >> 5, vb = (type == 0 ? h * 128 : h * 256 + voff) + 4 * vq, qb = h * 128;
        const f32x4 vv = *(const LAS f32x4*)(VS + vb); f32x4 o4 = (f32x4){0.f, 0.f, 0.f, 0.f};
        const int eo = kh * RS + voff + 4 * vq;
        f32x4 st[3][8];
#define SI_LOAD(bf, kb) do { _Pragma("unroll") for (int u = 0; u < 8; ++u) st[bf][u] = *(const f32x4*)(s0 + (size_t)(2 * (8 * (kb) + u)) * RS + eo); } while (0)
        SI_LOAD(0, 0); SI_LOAD(1, 1);
#pragma unroll
        for (int kb = 0; kb < 8; ++kb) {
            if (kb + 2 < 8) SI_LOAD((kb + 2) % 3, kb + 2);
#pragma unroll
            for (int u = 0; u < 8; ++u) { const int k = 2 * (8 * kb + u) + kh; const float fk = FS[qb + k], kk = KS[qb + k], qk = QS[qb + k];
                f32x4 t = st[kb % 3][u] * fk + vv * kk; o4 += t * qk; *(f32x4*)(so + (size_t)(2 * (8 * kb + u)) * RS + eo) = t; }
        }
#undef SI_LOAD
        o4.x += shx(o4.x, 32, lane); o4.y += shx(o4.y, 32, lane); o4.z += shx(o4.z, 32, lane); o4.w += shx(o4.w, 32, lane);
        if (kh == 0) *(LAS f32x4*)(OS_ + vb) = o4;
    } else {
        LAS float* PART = sm + SM_PART + w * 2304;
        const int nq = lane & 31, ph = lane >> 5, g = w >> 2;
        const f32x4 B4 = *(const LAS f32x4*)(KS + g * 128 + 4 * nq), C4 = *(const LAS f32x4*)(QS + g * 128 + 4 * nq);
        const float* s0 = c.in[I_SSSD] + (((size_t)l * DEC + s) * 16 + 2 * w) * 8192; float* so = c.out + O_SSD_S + (((size_t)l * DEC + s) * 16 + 2 * w) * 8192;
        const int eo = ph * 128 + 4 * nq;
        f32x4 st[3][8];
#define SI_LOAD(bf, kb) do { _Pragma("unroll") for (int u = 0; u < 8; ++u) st[bf][u] = *(const f32x4*)(s0 + (size_t)((kb) >> 2) * 8192 + (size_t)(2 * (8 * ((kb) & 3) + u)) * 128 + eo); } while (0)
        SI_LOAD(0, 0); SI_LOAD(1, 1);
#pragma unroll
        for (int kb = 0; kb < 8; ++kb) { const int h = 2 * w + (kb >> 2);
            if (kb + 2 < 8) SI_LOAD((kb + 2) % 3, kb + 2);
            const float dt = FS[h], dA = FS[16 + h];
#pragma unroll
            for (int u = 0; u < 8; ++u) { const int p = 2 * (8 * (kb & 3) + u) + ph; const float xv = VS[h * 64 + p] * dt;
                const f32x4 t = st[kb % 3][u] * dA + B4 * xv; *(f32x4*)(so + (size_t)(kb >> 2) * 8192 + (size_t)(2 * (8 * (kb & 3) + u)) * 128 + eo) = t;
                PART[p * 36 + nq] = (t.x * C4.x + t.y * C4.y) + (t.z * C4.z + t.w * C4.w); }
            if ((kb & 3) == 3) {
                asm volatile("s_waitcnt lgkmcnt(0)" ::: "memory");
                float o = 0.f;
#pragma unroll
                for (int q = 0; q < 8; ++q) { const f32x4 tt = *(const LAS f32x4*)(PART + lane * 36 + 4 * q); o += (tt.x + tt.y) + (tt.z + tt.w); }
                const float x = VS[h * 64 + lane], z = (ps4(pr + C_SSZ + h * 64 + lane) * rs);
                OS_[h * 64 + lane] = (o + c.in[I_SD][l * 16 + h] * x) * silu(z);
                asm volatile("s_waitcnt lgkmcnt(0)" ::: "memory"); }
        }
#undef SI_LOAD
    }
    __syncthreads();
    { const f32x2 o2 = *(const LAS f32x2*)(OS_ + 2 * tid);
      const float ssw = wave_sum(o2.x * o2.x + o2.y * o2.y, lane);
      if (lane == 0) WSUM[w] = ssw;
      __syncthreads();
      float ss, gsz; const float* nw; int mcol, gcol = 0;
      if (type == 0) { ss = WSUM[w]; gsz = 128.f; nw = c.in[I_HGN] + (size_t)l * 1024; mcol = 0; gcol = C_HGG; }
      else if (type == 1) { ss = WSUM[w & ~1] + WSUM[w | 1]; gsz = 256.f; nw = c.in[I_GLN] + (size_t)l * 1024; mcol = 2048; gcol = C_GLG; }
      else { const int b4 = w & ~3; ss = (WSUM[b4] + WSUM[b4 + 1]) + (WSUM[b4 + 2] + WSUM[b4 + 3]); gsz = 512.f; nw = c.in[I_SSN] + (size_t)l * 1024; mcol = 3072; }
      const float rstd = rsqrtf(ss / gsz + EPS);
      float y0 = o2.x * rstd, y1 = o2.y * rstd;
      if (type < 2) { y0 *= nw[2 * tid]; y1 *= nw[2 * tid + 1]; }
      if (type < 2) { y0 *= silu((ps4(pr + gcol + 2 * tid) * rs)); y1 *= silu((ps4(pr + gcol + 2 * tid + 1) * rs)); }
      *(unsigned*)(c.mix + (size_t)(TP + s) * D_MIX + mcol + 2 * tid) = pk2(y0, y1); }
}

DI void lds_barrier() { asm volatile("s_waitcnt lgkmcnt(0)\n\ts_barrier" ::: "memory"); }
DI f32x16 mfma32(bf16x8 a, bf16x8 b, f32x16 c) { return __builtin_amdgcn_mfma_f32_32x32x16_bf16(a, b, c, 0, 0, 0); }
DI bf16x8 ldfrag(const LAS unsigned char* p) { return *(const LAS bf16x8*)p; }
DI int crow(int i, int hh) { return (i & 3) + 8 * (i >> 2) + 4 * hh; }
constexpr int L_QP = 0, L_KP = 17408, L_KPT = 34816, L_VT = 53248, L_VT2 = 71680, L_AM = 90112, L_TOT = 108544, L_E1 = 112640, L_E2 = 113152, L_CUM = 113664;
constexpr int SQ = 272, SV = 144;
#define ZERO16(x) do { _Pragma("unroll") for (int _i = 0; _i < 16; ++_i) (x)[_i] = 0.f; } while (0)

template <int TYPE>
DI void la_head_unit(const Ctx& c, int l, int b, int hu) {
    constexpr int DV = 128, NSW = DV / 32, OS = DV * 2 + 16, NC = DV / 8;
    LAS unsigned char* L = c.lds;
    const int tid = get_tid(c.wave), lane = tid & 63, w = c.wave;
    const int r = lane & 31, hh = lane >> 5;
    const int row0 = b * SEQ;
    const bf16_t* P = TYPE == 2 ? c.xbcs : c.proj;
    constexpr int LDR = TYPE == 2 ? 1536 : LDP;
    LAS float* TOT = (LAS float*)(L + L_TOT); LAS float* E1 = (LAS float*)(L + L_E1); LAS float* E2 = (LAS float*)(L + L_E2);
    int colQ, colK, colG, colV, colGate, colOut, sidx; const int grp = hu >> 2;
    if constexpr (TYPE == 0) { colQ = C_HGQ + hu * 128; colK = 0; colG = C_HGF + hu * 128; colV = C_HGI + hu * 128; colGate = C_HGG + hu * 128; colOut = hu * 128; sidx = 0; }
    else if constexpr (TYPE == 1) { const int hd = hu >> 1; colQ = C_GLQ + hd * 128; colK = C_GLK + hd * 128; colG = C_GLF + hd * 128; colV = C_GLV + hu * 128; colGate = C_GLG + hu * 128; colOut = 2048 + hu * 128; sidx = 2 + hd; }
    else { colK = 1024 + grp * 128; colQ = 1280 + grp * 128; colG = 0; colV = hu * 128; colGate = C_SSZ + hu * 128; colOut = 3072 + hu * 128; sidx = grp; }
    float Ah[2], Dh[2];
    if constexpr (TYPE == 2) {
#pragma unroll
        for (int e = 0; e < 2; ++e) { Ah[e] = -expf(c.in[I_ALOG][l * 16 + 2 * hu + e]); Dh[e] = c.in[I_SD][l * 16 + 2 * hu + e]; }
    }
    unsigned r0[8], r1[8], r2[8], r3[8]; float dtn = 0.f;
#define LOAD_CHUNK(tn) do { const bf16_t* pq_ = P + (size_t)(row0 + (tn) + 8 * w) * LDR + 2 * lane; \
        if constexpr (TYPE == 0) { _Pragma("unroll") for (int i = 0; i < 8; ++i) { r0[i] = *(const unsigned*)(pq_ + (size_t)i * LDR + colQ); r1[i] = *(const unsigned*)(pq_ + (size_t)i * LDR + colG); r2[i] = *(const unsigned*)(pq_ + (size_t)i * LDR + colV); } } \
        else if constexpr (TYPE == 1) { _Pragma("unroll") for (int i = 0; i < 8; ++i) { r0[i] = *(const unsigned*)(pq_ + (size_t)i * LDR + colQ); r1[i] = *(const unsigned*)(pq_ + (size_t)i * LDR + colK); \
                                                                                       r2[i] = *(const unsigned*)(pq_ + (size_t)i * LDR + colG); r3[i] = *(const unsigned*)(pq_ + (size_t)i * LDR + colV); } } \
        else { _Pragma("unroll") for (int i = 0; i < 8; ++i) { r0[i] = *(const unsigned*)(pq_ + (size_t)i * LDR + colQ); r1[i] = *(const unsigned*)(pq_ + (size_t)i * LDR + colK); r2[i] = *(const unsigned*)(pq_ + (size_t)i * LDR + colV); } \
            if (w < 2) dtn = c.dtb[(size_t)(row0 + (tn) + lane) * 16 + 2 * hu + w]; } } while (0)
    f32x16 S[4];
#pragma unroll
    for (int kt = 0; kt < 4; ++kt) ZERO16(S[kt]);
    float e2pa = 1.f, e2pb = 1.f;
    constexpr bool PF = true;
    if constexpr (PF) LOAD_CHUNK(0);
    for (int ck = -(SEQ / 64) * (PROBE_LONG_REP - 1); ck < SEQ / 64; ++ck) {
        if (PROBE_LONG_REP > 1 && ck == 0) { e2pa = 1.f; e2pb = 1.f;
#pragma unroll
            for (int kt = 0; kt < 4; ++kt) ZERO16(S[kt]); }
        const int t0 = (ck & (SEQ / 64 - 1)) * 64;
        if constexpr (TYPE == 2) { if ((ck & (SEQ / 64 - 1)) == 15) {
            if (tid == 0) { unsigned* xp1 = c.ctl + CW_XPRE + 128 * l + 64; unsigned sp = 0;
                while (__hip_atomic_load(xp1, __ATOMIC_RELAXED, __HIP_MEMORY_SCOPE_AGENT) < 128u) { __builtin_amdgcn_s_sleep(8); if (++sp > (1u << 22)) break; }
                __builtin_amdgcn_fence(__ATOMIC_ACQUIRE, "agent"); asm volatile("s_waitcnt vmcnt(0)" ::: "memory"); }
            __syncthreads(); } }
        LAS float* CUM = (LAS float*)(L + L_CUM + (ck & 1) * 1536);
        if constexpr (!PF) LOAD_CHUNK(t0);
        float qa[8], qb[8], ka[8], kb[8], ga[8], gb[8], xa[8], xb[8]; unsigned uv[8];
        if constexpr (TYPE == 0) {
            float ta = 0.f, tb = 0.f;
#pragma unroll
            for (int i = 0; i < 8; ++i) { qa[i] = bflo(r0[i]); qb[i] = bfhi(r0[i]); const float g0 = bflo(r1[i]), g1 = bfhi(r1[i]); uv[i] = r2[i];
                ka[i] = 1.0f - fexp(g0); kb[i] = 1.0f - fexp(g1); ta += g0; tb += g1; ga[i] = ta; gb[i] = tb; }
            *(LAS f32x2*)(TOT + w * 128 + 2 * lane) = (f32x2){ta, tb};
        } else if constexpr (TYPE == 1) {
            float ta = 0.f, tb = 0.f;
#pragma unroll
            for (int i = 0; i < 8; ++i) { qa[i] = bflo(r0[i]); qb[i] = bfhi(r0[i]); ka[i] = bflo(r1[i]); kb[i] = bfhi(r1[i]); ta += bflo(r2[i]); tb += bfhi(r2[i]); ga[i] = ta; gb[i] = tb; uv[i] = r3[i]; }
            *(LAS f32x2*)(TOT + w * 128 + 2 * lane) = (f32x2){ta, tb};
        } else {
#pragma unroll
            for (int i = 0; i < 8; ++i) { qa[i] = bflo(r0[i]); qb[i] = bfhi(r0[i]); ka[i] = bflo(r1[i]); kb[i] = bfhi(r1[i]); xa[i] = bflo(r2[i]); xb[i] = bfhi(r2[i]); }
            if (w < 2) {
                const float dt = dtn; float x = dt * (w == 0 ? Ah[0] : Ah[1]);
#pragma unroll
                for (int o = 1; o < 64; o <<= 1) { const float y = shup(x, o, lane); if (lane >= o) x += y; }
                CUM[w * 192 + lane] = x; CUM[w * 192 + 64 + lane] = fmaxf(dt, 1e-30f); CUM[w * 192 + 128 + lane] = fexp(x);
            }
        }
        lds_barrier();
        if constexpr (TYPE < 2) {
            float offa = 0.f, offb = 0.f, brefa = 0.f, brefb = 0.f, bla = 0.f, blb = 0.f;
#pragma unroll
            for (int g = 0; g < 8; ++g) { const f32x2 t = *(const LAS f32x2*)(TOT + g * 128 + 2 * lane);
                if (g < w) { offa += t.x; offb += t.y; }
                if (g < 4) { brefa += t.x; brefb += t.y; }
                bla += t.x; blb += t.y; }
#pragma unroll
            for (int i = 0; i < 8; ++i) { const float da = clampf(ga[i] + offa - brefa, -80.f, 80.f), db = clampf(gb[i] + offb - brefb, -80.f, 80.f);
                qa[i] *= fexp(da); ka[i] *= fexp(-da); qb[i] *= fexp(db); kb[i] *= fexp(-db); }
            if (w == 0) {
                const float e2a = fexp(bla - brefa), e2b = fexp(blb - brefb);
                *(LAS f32x2*)(E1 + 2 * lane) = (f32x2){fexp(brefa) * e2pa, fexp(brefb) * e2pb}; *(LAS f32x2*)(E2 + 2 * lane) = (f32x2){e2a, e2b}; e2pa = e2a; e2pb = e2b; }
        }
#pragma unroll
        for (int i = 0; i < 8; ++i) { *(LAS unsigned*)(L + L_QP + (8 * w + i) * SQ + 4 * lane) = pk2(qa[i], qb[i]); *(LAS unsigned*)(L + L_KP + (8 * w + i) * SQ + 4 * lane) = pk2(ka[i], kb[i]); }
        { u32x4 a, bq; a.x = pk2(ka[0], ka[1]); a.y = pk2(ka[2], ka[3]); a.z = pk2(ka[4], ka[5]); a.w = pk2(ka[6], ka[7]);
          bq.x = pk2(kb[0], kb[1]); bq.y = pk2(kb[2], kb[3]); bq.z = pk2(kb[4], kb[5]); bq.w = pk2(kb[6], kb[7]);
          *(LAS u32x4*)(L + L_KPT + (2 * lane) * SV + 16 * w) = a; *(LAS u32x4*)(L + L_KPT + (2 * lane + 1) * SV + 16 * w) = bq; }
        if constexpr (TYPE < 2) {
            u32x4 a, bq;
            a.x = (uv[0] & 0xffffu) | (uv[1] << 16); a.y = (uv[2] & 0xffffu) | (uv[3] << 16); a.z = (uv[4] & 0xffffu) | (uv[5] << 16); a.w = (uv[6] & 0xffffu) | (uv[7] << 16);
            bq.x = (uv[0] >> 16) | (uv[1] & 0xffff0000u); bq.y = (uv[2] >> 16) | (uv[3] & 0xffff0000u); bq.z = (uv[4] >> 16) | (uv[5] & 0xffff0000u); bq.w = (uv[6] >> 16) | (uv[7] & 0xffff0000u);
            *(LAS u32x4*)(L + L_VT + (2 * lane) * SV + 16 * w) = a; *(LAS u32x4*)(L + L_VT + (2 * lane + 1) * SV + 16 * w) = bq;
        } else {
            const int hs = lane >> 5;
            const LAS float* cm = CUM + hs * 192; const float cl = cm[63];
            float v1a[8], v1b[8], v2a[8], v2b[8];
#pragma unroll
            for (int j = 0; j < 8; ++j) { const int s = 8 * w + j; const float dt = cm[64 + s], wgt = fexp(fminf(cl - cm[s], 0.f));
                v1a[j] = dt * xa[j]; v1b[j] = dt * xb[j]; v2a[j] = v1a[j] * wgt; v2b[j] = v1b[j] * wgt; }
            u32x4 a, bq;
            a.x = pk2(v1a[0], v1a[1]); a.y = pk2(v1a[2], v1a[3]); a.z = pk2(v1a[4], v1a[5]); a.w = pk2(v1a[6], v1a[7]);
            bq.x = pk2(v1b[0], v1b[1]); bq.y = pk2(v1b[2], v1b[3]); bq.z = pk2(v1b[4], v1b[5]); bq.w = pk2(v1b[6], v1b[7]);
            *(LAS u32x4*)(L + L_VT + (2 * lane) * SV + 16 * w) = a; *(LAS u32x4*)(L + L_VT + (2 * lane + 1) * SV + 16 * w) = bq;
            a.x = pk2(v2a[0], v2a[1]); a.y = pk2(v2a[2], v2a[3]); a.z = pk2(v2a[4], v2a[5]); a.w = pk2(v2a[6], v2a[7]);
            bq.x = pk2(v2b[0], v2b[1]); bq.y = pk2(v2b[2], v2b[3]); bq.z = pk2(v2b[4], v2b[5]); bq.w = pk2(v2b[6], v2b[7]);
            *(LAS u32x4*)(L + L_VT2 + (2 * lane) * SV + 16 * w) = a; *(LAS u32x4*)(L + L_VT2 + (2 * lane + 1) * SV + 16 * w) = bq;
        }
        lds_barrier();
        if constexpr (PF) { if (ck + 1 < SEQ / 64) LOAD_CHUNK(((ck + 1) & (SEQ / 64 - 1)) * 64); }
        if (w >= 5) {
            const int sb = (w == 7) ? 1 : 0, tb = (w == 5) ? 0 : 1;
            f32x16 X; ZERO16(X);
#pragma unroll
            for (int k4 = 0; k4 < 8; k4 += 4) { bf16x8 fk[4], fq[4];
#pragma unroll
                for (int u = 0; u < 4; ++u) { fk[u] = ldfrag(L + L_KP + (32 * sb + r) * SQ + (16 * (k4 + u) + 8 * hh) * 2); fq[u] = ldfrag(L + L_QP + (32 * tb + r) * SQ + (16 * (k4 + u) + 8 * hh) * 2); }
#pragma unroll
                for (int u = 0; u < 4; ++u) X = mfma32(fk[u], fq[u], X); }
            const int t = 32 * tb + r;
#pragma unroll
            for (int hs = 0; hs < (TYPE == 2 ? 2 : 1); ++hs) {
                float ct = 0.f, ddt = 0.f;
                if constexpr (TYPE == 2) { ct = CUM[hs * 192 + t]; ddt = (hs == 0 ? Dh[0] : Dh[1]) / CUM[hs * 192 + 64 + t]; }
#pragma unroll
                for (int g = 0; g < 4; ++g) { const int s0 = 32 * sb + 8 * g + 4 * hh;
                    float x0 = X[4 * g], x1 = X[4 * g + 1], x2 = X[4 * g + 2], x3 = X[4 * g + 3];
                    if constexpr (TYPE == 2) { const f32x4 cs = *(const LAS f32x4*)(CUM + hs * 192 + s0);
                        x0 *= fexp(fminf(ct - cs.x, 0.f)); x1 *= fexp(fminf(ct - cs.y, 0.f)); x2 *= fexp(fminf(ct - cs.z, 0.f)); x3 *= fexp(fminf(ct - cs.w, 0.f));
                        x0 += (s0 == t) ? ddt : 0.f; x1 += (s0 + 1 == t) ? ddt : 0.f; x2 += (s0 + 2 == t) ? ddt : 0.f; x3 += (s0 + 3 == t) ? ddt : 0.f; }
                    x0 = (s0 <= t) ? x0 : 0.f; x1 = (s0 + 1 <= t) ? x1 : 0.f; x2 = (s0 + 2 <= t) ? x2 : 0.f; x3 = (s0 + 3 <= t) ? x3 : 0.f;
                    u32x2 p; p.x = pk2(x0, x1); p.y = pk2(x2, x3);
                    *(LAS u32x2*)(L + L_AM + hs * 9216 + t * SV + s0 * 2) = p; }
            }
        }
        f32x16 O[2]; bf16x8 Bv[4];
        const int hsw = w >> 1;
        if (w < NSW) {
            if constexpr (TYPE < 2) {
#pragma unroll
                for (int kt = 0; kt < 4; ++kt)
#pragma unroll
                    for (int g = 0; g < 4; ++g) { const f32x4 e = *(const LAS f32x4*)(E1 + 32 * kt + 8 * g + 4 * hh);
                        S[kt][4 * g] *= e.x; S[kt][4 * g + 1] *= e.y; S[kt][4 * g + 2] *= e.z; S[kt][4 * g + 3] *= e.w; }
            }
            ZERO16(O[0]); ZERO16(O[1]);
#pragma unroll
            for (int kt = 0; kt < 4; ++kt) {
                u32x2 ql[2][2], qh[2][2];
#pragma unroll
                for (int s = 0; s < 2; ++s)
#pragma unroll
                    for (int tt = 0; tt < 2; ++tt) { const LAS unsigned char* qp = L + L_QP + (32 * tt + r) * SQ + (32 * kt + 16 * s + 4 * hh) * 2;
                        ql[s][tt] = *(const LAS u32x2*)qp; qh[s][tt] = *(const LAS u32x2*)(qp + 16); }
#pragma unroll
                for (int s = 0; s < 2; ++s) {
                    u32x4 pa; pa.x = pk2(S[kt][8 * s], S[kt][8 * s + 1]); pa.y = pk2(S[kt][8 * s + 2], S[kt][8 * s + 3]); pa.z = pk2(S[kt][8 * s + 4], S[kt][8 * s + 5]); pa.w = pk2(S[kt][8 * s + 6], S[kt][8 * s + 7]);
                    const bf16x8 A = __builtin_bit_cast(bf16x8, pa);
#pragma unroll
                    for (int tt = 0; tt < 2; ++tt) O[tt] = mfma32(A, __builtin_bit_cast(bf16x8, (u32x4){ql[s][tt].x, ql[s][tt].y, qh[s][tt].x, qh[s][tt].y}), O[tt]);
                }
            }
            if constexpr (TYPE == 2) {
                const LAS float* cm = CUM + hsw * 192; const float e0 = cm[128 + r], e1 = cm[128 + 32 + r], sc = cm[128 + 63];
#pragma unroll
                for (int i = 0; i < 16; ++i) { O[0][i] *= e0; O[1][i] *= e1; }
#pragma unroll
                for (int kt = 0; kt < 4; ++kt)
#pragma unroll
                    for (int i = 0; i < 16; ++i) S[kt][i] *= sc;
            }
#pragma unroll
            for (int st = 0; st < 4; ++st) { bf16x8 kf[4];
                Bv[st] = ldfrag(L + (TYPE == 2 ? L_VT2 : L_VT) + (32 * w + r) * SV + (16 * st + 8 * hh) * 2);
#pragma unroll
                for (int kt = 0; kt < 4; ++kt) kf[kt] = ldfrag(L + L_KPT + (32 * kt + r) * SV + (16 * st + 8 * hh) * 2);
#pragma unroll
                for (int kt = 0; kt < 4; ++kt) S[kt] = mfma32(kf[kt], Bv[st], S[kt]); }
        }
        const int nt_ = tid >> 3, nseg = tid & 7;
        u32x4 gq[NC / 8];
        { const bf16_t* pg = c.proj + (size_t)(row0 + t0 + nt_) * LDP + colGate + nseg * NC;
#pragma unroll
          for (int q = 0; q < NC / 8; ++q) gq[q] = *(const u32x4*)(pg + 8 * q); }
        lds_barrier();
        if (w < NSW) {
#pragma unroll
            for (int st = 0; st < 4; ++st) { bf16x8 Av = Bv[st];
                if constexpr (TYPE == 2) Av = ldfrag(L + L_VT + (32 * w + r) * SV + (16 * st + 8 * hh) * 2);
#pragma unroll
                for (int tt = 0; tt < 2; ++tt) if (st < 2 || tt == 1)
                    O[tt] = mfma32(Av, ldfrag(L + L_AM + (TYPE == 2 ? hsw * 9216 : 0) + (32 * tt + r) * SV + (16 * st + 8 * hh) * 2), O[tt]); }
#pragma unroll
            for (int tt = 0; tt < 2; ++tt)
#pragma unroll
                for (int g = 0; g < 4; ++g) { u32x2 p; p.x = pk2(O[tt][4 * g], O[tt][4 * g + 1]); p.y = pk2(O[tt][4 * g + 2], O[tt][4 * g + 3]);
                    *(LAS u32x2*)(L + (32 * tt + r) * OS + (32 * w + 8 * g + 4 * hh) * 2) = p; }
        }
        lds_barrier();
        {
            float o[NC], gv[NC]; float ss = 0.f;
#pragma unroll
            for (int q = 0; q < NC / 8; ++q) { const u32x4 ov = *(const LAS u32x4*)(L + nt_ * OS + (nseg * NC + 8 * q) * 2);
                o[8 * q] = bflo(ov.x); o[8 * q + 1] = bfhi(ov.x); o[8 * q + 2] = bflo(ov.y); o[8 * q + 3] = bfhi(ov.y); o[8 * q + 4] = bflo(ov.z); o[8 * q + 5] = bfhi(ov.z); o[8 * q + 6] = bflo(ov.w); o[8 * q + 7] = bfhi(ov.w);
                gv[8 * q] = bflo(gq[q].x); gv[8 * q + 1] = bfhi(gq[q].x); gv[8 * q + 2] = bflo(gq[q].y); gv[8 * q + 3] = bfhi(gq[q].y); gv[8 * q + 4] = bflo(gq[q].z); gv[8 * q + 5] = bfhi(gq[q].z); gv[8 * q + 6] = bflo(gq[q].w); gv[8 * q + 7] = bfhi(gq[q].w); }
            if constexpr (TYPE == 2) {
#pragma unroll
                for (int e = 0; e < NC; ++e) o[e] *= gv[e];
            }
#pragma unroll
            for (int e = 0; e < NC; ++e) ss += o[e] * o[e];
            ss += shx(ss, 1, lane); ss += shx(ss, 2, lane); ss += shx(ss, 4, lane);
            float mul = 1.0f;
            if constexpr (TYPE == 0) mul = rsqrtf(ss * (1.0f / DV) + EPS);
            else { if (nseg == 0 && ck >= 0) atomicAdd((float*)(c.ctl + CW_STATS) + ((size_t)l * TP + row0 + t0 + nt_) * 6 + sidx, ss); }
            if constexpr (TYPE < 2) {
#pragma unroll
                for (int e = 0; e < NC; ++e) o[e] *= mul * gv[e];
            }
            bf16_t* pm = c.mix + (size_t)(row0 + t0 + nt_) * D_MIX + colOut + nseg * NC;
#pragma unroll
            for (int q = 0; q < NC / 8; ++q) { u32x4 ov; ov.x = pk2(o[8 * q], o[8 * q + 1]); ov.y = pk2(o[8 * q + 2], o[8 * q + 3]); ov.z = pk2(o[8 * q + 4], o[8 * q + 5]); ov.w = pk2(o[8 * q + 6], o[8 * q + 7]);
                *(u32x4*)(pm + 8 * q) = ov; }
        }
    }
#undef LOAD_CHUNK
    if (w < NSW) {
        const int lane2 = get_tid(c.wave) & 63, r = lane2 & 31, hh = lane2 >> 5;
        if constexpr (TYPE < 2) {
#pragma unroll
            for (int kt = 0; kt < 4; ++kt)
#pragma unroll
                for (int g = 0; g < 4; ++g) { const f32x4 e = *(const LAS f32x4*)(E2 + 32 * kt + 8 * g + 4 * hh);
                    S[kt][4 * g] *= e.x; S[kt][4 * g + 1] *= e.y; S[kt][4 * g + 2] *= e.z; S[kt][4 * g + 3] *= e.w; }
        }
        float* sout; int sk, sv, vb;
        if constexpr (TYPE == 0) { sout = c.out + O_HG_P + (((size_t)l * NB + b) * 8 + hu) * 16384; sk = 128; sv = 1; vb = 32 * w; }
        else if constexpr (TYPE == 1) { sout = c.out + O_GLA_P + (((size_t)l * NB + b) * 4 + (hu >> 1)) * 32768; sk = 256; sv = 1; vb = 128 * (hu & 1) + 32 * w; }
        else { sout = c.out + O_SSD_P + (((size_t)l * NB + b) * 16 + 2 * hu + (w >> 1)) * 8192; sk = 1; sv = 128; vb = 32 * (w & 1); }
#pragma unroll
        for (int kt = 0; kt < 4; ++kt)
#pragma unroll
            for (int i = 0; i < 16; ++i) sout[(32 * kt + crow(i, hh)) * sk + (vb + r) * sv] = S[kt][i];
    }
}

constexpr int R_WT = 74752;
DI void rg_load_gates(const Ctx& c, int l, int n, int tid, int j, int hh, bf16x8 (&Br)[8], bf16x8 (&Bi)[8]) {
    LAS unsigned char* L = c.lds;
    const float* wr = c.in[I_WR] + (size_t)(l * 8 + n) * 128 * 128; const float* wi = c.in[I_WI] + (size_t)(l * 8 + n) * 128 * 128;
    __syncthreads();
    f32x4 v[16];
#pragma unroll
    for (int q = 0; q < 16; ++q) { const int e = tid + 512 * q, mat = e >> 12, rem = e & 4095; v[q] = *(const f32x4*)((mat ? wi : wr) + rem * 4); }
#pragma unroll
    for (int q = 0; q < 16; ++q) { const int e = tid + 512 * q, mat = e >> 12, rem = e & 4095, i = rem >> 5, j4 = (rem & 31) * 4;
        LAS unsigned char* p = L + R_WT + mat * 34816 + j4 * SQ + i * 2;
        *(LAS bf16_t*)(p) = (bf16_t)f2bf(v[q].x); *(LAS bf16_t*)(p + SQ) = (bf16_t)f2bf(v[q].y); *(LAS bf16_t*)(p + 2 * SQ) = (bf16_t)f2bf(v[q].z); *(LAS bf16_t*)(p + 3 * SQ) = (bf16_t)f2bf(v[q].w); }
    __syncthreads();
#pragma unroll
    for (int ks = 0; ks < 8; ++ks) { Br[ks] = ldfrag(L + R_WT + j * SQ + (16 * ks + 8 * hh) * 2); Bi[ks] = ldfrag(L + R_WT + 34816 + j * SQ + (16 * ks + 8 * hh) * 2); }
}
constexpr int R_XCB = 0, R_XCF = 17408, R_SUMA = 50176, R_SUMU = 58368, R_HIN = 66560;
DI void rg_chunk_unit(const Ctx& c, int l, int b, int n) {
    LAS unsigned char* L = c.lds;
    const int tid = get_tid(c.wave), lane = tid & 63, w = c.wave, r = lane & 31, hh = lane >> 5;
    const int tb = w >> 2, jb = w & 3;
    const int j = 32 * jb + r, ch = n * 128 + j;
    const int row0 = b * SEQ;
    const bf16_t* P = c.proj;
    LAS float* XCF = (LAS float*)(L + R_XCF); LAS float* SUMA = (LAS float*)(L + R_SUMA); LAS float* SUMU = (LAS float*)(L + R_SUMU); LAS float* HIN = (LAS float*)(L + R_HIN);
    bf16x8 Br[8], Bi[8];
    rg_load_gates(c, l, n, tid, j, hh, Br, Bi);
    const float sp = softplus(-c.in[I_LAM][l * 1024 + ch]), brv = c.in[I_BR][(l * 8 + n) * 128 + j], biv = c.in[I_BI][(l * 8 + n) * 128 + j];
    float cw[4][2], cb[2];
#pragma unroll
    for (int e = 0; e < 2; ++e) {
#pragma unroll
        for (int m = 0; m < 4; ++m) cw[m][e] = c.in[I_RCW][l * 4 * 1024 + m * 1024 + n * 128 + 2 * lane + e];
        cb[e] = c.in[I_RCB][l * 1024 + n * 128 + 2 * lane + e]; }
    float hcarry = 0.f;
    unsigned ux[11]; bf16_t gtr[16];
#define RG_LOAD(tn) do { const bf16_t* pq_ = P + (size_t)(row0 + (tn) + 8 * w) * LDP + C_RGX + n * 128 + 2 * lane; const bool first_ = ((tn) == 0 && w == 0); \
        _Pragma("unroll") for (int jx = 0; jx < 11; ++jx) ux[jx] = (first_ && jx < 3) ? 0u : *(const unsigned*)(pq_ + (ptrdiff_t)(jx - 3) * LDP); \
        const bf16_t* pg_ = P + (size_t)(row0 + (tn) + 32 * tb) * LDP; const int goff_ = 4 * hh * LDP + C_RGG + ch; \
        _Pragma("unroll") for (int i = 0; i < 16; ++i) gtr[i] = (pg_ + (size_t)((i & 3) + 8 * (i >> 2)) * LDP)[goff_]; } while (0)
    RG_LOAD(0);
    for (int ck = -(SEQ / 64) * (PROBE_RG_REP - 1); ck < SEQ / 64; ++ck) {
        if (PROBE_RG_REP > 1 && ck == 0) hcarry = 0.f;
        const int t0 = (ck & (SEQ / 64 - 1)) * 64;
#pragma unroll
        for (int i = 0; i < 8; ++i) { const int t = 8 * w + i;
            const float x0 = cb[0] + cw[0][0] * bflo(ux[i]) + cw[1][0] * bflo(ux[i + 1]) + cw[2][0] * bflo(ux[i + 2]) + cw[3][0] * bflo(ux[i + 3]);
            const float x1 = cb[1] + cw[0][1] * bfhi(ux[i]) + cw[1][1] * bfhi(ux[i + 1]) + cw[2][1] * bfhi(ux[i + 2]) + cw[3][1] * bfhi(ux[i + 3]);
            *(LAS f32x2*)(XCF + t * 128 + 2 * lane) = (f32x2){x0, x1}; *(LAS unsigned*)(L + R_XCB + t * SQ + 4 * lane) = pk2(x0, x1); }
        float gt[16];
#pragma unroll
        for (int i = 0; i < 16; ++i) gt[i] = bf1(gtr[i]);
        lds_barrier();
        if (ck + 1 < SEQ / 64) RG_LOAD(((ck + 1) & (SEQ / 64 - 1)) * 64);
        f32x16 R, I; ZERO16(R); ZERO16(I);
#pragma unroll
        for (int ks = 0; ks < 8; ++ks) { const bf16x8 a = ldfrag(L + R_XCB + (32 * tb + r) * SQ + (16 * ks + 8 * hh) * 2); R = mfma32(a, Br[ks], R); I = mfma32(a, Bi[ks], I); }
        float av[16], uv[16];
#pragma unroll
        for (int i = 0; i < 16; ++i) { const int t = 32 * tb + crow(i, hh); const float xc = XCF[t * 128 + j];
            const float e1 = fexp(fminf(-(R[i] + brv), 40.f)), e2 = fexp(fminf(-(I[i] + biv), 40.f)), p1 = 1.0f + e1, p2 = 1.0f + e2, inv = rcp(p1 * p2);
            const float rr = p2 * inv, ii = p1 * inv;
            const float la = -8.0f * rr * sp, a = fexp(la), x2 = 2.0f * la;
            const float ser = -x2 * (1.0f + 0.5f * x2 * (1.0f + 0.33333334f * x2 * (1.0f + 0.25f * x2 * (1.0f + 0.2f * x2))));
            const float om = fabsf(x2) < 0.25f ? ser : 1.0f - a * a;
            av[i] = a; uv[i] = __builtin_amdgcn_sqrtf(fmaxf(om, 0.f)) * (ii * xc); }
#pragma unroll
        for (int g = 0; g < 4; ++g) { float A = 1.f, U = 0.f;
#pragma unroll
            for (int m = 0; m < 4; ++m) { U = av[4 * g + m] * U + uv[4 * g + m]; A *= av[4 * g + m]; }
            const int gi = 8 * tb + 2 * g + hh; SUMA[gi * 128 + j] = A; SUMU[gi * 128 + j] = U; }
        lds_barrier();
        if (tid < 128) { float hc = hcarry, sa[16], su[16];
#pragma unroll
            for (int gi = 0; gi < 16; ++gi) { sa[gi] = SUMA[gi * 128 + tid]; su[gi] = SUMU[gi * 128 + tid]; }
#pragma unroll
            for (int gi = 0; gi < 16; ++gi) { HIN[gi * 128 + tid] = hc; hc = sa[gi] * hc + su[gi]; }
            hcarry = hc; }
        lds_barrier();
        { bf16_t* pm = c.mix + (size_t)(row0 + t0 + 32 * tb) * D_MIX; const int moff = 4 * hh * D_MIX + 1024 + ch;
#pragma unroll
          for (int g = 0; g < 4; ++g) { float hc = HIN[(8 * tb + 2 * g + hh) * 128 + j];
#pragma unroll
            for (int m = 0; m < 4; ++m) { const int i = 4 * g + m; hc = av[i] * hc + uv[i];
                (pm + (size_t)((i & 3) + 8 * (i >> 2)) * D_MIX)[moff] = (bf16_t)f2bf(hc * gt[i]); } } }
    }
#undef RG_LOAD
    if (tid < 128) c.out[O_RG_P + ((size_t)l * NB + b) * 1024 + n * 128 + tid] = hcarry;
    if (w == 7) {
#pragma unroll
        for (int jx = 0; jx < 3; ++jx) *(f32x2*)(c.out + O_RGC_P + ((size_t)l * NB + b) * 3072 + jx * 1024 + n * 128 + 2 * lane) = (f32x2){bflo(ux[8 + jx]), bfhi(ux[8 + jx])}; }
}

DI void rg_sample_unit(const Ctx& c, int l, int n) {
    LAS unsigned char* L = c.lds;
    const int tid = get_tid(c.wave), lane = tid & 63, w = c.wave, r = lane & 31, hh = lane >> 5;
    const int tb = w >> 2, jb = w & 3;
    const int j = 32 * jb + r, ch = n * 128 + j;
    LAS float* XCF = (LAS float*)(L + R_XCF);
    bf16x8 Br[8], Bi[8];
    rg_load_gates(c, l, n, tid, j, hh, Br, Bi);
    const float sp = softplus(-c.in[I_LAM][l * 1024 + ch]), brv = c.in[I_BR][(l * 8 + n) * 128 + j], biv = c.in[I_BI][(l * 8 + n) * 128 + j];
    float cw[4][2], cb[2];
#pragma unroll
    for (int e = 0; e < 2; ++e) {
#pragma unroll
        for (int m = 0; m < 4; ++m) cw[m][e] = c.in[I_RCW][l * 4 * 1024 + m * 1024 + n * 128 + 2 * lane + e];
        cb[e] = c.in[I_RCB][l * 1024 + n * 128 + 2 * lane + e]; }
    for (int chunk = 0; chunk < 2; ++chunk) {
        __syncthreads();
        f32x2 cb0[8], cb1[8], cb2[8], cxn[8];
#pragma unroll
        for (int i = 0; i < 8; ++i) { const int s = 64 * chunk + 8 * w + i;
            const float* buf = c.in[I_SRGC] + ((size_t)l * DEC + s) * 3 * 1024 + n * 128 + 2 * lane;
            cb0[i] = *(const f32x2*)buf; cb1[i] = *(const f32x2*)(buf + 1024); cb2[i] = *(const f32x2*)(buf + 2048);
            cxn[i] = (f32x2){ps4(c.projs + (size_t)s * LDP + C_RGX + n * 128 + 2 * lane), ps4(c.projs + (size_t)s * LDP + C_RGX + n * 128 + 2 * lane + 1)} * row_rstd(c.rowsq + (size_t)l * M_PAD, TP + s); }
#pragma unroll
        for (int i = 0; i < 8; ++i) { const int t = 8 * w + i, s = 64 * chunk + t;
            const f32x2 b0 = cb0[i], b1 = cb1[i], b2 = cb2[i], xn = cxn[i];
            const float x0 = cb[0] + cw[0][0] * b0.x + cw[1][0] * b1.x + cw[2][0] * b2.x + cw[3][0] * xn.x;
            const float x1 = cb[1] + cw[0][1] * b0.y + cw[1][1] * b1.y + cw[2][1] * b2.y + cw[3][1] * xn.y;
            *(LAS f32x2*)(XCF + t * 128 + 2 * lane) = (f32x2){x0, x1}; *(LAS unsigned*)(L + R_XCB + t * SQ + 4 * lane) = pk2(x0, x1);
            float* nb = c.out + O_RGC_S + ((size_t)l * DEC + s) * 3072 + n * 128 + 2 * lane;
            *(f32x2*)nb = b1; *(f32x2*)(nb + 1024) = b2; *(f32x2*)(nb + 2048) = xn; }
        __syncthreads();
        f32x16 R, I; ZERO16(R); ZERO16(I);
#pragma unroll
        for (int ks = 0; ks < 8; ++ks) { const bf16x8 a = ldfrag(L + R_XCB + (32 * tb + r) * SQ + (16 * ks + 8 * hh) * 2); R = mfma32(a, Br[ks], R); I = mfma32(a, Bi[ks], I); }
#pragma unroll
        for (int i = 0; i < 16; ++i) { const int t = 32 * tb + crow(i, hh), s = 64 * chunk + t;
            const float rr = sigm(R[i] + brv), ii = sigm(I[i] + biv), xc = XCF[t * 128 + j];
            const float la = -8.0f * rr * sp, a = fexp(la);
            const float hn = a * c.in[I_SRG][((size_t)l * DEC + s) * 1024 + ch] + sqrtf(fmaxf(neg_expm1(2.0f * la), 0.f)) * (ii * xc);
            c.mix[(size_t)(TP + s) * D_MIX + 1024 + ch] = (bf16_t)f2bf(hn * silu(ps4(c.projs + (size_t)s * LDP + C_RGG + ch) * row_rstd(c.rowsq + (size_t)l * M_PAD, TP + s)));
            c.out[O_RG_S + ((size_t)l * DEC + s) * 1024 + ch] = hn; }
    }
}

#ifndef PROBE_REP_LONG
#define PROBE_REP_LONG 1
#endif
#ifndef PROBE_G1_REP
#define PROBE_G1_REP 1
#endif
#ifndef PROBE_REP_SHORT
#define PROBE_REP_SHORT 1
#endif
DI void xbc_prepass_item(const Ctx& c, int l, int it) {
    const int tid = get_tid(c.wave);
    const float* scw = c.in[I_SCW] + (size_t)l * 4 * 1536; const float* scb = c.in[I_SCB] + (size_t)l * 1536;
    const int r0 = ((it & 7) >> 1) * SEQ + (it >> 3) * 64 + (it & 1) * 32;
    const bool head = (r0 & (SEQ - 1)) == 0;
    for (int p = tid; p < 768; p += 512) {
        float cw[4][2], cb[2];
#pragma unroll
        for (int e = 0; e < 2; ++e) { cb[e] = scb[2 * p + e];
#pragma unroll
            for (int m = 0; m < 4; ++m) cw[m][e] = scw[m * 1536 + 2 * p + e]; }
        const bf16_t* src = c.proj + (size_t)r0 * LDP + C_XBC + 2 * p; bf16_t* dst = c.xbcs + (size_t)r0 * 1536 + 2 * p;
        unsigned u[35];
#pragma unroll
        for (int i = 0; i < 35; ++i) u[i] = (head && i < 3) ? 0u : *(const unsigned*)(src + (ptrdiff_t)(i - 3) * LDP);
#pragma unroll
        for (int i = 0; i < 32; ++i) {
            const float a = silu(cb[0] + cw[0][0] * bflo(u[i]) + cw[1][0] * bflo(u[i + 1]) + cw[2][0] * bflo(u[i + 2]) + cw[3][0] * bflo(u[i + 3]));
            const float b = silu(cb[1] + cw[0][1] * bfhi(u[i]) + cw[1][1] * bfhi(u[i + 1]) + cw[2][1] * bfhi(u[i + 2]) + cw[3][1] * bfhi(u[i + 3]));
            __hip_atomic_store((unsigned*)(dst + (size_t)i * 1536), pk2(a, b), __ATOMIC_RELAXED, __HIP_MEMORY_SCOPE_AGENT); }
        if (((r0 + 32) & (SEQ - 1)) == 0) {
#pragma unroll
            for (int jx = 0; jx < 3; ++jx) *(f32x2*)(c.out + O_SSDC_P + ((size_t)l * NB + r0 / SEQ) * 4608 + jx * 1536 + 2 * p) = (f32x2){bflo(u[32 + jx]), bfhi(u[32 + jx])}; }
    }
}
DI void phase_mixer(int l, int wv) {
    const Ctx c = make_ctx(wv);
    constexpr int PER_B = 8 + 8 + 8 + 8;
    constexpr int N_LONG = NB * PER_B, N_SHORT = 8 + DEC * 3;
    constexpr int NREP = 1;
    volatile LAS int* slot = (volatile LAS int*)(c.lds + MISC_OFF + 64);
    unsigned* xpre = c.ctl + CW_XPRE + 128 * l;
    if (c.wg >= N_LONG || c.G <= N_LONG) {
        const int nfree = c.G > N_LONG ? c.G - N_LONG : c.G, first = c.G > N_LONG ? c.wg - N_LONG : c.wg;
        for (int it = first; it < TP / 32; it += nfree) {
            xbc_prepass_item(c, l, it);
            asm volatile("s_waitcnt vmcnt(0)" ::: "memory"); __syncthreads();
            if (c.tid == 0) __hip_atomic_fetch_add(xpre + (it < 128 ? 0 : 64), 1u, __ATOMIC_RELAXED, __HIP_MEMORY_SCOPE_AGENT);
        }
    }
    for (int rep = 0; rep < NREP; ++rep) {
    unsigned* ctr = c.ctl + CW_QCTR + 64 * (l * 4 + rep);
    int cur = c.wg; bool dyn = false;
    for (;;) {
        int item;
        if (!dyn) { if (cur < N_LONG) { item = cur; cur += c.G; } else { dyn = true; continue; } }
        else {
            __syncthreads();
            if (c.tid == 0) *slot = (int)atomicAdd(ctr, 1u);
            __syncthreads();
            item = N_LONG + *slot;
            if (item >= N_LONG + N_SHORT) break;
        }
        if (item < N_LONG) {
            const int b = item & 3, u = item >> 2;
            if (u < 8) la_head_unit<1>(c, l, b, u); else if (u < 16) la_head_unit<0>(c, l, b, u - 8); else if (u < 24) {
                if (c.tid == 0) { unsigned sp = 0; while (__hip_atomic_load(xpre, __ATOMIC_RELAXED, __HIP_MEMORY_SCOPE_AGENT) < 128u) { __builtin_amdgcn_s_sleep(8); if (++sp > (1u << 22)) break; }
                    __builtin_amdgcn_fence(__ATOMIC_ACQUIRE, "agent"); asm volatile("s_waitcnt vmcnt(0)" ::: "memory"); }
                __syncthreads();
                la_head_unit<2>(c, l, b, u - 16); } else rg_chunk_unit(c, l, b, u - 24);
            __syncthreads();
        } else { const int it = item - N_LONG;
            for (int rp = 0; rp < PROBE_REP_SHORT; ++rp) { if (it < 8) rg_sample_unit(c, l, it); else sample_item(c, l, (it - 8) / 3, (it - 8) % 3); } }
    }
    __syncthreads();
    }
}

DI void phase_dt(const Ctx& c, int l) {
    LAS float* PT = (LAS float*)c.lds;
    const int tid = get_tid(c.wave), lane = tid & 63, w = c.wave, r = lane & 31, hh = lane >> 5;
    for (int rt = c.wg; rt < TP / 32; rt += c.G) {
        const bf16_t* pa = c.xb + (size_t)(rt * 32 + r) * D_MODEL + w * 256 + 8 * hh;
        const bf16_t* pb = c.win + ((size_t)l * LDP + C_DT + r) * D_MODEL + w * 256 + 8 * hh;
        f32x16 acc; ZERO16(acc);
#pragma unroll
        for (int k4 = 0; k4 < 16; k4 += 8) { bf16x8 fa[8], fb[8];
#pragma unroll
            for (int u = 0; u < 8; ++u) { fa[u] = *(const bf16x8*)(pa + 16 * (k4 + u)); fb[u] = *(const bf16x8*)(pb + 16 * (k4 + u)); }
#pragma unroll
            for (int u = 0; u < 8; ++u) acc = mfma32(fa[u], fb[u], acc); }
        __syncthreads();
#pragma unroll
        for (int i = 0; i < 16; ++i) PT[w * 1024 + crow(i, hh) * 32 + r] = acc[i];
        __syncthreads();
        { const int row = tid >> 4, col = tid & 15; float s = 0.f;
#pragma unroll
          for (int q = 0; q < 8; ++q) s += PT[q * 1024 + row * 32 + col];
          c.dtb[(size_t)(rt * 32 + row) * 16 + col] = softplus(s * row_rstd(c.rowsq + (size_t)l * M_PAD, rt * 32 + row) + c.in[I_DTB][l * 16 + col]); }
    }
}

DI void g2_sample(const Ctx& c, int l) {
    LAS float* PT = (LAS float*)c.lds;
    const int tid = get_tid(c.wave), lane = tid & 63, w = c.wave, rr = lane & 15, quad = lane >> 4;
    float* rsq_next = c.rowsq + (size_t)(l + 1) * M_PAD;
    for (int it = c.wg; it < 4 * (D_MODEL / 32); it += c.G) {
        const int rb = it & 3, ct = it >> 2;
        const bf16_t* pa = c.mix + (size_t)(TP + 32 * rb + rr) * D_MIX + 512 * w + 8 * quad;
        const bf16_t* pb = c.wout + (size_t)l * D_MODEL * D_MIX + (size_t)(32 * ct + rr) * D_MIX + 512 * w + 8 * quad;
        f32x4 acc[2][2];
#pragma unroll
        for (int rt = 0; rt < 2; ++rt) { acc[rt][0] = (f32x4){0.f, 0.f, 0.f, 0.f}; acc[rt][1] = acc[rt][0]; }
        bf16x8 fa0[4][2], fb0[4][2], fa1[4][2], fb1[4][2];
#define G2S_LOAD(FA, FB, k4) do { _Pragma("unroll") for (int u = 0; u < 4; ++u) _Pragma("unroll") for (int t = 0; t < 2; ++t) { \
            FA[u][t] = *(const bf16x8*)(pa + (size_t)16 * t * D_MIX + 32 * ((k4) + u)); FB[u][t] = *(const bf16x8*)(pb + (size_t)16 * t * D_MIX + 32 * ((k4) + u)); } } while (0)
#define G2S_MMA(FA, FB) do { _Pragma("unroll") for (int u = 0; u < 4; ++u) _Pragma("unroll") for (int rt = 0; rt < 2; ++rt) _Pragma("unroll") for (int nt = 0; nt < 2; ++nt) \
            acc[rt][nt] = __builtin_amdgcn_mfma_f32_16x16x32_bf16(FA[u][rt], FB[u][nt], acc[rt][nt], 0, 0, 0); } while (0)
        G2S_LOAD(fa0, fb0, 0);
        G2S_LOAD(fa1, fb1, 4);
        G2S_MMA(fa0, fb0);
        G2S_LOAD(fa0, fb0, 8);
        G2S_MMA(fa1, fb1);
        G2S_LOAD(fa1, fb1, 12);
        G2S_MMA(fa0, fb0);
        G2S_MMA(fa1, fb1);
#undef G2S_LOAD
#undef G2S_MMA
        __syncthreads();
#pragma unroll
        for (int rt = 0; rt < 2; ++rt)
#pragma unroll
            for (int nt = 0; nt < 2; ++nt)
#pragma unroll
                for (int j = 0; j < 4; ++j) PT[(w * 32 + 16 * rt + 4 * quad + j) * 32 + 16 * nt + rr] = acc[rt][nt][j];
        __syncthreads();
        { const int row = tid >> 4, c2 = 2 * (tid & 15); float x0 = 0.f, x1 = 0.f;
#pragma unroll
          for (int q = 0; q < 8; ++q) { const f32x2 t = *(const LAS f32x2*)(PT + (q * 32 + row) * 32 + c2); x0 += t.x; x1 += t.y; }
          unsigned* xp = (unsigned*)(c.xb + (size_t)(TP + 32 * rb + row) * D_MODEL + 32 * ct + c2); const unsigned o = *xp;
          x0 += bflo(o); x1 += bfhi(o); *xp = pk2(x0, x1);
          float ss = x0 * x0 + x1 * x1; ss += shx(ss, 1, lane); ss += shx(ss, 2, lane); ss += shx(ss, 4, lane); ss += shx(ss, 8, lane);
          if ((tid & 15) == 0) atomicAdd(rsq_next + TP + 32 * rb + row, ss); }
    }
}

__global__ void __launch_bounds__(512, 2) mk_fwd(Params p) {
    extern __shared__ __attribute__((aligned(16))) unsigned char lds_raw[];
    LAS unsigned char* lds = (LAS unsigned char*)lds_raw;
    volatile LAS unsigned* misc = (volatile LAS unsigned*)(lds + MISC_OFF);
    const int wv = __builtin_amdgcn_readfirstlane(threadIdx.x >> 6);
    if (threadIdx.x < 32) misc[threadIdx.x] = 0u;
    __syncthreads();
    const int lo = p.ph_lo, hi = p.ph_hi;
    unsigned* barw = (unsigned*)(p.ws + WS_CTL) + CW_BAR;
    XcdBarrier bar; bar.bar = barw; bar.x = 0; bar.st = misc;
    if (hi - lo > 1) bar = xcd_barrier_post(barw, misc, get_tid(wv));
#define PH_IN(k) (lo <= (k) && (k) < hi)
#define SEAM(k) do { if (PH_IN(k) && PH_IN((k) + 1)) xcd_barrier(bar, wv); } while (0)
    if (PH_IN(0)) { phase_prologue(wv); }
    SEAM(0);
    for (int l = 0; l < DEPTH; ++l) {
        const int pb = 1 + 3 * l;
        if (PH_IN(pb)) {
            __syncthreads();
            const Ctx c = make_ctx(wv);
            {
                pg8::Gemm g{c.xb, c.win + (size_t)l * LDP * D_MODEL, TP, N_MAIN, D_MODEL, D_MODEL, D_MODEL}; pg8::StaticOrder S; S.init(TP, N_MAIN, c.G, c.wg); S.rep = PROBE_G1; S.balance = 1;
                pg8::EpiProj E{c.proj, c.lb + (size_t)l * 1024, c.in[I_HGN] + (size_t)l * 1024, c.in[I_GLN] + (size_t)l * 1024, c.in[I_GBU] + (size_t)l * 512, c.rowsq + (size_t)l * M_PAD};
                pg8::gemm_phase<pg8::EpiProj, pg8::StaticOrder>(c.lds, g, S, E, wv); }
            __syncthreads();
            {
                const int pn = c.wg % 49, ks = c.wg / 49;
                pg8::Gemm g{c.xb + (size_t)TP * D_MODEL + ks * 512, c.win + (size_t)l * LDP * D_MODEL + ks * 512, 256, LDP, 512, D_MODEL, D_MODEL};
                pg8::OneUnit S{0, pn, c.wg < 196 ? 1 : 0};
                pg8::EpiSample E{c.projs + (size_t)ks * PST};
                pg8::gemm_phase<pg8::EpiSample, pg8::OneUnit>(c.lds, g, S, E, wv); }
            __syncthreads();
            phase_dt(c, l);
            __syncthreads();
        }
        SEAM(pb);
        if (PH_IN(pb + 1)) phase_mixer(l, wv);
        SEAM(pb + 1);
        if (PH_IN(pb + 2)) {
            __syncthreads();
            const Ctx c = make_ctx(wv);
            {
                pg8::Gemm g{c.mix, c.wout + (size_t)l * D_MODEL * D_MIX, TP, D_MODEL, D_MIX, D_MIX, D_MIX}; pg8::StaticOrder S; S.init(TP, D_MODEL, c.G, c.wg);
                LAS float* tab = (LAS float*)(c.lds + pg8::STAGE_BYTES);
                pg8::EpiResid E{c.xb, c.rowsq + (size_t)(l + 1) * M_PAD, tab};
                const float* stats = (const float*)(c.ctl + CW_STATS) + (size_t)l * TP * 6;
                for (int i = 0; ; ++i) { pg8::Unit u; if (!S.next(i, u)) break;
                    __syncthreads();
                    { const int tid = get_tid(wv);
                      if (tid < 256) { const float* st = stats + (size_t)(u.pm * 256 + tid) * 6;
                        const f32x2 sa = *(const f32x2*)st, sb = *(const f32x2*)(st + 2), sc = *(const f32x2*)(st + 4);
                        const float d0 = __builtin_amdgcn_rsqf(sa.x * (1.0f / 512.0f) + EPS), d1 = __builtin_amdgcn_rsqf(sa.y * (1.0f / 512.0f) + EPS);
                        const float g0 = __builtin_amdgcn_rsqf(sb.x * (1.0f / 256.0f) + EPS), g1 = __builtin_amdgcn_rsqf(sb.y * (1.0f / 256.0f) + EPS), g2 = __builtin_amdgcn_rsqf(sc.x * (1.0f / 256.0f) + EPS), g3 = __builtin_amdgcn_rsqf(sc.y * (1.0f / 256.0f) + EPS);
                        tab[tid] = rcp(g0); tab[256 + tid] = g0 * rcp(g1); tab[512 + tid] = g1 * rcp(g2); tab[768 + tid] = g2 * rcp(g3); tab[1024 + tid] = g3 * rcp(d0); tab[1280 + tid] = d0 * rcp(d1); tab[1536 + tid] = d1; } }
                    __syncthreads();
                    pg8::OneUnit O{u.pm, u.pn, 1};
                    pg8::gemm_phase<pg8::EpiResid, pg8::OneUnit>(c.lds, g, O, E, wv); }
            }
            __syncthreads();
            g2_sample(c, l);
        }
        SEAM(pb + 2);
    }
    if (PH_IN(NPHASE - 1)) phase_final_norm(wv);
#undef PH_IN
#undef SEAM
}

extern "C" void kernel_launch(void* const* d_in, const int* in_sizes, int n_in, void* d_out, int out_size, void* d_ws, size_t ws_size, hipStream_t stream) {
    static int grid = 0;
    if (grid == 0) {
        if (n_in != N_INPUTS || (size_t)out_size != O_END || ws_size < WS_END) { fprintf(stderr, "kernel_launch: unexpected shapes (n_in %d out %d ws %zu)\n", n_in, out_size, ws_size); grid = -1; return; }
        int dev = 0, cus = 0;
        if (hipGetDevice(&dev) != hipSuccess || hipDeviceGetAttribute(&cus, hipDeviceAttributeMultiprocessorCount, dev) != hipSuccess) { grid = -1; return; }
        if (hipFuncSetAttribute((const void*)mk_fwd, hipFuncAttributeMaxDynamicSharedMemorySize, LDS_BYTES) != hipSuccess) { fprintf(stderr, "kernel_launch: hipFuncSetAttribute failed\n"); grid = -1; return; }
        int per_cu = 0;
        if (hipOccupancyMaxActiveBlocksPerMultiprocessor(&per_cu, (const void*)mk_fwd, 512, LDS_BYTES) != hipSuccess || per_cu < 1) fprintf(stderr, "kernel_launch: occupancy query says %d\n", per_cu);
        (void)hipGetLastError();
        grid = cus;
    }
    if (grid < 0) return;
    (void)hipMemsetAsync((char*)d_ws + WS_CTL, 0, CTL_ZERO_BYTES, stream);
    Params p{};
    for (int i = 0; i < N_INPUTS; ++i) p.in[i] = (const float*)d_in[i];
    p.out = (float*)d_out; p.ws = (unsigned char*)d_ws;
#if MK_ONE_LAUNCH
    p.ph_lo = 0; p.ph_hi = NPHASE;
    hipLaunchKernelGGL(mk_fwd, dim3(grid), dim3(512), LDS_BYTES, stream, p);
#else
    for (int ph = 0; ph < NPHASE; ++ph) { p.ph_lo = ph; p.ph_hi = ph + 1; hipLaunchKernelGGL(mk_fwd, dim3(grid), dim3(512), LDS_BYTES, stream, p); }
#endif
}
```
